# Optimizing an MI355X kernel written in HIP

```python
import math
import jax
import jax.numpy as jnp
from jax import lax
import numpy as np

D_MODEL = 1024
BATCH = 4
SEQ = 8192
DEPTH = 4
DEC_BATCH = 16
DEC_SEQ = 32
PAST_LEN = 2048

CHUNK = 64
Q_BLOCK = 128
EPS = 1e-6
A_HEADS = 4
A_HEAD_DIM = 64
A_VDIM = 2 * A_HEAD_DIM
A_WIDTH = A_HEADS * A_VDIM
ROPE_DIM = A_HEAD_DIM // 4
ROPE_THETA = 500000.0
G_HEADS = 4
G_DK = 64
G_DV = 128
G_WIDTH = G_HEADS * G_DV
G_GATE_RANK = 16
G_GATE_TAU = 16.0
LRU_WIDTH = 512
LRU_BLOCKS = 8
LRU_BLOCK = LRU_WIDTH // LRU_BLOCKS
LRU_CONV = 4
LRU_C = 8.0
D_FF = 2816
FFN_CONV = 3
N_BRANCH = 3
PROJ_SPLITS = (2 * A_HEADS * A_HEAD_DIM, 2 * A_HEADS * A_HEAD_DIM, A_WIDTH, G_HEADS * G_DK, G_HEADS * G_DK, G_WIDTH, G_WIDTH, G_GATE_RANK, LRU_WIDTH, LRU_WIDTH)
PROJ_WIDTH = sum(PROJ_SPLITS)

kernel_name = 'hybrid_stream_encoder_step'


def rmsnorm(x, g):
    xf = x.astype(jnp.float32)
    y = xf * lax.rsqrt(jnp.mean(xf * xf, axis=-1, keepdims=True) + EPS) * g.astype(jnp.float32)
    return y.astype(x.dtype)


def head_rmsnorm(o, g):
    return o * lax.rsqrt(jnp.mean(o * o, axis=-1, keepdims=True) + EPS) * g.astype(jnp.float32)


def split_cols(z, widths):
    outs = []
    start = 0
    for w in widths:
        outs.append(z[..., start:start + w])
        start += w
    return outs


def causal_dwconv(x, buf, w, b):
    width = w.shape[0]
    t = x.shape[1]
    xp = jnp.concatenate([buf.astype(x.dtype), x], axis=1)
    y = b
    for j in range(width):
        y = y + xp[:, j:j + t] * w[j]
    return y, xp[:, t:]


def rope(x, pos):
    half = ROPE_DIM // 2
    inv = ROPE_THETA ** (-jnp.arange(half, dtype=jnp.float32) / half)
    ang = pos[:, None] * inv[None, :]
    cos = jnp.cos(ang)[:, None, None, :]
    sin = jnp.sin(ang)[:, None, None, :]
    x1 = x[..., :half]
    x2 = x[..., half:ROPE_DIM]
    return jnp.concatenate([x1 * cos - x2 * sin, x2 * cos + x1 * sin, x[..., ROPE_DIM:]], axis=-1)


def diff_scores(q, k, v, mask, lam):
    s = jnp.einsum('bqhcd,bkhcd->bhcqk', q, k) * (A_HEAD_DIM ** -0.5)
    s = jnp.where(mask, s, -jnp.inf)
    p = jax.nn.softmax(s, axis=-1)
    p = p[:, :, 0] - lam * p[:, :, 1]
    return jnp.einsum('bhqk,bkhe->bqhe', p, v)


def diff_attention(q, k, v, q_pos, k_pos, lam):
    b, t, h, _, d = q.shape
    qc = q_pos // CHUNK
    kc = k_pos // CHUNK
    if t > Q_BLOCK and t % Q_BLOCK == 0:
        nb = t // Q_BLOCK
        qb = q.reshape(b, nb, Q_BLOCK, h, 2, d).swapaxes(0, 1)
        qcb = qc.reshape(nb, Q_BLOCK)

        def block(args):
            qi, qci = args
            return diff_scores(qi, k, v, kc[None, :] <= qci[:, None], lam)

        o = lax.map(block, (qb, qcb))
        return o.swapaxes(0, 1).reshape(b, t, h, v.shape[-1])
    return diff_scores(q, k, v, kc[None, :] <= qc[:, None], lam)


def gla_chunk(s0, q, k, v, la):
    L = q.shape[1]
    b_cum = jnp.cumsum(la, axis=1)
    inter = jnp.einsum('bthk,bhkv->bthv', q * jnp.exp(b_cum), s0)
    tri = jnp.tril(jnp.ones((L, L), dtype=bool))
    dif = b_cum[:, :, None] - b_cum[:, None, :]
    decay = jnp.exp(jnp.where(tri[None, :, :, None, None], dif, -jnp.inf))
    att = jnp.einsum('bthk,btshk,bshk->bhts', q, decay, k)
    intra = jnp.einsum('bhts,bshv->bthv', att, v)
    b_last = b_cum[:, -1]
    s_new = jnp.exp(b_last)[..., None] * s0 + jnp.einsum('bshk,bshv->bhkv', k * jnp.exp(b_last[:, None] - b_cum), v)
    return s_new, inter + intra


def gla(q, k, v, la, s0):
    b, t, h, _ = q.shape
    L = min(CHUNK, t)
    nc = t // L

    def to_blocks(a):
        return a.reshape(b, nc, L, h, a.shape[-1]).swapaxes(0, 1)

    def step(s, inp):
        qc, kc, vc, lc = inp
        return gla_chunk(s, qc, kc, vc, lc)

    s_fin, o = lax.scan(step, s0, (to_blocks(q), to_blocks(k), to_blocks(v), to_blocks(la)))
    return s_fin, o.swapaxes(0, 1).reshape(b, t, h, v.shape[-1])


def _lin_combine(e1, e2):
    a1, b1 = e1
    a2, b2 = e2
    return a1 * a2, a2 * b1 + b2


def rg_lru(xc, h0, wa, ba, wx, bx, lam):
    b, t, w = xc.shape
    xf = xc.astype(jnp.float32)
    xb = xf.reshape(b, t, LRU_BLOCKS, LRU_BLOCK)
    r = jax.nn.sigmoid(jnp.einsum('btni,nij->btnj', xb, wa.astype(jnp.float32)).reshape(b, t, w) + ba.astype(jnp.float32))
    i = jax.nn.sigmoid(jnp.einsum('btni,nij->btnj', xb, wx.astype(jnp.float32)).reshape(b, t, w) + bx.astype(jnp.float32))
    log_a = -LRU_C * r * jax.nn.softplus(-lam.astype(jnp.float32))
    a = jnp.exp(log_a)
    u = jnp.sqrt(-jnp.expm1(2.0 * log_a)) * (i * xf)
    a_cum, h_zero = lax.associative_scan(_lin_combine, (a, u), axis=1)
    h = a_cum * h0[:, None, :] + h_zero
    return h, h[:, -1]


def layer(x, l, k_past, v_past, s_gla, lru_buf, h_lru, ffn_buf, params):
    (norm_mix, w_in, lambda_qk, attn_subln, w_gla_gate2, b_gla_gate, gla_norm, lru_conv_w, lru_conv_b,
     lru_wa, lru_ba, lru_wx, lru_bx, lru_lambda, w_branch_attn, w_branch_gla, w_branch_lru, w_merge, b_merge,
     w_out, norm_ffn, w_ffn_gate, ffn_conv_w, ffn_conv_b, w_ffn_up, w_ffn_down) = params
    f32 = jnp.float32
    dt = x.dtype
    b, t, _ = x.shape
    p_len = k_past.shape[1]
    xn = rmsnorm(x, norm_mix)
    z = xn @ w_in
    aq, ak, av, gq, gk, gv, gr, ga, lx, lg = split_cols(z, PROJ_SPLITS)

    q_pos = p_len + jnp.arange(t, dtype=jnp.int32)
    k_pos = jnp.arange(p_len + t, dtype=jnp.int32)
    rp = q_pos.astype(f32)
    q = rope(aq.astype(f32).reshape(b, t, A_HEADS, 2, A_HEAD_DIM), rp)
    k = rope(ak.astype(f32).reshape(b, t, A_HEADS, 2, A_HEAD_DIM), rp)
    v = av.astype(f32).reshape(b, t, A_HEADS, A_VDIM)
    k_all = jnp.concatenate([k_past.astype(f32), k], axis=1)
    v_all = jnp.concatenate([v_past.astype(f32), v], axis=1)
    lam_init = 0.8 - 0.6 * math.exp(-0.3 * l)
    lq = lambda_qk.astype(f32)
    lam = jnp.exp(jnp.sum(lq[0] * lq[1])) - jnp.exp(jnp.sum(lq[2] * lq[3])) + lam_init
    o = diff_attention(q, k_all, v_all, q_pos, k_pos, lam)
    o = head_rmsnorm(o, attn_subln) * (1.0 - lam_init)
    y_attn = o.reshape(b, t, A_WIDTH).astype(dt) @ w_branch_attn

    gq_ = gq.astype(f32).reshape(b, t, G_HEADS, G_DK) * (G_DK ** -0.5)
    gk_ = gk.astype(f32).reshape(b, t, G_HEADS, G_DK)
    gv_ = gv.astype(f32).reshape(b, t, G_HEADS, G_DV)
    la = jax.nn.log_sigmoid((ga @ w_gla_gate2 + b_gla_gate).astype(f32)).reshape(b, t, G_HEADS, G_DK) / G_GATE_TAU
    s_new, go = gla(gq_, gk_, gv_, la, s_gla.astype(f32))
    go = head_rmsnorm(go, gla_norm) * jax.nn.silu(gr.astype(f32).reshape(b, t, G_HEADS, G_DV))
    y_gla = go.reshape(b, t, G_WIDTH).astype(dt) @ w_branch_gla

    xc, lru_buf_new = causal_dwconv(lx, lru_buf, lru_conv_w, lru_conv_b)
    h, h_last = rg_lru(xc, h_lru.astype(f32), lru_wa, lru_ba, lru_wx, lru_bx, lru_lambda)
    y_lru = (h * jax.nn.gelu(lg.astype(f32))).astype(dt) @ w_branch_lru

    g = jax.nn.sigmoid((xn @ w_merge + b_merge).astype(f32)).reshape(b, t, N_BRANCH, D_MODEL)
    merged = g[:, :, 0] * y_attn.astype(f32) + g[:, :, 1] * y_gla.astype(f32) + g[:, :, 2] * y_lru.astype(f32)
    x = x + merged.astype(dt) @ w_out

    hn = rmsnorm(x, norm_ffn)
    gu = hn @ w_ffn_gate
    gc, ffn_buf_new = causal_dwconv(gu, ffn_buf, ffn_conv_w, ffn_conv_b)
    f = jax.nn.gelu(gc.astype(f32)) * (hn @ w_ffn_up).astype(f32)
    x = x + f.astype(dt) @ w_ffn_down
    return x, (k.astype(dt), v.astype(dt), s_new.astype(dt), lru_buf_new, h_last.astype(dt), ffn_buf_new)


def trunk(x, cache_k, cache_v, st_gla, st_lru_conv, st_lru_h, st_ffn_conv, layer_params, norm_final):
    outs = [[], [], [], [], [], []]
    for l in range(DEPTH):
        p = tuple(w[l] for w in layer_params)
        x, new = layer(x, l, cache_k[l], cache_v[l], st_gla[l], st_lru_conv[l], st_lru_h[l], st_ffn_conv[l], p)
        for lst, a in zip(outs, new):
            lst.append(a)
    y = rmsnorm(x, norm_final)
    return y, [jnp.stack(lst) for lst in outs]


def setup_inputs(seed: int = 0) -> dict:
    key = jax.random.key(seed)
    ks = iter(list(jax.random.split(key, 64)))
    f32 = jnp.float32

    def nrm(shape, scale):
        return jax.random.normal(next(ks), shape, f32) * scale

    def gain(shape):
        return 1.0 + nrm(shape, 0.02)

    u = jax.random.uniform(next(ks), (DEPTH, LRU_WIDTH), f32, 0.9, 0.999)
    base = u ** (1.0 / LRU_C)
    lru_lambda = jnp.log(base) - jnp.log1p(-base)
    return {
        'x_prompt': nrm((BATCH, SEQ, D_MODEL), 1.0),
        'x_sample': nrm((DEC_BATCH, DEC_SEQ, D_MODEL), 1.0),
        'cache_attn_k': nrm((DEPTH, DEC_BATCH, PAST_LEN, A_HEADS, 2, A_HEAD_DIM), 1.0),
        'cache_attn_v': nrm((DEPTH, DEC_BATCH, PAST_LEN, A_HEADS, A_VDIM), 1.0),
        'state_gla': nrm((DEPTH, DEC_BATCH, G_HEADS, G_DK, G_DV), 1.0),
        'state_lru_conv': nrm((DEPTH, DEC_BATCH, LRU_CONV - 1, LRU_WIDTH), 1.0),
        'state_lru_h': nrm((DEPTH, DEC_BATCH, LRU_WIDTH), 0.5),
        'state_ffn_conv': nrm((DEPTH, DEC_BATCH, FFN_CONV - 1, D_FF), 1.0),
        'norm_mix': gain((DEPTH, D_MODEL)),
        'w_in': nrm((DEPTH, D_MODEL, PROJ_WIDTH), D_MODEL ** -0.5),
        'lambda_qk': nrm((DEPTH, 4, A_HEAD_DIM), 0.1),
        'attn_subln': gain((DEPTH, A_VDIM)),
        'w_gla_gate2': nrm((DEPTH, G_GATE_RANK, G_HEADS * G_DK), G_GATE_RANK ** -0.5),
        'b_gla_gate': nrm((DEPTH, G_HEADS * G_DK), 0.01),
        'gla_norm': gain((DEPTH, G_DV)),
        'lru_conv_w': nrm((DEPTH, LRU_CONV, LRU_WIDTH), 0.5),
        'lru_conv_b': nrm((DEPTH, LRU_WIDTH), 0.01),
        'lru_wa': nrm((DEPTH, LRU_BLOCKS, LRU_BLOCK, LRU_BLOCK), LRU_BLOCK ** -0.5),
        'lru_ba': nrm((DEPTH, LRU_WIDTH), 0.01),
        'lru_wx': nrm((DEPTH, LRU_BLOCKS, LRU_BLOCK, LRU_BLOCK), LRU_BLOCK ** -0.5),
        'lru_bx': nrm((DEPTH, LRU_WIDTH), 0.01),
        'lru_lambda': lru_lambda,
        'w_branch_attn': nrm((DEPTH, A_WIDTH, D_MODEL), A_WIDTH ** -0.5),
        'w_branch_gla': nrm((DEPTH, G_WIDTH, D_MODEL), G_WIDTH ** -0.5),
        'w_branch_lru': nrm((DEPTH, LRU_WIDTH, D_MODEL), LRU_WIDTH ** -0.5),
        'w_merge': nrm((DEPTH, D_MODEL, N_BRANCH * D_MODEL), D_MODEL ** -0.5),
        'b_merge': nrm((DEPTH, N_BRANCH * D_MODEL), 0.01),
        'w_out': nrm((DEPTH, D_MODEL, D_MODEL), D_MODEL ** -0.5),
        'norm_ffn': gain((DEPTH, D_MODEL)),
        'w_ffn_gate': nrm((DEPTH, D_MODEL, D_FF), D_MODEL ** -0.5),
        'ffn_conv_w': nrm((DEPTH, FFN_CONV, D_FF), FFN_CONV ** -0.5),
        'ffn_conv_b': nrm((DEPTH, D_FF), 0.01),
        'w_ffn_up': nrm((DEPTH, D_MODEL, D_FF), D_MODEL ** -0.5),
        'w_ffn_down': nrm((DEPTH, D_FF, D_MODEL), D_FF ** -0.5),
        'norm_final': gain((D_MODEL,)),
    }


def reference(x_prompt, x_sample, cache_attn_k, cache_attn_v, state_gla, state_lru_conv, state_lru_h, state_ffn_conv,
              norm_mix, w_in, lambda_qk, attn_subln, w_gla_gate2, b_gla_gate, gla_norm, lru_conv_w, lru_conv_b,
              lru_wa, lru_ba, lru_wx, lru_bx, lru_lambda, w_branch_attn, w_branch_gla, w_branch_lru, w_merge, b_merge,
              w_out, norm_ffn, w_ffn_gate, ffn_conv_w, ffn_conv_b, w_ffn_up, w_ffn_down, norm_final):
    layer_params = (norm_mix, w_in, lambda_qk, attn_subln, w_gla_gate2, b_gla_gate, gla_norm, lru_conv_w, lru_conv_b,
                    lru_wa, lru_ba, lru_wx, lru_bx, lru_lambda, w_branch_attn, w_branch_gla, w_branch_lru, w_merge,
                    b_merge, w_out, norm_ffn, w_ffn_gate, ffn_conv_w, ffn_conv_b, w_ffn_up, w_ffn_down)
    bp = x_prompt.shape[0]
    dt = x_prompt.dtype
    zero_k = jnp.zeros((DEPTH, bp, 0, A_HEADS, 2, A_HEAD_DIM), dt)
    zero_v = jnp.zeros((DEPTH, bp, 0, A_HEADS, A_VDIM), dt)
    zero_gla = jnp.zeros((DEPTH, bp, G_HEADS, G_DK, G_DV), jnp.float32)
    zero_lru_conv = jnp.zeros((DEPTH, bp, LRU_CONV - 1, LRU_WIDTH), dt)
    zero_lru_h = jnp.zeros((DEPTH, bp, LRU_WIDTH), jnp.float32)
    zero_ffn_conv = jnp.zeros((DEPTH, bp, FFN_CONV - 1, D_FF), dt)
    y_prompt, (k_p, v_p, gla_p, lconv_p, lh_p, fconv_p) = trunk(
        x_prompt, zero_k, zero_v, zero_gla, zero_lru_conv, zero_lru_h, zero_ffn_conv, layer_params, norm_final)
    y_sample, (k_s, v_s, gla_s, lconv_s, lh_s, fconv_s) = trunk(
        x_sample, cache_attn_k, cache_attn_v, state_gla, state_lru_conv, state_lru_h, state_ffn_conv, layer_params, norm_final)
    return (y_prompt, y_sample, k_p, v_p, gla_p, lconv_p, lh_p, fconv_p, k_s, v_s, gla_s, lconv_s, lh_s, fconv_s)
```

```cpp
#include <hip/hip_runtime.h>
#include <hip/hip_cooperative_groups.h>
#include <cstdio>
namespace cg = cooperative_groups;

#define DI __device__ __forceinline__
typedef unsigned short u16;
using bf16x8 = __attribute__((ext_vector_type(8))) short;
using f32x4 = __attribute__((ext_vector_type(4))) float;
using u32x4 = __attribute__((ext_vector_type(4))) unsigned;
#define MFMA16(a, b, c) __builtin_amdgcn_mfma_f32_16x16x32_bf16((a), (b), (c), 0, 0, 0)

constexpr int DM = 1024, PB = 4, PT = 8192, SBT = 16, STT = 32, PAST = 2048, NL = 4;
constexpr int MP = PB * PT, MS = SBT * STT, MT = MP + MS;
constexpr int SKP = 2112;
constexpr int SKV = PAST + STT;
constexpr int DFF = 2816, PW = 4112, PWP = 4224;
constexpr int NGI = PB * 4 * 128 + SBT * 4;
constexpr int NLC = MP / 64 + SBT;
constexpr float EPS = 1e-6f;

constexpr size_t W_IN = 0, W_MG = W_IN + (size_t)PWP * 1024, W_BR = W_MG + (size_t)3072 * 1024, W_OUT = W_BR + (size_t)3 * 1024 * 512,
                 W_FG = W_OUT + (size_t)1024 * 1024, W_FU = W_FG + (size_t)DFF * 1024, W_FD = W_FU + (size_t)DFF * 1024,
                 W_WA = W_FD + (size_t)1024 * DFF, W_WX = W_WA + 32768, W_LAYER = W_WX + 32768;

struct Params {
  const float* in[35];
  float* out;
  char* ws;
};

constexpr size_t al(size_t x) { return (x + 255) & ~(size_t)255; }
constexpr size_t O_WT = 0;
constexpr size_t O_ROPE = al(O_WT + W_LAYER * NL * 2);
constexpr size_t O_LAM = al(O_ROPE + 2 * 8192 * 8 * 4);
constexpr size_t O_XN = al(O_LAM + 256);
constexpr size_t O_REG = al(O_XN + (size_t)MT * 1024 * 2);
constexpr size_t O_QB = O_REG;
constexpr size_t O_KB = al(O_QB + (size_t)MT * 512 * 2);
constexpr size_t O_KS = al(O_KB + (size_t)MP * 512 * 2);
constexpr size_t O_VT = al(O_KS + (size_t)SBT * SKP * 512 * 2);
constexpr size_t O_VTS = al(O_VT + (size_t)MP * 512 * 2);
constexpr size_t O_GQ = al(O_VTS + (size_t)SBT * SKP * 512 * 2);
constexpr size_t O_GK = al(O_GQ + (size_t)MT * 256 * 2);
constexpr size_t O_GV = al(O_GK + (size_t)MT * 256 * 2);
constexpr size_t O_GR = al(O_GV + (size_t)MT * 512 * 2);
constexpr size_t O_GA = al(O_GR + (size_t)MT * 512 * 2);
constexpr size_t O_LX = al(O_GA + (size_t)MT * 16 * 4);
constexpr size_t O_LG = al(O_LX + (size_t)MT * 512 * 4);
constexpr size_t O_KVT = al(O_LG + (size_t)MT * 512 * 2);
constexpr size_t O_DEC = al(O_KVT + (size_t)NGI * 8192 * 2);
constexpr size_t O_HL = al(O_DEC + (size_t)NGI * 64 * 4);
constexpr size_t O_PP = al(O_HL + (size_t)MT * 512 * 2);
constexpr size_t O_CA = al(O_PP + (size_t)MT * 512 * 2);
constexpr size_t O_CH = al(O_CA + (size_t)NLC * 512 * 4);
constexpr size_t O_HS = al(O_CH + (size_t)NLC * 512 * 4);
constexpr size_t O_OA = al(O_HS + (size_t)NLC * 512 * 4);
constexpr size_t O_OG = al(O_OA + (size_t)MT * 512 * 2);
constexpr size_t O_OL = al(O_OG + (size_t)MT * 512 * 2);
constexpr size_t O_MG = al(O_OL + (size_t)MT * 512 * 2);
constexpr size_t O_END1 = al(O_MG + (size_t)MT * 1024 * 2);
constexpr size_t O_GU = O_REG;
constexpr size_t O_FF = al(O_GU + (size_t)MT * DFF * 2);
constexpr size_t O_END2 = al(O_FF + (size_t)MT * DFF * 2);
constexpr size_t WS_NEED = O_END1 > O_END2 ? O_END1 : O_END2;

constexpr size_t Y_P = 0, Y_S = Y_P + (size_t)MP * 1024, K_P = Y_S + (size_t)MS * 1024, V_P = K_P + (size_t)NL * MP * 512,
                 GLA_P = V_P + (size_t)NL * MP * 512, LC_P = GLA_P + (size_t)NL * PB * 32768, LH_P = LC_P + (size_t)NL * PB * 3 * 512,
                 FC_P = LH_P + (size_t)NL * PB * 512, K_S = FC_P + (size_t)NL * PB * 2 * DFF, V_S = K_S + (size_t)NL * MS * 512,
                 GLA_S = V_S + (size_t)NL * MS * 512, LC_S = GLA_S + (size_t)NL * SBT * 32768, LH_S = LC_S + (size_t)NL * SBT * 3 * 512,
                 FC_S = LH_S + (size_t)NL * SBT * 512, OUT_TOTAL = FC_S + (size_t)NL * SBT * 2 * DFF;

DI int TID() { int t = threadIdx.x; asm volatile("" : "+v"(t)); return t; }
DI u16 f2bf(float x) { unsigned u = __float_as_uint(x); u += 0x7fffu + ((u >> 16) & 1u); return (u16)(u >> 16); }
DI float bf2f(u16 h) { return __uint_as_float(((unsigned)h) << 16); }
DI unsigned pack2(float a, float b) { return (unsigned)f2bf(a) | ((unsigned)f2bf(b) << 16); }
DI float sigmoidf_(float x) { return 1.f / (1.f + __expf(-x)); }
DI float gelu_tanh(float x) { float u = 0.7978845608028654f * (x + 0.044715f * x * x * x); return x * sigmoidf_(2.f * u); }
DI float softplusf_(float x) { return fmaxf(x, 0.f) + __logf(1.f + __expf(-fabsf(x))); }
DI float wave_sum(float v) {
  for (int o = 32; o > 0; o >>= 1) v += __shfl_xor(v, o);
  return v;
}

template <int NT>
DI void gemm_core(const u16* __restrict__ A, int lda, const u16* __restrict__ B, int ldb, int K, f32x4 (&acc)[4][NT], char* smem) {
  constexpr int BN = NT * 32;
  constexpr int NBL = BN / 32;
  const int tid = TID(), lane = tid & 63, wid = tid >> 6, wr = wid >> 1, wc = wid & 1, fr = lane & 15, fq = lane >> 4;
  char* As = smem;
  char* Bs = smem + 2 * 16384;
  const int lrow = tid >> 3, lch = tid & 7;
  const u16* ag = A + (size_t)lrow * lda + lch * 8;
  const u16* bg = B + (size_t)lrow * ldb + lch * 8;
  const int soff = lrow * 128 + ((lch ^ ((lrow >> 1) & 7)) << 4);
  const int sw = (fr >> 1) & 7;
  const int aoff = (wr * 64 + fr) * 128, boff = (wc * (BN / 2) + fr) * 128;
  uint4 ra[4], rb[NBL];
  const int nk = K >> 6;
  __syncthreads();
#pragma unroll
  for (int i = 0; i < 4; ++i) ra[i] = *(const uint4*)(ag + (size_t)i * 32 * lda);
#pragma unroll
  for (int i = 0; i < NBL; ++i) rb[i] = *(const uint4*)(bg + (size_t)i * 32 * ldb);
#pragma unroll
  for (int i = 0; i < 4; ++i) *(uint4*)(As + soff + i * 4096) = ra[i];
#pragma unroll
  for (int i = 0; i < NBL; ++i) *(uint4*)(Bs + soff + i * 4096) = rb[i];
  __syncthreads();
  for (int kt = 0; kt < nk; ++kt) {
    const int buf = kt & 1;
    const bool more = kt + 1 < nk;
    if (more) {
#pragma unroll
      for (int i = 0; i < 4; ++i) ra[i] = *(const uint4*)(ag + (size_t)i * 32 * lda + (kt + 1) * 64);
#pragma unroll
      for (int i = 0; i < NBL; ++i) rb[i] = *(const uint4*)(bg + (size_t)i * 32 * ldb + (kt + 1) * 64);
    }
    const char* Ab = As + buf * 16384 + aoff;
    const char* Bb = Bs + buf * (BN * 128) + boff;
#pragma unroll
    for (int ks = 0; ks < 2; ++ks) {
      bf16x8 af[4], bfr[NT];
      const int co = ((ks * 4 + fq) ^ sw) << 4;
#pragma unroll
      for (int m = 0; m < 4; ++m) af[m] = *(const bf16x8*)(Ab + m * 2048 + co);
#pragma unroll
      for (int n = 0; n < NT; ++n) bfr[n] = *(const bf16x8*)(Bb + n * 2048 + co);
#pragma unroll
      for (int m = 0; m < 4; ++m)
#pragma unroll
        for (int n = 0; n < NT; ++n) acc[m][n] = MFMA16(af[m], bfr[n], acc[m][n]);
    }
    if (more) {
      const int nb = buf ^ 1;
#pragma unroll
      for (int i = 0; i < 4; ++i) *(uint4*)(As + nb * 16384 + soff + i * 4096) = ra[i];
#pragma unroll
      for (int i = 0; i < NBL; ++i) *(uint4*)(Bs + nb * (BN * 128) + soff + i * 4096) = rb[i];
    }
    __syncthreads();
  }
}

template <int NT>
DI void zero_acc(f32x4 (&acc)[4][NT]) {
#pragma unroll
  for (int m = 0; m < 4; ++m)
#pragma unroll
    for (int n = 0; n < NT; ++n) acc[m][n] = f32x4{0.f, 0.f, 0.f, 0.f};
}

template <int KS>
DI f32x4 lds_mm(const u16* As, int lsa, int arow, const u16* Bs, int lsb, int brow, f32x4 acc) {
  const int lane = TID() & 63, fr = lane & 15, fq = lane >> 4;
#pragma unroll
  for (int ks = 0; ks < KS; ++ks) {
    bf16x8 a = *(const bf16x8*)(As + (arow + fr) * lsa + ks * 32 + fq * 8);
    bf16x8 b = *(const bf16x8*)(Bs + (brow + fr) * lsb + ks * 32 + fq * 8);
    acc = MFMA16(a, b, acc);
  }
  return acc;
}

constexpr int PREP_T_PER_LAYER = 66 * 16 + 48 * 16 + 3 * 128 + 256 + 3 * 704 + 16;
constexpr int PREP_T = PREP_T_PER_LAYER * NL;
constexpr int PREP_COPY = MT * 1024 / 4096;
constexpr int PREP_ROPE = 8192 * 8 / 256;
constexpr int PREP_ITEMS = PREP_T + PREP_COPY + PREP_ROPE + 1;

DI void transpose_tile(const float* src, int lds_, int k0, int c0, int ncols_valid, u16* dst, int ldd, int n0, float* tile) {
  const int tid = TID();
  __syncthreads();
#pragma unroll
  for (int i = 0; i < 16; ++i) {
    int e = tid + i * 256, r = e >> 6, c = e & 63;
    tile[r * 65 + c] = (c < ncols_valid) ? src[(size_t)(k0 + r) * lds_ + c0 + c] : 0.f;
  }
  __syncthreads();
#pragma unroll
  for (int i = 0; i < 16; ++i) {
    int e = tid + i * 256, c = e >> 6, r = e & 63;
    dst[(size_t)(n0 + c) * ldd + k0 + r] = f2bf(tile[r * 65 + c]);
  }
}

DI void prep_item(const Params& p, int it, char* smem) {
  const int tid = TID();
  if (it < PREP_T) {
    const int l = it / PREP_T_PER_LAYER;
    int t = it % PREP_T_PER_LAYER;
    u16* W = (u16*)(p.ws + O_WT) + (size_t)l * W_LAYER;
    float* tile = (float*)smem;
    if (t < 66 * 16) {
      int nt = t / 16, kt = t % 16, n0 = nt * 64, c0, nv = 64;
      if (n0 < 3072) c0 = n0; else if (n0 < 4096) c0 = n0 + 16; else if (n0 == 4096) { c0 = 3072; nv = 16; } else { c0 = 0; nv = 0; }
      transpose_tile(p.in[9] + (size_t)l * 1024 * PW, PW, kt * 64, c0, nv, W + W_IN, 1024, n0, tile);
      return;
    }
    t -= 66 * 16;
    if (t < 48 * 16) { transpose_tile(p.in[25] + (size_t)l * 1024 * 3072, 3072, (t % 16) * 64, (t / 16) * 64, 64, W + W_MG, 1024, (t / 16) * 64, tile); return; }
    t -= 48 * 16;
    if (t < 3 * 128) {
      int br = t / 128, tt = t % 128;
      transpose_tile(p.in[22 + br] + (size_t)l * 512 * 1024, 1024, (tt % 8) * 64, (tt / 8) * 64, 64, W + W_BR + (size_t)br * 1024 * 512, 512, (tt / 8) * 64, tile);
      return;
    }
    t -= 3 * 128;
    if (t < 256) { transpose_tile(p.in[27] + (size_t)l * 1024 * 1024, 1024, (t % 16) * 64, (t / 16) * 64, 64, W + W_OUT, 1024, (t / 16) * 64, tile); return; }
    t -= 256;
    if (t < 704) { transpose_tile(p.in[29] + (size_t)l * 1024 * DFF, DFF, (t % 16) * 64, (t / 16) * 64, 64, W + W_FG, 1024, (t / 16) * 64, tile); return; }
    t -= 704;
    if (t < 704) { transpose_tile(p.in[32] + (size_t)l * 1024 * DFF, DFF, (t % 16) * 64, (t / 16) * 64, 64, W + W_FU, 1024, (t / 16) * 64, tile); return; }
    t -= 704;
    if (t < 704) { transpose_tile(p.in[33] + (size_t)l * DFF * 1024, 1024, (t % 44) * 64, (t / 44) * 64, 64, W + W_FD, DFF, (t / 44) * 64, tile); return; }
    t -= 704;
    if (t < 8) { transpose_tile(p.in[17] + (size_t)l * 32768 + t * 4096, 64, 0, 0, 64, W + W_WA + t * 4096, 64, 0, tile); return; }
    t -= 8;
    transpose_tile(p.in[19] + (size_t)l * 32768 + t * 4096, 64, 0, 0, 64, W + W_WX + t * 4096, 64, 0, tile);
    return;
  }
  it -= PREP_T;
  if (it < PREP_COPY) {
    size_t base = (size_t)it * 4096;
    float* X = p.out;
#pragma unroll
    for (int i = 0; i < 4; ++i) {
      size_t e = base + (size_t)(tid + i * 256) * 4;
      float4 v = (e < (size_t)MP * 1024) ? *(const float4*)(p.in[0] + e) : *(const float4*)(p.in[1] + (e - (size_t)MP * 1024));
      *(float4*)(X + e) = v;
    }
    return;
  }
  it -= PREP_COPY;
  if (it < PREP_ROPE) {
    int e = it * 256 + tid, pos = e >> 3, i = e & 7;
    double inv = pow(500000.0, -(double)i / 8.0);
    double ang = (double)pos * inv;
    double kq = rint(ang * 0.15915494309189535);
    double r = ang - kq * 6.283185307179586;
    float rf = (float)r;
    float* cs = (float*)(p.ws + O_ROPE);
    cs[e] = cosf(rf);
    cs[8192 * 8 + e] = sinf(rf);
    return;
  }
  if (tid < 64 * NL) {
    int l = tid >> 6, i = tid & 63;
    const float* lq = p.in[10] + (size_t)l * 256;
    float a = lq[i] * lq[64 + i], b = lq[128 + i] * lq[192 + i];
    a = wave_sum(a); b = wave_sum(b);
    if (i == 0) {
      float lam_init = 0.8f - 0.6f * __expf(-0.3f * (float)l);
      ((float*)(p.ws + O_LAM))[l] = __expf(a) - __expf(b) + lam_init;
    }
  }
}

DI void norm_item(const Params& p, int it, const float* gamma, bool final_) {
  const int lane = TID() & 63, wid = TID() >> 6;
  const int row = it * 4 + wid;
  float* X = p.out + (size_t)row * 1024;
  float4 v[4];
  float ss = 0.f;
#pragma unroll
  for (int i = 0; i < 4; ++i) { v[i] = *(const float4*)(X + i * 256 + lane * 4); ss += v[i].x * v[i].x + v[i].y * v[i].y + v[i].z * v[i].z + v[i].w * v[i].w; }
  ss = wave_sum(ss);
  const float rs = rsqrtf(ss * (1.f / 1024.f) + EPS);
  u16* XN = (u16*)(p.ws + O_XN) + (size_t)row * 1024;
#pragma unroll
  for (int i = 0; i < 4; ++i) {
    float4 g = *(const float4*)(gamma + i * 256 + lane * 4);
    float4 o = {v[i].x * rs * g.x, v[i].y * rs * g.y, v[i].z * rs * g.z, v[i].w * rs * g.w};
    if (final_) *(float4*)(X + i * 256 + lane * 4) = o;
    else *(uint2*)(XN + i * 256 + lane * 4) = uint2{pack2(o.x, o.y), pack2(o.z, o.w)};
  }
}

constexpr int PB_GEMM = 260 * 33;
constexpr int PB_KC = SBT * PAST * 512 / 4096;
constexpr int PB_VC = SBT * 32 * 8;
constexpr int PB_ITEMS = PB_GEMM + PB_KC + PB_VC;

DI void projin_tile(const Params& p, int l, int it, char* smem) {
  const int mt = it / 33, nt = it % 33;
  const int row0 = mt * 128, col0 = nt * 128;
  const u16* W = (const u16*)(p.ws + O_WT) + (size_t)l * W_LAYER + W_IN;
  const u16* XN = (const u16*)(p.ws + O_XN);
  f32x4 acc[4][4];
  zero_acc<4>(acc);
  gemm_core<4>(XN + (size_t)row0 * 1024, 1024, W + (size_t)col0 * 1024, 1024, 1024, acc, smem);
  const int tid = TID(), lane = tid & 63, wid = tid >> 6, wr = wid >> 1, wc = wid & 1, fr = lane & 15, fq = lane >> 4;
  const bool isS = row0 >= MP;
  const float* cosT = (const float*)(p.ws + O_ROPE);
  const float* sinT = cosT + 8192 * 8;
  if (nt < 8) {
    const bool isq = nt < 4;
    u16* QB = (u16*)(p.ws + O_QB);
    u16* KB = (u16*)(p.ws + O_KB);
    u16* KS = (u16*)(p.ws + O_KS);
#pragma unroll
    for (int m = 0; m < 4; ++m)
#pragma unroll
      for (int n = 0; n < 4; ++n)
#pragma unroll
        for (int j = 0; j < 4; ++j) {
          const int row = row0 + wr * 64 + m * 16 + fq * 4 + j;
          const int col = col0 + wc * 64 + n * 16 + fr;
          float v = acc[m][n][j];
          int b, t;
          if (isS) { int rs = row - MP; b = rs >> 5; t = rs & 31; } else { b = row >> 13; t = row & 8191; }
          const int pos = isS ? PAST + t : t;
          if (n == 0) {
            float pr = __shfl_xor(v, 8);
            float cs = cosT[pos * 8 + (fr & 7)], sn = sinT[pos * 8 + (fr & 7)];
            v = (fr < 8) ? v * cs - pr * sn : v * cs + pr * sn;
          }
          if (isq) {
            QB[(size_t)row * 512 + col] = f2bf(v * 0.125f);
          } else {
            const int ck = col - 512;
            if (isS) {
              p.out[K_S + ((size_t)l * MS + (row - MP)) * 512 + ck] = v;
              KS[((size_t)b * SKP + PAST + t) * 512 + ck] = f2bf(v);
            } else {
              p.out[K_P + ((size_t)l * MP + row) * 512 + ck] = v;
              KB[(size_t)row * 512 + ck] = f2bf(v);
            }
          }
        }
  } else if (nt < 12) {
    u16* VT = (u16*)(p.ws + O_VT);
    u16* VTS = (u16*)(p.ws + O_VTS);
#pragma unroll
    for (int m = 0; m < 4; ++m)
#pragma unroll
      for (int n = 0; n < 4; ++n) {
        const int rowb = row0 + wr * 64 + m * 16 + fq * 4;
        const int cv = col0 - 1024 + wc * 64 + n * 16 + fr;
        const int h = cv >> 7, vd = cv & 127;
        int b, t;
        if (isS) { int rs = rowb - MP; b = rs >> 5; t = rs & 31; } else { b = rowb >> 13; t = rowb & 8191; }
#pragma unroll
        for (int j = 0; j < 4; ++j) {
          if (isS) p.out[V_S + ((size_t)l * MS + (rowb + j - MP)) * 512 + cv] = acc[m][n][j];
          else p.out[V_P + ((size_t)l * MP + rowb + j) * 512 + cv] = acc[m][n][j];
        }
        uint2 pk = {pack2(acc[m][n][0], acc[m][n][1]), pack2(acc[m][n][2], acc[m][n][3])};
        if (isS) *(uint2*)(VTS + ((size_t)(b * 4 + h) * 128 + vd) * SKP + PAST + t) = pk;
        else *(uint2*)(VT + ((size_t)(b * 4 + h) * 128 + vd) * PT + t) = pk;
      }
  } else {
    u16* dst16 = nullptr; float* dst32 = nullptr; int ld = 0, cbase = 0; float scale = 1.f;
    if (nt < 14) { dst16 = (u16*)(p.ws + O_GQ); ld = 256; cbase = 1536; scale = 0.125f; }
    else if (nt < 16) { dst16 = (u16*)(p.ws + O_GK); ld = 256; cbase = 1792; }
    else if (nt < 20) { dst16 = (u16*)(p.ws + O_GV); ld = 512; cbase = 2048; }
    else if (nt < 24) { dst16 = (u16*)(p.ws + O_GR); ld = 512; cbase = 2560; }
    else if (nt < 28) { dst32 = (float*)(p.ws + O_LX); ld = 512; cbase = 3072; }
    else if (nt < 32) { dst16 = (u16*)(p.ws + O_LG); ld = 512; cbase = 3584; }
    else { dst32 = (float*)(p.ws + O_GA); ld = 16; cbase = 4096; }
#pragma unroll
    for (int m = 0; m < 4; ++m)
#pragma unroll
      for (int n = 0; n < 4; ++n)
#pragma unroll
        for (int j = 0; j < 4; ++j) {
          const int row = row0 + wr * 64 + m * 16 + fq * 4 + j;
          const int c = col0 + wc * 64 + n * 16 + fr - cbase;
          const float v = acc[m][n][j] * scale;
          if (c < ld) {
            if (dst16) dst16[(size_t)row * ld + c] = f2bf(v);
            else dst32[(size_t)row * ld + c] = v;
          }
        }
  }
}

DI void cache_conv_item(const Params& p, int l, int it, char* smem) {
  const int tid = TID();
  if (it < PB_KC) {
    const float* src = p.in[2] + (size_t)l * SBT * PAST * 512;
    u16* KS = (u16*)(p.ws + O_KS);
#pragma unroll
    for (int i = 0; i < 4; ++i) {
      size_t e = (size_t)it * 4096 + (size_t)(tid + i * 256) * 4;
      float4 v = *(const float4*)(src + e);
      size_t b = e / ((size_t)PAST * 512), r = e % ((size_t)PAST * 512);
      *(uint2*)(KS + b * SKP * 512 + r) = uint2{pack2(v.x, v.y), pack2(v.z, v.w)};
    }
    return;
  }
  it -= PB_KC;
  const int b = it / 256, r = it % 256, ptile = r / 8, ctile = r % 8;
  const float* src = p.in[3] + ((size_t)l * SBT + b) * PAST * 512;
  u16* VTS = (u16*)(p.ws + O_VTS);
  transpose_tile(src, 512, ptile * 64, ctile * 64, 64, VTS + (size_t)b * 512 * SKP, SKP, ctile * 64, (float*)smem);
}

DI int kswz(int key) { return (((key >> 3) & 3) << 2) | (key & 3); }

DI void attn_item(const Params& p, int l, int idx, char* smem) {
  const int tid = TID(), lane = tid & 63, wid = tid >> 6, fr = lane & 15, fq = lane >> 4;
  bool isS; int b, h, c;
  if (idx < 2048) {
    isS = false;
    const int r = idx >> 9, pos = idx & 511, q = pos >> 4, base = 127 - 32 * r;
    c = (r & 1) ? base - 31 + q : base - q;
    b = (pos & 15) >> 2; h = pos & 3;
  } else { isS = true; const int s = idx - 2048; b = s >> 2; h = s & 3; c = 0; }
  const int nkt = isS ? 33 : c + 1;
  const int klen = isS ? SKV : (c + 1) * 64;
  const u16* QB = (const u16*)(p.ws + O_QB);
  const u16* Kg = isS ? (const u16*)(p.ws + O_KS) + (size_t)b * SKP * 512 + h * 128 : (const u16*)(p.ws + O_KB) + (size_t)b * PT * 512 + h * 128;
  const int vstride = isS ? SKP : PT;
  const u16* Vg = (isS ? (const u16*)(p.ws + O_VTS) : (const u16*)(p.ws + O_VT)) + (size_t)(b * 4 + h) * 128 * vstride;
  const int qrow0 = isS ? MP + b * 32 : b * PT + c * 64;
  const bool active = isS ? (wid < 2) : true;
  const int qrow = qrow0 + wid * 16 + fr;
  bf16x8 qf[2][2];
#pragma unroll
  for (int mp = 0; mp < 2; ++mp)
#pragma unroll
    for (int ks = 0; ks < 2; ++ks)
      qf[mp][ks] = active ? *(const bf16x8*)(QB + (size_t)qrow * 512 + h * 128 + mp * 64 + ks * 32 + fq * 8) : bf16x8{0, 0, 0, 0, 0, 0, 0, 0};
  f32x4 ot[2][8];
#pragma unroll
  for (int mp = 0; mp < 2; ++mp)
#pragma unroll
    for (int n = 0; n < 8; ++n) ot[mp][n] = f32x4{0.f, 0.f, 0.f, 0.f};
  float mrun[2] = {-INFINITY, -INFINITY}, lrun[2] = {0.f, 0.f};
  char* Ks = smem;
  char* Vs = smem + 32768;
  const int kkey = tid >> 4, kch = tid & 15;
  const int vvd = tid >> 3, vch = tid & 7;
  u32x4 rk[4], rv[4];
  __syncthreads();
#pragma unroll
  for (int i = 0; i < 4; ++i) {
    rk[i] = *(const u32x4*)(Kg + (size_t)(kkey + i * 16) * 512 + kch * 8);
    rv[i] = *(const u32x4*)(Vg + (size_t)(vvd + i * 32) * vstride + vch * 8);
  }
#pragma unroll
  for (int i = 0; i < 4; ++i) {
    const int key = kkey + i * 16;
    *(u32x4*)(Ks + key * 256 + ((kch ^ kswz(key)) << 4)) = rk[i];
    const int vd = vvd + i * 32;
    *(u32x4*)(Vs + vd * 128 + ((vch ^ ((vd >> 1) & 7)) << 4)) = rv[i];
  }
  __syncthreads();
  for (int kt = 0; kt < nkt; ++kt) {
    const int buf = kt & 1;
    const bool more = kt + 1 < nkt;
    if (more) {
#pragma unroll
      for (int i = 0; i < 4; ++i) {
        rk[i] = *(const u32x4*)(Kg + (size_t)((kt + 1) * 64 + kkey + i * 16) * 512 + kch * 8);
        rv[i] = *(const u32x4*)(Vg + (size_t)(vvd + i * 32) * vstride + (kt + 1) * 64 + vch * 8);
      }
    }
    if (active) {
      const char* Kb = Ks + buf * 16384;
      const char* Vb = Vs + buf * 16384;
      f32x4 st[2][4];
#pragma unroll
      for (int mp = 0; mp < 2; ++mp)
#pragma unroll
        for (int mt = 0; mt < 4; ++mt) {
          const int key = 32 * (mt >> 1) + 8 * (fr >> 2) + 4 * (mt & 1) + (fr & 3);
          f32x4 a = {0.f, 0.f, 0.f, 0.f};
#pragma unroll
          for (int ks = 0; ks < 2; ++ks) {
            bf16x8 kf = *(const bf16x8*)(Kb + key * 256 + (((mp * 8 + ks * 4 + fq) ^ kswz(key)) << 4));
            a = MFMA16(kf, qf[mp][ks], a);
          }
          st[mp][mt] = a;
        }
      const bool needmask = (kt + 1) * 64 > klen;
#pragma unroll
      for (int mp = 0; mp < 2; ++mp) {
        if (needmask) {
#pragma unroll
          for (int mt = 0; mt < 4; ++mt)
#pragma unroll
            for (int j = 0; j < 4; ++j) {
              const int key = kt * 64 + 32 * (mt >> 1) + 8 * fq + 4 * (mt & 1) + j;
              if (key >= klen) st[mp][mt][j] = -INFINITY;
            }
        }
        float mx = -INFINITY;
#pragma unroll
        for (int mt = 0; mt < 4; ++mt)
#pragma unroll
          for (int j = 0; j < 4; ++j) mx = fmaxf(mx, st[mp][mt][j]);
        mx = fmaxf(mx, __shfl_xor(mx, 16));
        mx = fmaxf(mx, __shfl_xor(mx, 32));
        const float mnew = fmaxf(mrun[mp], mx);
        const float alpha = __expf(mrun[mp] - mnew);
        mrun[mp] = mnew;
        float ps = 0.f;
#pragma unroll
        for (int mt = 0; mt < 4; ++mt)
#pragma unroll
          for (int j = 0; j < 4; ++j) { float e = __expf(st[mp][mt][j] - mnew); st[mp][mt][j] = e; ps += e; }
        lrun[mp] = lrun[mp] * alpha + ps;
#pragma unroll
        for (int n = 0; n < 8; ++n) { ot[mp][n][0] *= alpha; ot[mp][n][1] *= alpha; ot[mp][n][2] *= alpha; ot[mp][n][3] *= alpha; }
      }
      bf16x8 pf[2][2];
#pragma unroll
      for (int mp = 0; mp < 2; ++mp)
#pragma unroll
        for (int s = 0; s < 2; ++s) {
          uint4 u = {pack2(st[mp][2 * s][0], st[mp][2 * s][1]), pack2(st[mp][2 * s][2], st[mp][2 * s][3]),
                     pack2(st[mp][2 * s + 1][0], st[mp][2 * s + 1][1]), pack2(st[mp][2 * s + 1][2], st[mp][2 * s + 1][3])};
          pf[mp][s] = __builtin_bit_cast(bf16x8, u);
        }
#pragma unroll
      for (int n = 0; n < 8; ++n) {
        const int vd = n * 16 + fr;
#pragma unroll
        for (int s = 0; s < 2; ++s) {
          bf16x8 vf = *(const bf16x8*)(Vb + vd * 128 + (((s * 4 + fq) ^ ((vd >> 1) & 7)) << 4));
          ot[0][n] = MFMA16(vf, pf[0][s], ot[0][n]);
          ot[1][n] = MFMA16(vf, pf[1][s], ot[1][n]);
        }
      }
    }
    if (more) {
      const int nb = buf ^ 1;
#pragma unroll
      for (int i = 0; i < 4; ++i) {
        const int key = kkey + i * 16;
        *(u32x4*)(Ks + nb * 16384 + key * 256 + ((kch ^ kswz(key)) << 4)) = rk[i];
        const int vd = vvd + i * 32;
        *(u32x4*)(Vs + nb * 16384 + vd * 128 + ((vch ^ ((vd >> 1) & 7)) << 4)) = rv[i];
      }
    }
    __syncthreads();
  }
  if (active) {
    float l0 = lrun[0], l1 = lrun[1];
    l0 += __shfl_xor(l0, 16); l0 += __shfl_xor(l0, 32);
    l1 += __shfl_xor(l1, 16); l1 += __shfl_xor(l1, 32);
    const float lam = ((const float*)(p.ws + O_LAM))[l];
    const float lam_init = 0.8f - 0.6f * __expf(-0.3f * (float)l);
    const float i0 = 1.f / l0, i1 = lam / l1;
    float ss = 0.f;
#pragma unroll
    for (int n = 0; n < 8; ++n)
#pragma unroll
      for (int j = 0; j < 4; ++j) { float o = ot[0][n][j] * i0 - ot[1][n][j] * i1; ot[0][n][j] = o; ss += o * o; }
    ss += __shfl_xor(ss, 16); ss += __shfl_xor(ss, 32);
    const float rs = rsqrtf(ss * (1.f / 128.f) + EPS) * (1.f - lam_init);
    const float* g = p.in[11] + (size_t)l * 128;
    u16* OA = (u16*)(p.ws + O_OA) + (size_t)qrow * 512 + h * 128;
#pragma unroll
    for (int n = 0; n < 8; ++n) {
      const int vd = n * 16 + fq * 4;
      float4 gg = *(const float4*)(g + vd);
      *(uint2*)(OA + vd) = uint2{pack2(ot[0][n][0] * rs * gg.x, ot[0][n][1] * rs * gg.y), pack2(ot[0][n][2] * rs * gg.z, ot[0][n][3] * rs * gg.w)};
    }
  }
}

constexpr int LP = 72;
DI void gla_decode(int gi, bool& isS, int& b, int& h, int& c, int& row0, int& Lc) {
  if (gi < PB * 4 * 128) { isS = false; c = gi & 127; h = (gi >> 7) & 3; b = gi >> 9; row0 = b * PT + c * 64; Lc = 64; }
  else { isS = true; int s = gi - PB * 4 * 128; b = s >> 2; h = s & 3; c = 0; row0 = MP + b * 32; Lc = 32; }
}
DI void gla_bcum(const Params& p, int l, int row0, int Lc, int h, float* bc, float* tot) {
  const int tid = TID(), kd = tid & 63, tq = tid >> 6;
  const float* W2 = p.in[12] + (size_t)l * 16 * 256 + h * 64 + kd;
  const float b2 = p.in[13][(size_t)l * 256 + h * 64 + kd];
  const float* GA = (const float*)(p.ws + O_GA);
  float w[16];
#pragma unroll
  for (int r = 0; r < 16; ++r) w[r] = W2[r * 256];
  float run = 0.f;
#pragma unroll 4
  for (int i = 0; i < 16; ++i) {
    const int t = tq * 16 + i;
    float la = 0.f;
    if (t < Lc) {
      const float4* ga = (const float4*)(GA + (size_t)(row0 + t) * 16);
      float4 g0 = ga[0], g1 = ga[1], g2 = ga[2], g3 = ga[3];
      float x = b2 + g0.x * w[0] + g0.y * w[1] + g0.z * w[2] + g0.w * w[3] + g1.x * w[4] + g1.y * w[5] + g1.z * w[6] + g1.w * w[7] +
                g2.x * w[8] + g2.y * w[9] + g2.z * w[10] + g2.w * w[11] + g3.x * w[12] + g3.y * w[13] + g3.z * w[14] + g3.w * w[15];
      la = -softplusf_(-x) * (1.f / 16.f);
    }
    run += la;
    bc[t * 64 + kd] = run;
  }
  tot[tq * 64 + kd] = run;
  __syncthreads();
  float off = 0.f;
  for (int g = 0; g < tq; ++g) off += tot[g * 64 + kd];
#pragma unroll 4
  for (int i = 0; i < 16; ++i) bc[(tq * 16 + i) * 64 + kd] += off;
  __syncthreads();
}

DI void gla1_item(const Params& p, int l, int gi, char* smem) {
  bool isS; int b, h, c, row0, Lc;
  gla_decode(gi, isS, b, h, c, row0, Lc);
  const int tid = TID(), lane = tid & 63, wid = tid >> 6, fr = lane & 15, fq = lane >> 4;
  float* bc = (float*)smem;
  float* tot = (float*)(smem + 16384);
  u16* kh = (u16*)(smem + 17408);
  u16* vt = (u16*)(smem + 17408 + 9216);
  __syncthreads();
  gla_bcum(p, l, row0, Lc, h, bc, tot);
  const u16* GK = (const u16*)(p.ws + O_GK);
  const u16* GV = (const u16*)(p.ws + O_GV);
  {
    const int kd = tid & 63, tq = tid >> 6;
    const float bl = bc[63 * 64 + kd];
    for (int i = 0; i < 16; ++i) {
      const int s = tq * 16 + i;
      float v = 0.f;
      if (s < Lc) v = bf2f(GK[(size_t)(row0 + s) * 256 + h * 64 + kd]) * __expf(bl - bc[s * 64 + kd]);
      kh[kd * LP + s] = f2bf(v);
    }
    if (tid < 64) ((float*)(p.ws + O_DEC))[(size_t)gi * 64 + tid] = __expf(bc[63 * 64 + tid]);
    const int vd = tid & 127, sh = tid >> 7;
    for (int i = 0; i < 32; ++i) {
      const int s = sh * 32 + i;
      u16 v = 0;
      if (s < Lc) v = GV[(size_t)(row0 + s) * 512 + h * 128 + vd];
      vt[vd * LP + s] = v;
    }
  }
  __syncthreads();
  u16* KVT = (u16*)(p.ws + O_KVT) + (size_t)gi * 8192;
#pragma unroll
  for (int mi = 0; mi < 2; ++mi)
#pragma unroll
    for (int n = 0; n < 4; ++n) {
      const int m = wid * 2 + mi;
      f32x4 a = lds_mm<2>(vt, LP, m * 16, kh, LP, n * 16, f32x4{0.f, 0.f, 0.f, 0.f});
#pragma unroll
      for (int j = 0; j < 4; ++j) KVT[(m * 16 + fq * 4 + j) * 64 + n * 16 + fr] = f2bf(a[j]);
    }
}

constexpr int G2_ITEMS = (PB * 4 + SBT * 4) * 32;
DI void gla2_item(const Params& p, int l, int it) {
  const int seq = it >> 5, e = (it & 31) * 256 + TID();
  const int vd = e >> 6, kd = e & 63;
  u16* KVT = (u16*)(p.ws + O_KVT);
  const float* DEC = (const float*)(p.ws + O_DEC);
  if (seq < PB * 4) {
    float S = 0.f;
    const int gi0 = seq * 128;
#pragma unroll 4
    for (int c = 0; c < 128; ++c) {
      u16* q = KVT + (size_t)(gi0 + c) * 8192 + e;
      const float kv = bf2f(*q);
      const float d = DEC[(size_t)(gi0 + c) * 64 + kd];
      *q = f2bf(S);
      S = d * S + kv;
    }
    p.out[GLA_P + ((size_t)l * PB * 4 + seq) * 8192 + kd * 128 + vd] = S;
  } else {
    const int s = seq - PB * 4, gi = PB * 4 * 128 + s;
    const float S0 = p.in[4][((size_t)l * SBT * 4 + s) * 8192 + kd * 128 + vd];
    u16* q = KVT + (size_t)gi * 8192 + e;
    const float kv = bf2f(*q);
    const float d = DEC[(size_t)gi * 64 + kd];
    *q = f2bf(S0);
    p.out[GLA_S + ((size_t)l * SBT * 4 + s) * 8192 + kd * 128 + vd] = d * S0 + kv;
  }
}

DI void gla3_item(const Params& p, int l, int gi, char* smem) {
  bool isS; int b, h, c, row0, Lc;
  gla_decode(gi, isS, b, h, c, row0, Lc);
  const int tid = TID(), lane = tid & 63, wid = tid >> 6, fr = lane & 15, fq = lane >> 4;
  float* bc = (float*)smem;
  u16* att = (u16*)smem;
  float* tot = (float*)(smem + 16384);
  u16* qt = (u16*)(smem + 17408);
  u16* kt_ = (u16*)(smem + 17408 + 9216);
  u16* vt = (u16*)(smem + 17408 + 2 * 9216);
  u16* st = (u16*)(smem + 17408 + 2 * 9216 + 18432);
  __syncthreads();
  gla_bcum(p, l, row0, Lc, h, bc, tot);
  const u16* GQ = (const u16*)(p.ws + O_GQ);
  const u16* GK = (const u16*)(p.ws + O_GK);
  const u16* GV = (const u16*)(p.ws + O_GV);
  const u16* KVT = (const u16*)(p.ws + O_KVT) + (size_t)gi * 8192;
  {
    const int kd = tid & 63, tq = tid >> 6;
    for (int i = 0; i < 16; ++i) {
      const int s = tq * 16 + i;
      float qv = 0.f, kv = 0.f;
      if (s < Lc) {
        const float bb = bc[s * 64 + kd];
        qv = bf2f(GQ[(size_t)(row0 + s) * 256 + h * 64 + kd]) * __expf(bb);
        kv = bf2f(GK[(size_t)(row0 + s) * 256 + h * 64 + kd]) * __expf(-bb);
      }
      qt[s * LP + kd] = f2bf(qv);
      kt_[s * LP + kd] = f2bf(kv);
    }
    const int vd = tid & 127, sh = tid >> 7;
    for (int i = 0; i < 32; ++i) {
      const int s = sh * 32 + i;
      u16 v = 0;
      if (s < Lc) v = GV[(size_t)(row0 + s) * 512 + h * 128 + vd];
      vt[vd * LP + s] = v;
    }
#pragma unroll
    for (int i = 0; i < 4; ++i) {
      const int id = tid + i * 256, r = id >> 3, ch = id & 7;
      *(uint4*)(st + r * LP + ch * 8) = *(const uint4*)(KVT + r * 64 + ch * 8);
    }
  }
  __syncthreads();
  {
    f32x4 a[4];
#pragma unroll
    for (int n = 0; n < 4; ++n) a[n] = lds_mm<2>(qt, LP, wid * 16, kt_, LP, n * 16, f32x4{0.f, 0.f, 0.f, 0.f});
    __syncthreads();
#pragma unroll
    for (int n = 0; n < 4; ++n)
#pragma unroll
      for (int j = 0; j < 4; ++j) {
        const int t = wid * 16 + fq * 4 + j, s = n * 16 + fr;
        att[t * LP + s] = f2bf(t >= s ? a[n][j] : 0.f);
      }
  }
  __syncthreads();
  f32x4 o[8];
#pragma unroll
  for (int n = 0; n < 8; ++n) {
    f32x4 a = lds_mm<2>(att, LP, wid * 16, vt, LP, n * 16, f32x4{0.f, 0.f, 0.f, 0.f});
    o[n] = lds_mm<2>(qt, LP, wid * 16, st, LP, n * 16, a);
  }
  const float* gn = p.in[14] + (size_t)l * 128;
  const u16* GR = (const u16*)(p.ws + O_GR);
  u16* OG = (u16*)(p.ws + O_OG);
#pragma unroll
  for (int j = 0; j < 4; ++j) {
    float ss = 0.f;
#pragma unroll
    for (int n = 0; n < 8; ++n) ss += o[n][j] * o[n][j];
    ss += __shfl_xor(ss, 1); ss += __shfl_xor(ss, 2); ss += __shfl_xor(ss, 4); ss += __shfl_xor(ss, 8);
    const float rs = rsqrtf(ss * (1.f / 128.f) + EPS);
    const int t = wid * 16 + fq * 4 + j;
    if (t < Lc) {
      const size_t ro = (size_t)(row0 + t) * 512 + h * 128;
#pragma unroll
      for (int n = 0; n < 8; ++n) {
        const int vd = n * 16 + fr;
        const float gr = bf2f(GR[ro + vd]);
        OG[ro + vd] = f2bf(o[n][j] * rs * gn[vd] * gr * sigmoidf_(gr));
      }
    }
  }
}

constexpr int L1_ITEMS = NLC * 8;
DI void lru_decode(int ci, bool& isS, int& b, int& row0, int& Lc, int& t0) {
  if (ci < MP / 64) { isS = false; b = ci >> 7; t0 = (ci & 127) * 64; row0 = ci * 64; Lc = 64; }
  else { isS = true; b = ci - MP / 64; t0 = 0; row0 = MP + b * 32; Lc = 32; }
}
DI void lru1_item(const Params& p, int l, int it, char* smem) {
  const int ci = it >> 3, nb = it & 7;
  bool isS; int b, row0, Lc, t0;
  lru_decode(ci, isS, b, row0, Lc, t0);
  const int tid = TID(), lane = tid & 63, wid = tid >> 6, fr = lane & 15, fq = lane >> 4;
  u16* xcs = (u16*)smem;
  u16* was = (u16*)(smem + 9216);
  u16* wxs = (u16*)(smem + 2 * 9216);
  float* as_ = (float*)(smem + 3 * 9216);
  float* us_ = (float*)(smem + 3 * 9216 + 16384);
  const float* LX = (const float*)(p.ws + O_LX);
  const u16* Wl = (const u16*)(p.ws + O_WT) + (size_t)l * W_LAYER;
  __syncthreads();
  {
    const int i = tid & 63, tq = tid >> 6, ch = nb * 64 + i;
    const float* cw = p.in[15] + (size_t)l * 4 * 512 + ch;
    const float w0 = cw[0], w1 = cw[512], w2 = cw[1024], w3 = cw[1536], cb = p.in[16][(size_t)l * 512 + ch];
    const float* buf = isS ? p.in[5] + ((size_t)l * SBT + b) * 3 * 512 + ch : nullptr;
    for (int k = 0; k < 16; ++k) {
      const int t = tq * 16 + k;
      float xv = 0.f;
      if (t < Lc) {
        float x[4];
#pragma unroll
        for (int d = 0; d < 4; ++d) {
          const int tt = t0 + t - 3 + d;
          if (tt >= 0) x[d] = LX[(size_t)(row0 + t - 3 + d) * 512 + ch];
          else x[d] = isS ? buf[(3 + tt) * 512] : 0.f;
        }
        xv = cb + w0 * x[0] + w1 * x[1] + w2 * x[2] + w3 * x[3];
      }
      xcs[t * LP + i] = f2bf(xv);
    }
#pragma unroll
    for (int k = 0; k < 2; ++k) {
      const int id = tid + k * 256, r = id >> 3, c8 = id & 7;
      *(uint4*)(was + r * LP + c8 * 8) = *(const uint4*)(Wl + W_WA + nb * 4096 + r * 64 + c8 * 8);
      *(uint4*)(wxs + r * LP + c8 * 8) = *(const uint4*)(Wl + W_WX + nb * 4096 + r * 64 + c8 * 8);
    }
    const int T = isS ? STT : PT;
    if (t0 + Lc == T && tid < 192) {
      const int k = tid >> 6;
      const float v = LX[(size_t)(row0 + Lc - 3 + k) * 512 + ch];
      if (isS) p.out[LC_S + (((size_t)l * SBT + b) * 3 + k) * 512 + ch] = v;
      else p.out[LC_P + (((size_t)l * PB + b) * 3 + k) * 512 + ch] = v;
    }
  }
  __syncthreads();
  {
    const float* ba = p.in[18] + (size_t)l * 512 + nb * 64;
    const float* bx = p.in[20] + (size_t)l * 512 + nb * 64;
    const float* lm = p.in[21] + (size_t)l * 512 + nb * 64;
#pragma unroll
    for (int n = 0; n < 4; ++n) {
      f32x4 r = lds_mm<2>(xcs, LP, wid * 16, was, LP, n * 16, f32x4{0.f, 0.f, 0.f, 0.f});
      f32x4 g = lds_mm<2>(xcs, LP, wid * 16, wxs, LP, n * 16, f32x4{0.f, 0.f, 0.f, 0.f});
      const int j = n * 16 + fr;
      const float sp = softplusf_(-lm[j]), bav = ba[j], bxv = bx[j];
#pragma unroll
      for (int q = 0; q < 4; ++q) {
        const int t = wid * 16 + fq * 4 + q;
        const float rr = sigmoidf_(r[q] + bav), ii = sigmoidf_(g[q] + bxv);
        const float la = -8.f * rr * sp;
        const float a = __expf(la);
        const float x2 = 2.f * la;
        const float om = (x2 > -0.01f) ? -x2 * (1.f + x2 * (0.5f + x2 * (1.f / 6.f))) : 1.f - __expf(x2);
        const float u = sqrtf(om) * ii * bf2f(xcs[t * LP + j]);
        as_[t * 64 + j] = a;
        us_[t * 64 + j] = u;
      }
    }
  }
  __syncthreads();
  if (tid < 64) {
    const int j = tid, ch = nb * 64 + j;
    u16* HL = (u16*)(p.ws + O_HL);
    u16* PPp = (u16*)(p.ws + O_PP);
    float hh = 0.f, P = 1.f;
    for (int t = 0; t < Lc; ++t) {
      const float a = as_[t * 64 + j], u = us_[t * 64 + j];
      P *= a; hh = a * hh + u;
      HL[(size_t)(row0 + t) * 512 + ch] = f2bf(hh);
      PPp[(size_t)(row0 + t) * 512 + ch] = f2bf(P);
    }
    ((float*)(p.ws + O_CA))[(size_t)ci * 512 + ch] = P;
    ((float*)(p.ws + O_CH))[(size_t)ci * 512 + ch] = hh;
  }
}
constexpr int L2_ITEMS = 8 + 32;
DI void lru2_item(const Params& p, int l, int it) {
  const float* CA = (const float*)(p.ws + O_CA);
  const float* CH = (const float*)(p.ws + O_CH);
  float* HS = (float*)(p.ws + O_HS);
  if (it < 8) {
    const int e = it * 256 + TID(), b = e >> 9, ch = e & 511;
    float hh = 0.f;
#pragma unroll 4
    for (int c = 0; c < 128; ++c) {
      const size_t o = (size_t)(b * 128 + c) * 512 + ch;
      HS[o] = hh;
      hh = CA[o] * hh + CH[o];
    }
    p.out[LH_P + ((size_t)l * PB + b) * 512 + ch] = hh;
  } else {
    const int e = (it - 8) * 256 + TID(), b = e >> 9, ch = e & 511;
    const float h0 = p.in[6][((size_t)l * SBT + b) * 512 + ch];
    const size_t o = (size_t)(MP / 64 + b) * 512 + ch;
    HS[o] = h0;
    p.out[LH_S + ((size_t)l * SBT + b) * 512 + ch] = CA[o] * h0 + CH[o];
  }
}
constexpr int L3_ITEMS = MT / 8;
DI void lru3_item(const Params& p, int it) {
  const u16* HL = (const u16*)(p.ws + O_HL);
  const u16* PPp = (const u16*)(p.ws + O_PP);
  const u16* LG = (const u16*)(p.ws + O_LG);
  const float* HS = (const float*)(p.ws + O_HS);
  u16* OL = (u16*)(p.ws + O_OL);
#pragma unroll
  for (int i = 0; i < 4; ++i) {
    const int id = TID() + i * 256;
    const int row = it * 8 + (id >> 7), c4 = (id & 127) * 4;
    const int ci = row < MP ? (row >> 6) : MP / 64 + ((row - MP) >> 5);
    const size_t o = (size_t)row * 512 + c4;
    const uint2 hl = *(const uint2*)(HL + o), pp = *(const uint2*)(PPp + o), lg = *(const uint2*)(LG + o);
    const float4 hs = *(const float4*)(HS + (size_t)ci * 512 + c4);
    float y0 = (bf2f(hl.x & 0xffff) + bf2f(pp.x & 0xffff) * hs.x) * gelu_tanh(bf2f(lg.x & 0xffff));
    float y1 = (bf2f(hl.x >> 16) + bf2f(pp.x >> 16) * hs.y) * gelu_tanh(bf2f(lg.x >> 16));
    float y2 = (bf2f(hl.y & 0xffff) + bf2f(pp.y & 0xffff) * hs.z) * gelu_tanh(bf2f(lg.y & 0xffff));
    float y3 = (bf2f(hl.y >> 16) + bf2f(pp.y >> 16) * hs.w) * gelu_tanh(bf2f(lg.y >> 16));
    *(uint2*)(OL + o) = uint2{pack2(y0, y1), pack2(y2, y3)};
  }
}

constexpr int PF_ITEMS = 260 * 16;
DI void merge_tile(const Params& p, int l, int it, char* smem) {
  const int mt = it >> 4, nt = it & 15;
  const int row0 = mt * 128, col0 = nt * 64;
  const u16* W = (const u16*)(p.ws + O_WT) + (size_t)l * W_LAYER;
  const u16* XN = (const u16*)(p.ws + O_XN) + (size_t)row0 * 1024;
  const int tid = TID(), lane = tid & 63, wid = tid >> 6, wr = wid >> 1, wc = wid & 1, fr = lane & 15, fq = lane >> 4;
  f32x4 mg[4][2];
  zero_acc<2>(mg);
#pragma unroll 1
  for (int br = 0; br < 3; ++br) {
    f32x4 g[4][2];
    zero_acc<2>(g);
    gemm_core<2>(XN, 1024, W + W_MG + (size_t)(br * 1024 + col0) * 1024, 1024, 1024, g, smem);
    const float* bm = p.in[26] + (size_t)l * 3072 + br * 1024 + col0 + wc * 32 + fr;
#pragma unroll
    for (int n = 0; n < 2; ++n) {
      const float bv = bm[n * 16];
#pragma unroll
      for (int m = 0; m < 4; ++m)
#pragma unroll
        for (int j = 0; j < 4; ++j) g[m][n][j] = sigmoidf_(g[m][n][j] + bv);
    }
    f32x4 y[4][2];
    zero_acc<2>(y);
    const u16* O = (const u16*)(p.ws + (br == 0 ? O_OA : (br == 1 ? O_OG : O_OL))) + (size_t)row0 * 512;
    gemm_core<2>(O, 512, W + W_BR + (size_t)br * 1024 * 512 + (size_t)col0 * 512, 512, 512, y, smem);
#pragma unroll
    for (int m = 0; m < 4; ++m)
#pragma unroll
      for (int n = 0; n < 2; ++n)
#pragma unroll
        for (int j = 0; j < 4; ++j) mg[m][n][j] += g[m][n][j] * y[m][n][j];
  }
  u16* MG = (u16*)(p.ws + O_MG);
#pragma unroll
  for (int m = 0; m < 4; ++m)
#pragma unroll
    for (int n = 0; n < 2; ++n)
#pragma unroll
      for (int j = 0; j < 4; ++j) {
        const int row = row0 + wr * 64 + m * 16 + fq * 4 + j, col = col0 + wc * 32 + n * 16 + fr;
        MG[(size_t)row * 1024 + col] = f2bf(mg[m][n][j]);
      }
}

DI void resid_tile(const Params& p, const u16* A, int K, const u16* W, int it, char* smem) {
  const int mt = it >> 3, nt = it & 7;
  const int row0 = mt * 128, col0 = nt * 128;
  f32x4 acc[4][4];
  zero_acc<4>(acc);
  gemm_core<4>(A + (size_t)row0 * K, K, W + (size_t)col0 * K, K, K, acc, smem);
  const int tid = TID(), lane = tid & 63, wid = tid >> 6, wr = wid >> 1, wc = wid & 1, fr = lane & 15, fq = lane >> 4;
#pragma unroll
  for (int m = 0; m < 4; ++m)
#pragma unroll
    for (int n = 0; n < 4; ++n)
#pragma unroll
      for (int j = 0; j < 4; ++j) {
        const int row = row0 + wr * 64 + m * 16 + fq * 4 + j, col = col0 + wc * 64 + n * 16 + fr;
        p.out[(size_t)row * 1024 + col] += acc[m][n][j];
      }
}

constexpr int FF_ITEMS = 260 * 22;
DI void ffgate_tile(const Params& p, int l, int it, char* smem) {
  const int mt = it / 22, nt = it % 22;
  const int row0 = mt * 128, col0 = nt * 128;
  const u16* W = (const u16*)(p.ws + O_WT) + (size_t)l * W_LAYER + W_FG;
  f32x4 acc[4][4];
  zero_acc<4>(acc);
  gemm_core<4>((const u16*)(p.ws + O_XN) + (size_t)row0 * 1024, 1024, W + (size_t)col0 * 1024, 1024, 1024, acc, smem);
  const int tid = TID(), lane = tid & 63, wid = tid >> 6, wr = wid >> 1, wc = wid & 1, fr = lane & 15, fq = lane >> 4;
  u16* GU = (u16*)(p.ws + O_GU);
  const bool isS = row0 >= MP;
#pragma unroll
  for (int m = 0; m < 4; ++m)
#pragma unroll
    for (int n = 0; n < 4; ++n)
#pragma unroll
      for (int j = 0; j < 4; ++j) {
        const int row = row0 + wr * 64 + m * 16 + fq * 4 + j, col = col0 + wc * 64 + n * 16 + fr;
        const float v = acc[m][n][j];
        GU[(size_t)row * DFF + col] = f2bf(v);
        if (isS) {
          const int rs = row - MP, b = rs >> 5, t = rs & 31;
          if (t >= STT - 2) p.out[FC_S + (((size_t)l * SBT + b) * 2 + (t - (STT - 2))) * DFF + col] = v;
        } else {
          const int b = row >> 13, t = row & 8191;
          if (t >= PT - 2) p.out[FC_P + (((size_t)l * PB + b) * 2 + (t - (PT - 2))) * DFF + col] = v;
        }
      }
}
DI void ffup_tile(const Params& p, int l, int it, char* smem) {
  const int mt = it / 22, nt = it % 22;
  const int row0 = mt * 128, col0 = nt * 128;
  const u16* W = (const u16*)(p.ws + O_WT) + (size_t)l * W_LAYER + W_FU;
  f32x4 acc[4][4];
  zero_acc<4>(acc);
  gemm_core<4>((const u16*)(p.ws + O_XN) + (size_t)row0 * 1024, 1024, W + (size_t)col0 * 1024, 1024, 1024, acc, smem);
  const int tid = TID(), lane = tid & 63, wid = tid >> 6, wr = wid >> 1, wc = wid & 1, fr = lane & 15, fq = lane >> 4;
  const u16* GU = (const u16*)(p.ws + O_GU);
  u16* FF = (u16*)(p.ws + O_FF);
  const bool isS = row0 >= MP;
#pragma unroll
  for (int n = 0; n < 4; ++n) {
    const int col = col0 + wc * 64 + n * 16 + fr;
    const float* cw = p.in[30] + (size_t)l * 3 * DFF + col;
    const float w0 = cw[0], w1 = cw[DFF], w2 = cw[2 * DFF], cb = p.in[31][(size_t)l * DFF + col];
#pragma unroll
    for (int m = 0; m < 4; ++m) {
      const int rowb = row0 + wr * 64 + m * 16 + fq * 4;
      int b, t;
      if (isS) { int rs = rowb - MP; b = rs >> 5; t = rs & 31; } else { b = rowb >> 13; t = rowb & 8191; }
      float g[6];
#pragma unroll
      for (int d = 0; d < 6; ++d) {
        const int tt = t - 2 + d;
        if (tt >= 0) g[d] = bf2f(GU[(size_t)(rowb - 2 + d) * DFF + col]);
        else g[d] = isS ? p.in[7][(((size_t)l * SBT + b) * 2 + (2 + tt)) * DFF + col] : 0.f;
      }
#pragma unroll
      for (int j = 0; j < 4; ++j) {
        const float gc = cb + w0 * g[j] + w1 * g[j + 1] + w2 * g[j + 2];
        FF[(size_t)(rowb + j) * DFF + col] = f2bf(gelu_tanh(gc) * acc[m][n][j]);
      }
    }
  }
}

#ifndef ONLY
#define ONLY -1
#endif
__global__ void __launch_bounds__(256, 2) mega(Params p) {
  cg::grid_group grid = cg::this_grid();
  extern __shared__ __attribute__((aligned(16))) char smem[];
  const int G = gridDim.x, B = blockIdx.x;
  if (ONLY < 0 || ONLY == 0) for (int it = B; it < PREP_ITEMS; it += G) prep_item(p, it, smem);
  grid.sync();
  for (int l = 0; l < NL; ++l) {
    const u16* W = (const u16*)(p.ws + O_WT) + (size_t)l * W_LAYER;
    if (ONLY < 0 || ONLY == 1) for (int it = B; it < MT / 4; it += G) norm_item(p, it, p.in[8] + (size_t)l * 1024, false);
    grid.sync();
    if (ONLY < 0 || ONLY == 2) for (int it = B; it < PB_ITEMS; it += G) { if (it < PB_GEMM) projin_tile(p, l, it, smem); else cache_conv_item(p, l, it - PB_GEMM, smem); }
    grid.sync();
    if (ONLY < 0 || ONLY == 3) for (int it = B; it < 2112; it += G) attn_item(p, l, it, smem);
    if (ONLY < 0 || ONLY == 13) for (int it = B; it < NGI; it += G) gla1_item(p, l, it, smem);
    if (ONLY < 0 || ONLY == 14) for (int it = B; it < L1_ITEMS; it += G) lru1_item(p, l, it, smem);
    grid.sync();
    if (ONLY < 0 || ONLY == 4) for (int it = B; it < G2_ITEMS + L2_ITEMS; it += G) { if (it < G2_ITEMS) gla2_item(p, l, it); else lru2_item(p, l, it - G2_ITEMS); }
    grid.sync();
    if (ONLY < 0 || ONLY == 5) for (int it = B; it < NGI + L3_ITEMS; it += G) { if (it < NGI) gla3_item(p, l, it, smem); else lru3_item(p, it - NGI); }
    grid.sync();
    if (ONLY < 0 || ONLY == 6) for (int it = B; it < PF_ITEMS; it += G) merge_tile(p, l, it, smem);
    grid.sync();
    if (ONLY < 0 || ONLY == 7) for (int it = B; it < 260 * 8; it += G) resid_tile(p, (const u16*)(p.ws + O_MG), 1024, W + W_OUT, it, smem);
    grid.sync();
    if (ONLY < 0 || ONLY == 8) for (int it = B; it < MT / 4; it += G) norm_item(p, it, p.in[28] + (size_t)l * 1024, false);
    grid.sync();
    if (ONLY < 0 || ONLY == 9) for (int it = B; it < FF_ITEMS; it += G) ffgate_tile(p, l, it, smem);
    grid.sync();
    if (ONLY < 0 || ONLY == 10) for (int it = B; it < FF_ITEMS; it += G) ffup_tile(p, l, it, smem);
    grid.sync();
    if (ONLY < 0 || ONLY == 11) for (int it = B; it < 260 * 8; it += G) resid_tile(p, (const u16*)(p.ws + O_FF), DFF, W + W_FD, it, smem);
    grid.sync();
  }
  if (ONLY < 0 || ONLY == 12) for (int it = B; it < MT / 4; it += G) norm_item(p, it, p.in[34], true);
}

constexpr int SMEM_BYTES = 73728;

extern "C" void kernel_launch(void* const* d_in, const int* in_sizes, int n_in, void* d_out, int out_size, void* d_ws, size_t ws_size,
                              hipStream_t stream) {
  static int grid_blocks = 0;
  if (!grid_blocks) {
    int dev = 0, cus = 0, per = 0;
    (void)hipGetDevice(&dev);
    (void)hipDeviceGetAttribute(&cus, hipDeviceAttributeMultiprocessorCount, dev);
    (void)hipFuncSetAttribute((const void*)mega, hipFuncAttributeMaxDynamicSharedMemorySize, SMEM_BYTES);
    (void)hipOccupancyMaxActiveBlocksPerMultiprocessor(&per, mega, 256, SMEM_BYTES);
    if (per > 2) per = 2;
    if (per < 1) per = 1;
    grid_blocks = cus * per;
  }
  if (ws_size < WS_NEED) fprintf(stderr, "workspace too small: %zu < %zu\n", ws_size, (size_t)WS_NEED);
  Params p{};
  for (int i = 0; i < 35; ++i) p.in[i] = (const float*)d_in[i];
  p.out = (float*)d_out;
  p.ws = (char*)d_ws;
  void* args[] = {&p};
  hipError_t e = hipLaunchCooperativeKernel((void*)mega, dim3(grid_blocks), dim3(256), args, SMEM_BYTES, stream);
  if (e != hipSuccess) fprintf(stderr, "cooperative launch failed: %s (grid %d)\n", hipGetErrorString(e), grid_blocks);
}
```

```cpp
#include <hip/hip_runtime.h>
#include <hip/hip_cooperative_groups.h>
#include <cstdio>
namespace cg = cooperative_groups;

#define DI __device__ __forceinline__
typedef unsigned short u16;
using bf16x8 = __attribute__((ext_vector_type(8))) short;
using f32x4 = __attribute__((ext_vector_type(4))) float;
using u32x4 = __attribute__((ext_vector_type(4))) unsigned;
#define MFMA16(a, b, c) __builtin_amdgcn_mfma_f32_16x16x32_bf16((a), (b), (c), 0, 0, 0)

constexpr int DM = 1024, PB = 4, PT = 8192, SBT = 16, STT = 32, PAST = 2048, NL = 4;
constexpr int MP = PB * PT, MS = SBT * STT, MT = MP + MS;
constexpr int SKP = 2112;
constexpr int SKV = PAST + STT;
constexpr int DFF = 2816, PW = 4112, PWP = 4224;
constexpr int NGI = PB * 4 * 128 + SBT * 4;
constexpr int NLC = MP / 64 + SBT;
constexpr float EPS = 1e-6f;

constexpr size_t W_IN = 0, W_MG = W_IN + (size_t)PWP * 1024, W_BR = W_MG + (size_t)3072 * 1024, W_OUT = W_BR + (size_t)3 * 1024 * 512,
                 W_FG = W_OUT + (size_t)1024 * 1024, W_FU = W_FG + (size_t)DFF * 1024, W_FD = W_FU + (size_t)DFF * 1024,
                 W_WA = W_FD + (size_t)1024 * DFF, W_WX = W_WA + 32768, W_LAYER = W_WX + 32768;

struct Params {
  const float* in[35];
  float* out;
  char* ws;
};

constexpr size_t al(size_t x) { return (x + 255) & ~(size_t)255; }
constexpr size_t O_WT = 0;
constexpr size_t O_ROPE = al(O_WT + W_LAYER * NL * 2);
constexpr size_t O_LAM = al(O_ROPE + 2 * 8192 * 8 * 4);
constexpr size_t O_XN = al(O_LAM + 256);
constexpr size_t O_REG = al(O_XN + (size_t)MT * 1024 * 2);
constexpr size_t O_QB = O_REG;
constexpr size_t O_KB = al(O_QB + (size_t)MT * 512 * 2);
constexpr size_t O_KS = al(O_KB + (size_t)MP * 512 * 2);
constexpr size_t O_VT = al(O_KS + (size_t)SBT * SKP * 512 * 2);
constexpr size_t O_VTS = al(O_VT + (size_t)MP * 512 * 2);
constexpr size_t O_GQ = al(O_VTS + (size_t)SBT * SKP * 512 * 2);
constexpr size_t O_GK = al(O_GQ + (size_t)MT * 256 * 2);
constexpr size_t O_GV = al(O_GK + (size_t)MT * 256 * 2);
constexpr size_t O_GR = al(O_GV + (size_t)MT * 512 * 2);
constexpr size_t O_GA = al(O_GR + (size_t)MT * 512 * 2);
constexpr size_t O_LX = al(O_GA + (size_t)MT * 16 * 4);
constexpr size_t O_LG = al(O_LX + (size_t)MT * 512 * 4);
constexpr size_t O_KVT = al(O_LG + (size_t)MT * 512 * 2);
constexpr size_t O_DEC = al(O_KVT + (size_t)NGI * 8192 * 2);
constexpr size_t O_HL = al(O_DEC + (size_t)NGI * 64 * 4);
constexpr size_t O_PP = al(O_HL + (size_t)MT * 512 * 2);
constexpr size_t O_CA = al(O_PP + (size_t)MT * 512 * 2);
constexpr size_t O_CH = al(O_CA + (size_t)NLC * 512 * 4);
constexpr size_t O_HS = al(O_CH + (size_t)NLC * 512 * 4);
constexpr size_t O_OA = al(O_HS + (size_t)NLC * 512 * 4);
constexpr size_t O_OG = al(O_OA + (size_t)MT * 512 * 2);
constexpr size_t O_OL = al(O_OG + (size_t)MT * 512 * 2);
constexpr size_t O_MG = al(O_OL + (size_t)MT * 512 * 2);
constexpr size_t O_END1 = al(O_MG + (size_t)MT * 1024 * 2);
constexpr size_t O_GU = O_REG;
constexpr size_t O_FF = al(O_GU + (size_t)MT * DFF * 2);
constexpr size_t O_END2 = al(O_FF + (size_t)MT * DFF * 2);
constexpr size_t WS_NEED = O_END1 > O_END2 ? O_END1 : O_END2;

constexpr size_t Y_P = 0, Y_S = Y_P + (size_t)MP * 1024, K_P = Y_S + (size_t)MS * 1024, V_P = K_P + (size_t)NL * MP * 512,
                 GLA_P = V_P + (size_t)NL * MP * 512, LC_P = GLA_P + (size_t)NL * PB * 32768, LH_P = LC_P + (size_t)NL * PB * 3 * 512,
                 FC_P = LH_P + (size_t)NL * PB * 512, K_S = FC_P + (size_t)NL * PB * 2 * DFF, V_S = K_S + (size_t)NL * MS * 512,
                 GLA_S = V_S + (size_t)NL * MS * 512, LC_S = GLA_S + (size_t)NL * SBT * 32768, LH_S = LC_S + (size_t)NL * SBT * 3 * 512,
                 FC_S = LH_S + (size_t)NL * SBT * 512, OUT_TOTAL = FC_S + (size_t)NL * SBT * 2 * DFF;

DI int TID() { int t = threadIdx.x; asm volatile("" : "+v"(t)); return t; }
DI u16 f2bf(float x) { __bf16 h = (__bf16)x; return __builtin_bit_cast(u16, h); }
DI float bf2f(u16 h) { return __uint_as_float(((unsigned)h) << 16); }
typedef __bf16 bf16v2_t __attribute__((ext_vector_type(2)));
typedef float f32v2_t __attribute__((ext_vector_type(2)));
DI unsigned pack2(float a, float b) { f32v2_t v = {a, b}; bf16v2_t r = __builtin_convertvector(v, bf16v2_t); return __builtin_bit_cast(unsigned, r); }
DI float sigmoidf_(float x) { return 1.f / (1.f + __expf(-x)); }
DI float gelu_tanh(float x) { float u = 0.7978845608028654f * (x + 0.044715f * x * x * x); return x * sigmoidf_(2.f * u); }
DI float softplusf_(float x) { return fmaxf(x, 0.f) + __logf(1.f + __expf(-fabsf(x))); }
DI float wave_sum(float v) {
  for (int o = 32; o > 0; o >>= 1) v += __shfl_xor(v, o);
  return v;
}

template <int NT>
DI void gemm_core(const u16* __restrict__ A, int lda, const u16* __restrict__ B, int ldb, int K, f32x4 (&acc)[4][NT], char* smem) {
  constexpr int BN = NT * 32;
  constexpr int NBL = BN / 32;
  const int tid = TID(), lane = tid & 63, wid = tid >> 6, wr = wid >> 1, wc = wid & 1, fr = lane & 15, fq = lane >> 4;
  char* As = smem;
  char* Bs = smem + 2 * 16384;
  const int lrow = tid >> 3, lch = tid & 7;
  const int gch = lch ^ ((lrow >> 1) & 7);
  const u16* ag = A + (size_t)lrow * lda + gch * 8;
  const u16* bg = B + (size_t)lrow * ldb + gch * 8;
  const int soff = tid * 16;
  const int sw = (fr >> 1) & 7;
  const int aoff = (wr * 64 + fr) * 128, boff = (wc * (BN / 2) + fr) * 128;
  const int nk = K >> 6;
  __syncthreads();
#pragma unroll
  for (int i = 0; i < 4; ++i) __builtin_amdgcn_global_load_lds((const unsigned*)(ag + (size_t)i * 32 * lda), (unsigned*)(As + soff + i * 4096), 16, 0, 0);
#pragma unroll
  for (int i = 0; i < NBL; ++i) __builtin_amdgcn_global_load_lds((const unsigned*)(bg + (size_t)i * 32 * ldb), (unsigned*)(Bs + soff + i * 4096), 16, 0, 0);
  asm volatile("s_waitcnt vmcnt(0)" ::: "memory");
  __syncthreads();
  for (int kt = 0; kt < nk; ++kt) {
    const int buf = kt & 1;
    if (kt + 1 < nk) {
      const int nb = buf ^ 1;
#pragma unroll
      for (int i = 0; i < 4; ++i)
        __builtin_amdgcn_global_load_lds((const unsigned*)(ag + (size_t)i * 32 * lda + (kt + 1) * 64), (unsigned*)(As + nb * 16384 + soff + i * 4096), 16, 0, 0);
#pragma unroll
      for (int i = 0; i < NBL; ++i)
        __builtin_amdgcn_global_load_lds((const unsigned*)(bg + (size_t)i * 32 * ldb + (kt + 1) * 64), (unsigned*)(Bs + nb * (BN * 128) + soff + i * 4096), 16, 0, 0);
    }
    const char* Ab = As + buf * 16384 + aoff;
    const char* Bb = Bs + buf * (BN * 128) + boff;
#pragma unroll
    for (int ks = 0; ks < 2; ++ks) {
      bf16x8 af[4], bfr[NT];
      const int co = ((ks * 4 + fq) ^ sw) << 4;
#pragma unroll
      for (int m = 0; m < 4; ++m) af[m] = *(const bf16x8*)(Ab + m * 2048 + co);
#pragma unroll
      for (int n = 0; n < NT; ++n) bfr[n] = *(const bf16x8*)(Bb + n * 2048 + co);
#pragma unroll
      for (int m = 0; m < 4; ++m)
#pragma unroll
        for (int n = 0; n < NT; ++n) acc[m][n] = MFMA16(af[m], bfr[n], acc[m][n]);
    }
    asm volatile("s_waitcnt vmcnt(0)" ::: "memory");
    __syncthreads();
  }
}

template <int NT>
DI void zero_acc(f32x4 (&acc)[4][NT]) {
#pragma unroll
  for (int m = 0; m < 4; ++m)
#pragma unroll
    for (int n = 0; n < NT; ++n) acc[m][n] = f32x4{0.f, 0.f, 0.f, 0.f};
}

template <int KS>
DI f32x4 lds_mm(const u16* As, int lsa, int arow, const u16* Bs, int lsb, int brow, f32x4 acc) {
  const int lane = TID() & 63, fr = lane & 15, fq = lane >> 4;
#pragma unroll
  for (int ks = 0; ks < KS; ++ks) {
    bf16x8 a = *(const bf16x8*)(As + (arow + fr) * lsa + ks * 32 + fq * 8);
    bf16x8 b = *(const bf16x8*)(Bs + (brow + fr) * lsb + ks * 32 + fq * 8);
    acc = MFMA16(a, b, acc);
  }
  return acc;
}

constexpr int PREP_T_PER_LAYER = 66 * 16 + 48 * 16 + 3 * 128 + 256 + 3 * 704 + 16;
constexpr int PREP_T = PREP_T_PER_LAYER * NL;
constexpr int PREP_COPY = MT * 1024 / 4096;
constexpr int PREP_ROPE = 8192 * 8 / 256;
constexpr int PREP_ITEMS = PREP_T + PREP_COPY + PREP_ROPE + 1;

DI void transpose_tile(const float* src, int lds_, int k0, int c0, int ncols_valid, u16* dst, int ldd, int n0, float* tile) {
  const int tid = TID();
  __syncthreads();
#pragma unroll
  for (int i = 0; i < 16; ++i) {
    int e = tid + i * 256, r = e >> 6, c = e & 63;
    tile[r * 65 + c] = (c < ncols_valid) ? src[(size_t)(k0 + r) * lds_ + c0 + c] : 0.f;
  }
  __syncthreads();
#pragma unroll
  for (int i = 0; i < 16; ++i) {
    int e = tid + i * 256, c = e >> 6, r = e & 63;
    dst[(size_t)(n0 + c) * ldd + k0 + r] = f2bf(tile[r * 65 + c]);
  }
}

DI void prep_item(const Params& p, int it, char* smem) {
  const int tid = TID();
  if (it < PREP_T) {
    const int l = it / PREP_T_PER_LAYER;
    int t = it % PREP_T_PER_LAYER;
    u16* W = (u16*)(p.ws + O_WT) + (size_t)l * W_LAYER;
    float* tile = (float*)smem;
    if (t < 66 * 16) {
      int nt = t / 16, kt = t % 16, n0 = nt * 64, c0, nv = 64;
      if (n0 < 3072) c0 = n0; else if (n0 < 4096) c0 = n0 + 16; else if (n0 == 4096) { c0 = 3072; nv = 16; } else { c0 = 0; nv = 0; }
      transpose_tile(p.in[9] + (size_t)l * 1024 * PW, PW, kt * 64, c0, nv, W + W_IN, 1024, n0, tile);
      return;
    }
    t -= 66 * 16;
    if (t < 48 * 16) { transpose_tile(p.in[25] + (size_t)l * 1024 * 3072, 3072, (t % 16) * 64, (t / 16) * 64, 64, W + W_MG, 1024, (t / 16) * 64, tile); return; }
    t -= 48 * 16;
    if (t < 3 * 128) {
      int br = t / 128, tt = t % 128;
      transpose_tile(p.in[22 + br] + (size_t)l * 512 * 1024, 1024, (tt % 8) * 64, (tt / 8) * 64, 64, W + W_BR + (size_t)br * 1024 * 512, 512, (tt / 8) * 64, tile);
      return;
    }
    t -= 3 * 128;
    if (t < 256) { transpose_tile(p.in[27] + (size_t)l * 1024 * 1024, 1024, (t % 16) * 64, (t / 16) * 64, 64, W + W_OUT, 1024, (t / 16) * 64, tile); return; }
    t -= 256;
    if (t < 704) { transpose_tile(p.in[29] + (size_t)l * 1024 * DFF, DFF, (t % 16) * 64, (t / 16) * 64, 64, W + W_FG, 1024, (t / 16) * 64, tile); return; }
    t -= 704;
    if (t < 704) { transpose_tile(p.in[32] + (size_t)l * 1024 * DFF, DFF, (t % 16) * 64, (t / 16) * 64, 64, W + W_FU, 1024, (t / 16) * 64, tile); return; }
    t -= 704;
    if (t < 704) { transpose_tile(p.in[33] + (size_t)l * DFF * 1024, 1024, (t % 44) * 64, (t / 44) * 64, 64, W + W_FD, DFF, (t / 44) * 64, tile); return; }
    t -= 704;
    if (t < 8) { transpose_tile(p.in[17] + (size_t)l * 32768 + t * 4096, 64, 0, 0, 64, W + W_WA + t * 4096, 64, 0, tile); return; }
    t -= 8;
    transpose_tile(p.in[19] + (size_t)l * 32768 + t * 4096, 64, 0, 0, 64, W + W_WX + t * 4096, 64, 0, tile);
    return;
  }
  it -= PREP_T;
  if (it < PREP_COPY) {
    size_t base = (size_t)it * 4096;
    float* X = p.out;
#pragma unroll
    for (int i = 0; i < 4; ++i) {
      size_t e = base + (size_t)(tid + i * 256) * 4;
      float4 v = (e < (size_t)MP * 1024) ? *(const float4*)(p.in[0] + e) : *(const float4*)(p.in[1] + (e - (size_t)MP * 1024));
      *(float4*)(X + e) = v;
    }
    return;
  }
  it -= PREP_COPY;
  if (it < PREP_ROPE) {
    int e = it * 256 + tid, pos = e >> 3, i = e & 7;
    double inv = pow(500000.0, -(double)i / 8.0);
    double ang = (double)pos * inv;
    double kq = rint(ang * 0.15915494309189535);
    double r = ang - kq * 6.283185307179586;
    float rf = (float)r;
    float* cs = (float*)(p.ws + O_ROPE);
    cs[e] = cosf(rf);
    cs[8192 * 8 + e] = sinf(rf);
    return;
  }
  if (tid < 64 * NL) {
    int l = tid >> 6, i = tid & 63;
    const float* lq = p.in[10] + (size_t)l * 256;
    float a = lq[i] * lq[64 + i], b = lq[128 + i] * lq[192 + i];
    a = wave_sum(a); b = wave_sum(b);
    if (i == 0) {
      float lam_init = 0.8f - 0.6f * __expf(-0.3f * (float)l);
      ((float*)(p.ws + O_LAM))[l] = __expf(a) - __expf(b) + lam_init;
    }
  }
}

DI void norm_item(const Params& p, int it, const float* gamma, bool final_) {
  const int lane = TID() & 63, wid = TID() >> 6;
  const int row = it * 4 + wid;
  float* X = p.out + (size_t)row * 1024;
  float4 v[4];
  float ss = 0.f;
#pragma unroll
  for (int i = 0; i < 4; ++i) { v[i] = *(const float4*)(X + i * 256 + lane * 4); ss += v[i].x * v[i].x + v[i].y * v[i].y + v[i].z * v[i].z + v[i].w * v[i].w; }
  ss = wave_sum(ss);
  const float rs = rsqrtf(ss * (1.f / 1024.f) + EPS);
  u16* XN = (u16*)(p.ws + O_XN) + (size_t)row * 1024;
#pragma unroll
  for (int i = 0; i < 4; ++i) {
    float4 g = *(const float4*)(gamma + i * 256 + lane * 4);
    float4 o = {v[i].x * rs * g.x, v[i].y * rs * g.y, v[i].z * rs * g.z, v[i].w * rs * g.w};
    if (final_) *(float4*)(X + i * 256 + lane * 4) = o;
    else *(uint2*)(XN + i * 256 + lane * 4) = uint2{pack2(o.x, o.y), pack2(o.z, o.w)};
  }
}

constexpr int PB_GEMM = 260 * 33;
constexpr int PB_KC = SBT * PAST * 512 / 4096;
constexpr int PB_VC = SBT * 32 * 8;
constexpr int PB_ITEMS = PB_GEMM + PB_KC + PB_VC;

DI void projin_tile(const Params& p, int l, int it, char* smem) {
  const int mt = it / 33, nt = it % 33;
  const int row0 = mt * 128, col0 = nt * 128;
  const u16* W = (const u16*)(p.ws + O_WT) + (size_t)l * W_LAYER + W_IN;
  const u16* XN = (const u16*)(p.ws + O_XN);
  f32x4 acc[4][4];
  zero_acc<4>(acc);
  gemm_core<4>(XN + (size_t)row0 * 1024, 1024, W + (size_t)col0 * 1024, 1024, 1024, acc, smem);
  const int tid = TID(), lane = tid & 63, wid = tid >> 6, wr = wid >> 1, wc = wid & 1, fr = lane & 15, fq = lane >> 4;
  const bool isS = row0 >= MP;
  const float* cosT = (const float*)(p.ws + O_ROPE);
  const float* sinT = cosT + 8192 * 8;
  if (nt < 8) {
    const bool isq = nt < 4;
    u16* QB = (u16*)(p.ws + O_QB);
    u16* KB = (u16*)(p.ws + O_KB);
    u16* KS = (u16*)(p.ws + O_KS);
#pragma unroll
    for (int m = 0; m < 4; ++m)
#pragma unroll
      for (int n = 0; n < 4; ++n)
#pragma unroll
        for (int j = 0; j < 4; ++j) {
          const int row = row0 + wr * 64 + m * 16 + fq * 4 + j;
          const int col = col0 + wc * 64 + n * 16 + fr;
          float v = acc[m][n][j];
          int b, t;
          if (isS) { int rs = row - MP; b = rs >> 5; t = rs & 31; } else { b = row >> 13; t = row & 8191; }
          const int pos = isS ? PAST + t : t;
          if (n == 0) {
            float pr = __shfl_xor(v, 8);
            float cs = cosT[pos * 8 + (fr & 7)], sn = sinT[pos * 8 + (fr & 7)];
            v = (fr < 8) ? v * cs - pr * sn : v * cs + pr * sn;
          }
          if (isq) {
            QB[(size_t)row * 512 + col] = f2bf(v * 0.125f);
          } else {
            const int ck = col - 512;
            if (isS) {
              p.out[K_S + ((size_t)l * MS + (row - MP)) * 512 + ck] = v;
              KS[((size_t)b * SKP + PAST + t) * 512 + ck] = f2bf(v);
            } else {
              p.out[K_P + ((size_t)l * MP + row) * 512 + ck] = v;
              KB[(size_t)row * 512 + ck] = f2bf(v);
            }
          }
        }
  } else if (nt < 12) {
    u16* VT = (u16*)(p.ws + O_VT);
    u16* VTS = (u16*)(p.ws + O_VTS);
#pragma unroll
    for (int m = 0; m < 4; ++m)
#pragma unroll
      for (int n = 0; n < 4; ++n) {
        const int rowb = row0 + wr * 64 + m * 16 + fq * 4;
        const int cv = col0 - 1024 + wc * 64 + n * 16 + fr;
        const int h = cv >> 7, vd = cv & 127;
        int b, t;
        if (isS) { int rs = rowb - MP; b = rs >> 5; t = rs & 31; } else { b = rowb >> 13; t = rowb & 8191; }
#pragma unroll
        for (int j = 0; j < 4; ++j) {
          if (isS) p.out[V_S + ((size_t)l * MS + (rowb + j - MP)) * 512 + cv] = acc[m][n][j];
          else p.out[V_P + ((size_t)l * MP + rowb + j) * 512 + cv] = acc[m][n][j];
        }
        uint2 pk = {pack2(acc[m][n][0], acc[m][n][1]), pack2(acc[m][n][2], acc[m][n][3])};
        if (isS) *(uint2*)(VTS + ((size_t)(b * 4 + h) * 128 + vd) * SKP + PAST + t) = pk;
        else *(uint2*)(VT + ((size_t)(b * 4 + h) * 128 + vd) * PT + t) = pk;
      }
  } else {
    u16* dst16 = nullptr; float* dst32 = nullptr; int ld = 0, cbase = 0; float scale = 1.f;
    if (nt < 14) { dst16 = (u16*)(p.ws + O_GQ); ld = 256; cbase = 1536; scale = 0.125f; }
    else if (nt < 16) { dst16 = (u16*)(p.ws + O_GK); ld = 256; cbase = 1792; }
    else if (nt < 20) { dst16 = (u16*)(p.ws + O_GV); ld = 512; cbase = 2048; }
    else if (nt < 24) { dst16 = (u16*)(p.ws + O_GR); ld = 512; cbase = 2560; }
    else if (nt < 28) { dst32 = (float*)(p.ws + O_LX); ld = 512; cbase = 3072; }
    else if (nt < 32) { dst16 = (u16*)(p.ws + O_LG); ld = 512; cbase = 3584; }
    else { dst32 = (float*)(p.ws + O_GA); ld = 16; cbase = 4096; }
#pragma unroll
    for (int m = 0; m < 4; ++m)
#pragma unroll
      for (int n = 0; n < 4; ++n)
#pragma unroll
        for (int j = 0; j < 4; ++j) {
          const int row = row0 + wr * 64 + m * 16 + fq * 4 + j;
          const int c = col0 + wc * 64 + n * 16 + fr - cbase;
          const float v = acc[m][n][j] * scale;
          if (c < ld) {
            if (dst16) dst16[(size_t)row * ld + c] = f2bf(v);
            else dst32[(size_t)row * ld + c] = v;
          }
        }
  }
}

DI void cache_conv_item(const Params& p, int l, int it, char* smem) {
  const int tid = TID();
  if (it < PB_KC) {
    const float* src = p.in[2] + (size_t)l * SBT * PAST * 512;
    u16* KS = (u16*)(p.ws + O_KS);
#pragma unroll
    for (int i = 0; i < 4; ++i) {
      size_t e = (size_t)it * 4096 + (size_t)(tid + i * 256) * 4;
      float4 v = *(const float4*)(src + e);
      size_t b = e / ((size_t)PAST * 512), r = e % ((size_t)PAST * 512);
      *(uint2*)(KS + b * SKP * 512 + r) = uint2{pack2(v.x, v.y), pack2(v.z, v.w)};
    }
    return;
  }
  it -= PB_KC;
  const int b = it / 256, r = it % 256, ptile = r / 8, ctile = r % 8;
  const float* src = p.in[3] + ((size_t)l * SBT + b) * PAST * 512;
  u16* VTS = (u16*)(p.ws + O_VTS);
  transpose_tile(src, 512, ptile * 64, ctile * 64, 64, VTS + (size_t)b * 512 * SKP, SKP, ctile * 64, (float*)smem);
}

DI int kswz(int key) { return (((key >> 3) & 3) << 2) | (key & 3); }

DI void attn_item(const Params& p, int l, int idx, char* smem) {
  const int tid = TID(), lane = tid & 63, wid = tid >> 6, fr = lane & 15, fq = lane >> 4;
  bool isS; int b, h, c;
  if (idx < 2048) {
    isS = false;
    const int r = idx >> 9, pos = idx & 511, q = pos >> 4, base = 127 - 32 * r;
    c = (r & 1) ? base - 31 + q : base - q;
    b = (pos & 15) >> 2; h = pos & 3;
  } else { isS = true; const int s = idx - 2048; b = s >> 2; h = s & 3; c = 0; }
  const int nkt = isS ? 33 : c + 1;
  const int klen = isS ? SKV : (c + 1) * 64;
  const u16* QB = (const u16*)(p.ws + O_QB);
  const u16* Kg = isS ? (const u16*)(p.ws + O_KS) + (size_t)b * SKP * 512 + h * 128 : (const u16*)(p.ws + O_KB) + (size_t)b * PT * 512 + h * 128;
  const int vstride = isS ? SKP : PT;
  const u16* Vg = (isS ? (const u16*)(p.ws + O_VTS) : (const u16*)(p.ws + O_VT)) + (size_t)(b * 4 + h) * 128 * vstride;
  const int qrow0 = isS ? MP + b * 32 : b * PT + c * 64;
  const bool active = isS ? (wid < 2) : true;
  const int qrow = qrow0 + wid * 16 + fr;
  bf16x8 qf[2][2];
#pragma unroll
  for (int mp = 0; mp < 2; ++mp)
#pragma unroll
    for (int ks = 0; ks < 2; ++ks)
      qf[mp][ks] = active ? *(const bf16x8*)(QB + (size_t)qrow * 512 + h * 128 + mp * 64 + ks * 32 + fq * 8) : bf16x8{0, 0, 0, 0, 0, 0, 0, 0};
  f32x4 ot[2][8];
#pragma unroll
  for (int mp = 0; mp < 2; ++mp)
#pragma unroll
    for (int n = 0; n < 8; ++n) ot[mp][n] = f32x4{0.f, 0.f, 0.f, 0.f};
  float mrun[2] = {-INFINITY, -INFINITY}, lrun[2] = {0.f, 0.f};
  char* Ks = smem;
  char* Vs = smem + 32768;
  const int kkey = tid >> 4, vvd = tid >> 3;
  const int vgch = (tid & 7) ^ ((vvd >> 1) & 7);
  const int soff = tid * 16;
  __syncthreads();
#pragma unroll
  for (int i = 0; i < 4; ++i) {
    const int key = kkey + i * 16;
    const int kgch = (tid & 15) ^ kswz(key);
    __builtin_amdgcn_global_load_lds((const unsigned*)(Kg + (size_t)key * 512 + kgch * 8), (unsigned*)(Ks + soff + i * 4096), 16, 0, 0);
    __builtin_amdgcn_global_load_lds((const unsigned*)(Vg + (size_t)(vvd + i * 32) * vstride + vgch * 8), (unsigned*)(Vs + soff + i * 4096), 16, 0, 0);
  }
  asm volatile("s_waitcnt vmcnt(0)" ::: "memory");
  __syncthreads();
  for (int kt = 0; kt < nkt; ++kt) {
    const int buf = kt & 1;
    const bool more = kt + 1 < nkt;
    if (more) {
      const int nb = buf ^ 1;
#pragma unroll
      for (int i = 0; i < 4; ++i) {
        const int key = kkey + i * 16;
        const int kgch = (tid & 15) ^ kswz(key);
        __builtin_amdgcn_global_load_lds((const unsigned*)(Kg + (size_t)((kt + 1) * 64 + key) * 512 + kgch * 8), (unsigned*)(Ks + nb * 16384 + soff + i * 4096), 16, 0, 0);
        __builtin_amdgcn_global_load_lds((const unsigned*)(Vg + (size_t)(vvd + i * 32) * vstride + (kt + 1) * 64 + vgch * 8), (unsigned*)(Vs + nb * 16384 + soff + i * 4096), 16, 0, 0);
      }
    }
    if (active) {
      const char* Kb = Ks + buf * 16384;
      const char* Vb = Vs + buf * 16384;
      f32x4 st[2][4];
#pragma unroll
      for (int mp = 0; mp < 2; ++mp)
#pragma unroll
        for (int mt = 0; mt < 4; ++mt) {
          const int key = 32 * (mt >> 1) + 8 * (fr >> 2) + 4 * (mt & 1) + (fr & 3);
          f32x4 a = {0.f, 0.f, 0.f, 0.f};
#pragma unroll
          for (int ks = 0; ks < 2; ++ks) {
            bf16x8 kf = *(const bf16x8*)(Kb + key * 256 + (((mp * 8 + ks * 4 + fq) ^ kswz(key)) << 4));
            a = MFMA16(kf, qf[mp][ks], a);
          }
          st[mp][mt] = a;
        }
      const bool needmask = (kt + 1) * 64 > klen;
#pragma unroll
      for (int mp = 0; mp < 2; ++mp) {
        if (needmask) {
#pragma unroll
          for (int mt = 0; mt < 4; ++mt)
#pragma unroll
            for (int j = 0; j < 4; ++j) {
              const int key = kt * 64 + 32 * (mt >> 1) + 8 * fq + 4 * (mt & 1) + j;
              if (key >= klen) st[mp][mt][j] = -INFINITY;
            }
        }
        float mx = -INFINITY;
#pragma unroll
        for (int mt = 0; mt < 4; ++mt)
#pragma unroll
          for (int j = 0; j < 4; ++j) mx = fmaxf(mx, st[mp][mt][j]);
        mx = fmaxf(mx, __shfl_xor(mx, 16));
        mx = fmaxf(mx, __shfl_xor(mx, 32));
        const float mnew = fmaxf(mrun[mp], mx);
        const float alpha = __expf(mrun[mp] - mnew);
        mrun[mp] = mnew;
        float ps = 0.f;
#pragma unroll
        for (int mt = 0; mt < 4; ++mt)
#pragma unroll
          for (int j = 0; j < 4; ++j) { float e = __expf(st[mp][mt][j] - mnew); st[mp][mt][j] = e; ps += e; }
        lrun[mp] = lrun[mp] * alpha + ps;
#pragma unroll
        for (int n = 0; n < 8; ++n) { ot[mp][n][0] *= alpha; ot[mp][n][1] *= alpha; ot[mp][n][2] *= alpha; ot[mp][n][3] *= alpha; }
      }
      bf16x8 pf[2][2];
#pragma unroll
      for (int mp = 0; mp < 2; ++mp)
#pragma unroll
        for (int s = 0; s < 2; ++s) {
          uint4 u = {pack2(st[mp][2 * s][0], st[mp][2 * s][1]), pack2(st[mp][2 * s][2], st[mp][2 * s][3]),
                     pack2(st[mp][2 * s + 1][0], st[mp][2 * s + 1][1]), pack2(st[mp][2 * s + 1][2], st[mp][2 * s + 1][3])};
          pf[mp][s] = __builtin_bit_cast(bf16x8, u);
        }
#pragma unroll
      for (int n = 0; n < 8; ++n) {
        const int vd = n * 16 + fr;
#pragma unroll
        for (int s = 0; s < 2; ++s) {
          bf16x8 vf = *(const bf16x8*)(Vb + vd * 128 + (((s * 4 + fq) ^ ((vd >> 1) & 7)) << 4));
          ot[0][n] = MFMA16(vf, pf[0][s], ot[0][n]);
          ot[1][n] = MFMA16(vf, pf[1][s], ot[1][n]);
        }
      }
    }
    asm volatile("s_waitcnt vmcnt(0)" ::: "memory");
    __syncthreads();
  }
  if (active) {
    float l0 = lrun[0], l1 = lrun[1];
    l0 += __shfl_xor(l0, 16); l0 += __shfl_xor(l0, 32);
    l1 += __shfl_xor(l1, 16); l1 += __shfl_xor(l1, 32);
    const float lam = ((const float*)(p.ws + O_LAM))[l];
    const float lam_init = 0.8f - 0.6f * __expf(-0.3f * (float)l);
    const float i0 = 1.f / l0, i1 = lam / l1;
    float ss = 0.f;
#pragma unroll
    for (int n = 0; n < 8; ++n)
#pragma unroll
      for (int j = 0; j < 4; ++j) { float o = ot[0][n][j] * i0 - ot[1][n][j] * i1; ot[0][n][j] = o; ss += o * o; }
    ss += __shfl_xor(ss, 16); ss += __shfl_xor(ss, 32);
    const float rs = rsqrtf(ss * (1.f / 128.f) + EPS) * (1.f - lam_init);
    const float* g = p.in[11] + (size_t)l * 128;
    u16* OA = (u16*)(p.ws + O_OA) + (size_t)qrow * 512 + h * 128;
#pragma unroll
    for (int n = 0; n < 8; ++n) {
      const int vd = n * 16 + fq * 4;
      float4 gg = *(const float4*)(g + vd);
      *(uint2*)(OA + vd) = uint2{pack2(ot[0][n][0] * rs * gg.x, ot[0][n][1] * rs * gg.y), pack2(ot[0][n][2] * rs * gg.z, ot[0][n][3] * rs * gg.w)};
    }
  }
}

constexpr int LP = 72;
constexpr int BCS = 68;
DI void gla_decode(int gi, bool& isS, int& b, int& h, int& c, int& row0, int& Lc) {
  if (gi < PB * 4 * 128) { isS = false; c = gi & 127; h = (gi >> 7) & 3; b = gi >> 9; row0 = b * PT + c * 64; Lc = 64; }
  else { isS = true; int s = gi - PB * 4 * 128; b = s >> 2; h = s & 3; c = 0; row0 = MP + b * 32; Lc = 32; }
}
DI void gla_bcum(const Params& p, int l, int row0, int Lc, int h, float* bc, float* tot, float* gas) {
  const int tid = TID(), kd = tid & 63, tq = tid >> 6;
  const float* W2 = p.in[12] + (size_t)l * 16 * 256 + h * 64 + kd;
  const float b2 = p.in[13][(size_t)l * 256 + h * 64 + kd];
  const float* GA = (const float*)(p.ws + O_GA);
  {
    const int r = tid >> 2, part = tid & 3;
    float4 v = {0.f, 0.f, 0.f, 0.f};
    if (r < Lc) v = *(const float4*)(GA + (size_t)(row0 + r) * 16 + part * 4);
    *(float4*)(gas + r * 16 + part * 4) = v;
  }
  float w[16];
#pragma unroll
  for (int r = 0; r < 16; ++r) w[r] = W2[r * 256];
  __syncthreads();
  float run = 0.f;
#pragma unroll
  for (int i = 0; i < 16; ++i) {
    const int t = tq * 16 + i;
    const float4* ga = (const float4*)(gas + t * 16);
    const float4 g0 = ga[0], g1 = ga[1], g2 = ga[2], g3 = ga[3];
    const float x = b2 + g0.x * w[0] + g0.y * w[1] + g0.z * w[2] + g0.w * w[3] + g1.x * w[4] + g1.y * w[5] + g1.z * w[6] + g1.w * w[7] +
                    g2.x * w[8] + g2.y * w[9] + g2.z * w[10] + g2.w * w[11] + g3.x * w[12] + g3.y * w[13] + g3.z * w[14] + g3.w * w[15];
    const float la = (t < Lc) ? -softplusf_(-x) * (1.f / 16.f) : 0.f;
    run += la;
    bc[t * BCS + kd] = run;
  }
  tot[tq * 64 + kd] = run;
  __syncthreads();
  float off = 0.f;
  for (int g = 0; g < tq; ++g) off += tot[g * 64 + kd];
#pragma unroll
  for (int i = 0; i < 16; ++i) bc[(tq * 16 + i) * BCS + kd] += off;
  __syncthreads();
}
DI void gla_load_vt(const Params& p, int row0, int Lc, int h, u16* vt) {
  const int tid = TID(), s = tid & 63, cg4 = tid >> 6;
  const u16* GV = (const u16*)(p.ws + O_GV) + (size_t)(row0 + s) * 512 + h * 128;
  u32x4 v[4];
#pragma unroll
  for (int i = 0; i < 4; ++i) v[i] = (s < Lc) ? *(const u32x4*)(GV + (cg4 + 4 * i) * 8) : u32x4{0u, 0u, 0u, 0u};
#pragma unroll
  for (int i = 0; i < 4; ++i) {
    const int vd0 = (cg4 + 4 * i) * 8;
#pragma unroll
    for (int e = 0; e < 4; ++e) {
      vt[(vd0 + 2 * e) * LP + s] = (u16)(v[i][e] & 0xffffu);
      vt[(vd0 + 2 * e + 1) * LP + s] = (u16)(v[i][e] >> 16);
    }
  }
}

DI void gla1_item(const Params& p, int l, int gi, char* smem) {
  bool isS; int b, h, c, row0, Lc;
  gla_decode(gi, isS, b, h, c, row0, Lc);
  const int tid = TID(), lane = tid & 63, wid = tid >> 6, fr = lane & 15, fq = lane >> 4;
  float* bc = (float*)smem;
  float* tot = (float*)(smem + 17408);
  u16* kh = (u16*)(smem + 18432);
  u16* vt = (u16*)(smem + 18432 + 9216);
  __syncthreads();
  gla_bcum(p, l, row0, Lc, h, bc, tot, (float*)kh);
  {
    const int s = tid & 63, c2 = tid >> 6;
    const u16* GK = (const u16*)(p.ws + O_GK) + (size_t)(row0 + s) * 256 + h * 64;
    u32x4 kv[2];
#pragma unroll
    for (int i = 0; i < 2; ++i) kv[i] = (s < Lc) ? *(const u32x4*)(GK + (c2 + 4 * i) * 8) : u32x4{0u, 0u, 0u, 0u};
#pragma unroll
    for (int i = 0; i < 2; ++i) {
      const int kd0 = (c2 + 4 * i) * 8;
#pragma unroll
      for (int e = 0; e < 8; ++e) {
        const unsigned w = kv[i][e >> 1];
        const float kf = bf2f((u16)((e & 1) ? (w >> 16) : (w & 0xffffu)));
        const float bl = bc[63 * BCS + kd0 + e];
        kh[(kd0 + e) * LP + s] = f2bf(kf * __expf(bl - bc[s * BCS + kd0 + e]));
      }
    }
    if (tid < 64) ((float*)(p.ws + O_DEC))[(size_t)gi * 64 + tid] = __expf(bc[63 * BCS + tid]);
  }
  gla_load_vt(p, row0, Lc, h, vt);
  __syncthreads();
  u16* KVT = (u16*)(p.ws + O_KVT) + (size_t)gi * 8192;
#pragma unroll
  for (int mi = 0; mi < 2; ++mi)
#pragma unroll
    for (int n = 0; n < 4; ++n) {
      const int m = wid * 2 + mi;
      f32x4 a = lds_mm<2>(vt, LP, m * 16, kh, LP, n * 16, f32x4{0.f, 0.f, 0.f, 0.f});
#pragma unroll
      for (int j = 0; j < 4; ++j) KVT[(m * 16 + fq * 4 + j) * 64 + n * 16 + fr] = f2bf(a[j]);
    }
}

constexpr int G2_ITEMS = (PB * 4 + SBT * 4) * 32;
DI void gla2_item(const Params& p, int l, int it) {
  const int seq = it >> 5, e = (it & 31) * 256 + TID();
  const int vd = e >> 6, kd = e & 63;
  u16* KVT = (u16*)(p.ws + O_KVT);
  const float* DEC = (const float*)(p.ws + O_DEC);
  if (seq < PB * 4) {
    float S = 0.f;
    const int gi0 = seq * 128;
    for (int c0 = 0; c0 < 128; c0 += 16) {
      u16 kvv[16]; float dd[16];
#pragma unroll
      for (int c = 0; c < 16; ++c) { kvv[c] = KVT[(size_t)(gi0 + c0 + c) * 8192 + e]; dd[c] = DEC[(size_t)(gi0 + c0 + c) * 64 + kd]; }
#pragma unroll
      for (int c = 0; c < 16; ++c) { KVT[(size_t)(gi0 + c0 + c) * 8192 + e] = f2bf(S); S = dd[c] * S + bf2f(kvv[c]); }
    }
    p.out[GLA_P + ((size_t)l * PB * 4 + seq) * 8192 + kd * 128 + vd] = S;
  } else {
    const int s = seq - PB * 4, gi = PB * 4 * 128 + s;
    const float S0 = p.in[4][((size_t)l * SBT * 4 + s) * 8192 + kd * 128 + vd];
    u16* q = KVT + (size_t)gi * 8192 + e;
    const float kv = bf2f(*q);
    const float d = DEC[(size_t)gi * 64 + kd];
    *q = f2bf(S0);
    p.out[GLA_S + ((size_t)l * SBT * 4 + s) * 8192 + kd * 128 + vd] = d * S0 + kv;
  }
}

DI void gla3_item(const Params& p, int l, int gi, char* smem) {
  bool isS; int b, h, c, row0, Lc;
  gla_decode(gi, isS, b, h, c, row0, Lc);
  const int tid = TID(), lane = tid & 63, wid = tid >> 6, fr = lane & 15, fq = lane >> 4;
  float* bc = (float*)smem;
  u16* att = (u16*)smem;
  float* tot = (float*)(smem + 17408);
  u16* qt = (u16*)(smem + 18432);
  u16* kt_ = (u16*)(smem + 18432 + 9216);
  u16* vt = (u16*)(smem + 18432 + 2 * 9216);
  u16* st = (u16*)(smem + 18432 + 2 * 9216 + 18432);
  __syncthreads();
  gla_bcum(p, l, row0, Lc, h, bc, tot, (float*)qt);
  const u16* KVT = (const u16*)(p.ws + O_KVT) + (size_t)gi * 8192;
  {
    const int s = tid & 63, c2 = tid >> 6;
    const u16* GQ = (const u16*)(p.ws + O_GQ) + (size_t)(row0 + s) * 256 + h * 64;
    const u16* GK = (const u16*)(p.ws + O_GK) + (size_t)(row0 + s) * 256 + h * 64;
    u32x4 qv[2], kv[2], sv[4];
#pragma unroll
    for (int i = 0; i < 2; ++i) {
      qv[i] = (s < Lc) ? *(const u32x4*)(GQ + (c2 + 4 * i) * 8) : u32x4{0u, 0u, 0u, 0u};
      kv[i] = (s < Lc) ? *(const u32x4*)(GK + (c2 + 4 * i) * 8) : u32x4{0u, 0u, 0u, 0u};
    }
#pragma unroll
    for (int i = 0; i < 4; ++i) { const int id = tid + i * 256; sv[i] = *(const u32x4*)(KVT + (id >> 3) * 64 + (id & 7) * 8); }
#pragma unroll
    for (int i = 0; i < 2; ++i) {
      const int kd0 = (c2 + 4 * i) * 8;
      u32x4 qo, ko;
#pragma unroll
      for (int e2 = 0; e2 < 4; ++e2) {
        const float b0 = bc[s * BCS + kd0 + 2 * e2], b1 = bc[s * BCS + kd0 + 2 * e2 + 1];
        const float e0 = __expf(b0), e1 = __expf(b1);
        const float q0 = bf2f((u16)(qv[i][e2] & 0xffffu)) * e0, q1 = bf2f((u16)(qv[i][e2] >> 16)) * e1;
        const float k0 = bf2f((u16)(kv[i][e2] & 0xffffu)) / e0, k1 = bf2f((u16)(kv[i][e2] >> 16)) / e1;
        qo[e2] = pack2(q0, q1);
        ko[e2] = pack2(k0, k1);
      }
      *(u32x4*)(qt + s * LP + kd0) = qo;
      *(u32x4*)(kt_ + s * LP + kd0) = ko;
    }
#pragma unroll
    for (int i = 0; i < 4; ++i) { const int id = tid + i * 256; *(u32x4*)(st + (id >> 3) * LP + (id & 7) * 8) = sv[i]; }
  }
  gla_load_vt(p, row0, Lc, h, vt);
  __syncthreads();
  {
    f32x4 a[4];
#pragma unroll
    for (int n = 0; n < 4; ++n) a[n] = lds_mm<2>(qt, LP, wid * 16, kt_, LP, n * 16, f32x4{0.f, 0.f, 0.f, 0.f});
#pragma unroll
    for (int n = 0; n < 4; ++n)
#pragma unroll
      for (int j = 0; j < 4; ++j) {
        const int t = wid * 16 + fq * 4 + j, s = n * 16 + fr;
        att[t * LP + s] = f2bf(t >= s ? a[n][j] : 0.f);
      }
  }
  __syncthreads();
  f32x4 o[8];
#pragma unroll
  for (int n = 0; n < 8; ++n) {
    f32x4 a = lds_mm<2>(att, LP, wid * 16, vt, LP, n * 16, f32x4{0.f, 0.f, 0.f, 0.f});
    o[n] = lds_mm<2>(qt, LP, wid * 16, st, LP, n * 16, a);
  }
  const float* gn = p.in[14] + (size_t)l * 128;
  const u16* GR = (const u16*)(p.ws + O_GR);
  u16* OG = (u16*)(p.ws + O_OG);
  float gnv[8];
#pragma unroll
  for (int n = 0; n < 8; ++n) gnv[n] = gn[n * 16 + fr];
#pragma unroll
  for (int j = 0; j < 4; ++j) {
    float ss = 0.f;
#pragma unroll
    for (int n = 0; n < 8; ++n) ss += o[n][j] * o[n][j];
    ss += __shfl_xor(ss, 1); ss += __shfl_xor(ss, 2); ss += __shfl_xor(ss, 4); ss += __shfl_xor(ss, 8);
    const float rs = rsqrtf(ss * (1.f / 128.f) + EPS);
    const int t = wid * 16 + fq * 4 + j;
    if (t < Lc) {
      const size_t ro = (size_t)(row0 + t) * 512 + h * 128;
      u16 grv[8];
#pragma unroll
      for (int n = 0; n < 8; ++n) grv[n] = GR[ro + n * 16 + fr];
#pragma unroll
      for (int n = 0; n < 8; ++n) {
        const float gr = bf2f(grv[n]);
        OG[ro + n * 16 + fr] = f2bf(o[n][j] * rs * gnv[n] * gr * sigmoidf_(gr));
      }
    }
  }
}

constexpr int L1_ITEMS = NLC * 8;
DI void lru_decode(int ci, bool& isS, int& b, int& row0, int& Lc, int& t0) {
  if (ci < MP / 64) { isS = false; b = ci >> 7; t0 = (ci & 127) * 64; row0 = ci * 64; Lc = 64; }
  else { isS = true; b = ci - MP / 64; t0 = 0; row0 = MP + b * 32; Lc = 32; }
}
DI void lru1_item(const Params& p, int l, int it, char* smem) {
  const int ci = it >> 3, nb = it & 7;
  bool isS; int b, row0, Lc, t0;
  lru_decode(ci, isS, b, row0, Lc, t0);
  const int tid = TID(), lane = tid & 63, wid = tid >> 6, fr = lane & 15, fq = lane >> 4;
  u16* xcs = (u16*)smem;
  u16* was = (u16*)(smem + 9216);
  u16* wxs = (u16*)(smem + 2 * 9216);
  float* as_ = (float*)(smem + 3 * 9216);
  float* us_ = (float*)(smem + 3 * 9216 + 16384);
  float* segP = (float*)(smem + 3 * 9216 + 32768);
  float* segH = (float*)(smem + 3 * 9216 + 32768 + 1024);
  const float* LX = (const float*)(p.ws + O_LX);
  const u16* Wl = (const u16*)(p.ws + O_WT) + (size_t)l * W_LAYER;
  const int i = tid & 63, tq = tid >> 6, ch = nb * 64 + i;
  __syncthreads();
  {
    const float* cw = p.in[15] + (size_t)l * 4 * 512 + ch;
    const float w0 = cw[0], w1 = cw[512], w2 = cw[1024], w3 = cw[1536], cb = p.in[16][(size_t)l * 512 + ch];
    const float* buf = isS ? p.in[5] + ((size_t)l * SBT + b) * 3 * 512 + ch : nullptr;
    float x[19];
#pragma unroll
    for (int j = 0; j < 19; ++j) {
      const int tl = tq * 16 - 3 + j;
      const int tt = t0 + tl;
      float v = 0.f;
      if (tl < Lc) {
        if (tt >= 0) v = LX[(size_t)(row0 + tl) * 512 + ch];
        else if (isS) v = buf[(3 + tt) * 512];
      }
      x[j] = v;
    }
#pragma unroll
    for (int k = 0; k < 16; ++k) {
      const int t = tq * 16 + k;
      const float xv = (t < Lc) ? cb + w0 * x[k] + w1 * x[k + 1] + w2 * x[k + 2] + w3 * x[k + 3] : 0.f;
      xcs[t * LP + i] = f2bf(xv);
    }
#pragma unroll
    for (int k = 0; k < 2; ++k) {
      const int id = tid + k * 256, r = id >> 3, c8 = id & 7;
      *(uint4*)(was + r * LP + c8 * 8) = *(const uint4*)(Wl + W_WA + nb * 4096 + r * 64 + c8 * 8);
      *(uint4*)(wxs + r * LP + c8 * 8) = *(const uint4*)(Wl + W_WX + nb * 4096 + r * 64 + c8 * 8);
    }
    const int T = isS ? STT : PT;
    if (t0 + Lc == T && tid < 192) {
      const int k = tid >> 6;
      const float v = LX[(size_t)(row0 + Lc - 3 + k) * 512 + ch];
      if (isS) p.out[LC_S + (((size_t)l * SBT + b) * 3 + k) * 512 + ch] = v;
      else p.out[LC_P + (((size_t)l * PB + b) * 3 + k) * 512 + ch] = v;
    }
  }
  __syncthreads();
  {
    const float* ba = p.in[18] + (size_t)l * 512 + nb * 64;
    const float* bx = p.in[20] + (size_t)l * 512 + nb * 64;
    const float* lm = p.in[21] + (size_t)l * 512 + nb * 64;
#pragma unroll
    for (int n = 0; n < 4; ++n) {
      f32x4 r = lds_mm<2>(xcs, LP, wid * 16, was, LP, n * 16, f32x4{0.f, 0.f, 0.f, 0.f});
      f32x4 g = lds_mm<2>(xcs, LP, wid * 16, wxs, LP, n * 16, f32x4{0.f, 0.f, 0.f, 0.f});
      const int j = n * 16 + fr;
      const float sp = softplusf_(-lm[j]), bav = ba[j], bxv = bx[j];
#pragma unroll
      for (int q = 0; q < 4; ++q) {
        const int t = wid * 16 + fq * 4 + q;
        const float rr = sigmoidf_(r[q] + bav), ii = sigmoidf_(g[q] + bxv);
        const float la = -8.f * rr * sp;
        const float a = __expf(la);
        const float x2 = 2.f * la;
        const float om = (x2 > -0.01f) ? -x2 * (1.f + x2 * (0.5f + x2 * (1.f / 6.f))) : 1.f - __expf(x2);
        const float u = sqrtf(om) * ii * bf2f(xcs[t * LP + j]);
        as_[t * 64 + j] = a;
        us_[t * 64 + j] = u;
      }
    }
  }
  __syncthreads();
  {
    float av[16], uv[16];
#pragma unroll
    for (int k = 0; k < 16; ++k) { av[k] = as_[(tq * 16 + k) * 64 + i]; uv[k] = us_[(tq * 16 + k) * 64 + i]; }
    float P = 1.f, hh = 0.f;
#pragma unroll
    for (int k = 0; k < 16; ++k) { P *= av[k]; hh = av[k] * hh + uv[k]; }
    segP[tq * 64 + i] = P; segH[tq * 64 + i] = hh;
    __syncthreads();
    float Pin = 1.f, hin = 0.f;
    for (int g = 0; g < tq; ++g) { const float pg = segP[g * 64 + i], hg = segH[g * 64 + i]; hin = pg * hin + hg; Pin *= pg; }
    u16* HL = (u16*)(p.ws + O_HL);
    u16* PPp = (u16*)(p.ws + O_PP);
    P = Pin; hh = hin;
#pragma unroll
    for (int k = 0; k < 16; ++k) {
      const int t = tq * 16 + k;
      P *= av[k]; hh = av[k] * hh + uv[k];
      if (t < Lc) {
        HL[(size_t)(row0 + t) * 512 + ch] = f2bf(hh);
        PPp[(size_t)(row0 + t) * 512 + ch] = f2bf(P);
      }
    }
    if (tq * 16 + 16 == Lc) {
      ((float*)(p.ws + O_CA))[(size_t)ci * 512 + ch] = P;
      ((float*)(p.ws + O_CH))[(size_t)ci * 512 + ch] = hh;
    }
  }
}
constexpr int L2_ITEMS = 8 + 32;
DI void lru2_item(const Params& p, int l, int it) {
  const float* CA = (const float*)(p.ws + O_CA);
  const float* CH = (const float*)(p.ws + O_CH);
  float* HS = (float*)(p.ws + O_HS);
  if (it < 8) {
    const int e = it * 256 + TID(), b = e >> 9, ch = e & 511;
    float hh = 0.f;
    for (int c0 = 0; c0 < 128; c0 += 16) {
      float ca[16], chv[16];
#pragma unroll
      for (int c = 0; c < 16; ++c) { const size_t o = (size_t)(b * 128 + c0 + c) * 512 + ch; ca[c] = CA[o]; chv[c] = CH[o]; }
#pragma unroll
      for (int c = 0; c < 16; ++c) { const size_t o = (size_t)(b * 128 + c0 + c) * 512 + ch; HS[o] = hh; hh = ca[c] * hh + chv[c]; }
    }
    p.out[LH_P + ((size_t)l * PB + b) * 512 + ch] = hh;
  } else {
    const int e = (it - 8) * 256 + TID(), b = e >> 9, ch = e & 511;
    const float h0 = p.in[6][((size_t)l * SBT + b) * 512 + ch];
    const size_t o = (size_t)(MP / 64 + b) * 512 + ch;
    HS[o] = h0;
    p.out[LH_S + ((size_t)l * SBT + b) * 512 + ch] = CA[o] * h0 + CH[o];
  }
}
constexpr int L3_ITEMS = MT / 8;
DI void lru3_item(const Params& p, int it) {
  const u16* HL = (const u16*)(p.ws + O_HL);
  const u16* PPp = (const u16*)(p.ws + O_PP);
  const u16* LG = (const u16*)(p.ws + O_LG);
  const float* HS = (const float*)(p.ws + O_HS);
  u16* OL = (u16*)(p.ws + O_OL);
#pragma unroll
  for (int i = 0; i < 4; ++i) {
    const int id = TID() + i * 256;
    const int row = it * 8 + (id >> 7), c4 = (id & 127) * 4;
    const int ci = row < MP ? (row >> 6) : MP / 64 + ((row - MP) >> 5);
    const size_t o = (size_t)row * 512 + c4;
    const uint2 hl = *(const uint2*)(HL + o), pp = *(const uint2*)(PPp + o), lg = *(const uint2*)(LG + o);
    const float4 hs = *(const float4*)(HS + (size_t)ci * 512 + c4);
    float y0 = (bf2f(hl.x & 0xffff) + bf2f(pp.x & 0xffff) * hs.x) * gelu_tanh(bf2f(lg.x & 0xffff));
    float y1 = (bf2f(hl.x >> 16) + bf2f(pp.x >> 16) * hs.y) * gelu_tanh(bf2f(lg.x >> 16));
    float y2 = (bf2f(hl.y & 0xffff) + bf2f(pp.y & 0xffff) * hs.z) * gelu_tanh(bf2f(lg.y & 0xffff));
    float y3 = (bf2f(hl.y >> 16) + bf2f(pp.y >> 16) * hs.w) * gelu_tanh(bf2f(lg.y >> 16));
    *(uint2*)(OL + o) = uint2{pack2(y0, y1), pack2(y2, y3)};
  }
}

constexpr int PF_ITEMS = 260 * 16;
DI void merge_tile(const Params& p, int l, int it, char* smem) {
  const int mt = it >> 4, nt = it & 15;
  const int row0 = mt * 128, col0 = nt * 64;
  const u16* W = (const u16*)(p.ws + O_WT) + (size_t)l * W_LAYER;
  const u16* XN = (const u16*)(p.ws + O_XN) + (size_t)row0 * 1024;
  const int tid = TID(), lane = tid & 63, wid = tid >> 6, wr = wid >> 1, wc = wid & 1, fr = lane & 15, fq = lane >> 4;
  f32x4 mg[4][2];
  zero_acc<2>(mg);
#pragma unroll 1
  for (int br = 0; br < 3; ++br) {
    f32x4 g[4][2];
    zero_acc<2>(g);
    gemm_core<2>(XN, 1024, W + W_MG + (size_t)(br * 1024 + col0) * 1024, 1024, 1024, g, smem);
    const float* bm = p.in[26] + (size_t)l * 3072 + br * 1024 + col0 + wc * 32 + fr;
#pragma unroll
    for (int n = 0; n < 2; ++n) {
      const float bv = bm[n * 16];
#pragma unroll
      for (int m = 0; m < 4; ++m)
#pragma unroll
        for (int j = 0; j < 4; ++j) g[m][n][j] = sigmoidf_(g[m][n][j] + bv);
    }
    f32x4 y[4][2];
    zero_acc<2>(y);
    const u16* O = (const u16*)(p.ws + (br == 0 ? O_OA : (br == 1 ? O_OG : O_OL))) + (size_t)row0 * 512;
    gemm_core<2>(O, 512, W + W_BR + (size_t)br * 1024 * 512 + (size_t)col0 * 512, 512, 512, y, smem);
#pragma unroll
    for (int m = 0; m < 4; ++m)
#pragma unroll
      for (int n = 0; n < 2; ++n)
#pragma unroll
        for (int j = 0; j < 4; ++j) mg[m][n][j] += g[m][n][j] * y[m][n][j];
  }
  u16* MG = (u16*)(p.ws + O_MG);
#pragma unroll
  for (int m = 0; m < 4; ++m)
#pragma unroll
    for (int n = 0; n < 2; ++n)
#pragma unroll
      for (int j = 0; j < 4; ++j) {
        const int row = row0 + wr * 64 + m * 16 + fq * 4 + j, col = col0 + wc * 32 + n * 16 + fr;
        MG[(size_t)row * 1024 + col] = f2bf(mg[m][n][j]);
      }
}

DI void resid_tile(const Params& p, const u16* A, int K, const u16* W, int it, char* smem) {
  const int mt = it >> 3, nt = it & 7;
  const int row0 = mt * 128, col0 = nt * 128;
  f32x4 acc[4][4];
  zero_acc<4>(acc);
  gemm_core<4>(A + (size_t)row0 * K, K, W + (size_t)col0 * K, K, K, acc, smem);
  const int tid = TID(), lane = tid & 63, wid = tid >> 6, wr = wid >> 1, wc = wid & 1, fr = lane & 15, fq = lane >> 4;
#pragma unroll
  for (int m = 0; m < 4; ++m)
#pragma unroll
    for (int n = 0; n < 4; ++n)
#pragma unroll
      for (int j = 0; j < 4; ++j) {
        const int row = row0 + wr * 64 + m * 16 + fq * 4 + j, col = col0 + wc * 64 + n * 16 + fr;
        p.out[(size_t)row * 1024 + col] += acc[m][n][j];
      }
}

constexpr int FF_ITEMS = 260 * 22;
DI void ffgate_tile(const Params& p, int l, int it, char* smem) {
  const int mt = it / 22, nt = it % 22;
  const int row0 = mt * 128, col0 = nt * 128;
  const u16* W = (const u16*)(p.ws + O_WT) + (size_t)l * W_LAYER + W_FG;
  f32x4 acc[4][4];
  zero_acc<4>(acc);
  gemm_core<4>((const u16*)(p.ws + O_XN) + (size_t)row0 * 1024, 1024, W + (size_t)col0 * 1024, 1024, 1024, acc, smem);
  const int tid = TID(), lane = tid & 63, wid = tid >> 6, wr = wid >> 1, wc = wid & 1, fr = lane & 15, fq = lane >> 4;
  u16* GU = (u16*)(p.ws + O_GU);
  const bool isS = row0 >= MP;
#pragma unroll
  for (int m = 0; m < 4; ++m)
#pragma unroll
    for (int n = 0; n < 4; ++n)
#pragma unroll
      for (int j = 0; j < 4; ++j) {
        const int row = row0 + wr * 64 + m * 16 + fq * 4 + j, col = col0 + wc * 64 + n * 16 + fr;
        const float v = acc[m][n][j];
        GU[(size_t)row * DFF + col] = f2bf(v);
        if (isS) {
          const int rs = row - MP, b = rs >> 5, t = rs & 31;
          if (t >= STT - 2) p.out[FC_S + (((size_t)l * SBT + b) * 2 + (t - (STT - 2))) * DFF + col] = v;
        } else {
          const int b = row >> 13, t = row & 8191;
          if (t >= PT - 2) p.out[FC_P + (((size_t)l * PB + b) * 2 + (t - (PT - 2))) * DFF + col] = v;
        }
      }
}
DI void ffup_tile(const Params& p, int l, int it, char* smem) {
  const int mt = it / 22, nt = it % 22;
  const int row0 = mt * 128, col0 = nt * 128;
  const u16* W = (const u16*)(p.ws + O_WT) + (size_t)l * W_LAYER + W_FU;
  f32x4 acc[4][4];
  zero_acc<4>(acc);
  gemm_core<4>((const u16*)(p.ws + O_XN) + (size_t)row0 * 1024, 1024, W + (size_t)col0 * 1024, 1024, 1024, acc, smem);
  const int tid = TID(), lane = tid & 63, wid = tid >> 6, wr = wid >> 1, wc = wid & 1, fr = lane & 15, fq = lane >> 4;
  const u16* GU = (const u16*)(p.ws + O_GU);
  u16* FF = (u16*)(p.ws + O_FF);
  const bool isS = row0 >= MP;
#pragma unroll
  for (int n = 0; n < 4; ++n) {
    const int col = col0 + wc * 64 + n * 16 + fr;
    const float* cw = p.in[30] + (size_t)l * 3 * DFF + col;
    const float w0 = cw[0], w1 = cw[DFF], w2 = cw[2 * DFF], cb = p.in[31][(size_t)l * DFF + col];
#pragma unroll
    for (int m = 0; m < 4; ++m) {
      const int rowb = row0 + wr * 64 + m * 16 + fq * 4;
      int b, t;
      if (isS) { int rs = rowb - MP; b = rs >> 5; t = rs & 31; } else { b = rowb >> 13; t = rowb & 8191; }
      float g[6];
#pragma unroll
      for (int d = 0; d < 6; ++d) {
        const int tt = t - 2 + d;
        if (tt >= 0) g[d] = bf2f(GU[(size_t)(rowb - 2 + d) * DFF + col]);
        else g[d] = isS ? p.in[7][(((size_t)l * SBT + b) * 2 + (2 + tt)) * DFF + col] : 0.f;
      }
#pragma unroll
      for (int j = 0; j < 4; ++j) {
        const float gc = cb + w0 * g[j] + w1 * g[j + 1] + w2 * g[j + 2];
        FF[(size_t)(rowb + j) * DFF + col] = f2bf(gelu_tanh(gc) * acc[m][n][j]);
      }
    }
  }
}

#ifndef ONLY
#define ONLY -1
#endif
__global__ void __launch_bounds__(256, 2) mega(Params p) {
  cg::grid_group grid = cg::this_grid();
  extern __shared__ __attribute__((aligned(16))) char smem[];
  const int G = gridDim.x, B = blockIdx.x;
  if (ONLY < 0 || ONLY == 0) for (int it = B; it < PREP_ITEMS; it += G) prep_item(p, it, smem);
  grid.sync();
  for (int l = 0; l < NL; ++l) {
    const u16* W = (const u16*)(p.ws + O_WT) + (size_t)l * W_LAYER;
    if (ONLY < 0 || ONLY == 1) for (int it = B; it < MT / 4; it += G) norm_item(p, it, p.in[8] + (size_t)l * 1024, false);
    grid.sync();
    if (ONLY < 0 || ONLY == 2) for (int it = B; it < PB_ITEMS; it += G) { if (it < PB_GEMM) projin_tile(p, l, it, smem); else cache_conv_item(p, l, it - PB_GEMM, smem); }
    grid.sync();
    if (ONLY < 0 || ONLY == 3) for (int it = B; it < 2112; it += G) attn_item(p, l, it, smem);
    if (ONLY < 0 || ONLY == 13) for (int it = B; it < NGI; it += G) gla1_item(p, l, it, smem);
    if (ONLY < 0 || ONLY == 14) for (int it = B; it < L1_ITEMS; it += G) lru1_item(p, l, it, smem);
    grid.sync();
    if (ONLY < 0 || ONLY == 4) for (int it = B; it < G2_ITEMS + L2_ITEMS; it += G) { if (it < G2_ITEMS) gla2_item(p, l, it); else lru2_item(p, l, it - G2_ITEMS); }
    grid.sync();
    if (ONLY < 0 || ONLY == 5) for (int it = B; it < NGI + L3_ITEMS; it += G) { if (it < NGI) gla3_item(p, l, it, smem); else lru3_item(p, it - NGI); }
    grid.sync();
    if (ONLY < 0 || ONLY == 6) for (int it = B; it < PF_ITEMS; it += G) merge_tile(p, l, it, smem);
    grid.sync();
    if (ONLY < 0 || ONLY == 7) for (int it = B; it < 260 * 8; it += G) resid_tile(p, (const u16*)(p.ws + O_MG), 1024, W + W_OUT, it, smem);
    grid.sync();
    if (ONLY < 0 || ONLY == 8) for (int it = B; it < MT / 4; it += G) norm_item(p, it, p.in[28] + (size_t)l * 1024, false);
    grid.sync();
    if (ONLY < 0 || ONLY == 9) for (int it = B; it < FF_ITEMS; it += G) ffgate_tile(p, l, it, smem);
    grid.sync();
    if (ONLY < 0 || ONLY == 10) for (int it = B; it < FF_ITEMS; it += G) ffup_tile(p, l, it, smem);
    grid.sync();
    if (ONLY < 0 || ONLY == 11) for (int it = B; it < 260 * 8; it += G) resid_tile(p, (const u16*)(p.ws + O_FF), DFF, W + W_FD, it, smem);
    grid.sync();
  }
  if (ONLY < 0 || ONLY == 12) for (int it = B; it < MT / 4; it += G) norm_item(p, it, p.in[34], true);
}

constexpr int SMEM_BYTES = 73728;

extern "C" void kernel_launch(void* const* d_in, const int* in_sizes, int n_in, void* d_out, int out_size, void* d_ws, size_t ws_size,
                              hipStream_t stream) {
  static int grid_blocks = 0;
  if (!grid_blocks) {
    int dev = 0, cus = 0, per = 0;
    (void)hipGetDevice(&dev);
    (void)hipDeviceGetAttribute(&cus, hipDeviceAttributeMultiprocessorCount, dev);
    (void)hipFuncSetAttribute((const void*)mega, hipFuncAttributeMaxDynamicSharedMemorySize, SMEM_BYTES);
    (void)hipOccupancyMaxActiveBlocksPerMultiprocessor(&per, mega, 256, SMEM_BYTES);
    if (per > 2) per = 2;
    if (per < 1) per = 1;
    grid_blocks = cus * per;
  }
  if (ws_size < WS_NEED) fprintf(stderr, "workspace too small: %zu < %zu\n", ws_size, (size_t)WS_NEED);
  Params p{};
  for (int i = 0; i < 35; ++i) p.in[i] = (const float*)d_in[i];
  p.out = (float*)d_out;
  p.ws = (char*)d_ws;
  void* args[] = {&p};
  hipError_t e = hipLaunchCooperativeKernel((void*)mega, dim3(grid_blocks), dim3(256), args, SMEM_BYTES, stream);
  if (e != hipSuccess) fprintf(stderr, "cooperative launch failed: %s (grid %d)\n", hipGetErrorString(e), grid_blocks);
}
```

```cpp
#include <hip/hip_runtime.h>
#include <hip/hip_cooperative_groups.h>
#include <cstdio>
namespace cg = cooperative_groups;

#define DI __device__ __forceinline__
typedef unsigned short u16;
using bf16x8 = __attribute__((ext_vector_type(8))) short;
using f32x4 = __attribute__((ext_vector_type(4))) float;
using u32x4 = __attribute__((ext_vector_type(4))) unsigned;
#define MFMA16(a, b, c) __builtin_amdgcn_mfma_f32_16x16x32_bf16((a), (b), (c), 0, 0, 0)

constexpr int DM = 1024, PB = 4, PT = 8192, SBT = 16, STT = 32, PAST = 2048, NL = 4;
constexpr int MP = PB * PT, MS = SBT * STT, MT = MP + MS;
constexpr int SKP = 2112;
constexpr int SKV = PAST + STT;
constexpr int DFF = 2816, PW = 4112, PWP = 4224;
constexpr int NGI = PB * 4 * 128 + SBT * 4;
constexpr int NLC = MP / 64 + SBT;
constexpr float EPS = 1e-6f;

constexpr size_t W_IN = 0, W_MG = W_IN + (size_t)PWP * 1024, W_BR = W_MG + (size_t)3072 * 1024, W_OUT = W_BR + (size_t)3 * 1024 * 512,
                 W_FG = W_OUT + (size_t)1024 * 1024, W_FU = W_FG + (size_t)DFF * 1024, W_FD = W_FU + (size_t)DFF * 1024,
                 W_WA = W_FD + (size_t)1024 * DFF, W_WX = W_WA + 32768, W_LAYER = W_WX + 32768;

struct Params {
  const float* in[35];
  float* out;
  char* ws;
};

constexpr size_t al(size_t x) { return (x + 255) & ~(size_t)255; }
constexpr size_t O_WT = 0;
constexpr size_t O_ROPE = al(O_WT + W_LAYER * NL * 2);
constexpr size_t O_LAM = al(O_ROPE + 2 * 8192 * 8 * 4);
constexpr size_t O_XN = al(O_LAM + 256);
constexpr size_t O_REG = al(O_XN + (size_t)MT * 1024 * 2);
constexpr size_t O_QB = O_REG;
constexpr size_t O_KB = al(O_QB + (size_t)MT * 512 * 2);
constexpr size_t O_KS = al(O_KB + (size_t)MP * 512 * 2);
constexpr size_t O_VT = al(O_KS + (size_t)SBT * SKP * 512 * 2);
constexpr size_t O_VTS = al(O_VT + (size_t)MP * 512 * 2);
constexpr size_t O_GQ = al(O_VTS + (size_t)SBT * SKP * 512 * 2);
constexpr size_t O_GK = al(O_GQ + (size_t)MT * 256 * 2);
constexpr size_t O_GV = al(O_GK + (size_t)MT * 256 * 2);
constexpr size_t O_GR = al(O_GV + (size_t)MT * 512 * 2);
constexpr size_t O_GA = al(O_GR + (size_t)MT * 512 * 2);
constexpr size_t O_LX = al(O_GA + (size_t)MT * 16 * 4);
constexpr size_t O_LG = al(O_LX + (size_t)MT * 512 * 4);
constexpr size_t O_KVT = al(O_LG + (size_t)MT * 512 * 2);
constexpr size_t O_DEC = al(O_KVT + (size_t)NGI * 8192 * 2);
constexpr size_t O_HL = al(O_DEC + (size_t)NGI * 64 * 4);
constexpr size_t O_PP = al(O_HL + (size_t)MT * 512 * 2);
constexpr size_t O_CA = al(O_PP + (size_t)MT * 512 * 2);
constexpr size_t O_CH = al(O_CA + (size_t)NLC * 512 * 4);
constexpr size_t O_HS = al(O_CH + (size_t)NLC * 512 * 4);
constexpr size_t O_OA = al(O_HS + (size_t)NLC * 512 * 4);
constexpr size_t O_OG = al(O_OA + (size_t)MT * 512 * 2);
constexpr size_t O_OL = al(O_OG + (size_t)MT * 512 * 2);
constexpr size_t O_MG = al(O_OL + (size_t)MT * 512 * 2);
constexpr size_t O_END1 = al(O_MG + (size_t)MT * 1024 * 2);
constexpr size_t O_GU = O_REG;
constexpr size_t O_FF = al(O_GU + (size_t)MT * DFF * 2);
constexpr size_t O_END2 = al(O_FF + (size_t)MT * DFF * 2);
constexpr size_t WS_NEED = O_END1 > O_END2 ? O_END1 : O_END2;

constexpr size_t Y_P = 0, Y_S = Y_P + (size_t)MP * 1024, K_P = Y_S + (size_t)MS * 1024, V_P = K_P + (size_t)NL * MP * 512,
                 GLA_P = V_P + (size_t)NL * MP * 512, LC_P = GLA_P + (size_t)NL * PB * 32768, LH_P = LC_P + (size_t)NL * PB * 3 * 512,
                 FC_P = LH_P + (size_t)NL * PB * 512, K_S = FC_P + (size_t)NL * PB * 2 * DFF, V_S = K_S + (size_t)NL * MS * 512,
                 GLA_S = V_S + (size_t)NL * MS * 512, LC_S = GLA_S + (size_t)NL * SBT * 32768, LH_S = LC_S + (size_t)NL * SBT * 3 * 512,
                 FC_S = LH_S + (size_t)NL * SBT * 512, OUT_TOTAL = FC_S + (size_t)NL * SBT * 2 * DFF;

DI int TID() { int t = threadIdx.x; asm volatile("" : "+v"(t)); return t; }
DI u16 f2bf(float x) { __bf16 h = (__bf16)x; return __builtin_bit_cast(u16, h); }
DI float bf2f(u16 h) { return __uint_as_float(((unsigned)h) << 16); }
typedef __bf16 bf16v2_t __attribute__((ext_vector_type(2)));
typedef float f32v2_t __attribute__((ext_vector_type(2)));
DI unsigned pack2(float a, float b) { f32v2_t v = {a, b}; bf16v2_t r = __builtin_convertvector(v, bf16v2_t); return __builtin_bit_cast(unsigned, r); }
DI float sigmoidf_(float x) { return 1.f / (1.f + __expf(-x)); }
DI float gelu_tanh(float x) { float u = 0.7978845608028654f * (x + 0.044715f * x * x * x); return x * sigmoidf_(2.f * u); }
DI float softplusf_(float x) { return fmaxf(x, 0.f) + __logf(1.f + __expf(-fabsf(x))); }
DI float wave_sum(float v) {
  for (int o = 32; o > 0; o >>= 1) v += __shfl_xor(v, o);
  return v;
}

template <int NT>
DI void gemm_core(const u16* __restrict__ A, int lda, const u16* __restrict__ B, int ldb, int K, f32x4 (&acc)[4][NT], char* smem) {
  constexpr int BN = NT * 32;
  constexpr int NBL = BN / 32;
  const int tid = TID(), lane = tid & 63, wid = tid >> 6, wr = wid >> 1, wc = wid & 1, fr = lane & 15, fq = lane >> 4;
  char* As = smem;
  char* Bs = smem + 2 * 16384;
  const int lrow = tid >> 3, lch = tid & 7;
  const int gch = lch ^ ((lrow >> 1) & 7);
  const u16* ag = A + (size_t)lrow * lda + gch * 8;
  const u16* bg = B + (size_t)lrow * ldb + gch * 8;
  const int soff = tid * 16;
  const int sw = (fr >> 1) & 7;
  const int aoff = (wr * 64 + fr) * 128, boff = (wc * (BN / 2) + fr) * 128;
  const int nk = K >> 6;
  __syncthreads();
#pragma unroll
  for (int i = 0; i < 4; ++i) __builtin_amdgcn_global_load_lds((const unsigned*)(ag + (size_t)i * 32 * lda), (unsigned*)(As + soff + i * 4096), 16, 0, 0);
#pragma unroll
  for (int i = 0; i < NBL; ++i) __builtin_amdgcn_global_load_lds((const unsigned*)(bg + (size_t)i * 32 * ldb), (unsigned*)(Bs + soff + i * 4096), 16, 0, 0);
  asm volatile("s_waitcnt vmcnt(0)" ::: "memory");
  __syncthreads();
  for (int kt = 0; kt < nk; ++kt) {
    const int buf = kt & 1;
    if (kt + 1 < nk) {
      const int nb = buf ^ 1;
#pragma unroll
      for (int i = 0; i < 4; ++i)
        __builtin_amdgcn_global_load_lds((const unsigned*)(ag + (size_t)i * 32 * lda + (kt + 1) * 64), (unsigned*)(As + nb * 16384 + soff + i * 4096), 16, 0, 0);
#pragma unroll
      for (int i = 0; i < NBL; ++i)
        __builtin_amdgcn_global_load_lds((const unsigned*)(bg + (size_t)i * 32 * ldb + (kt + 1) * 64), (unsigned*)(Bs + nb * (BN * 128) + soff + i * 4096), 16, 0, 0);
    }
    const char* Ab = As + buf * 16384 + aoff;
    const char* Bb = Bs + buf * (BN * 128) + boff;
#pragma unroll
    for (int ks = 0; ks < 2; ++ks) {
      bf16x8 af[4], bfr[NT];
      const int co = ((ks * 4 + fq) ^ sw) << 4;
#pragma unroll
      for (int m = 0; m < 4; ++m) af[m] = *(const bf16x8*)(Ab + m * 2048 + co);
#pragma unroll
      for (int n = 0; n < NT; ++n) bfr[n] = *(const bf16x8*)(Bb + n * 2048 + co);
#pragma unroll
      for (int m = 0; m < 4; ++m)
#pragma unroll
        for (int n = 0; n < NT; ++n) acc[m][n] = MFMA16(af[m], bfr[n], acc[m][n]);
    }
    asm volatile("s_waitcnt vmcnt(0)" ::: "memory");
    __syncthreads();
  }
}

template <int NT>
DI void zero_acc(f32x4 (&acc)[4][NT]) {
#pragma unroll
  for (int m = 0; m < 4; ++m)
#pragma unroll
    for (int n = 0; n < NT; ++n) acc[m][n] = f32x4{0.f, 0.f, 0.f, 0.f};
}

template <int KS>
DI f32x4 lds_mm(const u16* As, int lsa, int arow, const u16* Bs, int lsb, int brow, f32x4 acc) {
  const int lane = TID() & 63, fr = lane & 15, fq = lane >> 4;
#pragma unroll
  for (int ks = 0; ks < KS; ++ks) {
    bf16x8 a = *(const bf16x8*)(As + (arow + fr) * lsa + ks * 32 + fq * 8);
    bf16x8 b = *(const bf16x8*)(Bs + (brow + fr) * lsb + ks * 32 + fq * 8);
    acc = MFMA16(a, b, acc);
  }
  return acc;
}

constexpr int PREP_T_PER_LAYER = 66 * 16 + 48 * 16 + 3 * 128 + 256 + 3 * 704 + 16;
constexpr int PREP_T = PREP_T_PER_LAYER * NL;
constexpr int PREP_COPY = MT * 1024 / 4096;
constexpr int PREP_ROPE = 8192 * 8 / 256;
constexpr int PREP_ITEMS = PREP_T + PREP_COPY + PREP_ROPE + 1;

DI void transpose_tile(const float* src, int lds_, int k0, int c0, int ncols_valid, u16* dst, int ldd, int n0, float* tile) {
  const int tid = TID();
  __syncthreads();
#pragma unroll
  for (int i = 0; i < 16; ++i) {
    int e = tid + i * 256, r = e >> 6, c = e & 63;
    tile[r * 65 + c] = (c < ncols_valid) ? src[(size_t)(k0 + r) * lds_ + c0 + c] : 0.f;
  }
  __syncthreads();
#pragma unroll
  for (int i = 0; i < 16; ++i) {
    int e = tid + i * 256, c = e >> 6, r = e & 63;
    dst[(size_t)(n0 + c) * ldd + k0 + r] = f2bf(tile[r * 65 + c]);
  }
}

DI void prep_item(const Params& p, int it, char* smem) {
  const int tid = TID();
  if (it < PREP_T) {
    const int l = it / PREP_T_PER_LAYER;
    int t = it % PREP_T_PER_LAYER;
    u16* W = (u16*)(p.ws + O_WT) + (size_t)l * W_LAYER;
    float* tile = (float*)smem;
    if (t < 66 * 16) {
      int nt = t / 16, kt = t % 16, n0 = nt * 64, c0, nv = 64;
      if (n0 < 3072) c0 = n0; else if (n0 < 4096) c0 = n0 + 16; else if (n0 == 4096) { c0 = 3072; nv = 16; } else { c0 = 0; nv = 0; }
      transpose_tile(p.in[9] + (size_t)l * 1024 * PW, PW, kt * 64, c0, nv, W + W_IN, 1024, n0, tile);
      return;
    }
    t -= 66 * 16;
    if (t < 48 * 16) { transpose_tile(p.in[25] + (size_t)l * 1024 * 3072, 3072, (t % 16) * 64, (t / 16) * 64, 64, W + W_MG, 1024, (t / 16) * 64, tile); return; }
    t -= 48 * 16;
    if (t < 3 * 128) {
      int br = t / 128, tt = t % 128;
      transpose_tile(p.in[22 + br] + (size_t)l * 512 * 1024, 1024, (tt % 8) * 64, (tt / 8) * 64, 64, W + W_BR + (size_t)br * 1024 * 512, 512, (tt / 8) * 64, tile);
      return;
    }
    t -= 3 * 128;
    if (t < 256) { transpose_tile(p.in[27] + (size_t)l * 1024 * 1024, 1024, (t % 16) * 64, (t / 16) * 64, 64, W + W_OUT, 1024, (t / 16) * 64, tile); return; }
    t -= 256;
    if (t < 704) { transpose_tile(p.in[29] + (size_t)l * 1024 * DFF, DFF, (t % 16) * 64, (t / 16) * 64, 64, W + W_FG, 1024, (t / 16) * 64, tile); return; }
    t -= 704;
    if (t < 704) { transpose_tile(p.in[32] + (size_t)l * 1024 * DFF, DFF, (t % 16) * 64, (t / 16) * 64, 64, W + W_FU, 1024, (t / 16) * 64, tile); return; }
    t -= 704;
    if (t < 704) { transpose_tile(p.in[33] + (size_t)l * DFF * 1024, 1024, (t % 44) * 64, (t / 44) * 64, 64, W + W_FD, DFF, (t / 44) * 64, tile); return; }
    t -= 704;
    if (t < 8) { transpose_tile(p.in[17] + (size_t)l * 32768 + t * 4096, 64, 0, 0, 64, W + W_WA + t * 4096, 64, 0, tile); return; }
    t -= 8;
    transpose_tile(p.in[19] + (size_t)l * 32768 + t * 4096, 64, 0, 0, 64, W + W_WX + t * 4096, 64, 0, tile);
    return;
  }
  it -= PREP_T;
  if (it < PREP_COPY) {
    size_t base = (size_t)it * 4096;
    float* X = p.out;
#pragma unroll
    for (int i = 0; i < 4; ++i) {
      size_t e = base + (size_t)(tid + i * 256) * 4;
      float4 v = (e < (size_t)MP * 1024) ? *(const float4*)(p.in[0] + e) : *(const float4*)(p.in[1] + (e - (size_t)MP * 1024));
      *(float4*)(X + e) = v;
    }
    return;
  }
  it -= PREP_COPY;
  if (it < PREP_ROPE) {
    int e = it * 256 + tid, pos = e >> 3, i = e & 7;
    double inv = pow(500000.0, -(double)i / 8.0);
    double ang = (double)pos * inv;
    double kq = rint(ang * 0.15915494309189535);
    double r = ang - kq * 6.283185307179586;
    float rf = (float)r;
    float* cs = (float*)(p.ws + O_ROPE);
    cs[e] = cosf(rf);
    cs[8192 * 8 + e] = sinf(rf);
    return;
  }
  if (tid < 64 * NL) {
    int l = tid >> 6, i = tid & 63;
    const float* lq = p.in[10] + (size_t)l * 256;
    float a = lq[i] * lq[64 + i], b = lq[128 + i] * lq[192 + i];
    a = wave_sum(a); b = wave_sum(b);
    if (i == 0) {
      float lam_init = 0.8f - 0.6f * __expf(-0.3f * (float)l);
      ((float*)(p.ws + O_LAM))[l] = __expf(a) - __expf(b) + lam_init;
    }
  }
}

DI void norm_item(const Params& p, int it, const float* gamma, bool final_) {
  const int lane = TID() & 63, wid = TID() >> 6;
  const int row = it * 4 + wid;
  float* X = p.out + (size_t)row * 1024;
  float4 v[4];
  float ss = 0.f;
#pragma unroll
  for (int i = 0; i < 4; ++i) { v[i] = *(const float4*)(X + i * 256 + lane * 4); ss += v[i].x * v[i].x + v[i].y * v[i].y + v[i].z * v[i].z + v[i].w * v[i].w; }
  ss = wave_sum(ss);
  const float rs = rsqrtf(ss * (1.f / 1024.f) + EPS);
  u16* XN = (u16*)(p.ws + O_XN) + (size_t)row * 1024;
#pragma unroll
  for (int i = 0; i < 4; ++i) {
    float4 g = *(const float4*)(gamma + i * 256 + lane * 4);
    float4 o = {v[i].x * rs * g.x, v[i].y * rs * g.y, v[i].z * rs * g.z, v[i].w * rs * g.w};
    if (final_) *(float4*)(X + i * 256 + lane * 4) = o;
    else *(uint2*)(XN + i * 256 + lane * 4) = uint2{pack2(o.x, o.y), pack2(o.z, o.w)};
  }
}

DI bool xcd_tile(int B, int G, int iter, int MTILES, int NT, int& mt, int& nt) {
  const int nxb = G >> 3;
  const int x = B & 7, lb = B >> 3;
  const int q = MTILES >> 3, r = MTILES & 7;
  const int mx = q + (x < r ? 1 : 0);
  const int mbase = x * q + (x < r ? x : r);
  const int j = lb + iter * nxb;
  if (j >= mx * NT) return false;
  const int band = j / (8 * NT);
  const int rem = j - band * 8 * NT;
  const int nb = (mx - band * 8) < 8 ? (mx - band * 8) : 8;
  mt = mbase + band * 8 + rem % nb;
  nt = rem / nb;
  return true;
}

constexpr int PB_GEMM = 260 * 33;
constexpr int PB_KC = SBT * PAST * 512 / 4096;
constexpr int PB_VC = SBT * 32 * 8;
constexpr int PB_ITEMS = PB_GEMM + PB_KC + PB_VC;

DI void projin_tile(const Params& p, int l, int mt, int nt, char* smem) {
  const int row0 = mt * 128, col0 = nt * 128;
  const u16* W = (const u16*)(p.ws + O_WT) + (size_t)l * W_LAYER + W_IN;
  const u16* XN = (const u16*)(p.ws + O_XN);
  f32x4 acc[4][4];
  zero_acc<4>(acc);
  gemm_core<4>(XN + (size_t)row0 * 1024, 1024, W + (size_t)col0 * 1024, 1024, 1024, acc, smem);
  const int tid = TID(), lane = tid & 63, wid = tid >> 6, wr = wid >> 1, wc = wid & 1, fr = lane & 15, fq = lane >> 4;
  const bool isS = row0 >= MP;
  const float* cosT = (const float*)(p.ws + O_ROPE);
  const float* sinT = cosT + 8192 * 8;
  if (nt < 8) {
    const bool isq = nt < 4;
    u16* QB = (u16*)(p.ws + O_QB);
    u16* KB = (u16*)(p.ws + O_KB);
    u16* KS = (u16*)(p.ws + O_KS);
#pragma unroll
    for (int m = 0; m < 4; ++m)
#pragma unroll
      for (int n = 0; n < 4; ++n)
#pragma unroll
        for (int j = 0; j < 4; ++j) {
          const int row = row0 + wr * 64 + m * 16 + fq * 4 + j;
          const int col = col0 + wc * 64 + n * 16 + fr;
          float v = acc[m][n][j];
          int b, t;
          if (isS) { int rs = row - MP; b = rs >> 5; t = rs & 31; } else { b = row >> 13; t = row & 8191; }
          const int pos = isS ? PAST + t : t;
          if (n == 0) {
            float pr = __shfl_xor(v, 8);
            float cs = cosT[pos * 8 + (fr & 7)], sn = sinT[pos * 8 + (fr & 7)];
            v = (fr < 8) ? v * cs - pr * sn : v * cs + pr * sn;
          }
          if (isq) {
            QB[(size_t)row * 512 + col] = f2bf(v * 0.125f);
          } else {
            const int ck = col - 512;
            if (isS) {
              p.out[K_S + ((size_t)l * MS + (row - MP)) * 512 + ck] = v;
              KS[((size_t)b * SKP + PAST + t) * 512 + ck] = f2bf(v);
            } else {
              p.out[K_P + ((size_t)l * MP + row) * 512 + ck] = v;
              KB[(size_t)row * 512 + ck] = f2bf(v);
            }
          }
        }
  } else if (nt < 12) {
    u16* VT = (u16*)(p.ws + O_VT);
    u16* VTS = (u16*)(p.ws + O_VTS);
#pragma unroll
    for (int m = 0; m < 4; ++m)
#pragma unroll
      for (int n = 0; n < 4; ++n) {
        const int rowb = row0 + wr * 64 + m * 16 + fq * 4;
        const int cv = col0 - 1024 + wc * 64 + n * 16 + fr;
        const int h = cv >> 7, vd = cv & 127;
        int b, t;
        if (isS) { int rs = rowb - MP; b = rs >> 5; t = rs & 31; } else { b = rowb >> 13; t = rowb & 8191; }
#pragma unroll
        for (int j = 0; j < 4; ++j) {
          if (isS) p.out[V_S + ((size_t)l * MS + (rowb + j - MP)) * 512 + cv] = acc[m][n][j];
          else p.out[V_P + ((size_t)l * MP + rowb + j) * 512 + cv] = acc[m][n][j];
        }
        uint2 pk = {pack2(acc[m][n][0], acc[m][n][1]), pack2(acc[m][n][2], acc[m][n][3])};
        if (isS) *(uint2*)(VTS + ((size_t)(b * 4 + h) * 128 + vd) * SKP + PAST + t) = pk;
        else *(uint2*)(VT + ((size_t)(b * 4 + h) * 128 + vd) * PT + t) = pk;
      }
  } else {
    u16* dst16 = nullptr; float* dst32 = nullptr; int ld = 0, cbase = 0; float scale = 1.f;
    if (nt < 14) { dst16 = (u16*)(p.ws + O_GQ); ld = 256; cbase = 1536; scale = 0.125f; }
    else if (nt < 16) { dst16 = (u16*)(p.ws + O_GK); ld = 256; cbase = 1792; }
    else if (nt < 20) { dst16 = (u16*)(p.ws + O_GV); ld = 512; cbase = 2048; }
    else if (nt < 24) { dst16 = (u16*)(p.ws + O_GR); ld = 512; cbase = 2560; }
    else if (nt < 28) { dst32 = (float*)(p.ws + O_LX); ld = 512; cbase = 3072; }
    else if (nt < 32) { dst16 = (u16*)(p.ws + O_LG); ld = 512; cbase = 3584; }
    else { dst32 = (float*)(p.ws + O_GA); ld = 16; cbase = 4096; }
#pragma unroll
    for (int m = 0; m < 4; ++m)
#pragma unroll
      for (int n = 0; n < 4; ++n)
#pragma unroll
        for (int j = 0; j < 4; ++j) {
          const int row = row0 + wr * 64 + m * 16 + fq * 4 + j;
          const int c = col0 + wc * 64 + n * 16 + fr - cbase;
          const float v = acc[m][n][j] * scale;
          if (c < ld) {
            if (dst16) dst16[(size_t)row * ld + c] = f2bf(v);
            else dst32[(size_t)row * ld + c] = v;
          }
        }
  }
}

DI void cache_conv_item(const Params& p, int l, int it, char* smem) {
  const int tid = TID();
  if (it < PB_KC) {
    const float* src = p.in[2] + (size_t)l * SBT * PAST * 512;
    u16* KS = (u16*)(p.ws + O_KS);
#pragma unroll
    for (int i = 0; i < 4; ++i) {
      size_t e = (size_t)it * 4096 + (size_t)(tid + i * 256) * 4;
      float4 v = *(const float4*)(src + e);
      size_t b = e / ((size_t)PAST * 512), r = e % ((size_t)PAST * 512);
      *(uint2*)(KS + b * SKP * 512 + r) = uint2{pack2(v.x, v.y), pack2(v.z, v.w)};
    }
    return;
  }
  it -= PB_KC;
  const int b = it / 256, r = it % 256, ptile = r / 8, ctile = r % 8;
  const float* src = p.in[3] + ((size_t)l * SBT + b) * PAST * 512;
  u16* VTS = (u16*)(p.ws + O_VTS);
  transpose_tile(src, 512, ptile * 64, ctile * 64, 64, VTS + (size_t)b * 512 * SKP, SKP, ctile * 64, (float*)smem);
}

DI int kswz(int key) { return (((key >> 3) & 3) << 2) | (key & 3); }

DI void attn_item(const Params& p, int l, int idx, char* smem) {
  const int tid = TID(), lane = tid & 63, wid = tid >> 6, fr = lane & 15, fq = lane >> 4;
  bool isS; int b, h, c;
  if (idx < 2048) {
    isS = false;
    const int r = idx >> 9, pos = idx & 511, q = pos >> 4, base = 127 - 32 * r;
    c = (r & 1) ? base - 31 + q : base - q;
    b = (pos & 15) >> 2; h = pos & 3;
  } else { isS = true; const int s = idx - 2048; b = s >> 2; h = s & 3; c = 0; }
  const int nkt = isS ? 33 : c + 1;
  const int klen = isS ? SKV : (c + 1) * 64;
  const u16* QB = (const u16*)(p.ws + O_QB);
  const u16* Kg = isS ? (const u16*)(p.ws + O_KS) + (size_t)b * SKP * 512 + h * 128 : (const u16*)(p.ws + O_KB) + (size_t)b * PT * 512 + h * 128;
  const int vstride = isS ? SKP : PT;
  const u16* Vg = (isS ? (const u16*)(p.ws + O_VTS) : (const u16*)(p.ws + O_VT)) + (size_t)(b * 4 + h) * 128 * vstride;
  const int qrow0 = isS ? MP + b * 32 : b * PT + c * 64;
  const bool active = isS ? (wid < 2) : true;
  const int qrow = qrow0 + wid * 16 + fr;
  bf16x8 qf[2][2];
#pragma unroll
  for (int mp = 0; mp < 2; ++mp)
#pragma unroll
    for (int ks = 0; ks < 2; ++ks)
      qf[mp][ks] = active ? *(const bf16x8*)(QB + (size_t)qrow * 512 + h * 128 + mp * 64 + ks * 32 + fq * 8) : bf16x8{0, 0, 0, 0, 0, 0, 0, 0};
  f32x4 ot[2][8];
#pragma unroll
  for (int mp = 0; mp < 2; ++mp)
#pragma unroll
    for (int n = 0; n < 8; ++n) ot[mp][n] = f32x4{0.f, 0.f, 0.f, 0.f};
  float mrun[2] = {-INFINITY, -INFINITY}, lrun[2] = {0.f, 0.f};
  char* Ks = smem;
  char* Vs = smem + 32768;
  const int kkey = tid >> 4, vvd = tid >> 3;
  const int vgch = (tid & 7) ^ ((vvd >> 1) & 7);
  const int soff = tid * 16;
  __syncthreads();
#pragma unroll
  for (int i = 0; i < 4; ++i) {
    const int key = kkey + i * 16;
    const int kgch = (tid & 15) ^ kswz(key);
    __builtin_amdgcn_global_load_lds((const unsigned*)(Kg + (size_t)key * 512 + kgch * 8), (unsigned*)(Ks + soff + i * 4096), 16, 0, 0);
    __builtin_amdgcn_global_load_lds((const unsigned*)(Vg + (size_t)(vvd + i * 32) * vstride + vgch * 8), (unsigned*)(Vs + soff + i * 4096), 16, 0, 0);
  }
  asm volatile("s_waitcnt vmcnt(0)" ::: "memory");
  __syncthreads();
  for (int kt = 0; kt < nkt; ++kt) {
    const int buf = kt & 1;
    const bool more = kt + 1 < nkt;
    if (more) {
      const int nb = buf ^ 1;
#pragma unroll
      for (int i = 0; i < 4; ++i) {
        const int key = kkey + i * 16;
        const int kgch = (tid & 15) ^ kswz(key);
        __builtin_amdgcn_global_load_lds((const unsigned*)(Kg + (size_t)((kt + 1) * 64 + key) * 512 + kgch * 8), (unsigned*)(Ks + nb * 16384 + soff + i * 4096), 16, 0, 0);
        __builtin_amdgcn_global_load_lds((const unsigned*)(Vg + (size_t)(vvd + i * 32) * vstride + (kt + 1) * 64 + vgch * 8), (unsigned*)(Vs + nb * 16384 + soff + i * 4096), 16, 0, 0);
      }
    }
    if (active) {
      const char* Kb = Ks + buf * 16384;
      const char* Vb = Vs + buf * 16384;
      f32x4 st[2][4];
#pragma unroll
      for (int mp = 0; mp < 2; ++mp)
#pragma unroll
        for (int mt = 0; mt < 4; ++mt) {
          const int key = 32 * (mt >> 1) + 8 * (fr >> 2) + 4 * (mt & 1) + (fr & 3);
          f32x4 a = {0.f, 0.f, 0.f, 0.f};
#pragma unroll
          for (int ks = 0; ks < 2; ++ks) {
            bf16x8 kf = *(const bf16x8*)(Kb + key * 256 + (((mp * 8 + ks * 4 + fq) ^ kswz(key)) << 4));
            a = MFMA16(kf, qf[mp][ks], a);
          }
          st[mp][mt] = a;
        }
      const bool needmask = (kt + 1) * 64 > klen;
#pragma unroll
      for (int mp = 0; mp < 2; ++mp) {
        if (needmask) {
#pragma unroll
          for (int mt = 0; mt < 4; ++mt)
#pragma unroll
            for (int j = 0; j < 4; ++j) {
              const int key = kt * 64 + 32 * (mt >> 1) + 8 * fq + 4 * (mt & 1) + j;
              if (key >= klen) st[mp][mt][j] = -INFINITY;
            }
        }
        float mx = -INFINITY;
#pragma unroll
        for (int mt = 0; mt < 4; ++mt)
#pragma unroll
          for (int j = 0; j < 4; ++j) mx = fmaxf(mx, st[mp][mt][j]);
        mx = fmaxf(mx, __shfl_xor(mx, 16));
        mx = fmaxf(mx, __shfl_xor(mx, 32));
        const float mnew = fmaxf(mrun[mp], mx);
        const float alpha = __expf(mrun[mp] - mnew);
        mrun[mp] = mnew;
        float ps = 0.f;
#pragma unroll
        for (int mt = 0; mt < 4; ++mt)
#pragma unroll
          for (int j = 0; j < 4; ++j) { float e = __expf(st[mp][mt][j] - mnew); st[mp][mt][j] = e; ps += e; }
        lrun[mp] = lrun[mp] * alpha + ps;
#pragma unroll
        for (int n = 0; n < 8; ++n) { ot[mp][n][0] *= alpha; ot[mp][n][1] *= alpha; ot[mp][n][2] *= alpha; ot[mp][n][3] *= alpha; }
      }
      bf16x8 pf[2][2];
#pragma unroll
      for (int mp = 0; mp < 2; ++mp)
#pragma unroll
        for (int s = 0; s < 2; ++s) {
          uint4 u = {pack2(st[mp][2 * s][0], st[mp][2 * s][1]), pack2(st[mp][2 * s][2], st[mp][2 * s][3]),
                     pack2(st[mp][2 * s + 1][0], st[mp][2 * s + 1][1]), pack2(st[mp][2 * s + 1][2], st[mp][2 * s + 1][3])};
          pf[mp][s] = __builtin_bit_cast(bf16x8, u);
        }
#pragma unroll
      for (int n = 0; n < 8; ++n) {
        const int vd = n * 16 + fr;
#pragma unroll
        for (int s = 0; s < 2; ++s) {
          bf16x8 vf = *(const bf16x8*)(Vb + vd * 128 + (((s * 4 + fq) ^ ((vd >> 1) & 7)) << 4));
          ot[0][n] = MFMA16(vf, pf[0][s], ot[0][n]);
          ot[1][n] = MFMA16(vf, pf[1][s], ot[1][n]);
        }
      }
    }
    asm volatile("s_waitcnt vmcnt(0)" ::: "memory");
    __syncthreads();
  }
  if (active) {
    float l0 = lrun[0], l1 = lrun[1];
    l0 += __shfl_xor(l0, 16); l0 += __shfl_xor(l0, 32);
    l1 += __shfl_xor(l1, 16); l1 += __shfl_xor(l1, 32);
    const float lam = ((const float*)(p.ws + O_LAM))[l];
    const float lam_init = 0.8f - 0.6f * __expf(-0.3f * (float)l);
    const float i0 = 1.f / l0, i1 = lam / l1;
    float ss = 0.f;
#pragma unroll
    for (int n = 0; n < 8; ++n)
#pragma unroll
      for (int j = 0; j < 4; ++j) { float o = ot[0][n][j] * i0 - ot[1][n][j] * i1; ot[0][n][j] = o; ss += o * o; }
    ss += __shfl_xor(ss, 16); ss += __shfl_xor(ss, 32);
    const float rs = rsqrtf(ss * (1.f / 128.f) + EPS) * (1.f - lam_init);
    const float* g = p.in[11] + (size_t)l * 128;
    u16* OA = (u16*)(p.ws + O_OA) + (size_t)qrow * 512 + h * 128;
#pragma unroll
    for (int n = 0; n < 8; ++n) {
      const int vd = n * 16 + fq * 4;
      float4 gg = *(const float4*)(g + vd);
      *(uint2*)(OA + vd) = uint2{pack2(ot[0][n][0] * rs * gg.x, ot[0][n][1] * rs * gg.y), pack2(ot[0][n][2] * rs * gg.z, ot[0][n][3] * rs * gg.w)};
    }
  }
}

constexpr int LP = 72;
constexpr int BCS = 68;
DI void gla_decode(int gi, bool& isS, int& b, int& h, int& c, int& row0, int& Lc) {
  if (gi < PB * 4 * 128) { isS = false; c = gi & 127; h = (gi >> 7) & 3; b = gi >> 9; row0 = b * PT + c * 64; Lc = 64; }
  else { isS = true; int s = gi - PB * 4 * 128; b = s >> 2; h = s & 3; c = 0; row0 = MP + b * 32; Lc = 32; }
}
DI void gla_bcum(const Params& p, int l, int row0, int Lc, int h, float* bc, float* tot, float* gas) {
  const int tid = TID(), kd = tid & 63, tq = tid >> 6;
  const float* W2 = p.in[12] + (size_t)l * 16 * 256 + h * 64 + kd;
  const float b2 = p.in[13][(size_t)l * 256 + h * 64 + kd];
  const float* GA = (const float*)(p.ws + O_GA);
  {
    const int r = tid >> 2, part = tid & 3;
    float4 v = {0.f, 0.f, 0.f, 0.f};
    if (r < Lc) v = *(const float4*)(GA + (size_t)(row0 + r) * 16 + part * 4);
    *(float4*)(gas + r * 16 + part * 4) = v;
  }
  float w[16];
#pragma unroll
  for (int r = 0; r < 16; ++r) w[r] = W2[r * 256];
  __syncthreads();
  float run = 0.f;
#pragma unroll
  for (int i = 0; i < 16; ++i) {
    const int t = tq * 16 + i;
    const float4* ga = (const float4*)(gas + t * 16);
    const float4 g0 = ga[0], g1 = ga[1], g2 = ga[2], g3 = ga[3];
    const float x = b2 + g0.x * w[0] + g0.y * w[1] + g0.z * w[2] + g0.w * w[3] + g1.x * w[4] + g1.y * w[5] + g1.z * w[6] + g1.w * w[7] +
                    g2.x * w[8] + g2.y * w[9] + g2.z * w[10] + g2.w * w[11] + g3.x * w[12] + g3.y * w[13] + g3.z * w[14] + g3.w * w[15];
    const float la = (t < Lc) ? -softplusf_(-x) * (1.f / 16.f) : 0.f;
    run += la;
    bc[t * BCS + kd] = run;
  }
  tot[tq * 64 + kd] = run;
  __syncthreads();
  float off = 0.f;
  for (int g = 0; g < tq; ++g) off += tot[g * 64 + kd];
#pragma unroll
  for (int i = 0; i < 16; ++i) bc[(tq * 16 + i) * BCS + kd] += off;
  __syncthreads();
}
DI void gla_load_vt(const Params& p, int row0, int Lc, int h, u16* vt) {
  const int tid = TID(), s = tid & 63, cg4 = tid >> 6;
  const u16* GV = (const u16*)(p.ws + O_GV) + (size_t)(row0 + s) * 512 + h * 128;
  u32x4 v[4];
#pragma unroll
  for (int i = 0; i < 4; ++i) v[i] = (s < Lc) ? *(const u32x4*)(GV + (cg4 + 4 * i) * 8) : u32x4{0u, 0u, 0u, 0u};
#pragma unroll
  for (int i = 0; i < 4; ++i) {
    const int vd0 = (cg4 + 4 * i) * 8;
#pragma unroll
    for (int e = 0; e < 4; ++e) {
      vt[(vd0 + 2 * e) * LP + s] = (u16)(v[i][e] & 0xffffu);
      vt[(vd0 + 2 * e + 1) * LP + s] = (u16)(v[i][e] >> 16);
    }
  }
}

DI void gla1_item(const Params& p, int l, int gi, char* smem) {
  bool isS; int b, h, c, row0, Lc;
  gla_decode(gi, isS, b, h, c, row0, Lc);
  const int tid = TID(), lane = tid & 63, wid = tid >> 6, fr = lane & 15, fq = lane >> 4;
  float* bc = (float*)smem;
  float* tot = (float*)(smem + 17408);
  u16* kh = (u16*)(smem + 18432);
  u16* vt = (u16*)(smem + 18432 + 9216);
  __syncthreads();
  gla_bcum(p, l, row0, Lc, h, bc, tot, (float*)kh);
  {
    const int s = tid & 63, c2 = tid >> 6;
    const u16* GK = (const u16*)(p.ws + O_GK) + (size_t)(row0 + s) * 256 + h * 64;
    u32x4 kv[2];
#pragma unroll
    for (int i = 0; i < 2; ++i) kv[i] = (s < Lc) ? *(const u32x4*)(GK + (c2 + 4 * i) * 8) : u32x4{0u, 0u, 0u, 0u};
#pragma unroll
    for (int i = 0; i < 2; ++i) {
      const int kd0 = (c2 + 4 * i) * 8;
#pragma unroll
      for (int e = 0; e < 8; ++e) {
        const unsigned w = kv[i][e >> 1];
        const float kf = bf2f((u16)((e & 1) ? (w >> 16) : (w & 0xffffu)));
        const float bl = bc[63 * BCS + kd0 + e];
        kh[(kd0 + e) * LP + s] = f2bf(kf * __expf(bl - bc[s * BCS + kd0 + e]));
      }
    }
    if (tid < 64) ((float*)(p.ws + O_DEC))[(size_t)gi * 64 + tid] = __expf(bc[63 * BCS + tid]);
  }
  gla_load_vt(p, row0, Lc, h, vt);
  __syncthreads();
  u16* KVT = (u16*)(p.ws + O_KVT) + (size_t)gi * 8192;
#pragma unroll
  for (int mi = 0; mi < 2; ++mi)
#pragma unroll
    for (int n = 0; n < 4; ++n) {
      const int m = wid * 2 + mi;
      f32x4 a = lds_mm<2>(vt, LP, m * 16, kh, LP, n * 16, f32x4{0.f, 0.f, 0.f, 0.f});
#pragma unroll
      for (int j = 0; j < 4; ++j) KVT[(m * 16 + fq * 4 + j) * 64 + n * 16 + fr] = f2bf(a[j]);
    }
}

constexpr int G2_ITEMS = (PB * 4 + SBT * 4) * 32;
DI void gla2_item(const Params& p, int l, int it) {
  const int seq = it >> 5, e = (it & 31) * 256 + TID();
  const int vd = e >> 6, kd = e & 63;
  u16* KVT = (u16*)(p.ws + O_KVT);
  const float* DEC = (const float*)(p.ws + O_DEC);
  if (seq < PB * 4) {
    float S = 0.f;
    const int gi0 = seq * 128;
    for (int c0 = 0; c0 < 128; c0 += 16) {
      u16 kvv[16]; float dd[16];
#pragma unroll
      for (int c = 0; c < 16; ++c) { kvv[c] = KVT[(size_t)(gi0 + c0 + c) * 8192 + e]; dd[c] = DEC[(size_t)(gi0 + c0 + c) * 64 + kd]; }
#pragma unroll
      for (int c = 0; c < 16; ++c) { KVT[(size_t)(gi0 + c0 + c) * 8192 + e] = f2bf(S); S = dd[c] * S + bf2f(kvv[c]); }
    }
    p.out[GLA_P + ((size_t)l * PB * 4 + seq) * 8192 + kd * 128 + vd] = S;
  } else {
    const int s = seq - PB * 4, gi = PB * 4 * 128 + s;
    const float S0 = p.in[4][((size_t)l * SBT * 4 + s) * 8192 + kd * 128 + vd];
    u16* q = KVT + (size_t)gi * 8192 + e;
    const float kv = bf2f(*q);
    const float d = DEC[(size_t)gi * 64 + kd];
    *q = f2bf(S0);
    p.out[GLA_S + ((size_t)l * SBT * 4 + s) * 8192 + kd * 128 + vd] = d * S0 + kv;
  }
}

DI void gla3_item(const Params& p, int l, int gi, char* smem) {
  bool isS; int b, h, c, row0, Lc;
  gla_decode(gi, isS, b, h, c, row0, Lc);
  const int tid = TID(), lane = tid & 63, wid = tid >> 6, fr = lane & 15, fq = lane >> 4;
  float* bc = (float*)smem;
  u16* att = (u16*)smem;
  float* tot = (float*)(smem + 17408);
  u16* qt = (u16*)(smem + 18432);
  u16* kt_ = (u16*)(smem + 18432 + 9216);
  u16* vt = (u16*)(smem + 18432 + 2 * 9216);
  u16* st = (u16*)(smem + 18432 + 2 * 9216 + 18432);
  __syncthreads();
  gla_bcum(p, l, row0, Lc, h, bc, tot, (float*)qt);
  const u16* KVT = (const u16*)(p.ws + O_KVT) + (size_t)gi * 8192;
  {
    const int s = tid & 63, c2 = tid >> 6;
    const u16* GQ = (const u16*)(p.ws + O_GQ) + (size_t)(row0 + s) * 256 + h * 64;
    const u16* GK = (const u16*)(p.ws + O_GK) + (size_t)(row0 + s) * 256 + h * 64;
    u32x4 qv[2], kv[2], sv[4];
#pragma unroll
    for (int i = 0; i < 2; ++i) {
      qv[i] = (s < Lc) ? *(const u32x4*)(GQ + (c2 + 4 * i) * 8) : u32x4{0u, 0u, 0u, 0u};
      kv[i] = (s < Lc) ? *(const u32x4*)(GK + (c2 + 4 * i) * 8) : u32x4{0u, 0u, 0u, 0u};
    }
#pragma unroll
    for (int i = 0; i < 4; ++i) { const int id = tid + i * 256; sv[i] = *(const u32x4*)(KVT + (id >> 3) * 64 + (id & 7) * 8); }
#pragma unroll
    for (int i = 0; i < 2; ++i) {
      const int kd0 = (c2 + 4 * i) * 8;
      u32x4 qo, ko;
#pragma unroll
      for (int e2 = 0; e2 < 4; ++e2) {
        const float b0 = bc[s * BCS + kd0 + 2 * e2], b1 = bc[s * BCS + kd0 + 2 * e2 + 1];
        const float e0 = __expf(b0), e1 = __expf(b1);
        const float q0 = bf2f((u16)(qv[i][e2] & 0xffffu)) * e0, q1 = bf2f((u16)(qv[i][e2] >> 16)) * e1;
        const float k0 = bf2f((u16)(kv[i][e2] & 0xffffu)) / e0, k1 = bf2f((u16)(kv[i][e2] >> 16)) / e1;
        qo[e2] = pack2(q0, q1);
        ko[e2] = pack2(k0, k1);
      }
      *(u32x4*)(qt + s * LP + kd0) = qo;
      *(u32x4*)(kt_ + s * LP + kd0) = ko;
    }
#pragma unroll
    for (int i = 0; i < 4; ++i) { const int id = tid + i * 256; *(u32x4*)(st + (id >> 3) * LP + (id & 7) * 8) = sv[i]; }
  }
  gla_load_vt(p, row0, Lc, h, vt);
  __syncthreads();
  {
    f32x4 a[4];
#pragma unroll
    for (int n = 0; n < 4; ++n) a[n] = lds_mm<2>(qt, LP, wid * 16, kt_, LP, n * 16, f32x4{0.f, 0.f, 0.f, 0.f});
#pragma unroll
    for (int n = 0; n < 4; ++n)
#pragma unroll
      for (int j = 0; j < 4; ++j) {
        const int t = wid * 16 + fq * 4 + j, s = n * 16 + fr;
        att[t * LP + s] = f2bf(t >= s ? a[n][j] : 0.f);
      }
  }
  __syncthreads();
  f32x4 o[8];
#pragma unroll
  for (int n = 0; n < 8; ++n) {
    f32x4 a = lds_mm<2>(att, LP, wid * 16, vt, LP, n * 16, f32x4{0.f, 0.f, 0.f, 0.f});
    o[n] = lds_mm<2>(qt, LP, wid * 16, st, LP, n * 16, a);
  }
  const float* gn = p.in[14] + (size_t)l * 128;
  const u16* GR = (const u16*)(p.ws + O_GR);
  u16* OG = (u16*)(p.ws + O_OG);
  float gnv[8];
#pragma unroll
  for (int n = 0; n < 8; ++n) gnv[n] = gn[n * 16 + fr];
#pragma unroll
  for (int j = 0; j < 4; ++j) {
    float ss = 0.f;
#pragma unroll
    for (int n = 0; n < 8; ++n) ss += o[n][j] * o[n][j];
    ss += __shfl_xor(ss, 1); ss += __shfl_xor(ss, 2); ss += __shfl_xor(ss, 4); ss += __shfl_xor(ss, 8);
    const float rs = rsqrtf(ss * (1.f / 128.f) + EPS);
    const int t = wid * 16 + fq * 4 + j;
    if (t < Lc) {
      const size_t ro = (size_t)(row0 + t) * 512 + h * 128;
      u16 grv[8];
#pragma unroll
      for (int n = 0; n < 8; ++n) grv[n] = GR[ro + n * 16 + fr];
#pragma unroll
      for (int n = 0; n < 8; ++n) {
        const float gr = bf2f(grv[n]);
        OG[ro + n * 16 + fr] = f2bf(o[n][j] * rs * gnv[n] * gr * sigmoidf_(gr));
      }
    }
  }
}

constexpr int L1_ITEMS = NLC * 8;
DI void lru_decode(int ci, bool& isS, int& b, int& row0, int& Lc, int& t0) {
  if (ci < MP / 64) { isS = false; b = ci >> 7; t0 = (ci & 127) * 64; row0 = ci * 64; Lc = 64; }
  else { isS = true; b = ci - MP / 64; t0 = 0; row0 = MP + b * 32; Lc = 32; }
}
DI void lru1_item(const Params& p, int l, int it, char* smem) {
  const int ci = it >> 3, nb = it & 7;
  bool isS; int b, row0, Lc, t0;
  lru_decode(ci, isS, b, row0, Lc, t0);
  const int tid = TID(), lane = tid & 63, wid = tid >> 6, fr = lane & 15, fq = lane >> 4;
  u16* xcs = (u16*)smem;
  u16* was = (u16*)(smem + 9216);
  u16* wxs = (u16*)(smem + 2 * 9216);
  float* as_ = (float*)(smem + 3 * 9216);
  float* us_ = (float*)(smem + 3 * 9216 + 16384);
  float* segP = (float*)(smem + 3 * 9216 + 32768);
  float* segH = (float*)(smem + 3 * 9216 + 32768 + 1024);
  const float* LX = (const float*)(p.ws + O_LX);
  const u16* Wl = (const u16*)(p.ws + O_WT) + (size_t)l * W_LAYER;
  const int i = tid & 63, tq = tid >> 6, ch = nb * 64 + i;
  __syncthreads();
  {
    const float* cw = p.in[15] + (size_t)l * 4 * 512 + ch;
    const float w0 = cw[0], w1 = cw[512], w2 = cw[1024], w3 = cw[1536], cb = p.in[16][(size_t)l * 512 + ch];
    const float* buf = isS ? p.in[5] + ((size_t)l * SBT + b) * 3 * 512 + ch : nullptr;
    float x[19];
#pragma unroll
    for (int j = 0; j < 19; ++j) {
      const int tl = tq * 16 - 3 + j;
      const int tt = t0 + tl;
      float v = 0.f;
      if (tl < Lc) {
        if (tt >= 0) v = LX[(size_t)(row0 + tl) * 512 + ch];
        else if (isS) v = buf[(3 + tt) * 512];
      }
      x[j] = v;
    }
#pragma unroll
    for (int k = 0; k < 16; ++k) {
      const int t = tq * 16 + k;
      const float xv = (t < Lc) ? cb + w0 * x[k] + w1 * x[k + 1] + w2 * x[k + 2] + w3 * x[k + 3] : 0.f;
      xcs[t * LP + i] = f2bf(xv);
    }
#pragma unroll
    for (int k = 0; k < 2; ++k) {
      const int id = tid + k * 256, r = id >> 3, c8 = id & 7;
      *(uint4*)(was + r * LP + c8 * 8) = *(const uint4*)(Wl + W_WA + nb * 4096 + r * 64 + c8 * 8);
      *(uint4*)(wxs + r * LP + c8 * 8) = *(const uint4*)(Wl + W_WX + nb * 4096 + r * 64 + c8 * 8);
    }
    const int T = isS ? STT : PT;
    if (t0 + Lc == T && tid < 192) {
      const int k = tid >> 6;
      const float v = LX[(size_t)(row0 + Lc - 3 + k) * 512 + ch];
      if (isS) p.out[LC_S + (((size_t)l * SBT + b) * 3 + k) * 512 + ch] = v;
      else p.out[LC_P + (((size_t)l * PB + b) * 3 + k) * 512 + ch] = v;
    }
  }
  __syncthreads();
  {
    const float* ba = p.in[18] + (size_t)l * 512 + nb * 64;
    const float* bx = p.in[20] + (size_t)l * 512 + nb * 64;
    const float* lm = p.in[21] + (size_t)l * 512 + nb * 64;
#pragma unroll
    for (int n = 0; n < 4; ++n) {
      f32x4 r = lds_mm<2>(xcs, LP, wid * 16, was, LP, n * 16, f32x4{0.f, 0.f, 0.f, 0.f});
      f32x4 g = lds_mm<2>(xcs, LP, wid * 16, wxs, LP, n * 16, f32x4{0.f, 0.f, 0.f, 0.f});
      const int j = n * 16 + fr;
      const float sp = softplusf_(-lm[j]), bav = ba[j], bxv = bx[j];
#pragma unroll
      for (int q = 0; q < 4; ++q) {
        const int t = wid * 16 + fq * 4 + q;
        const float rr = sigmoidf_(r[q] + bav), ii = sigmoidf_(g[q] + bxv);
        const float la = -8.f * rr * sp;
        const float a = __expf(la);
        const float x2 = 2.f * la;
        const float om = (x2 > -0.01f) ? -x2 * (1.f + x2 * (0.5f + x2 * (1.f / 6.f))) : 1.f - __expf(x2);
        const float u = sqrtf(om) * ii * bf2f(xcs[t * LP + j]);
        as_[t * 64 + j] = a;
        us_[t * 64 + j] = u;
      }
    }
  }
  __syncthreads();
  {
    float av[16], uv[16];
#pragma unroll
    for (int k = 0; k < 16; ++k) { av[k] = as_[(tq * 16 + k) * 64 + i]; uv[k] = us_[(tq * 16 + k) * 64 + i]; }
    float P = 1.f, hh = 0.f;
#pragma unroll
    for (int k = 0; k < 16; ++k) { P *= av[k]; hh = av[k] * hh + uv[k]; }
    segP[tq * 64 + i] = P; segH[tq * 64 + i] = hh;
    __syncthreads();
    float Pin = 1.f, hin = 0.f;
    for (int g = 0; g < tq; ++g) { const float pg = segP[g * 64 + i], hg = segH[g * 64 + i]; hin = pg * hin + hg; Pin *= pg; }
    u16* HL = (u16*)(p.ws + O_HL);
    u16* PPp = (u16*)(p.ws + O_PP);
    P = Pin; hh = hin;
#pragma unroll
    for (int k = 0; k < 16; ++k) {
      const int t = tq * 16 + k;
      P *= av[k]; hh = av[k] * hh + uv[k];
      if (t < Lc) {
        HL[(size_t)(row0 + t) * 512 + ch] = f2bf(hh);
        PPp[(size_t)(row0 + t) * 512 + ch] = f2bf(P);
      }
    }
    if (tq * 16 + 16 == Lc) {
      ((float*)(p.ws + O_CA))[(size_t)ci * 512 + ch] = P;
      ((float*)(p.ws + O_CH))[(size_t)ci * 512 + ch] = hh;
    }
  }
}
constexpr int L2_ITEMS = 8 + 32;
DI void lru2_item(const Params& p, int l, int it) {
  const float* CA = (const float*)(p.ws + O_CA);
  const float* CH = (const float*)(p.ws + O_CH);
  float* HS = (float*)(p.ws + O_HS);
  if (it < 8) {
    const int e = it * 256 + TID(), b = e >> 9, ch = e & 511;
    float hh = 0.f;
    for (int c0 = 0; c0 < 128; c0 += 16) {
      float ca[16], chv[16];
#pragma unroll
      for (int c = 0; c < 16; ++c) { const size_t o = (size_t)(b * 128 + c0 + c) * 512 + ch; ca[c] = CA[o]; chv[c] = CH[o]; }
#pragma unroll
      for (int c = 0; c < 16; ++c) { const size_t o = (size_t)(b * 128 + c0 + c) * 512 + ch; HS[o] = hh; hh = ca[c] * hh + chv[c]; }
    }
    p.out[LH_P + ((size_t)l * PB + b) * 512 + ch] = hh;
  } else {
    const int e = (it - 8) * 256 + TID(), b = e >> 9, ch = e & 511;
    const float h0 = p.in[6][((size_t)l * SBT + b) * 512 + ch];
    const size_t o = (size_t)(MP / 64 + b) * 512 + ch;
    HS[o] = h0;
    p.out[LH_S + ((size_t)l * SBT + b) * 512 + ch] = CA[o] * h0 + CH[o];
  }
}
constexpr int L3_ITEMS = MT / 8;
DI void lru3_item(const Params& p, int it) {
  const u16* HL = (const u16*)(p.ws + O_HL);
  const u16* PPp = (const u16*)(p.ws + O_PP);
  const u16* LG = (const u16*)(p.ws + O_LG);
  const float* HS = (const float*)(p.ws + O_HS);
  u16* OL = (u16*)(p.ws + O_OL);
#pragma unroll
  for (int i = 0; i < 4; ++i) {
    const int id = TID() + i * 256;
    const int row = it * 8 + (id >> 7), c4 = (id & 127) * 4;
    const int ci = row < MP ? (row >> 6) : MP / 64 + ((row - MP) >> 5);
    const size_t o = (size_t)row * 512 + c4;
    const uint2 hl = *(const uint2*)(HL + o), pp = *(const uint2*)(PPp + o), lg = *(const uint2*)(LG + o);
    const float4 hs = *(const float4*)(HS + (size_t)ci * 512 + c4);
    float y0 = (bf2f(hl.x & 0xffff) + bf2f(pp.x & 0xffff) * hs.x) * gelu_tanh(bf2f(lg.x & 0xffff));
    float y1 = (bf2f(hl.x >> 16) + bf2f(pp.x >> 16) * hs.y) * gelu_tanh(bf2f(lg.x >> 16));
    float y2 = (bf2f(hl.y & 0xffff) + bf2f(pp.y & 0xffff) * hs.z) * gelu_tanh(bf2f(lg.y & 0xffff));
    float y3 = (bf2f(hl.y >> 16) + bf2f(pp.y >> 16) * hs.w) * gelu_tanh(bf2f(lg.y >> 16));
    *(uint2*)(OL + o) = uint2{pack2(y0, y1), pack2(y2, y3)};
  }
}

constexpr int PF_ITEMS = 260 * 16;
DI void merge_tile(const Params& p, int l, int mt, int nt, char* smem) {
  const int row0 = mt * 128, col0 = nt * 64;
  const u16* W = (const u16*)(p.ws + O_WT) + (size_t)l * W_LAYER;
  const u16* XN = (const u16*)(p.ws + O_XN) + (size_t)row0 * 1024;
  const int tid = TID(), lane = tid & 63, wid = tid >> 6, wr = wid >> 1, wc = wid & 1, fr = lane & 15, fq = lane >> 4;
  f32x4 mg[4][2];
  zero_acc<2>(mg);
#pragma unroll 1
  for (int br = 0; br < 3; ++br) {
    f32x4 g[4][2];
    zero_acc<2>(g);
    gemm_core<2>(XN, 1024, W + W_MG + (size_t)(br * 1024 + col0) * 1024, 1024, 1024, g, smem);
    const float* bm = p.in[26] + (size_t)l * 3072 + br * 1024 + col0 + wc * 32 + fr;
#pragma unroll
    for (int n = 0; n < 2; ++n) {
      const float bv = bm[n * 16];
#pragma unroll
      for (int m = 0; m < 4; ++m)
#pragma unroll
        for (int j = 0; j < 4; ++j) g[m][n][j] = sigmoidf_(g[m][n][j] + bv);
    }
    f32x4 y[4][2];
    zero_acc<2>(y);
    const u16* O = (const u16*)(p.ws + (br == 0 ? O_OA : (br == 1 ? O_OG : O_OL))) + (size_t)row0 * 512;
    gemm_core<2>(O, 512, W + W_BR + (size_t)br * 1024 * 512 + (size_t)col0 * 512, 512, 512, y, smem);
#pragma unroll
    for (int m = 0; m < 4; ++m)
#pragma unroll
      for (int n = 0; n < 2; ++n)
#pragma unroll
        for (int j = 0; j < 4; ++j) mg[m][n][j] += g[m][n][j] * y[m][n][j];
  }
  u16* MG = (u16*)(p.ws + O_MG);
#pragma unroll
  for (int m = 0; m < 4; ++m)
#pragma unroll
    for (int n = 0; n < 2; ++n)
#pragma unroll
      for (int j = 0; j < 4; ++j) {
        const int row = row0 + wr * 64 + m * 16 + fq * 4 + j, col = col0 + wc * 32 + n * 16 + fr;
        MG[(size_t)row * 1024 + col] = f2bf(mg[m][n][j]);
      }
}

DI void resid_tile(const Params& p, const u16* A, int K, const u16* W, int mt, int nt, char* smem) {
  const int row0 = mt * 128, col0 = nt * 128;
  f32x4 acc[4][4];
  zero_acc<4>(acc);
  gemm_core<4>(A + (size_t)row0 * K, K, W + (size_t)col0 * K, K, K, acc, smem);
  const int tid = TID(), lane = tid & 63, wid = tid >> 6, wr = wid >> 1, wc = wid & 1, fr = lane & 15, fq = lane >> 4;
#pragma unroll
  for (int m = 0; m < 4; ++m)
#pragma unroll
    for (int n = 0; n < 4; ++n)
#pragma unroll
      for (int j = 0; j < 4; ++j) {
        const int row = row0 + wr * 64 + m * 16 + fq * 4 + j, col = col0 + wc * 64 + n * 16 + fr;
        p.out[(size_t)row * 1024 + col] += acc[m][n][j];
      }
}

constexpr int FF_ITEMS = 260 * 22;
DI void ffgate_tile(const Params& p, int l, int mt, int nt, char* smem) {
  const int row0 = mt * 128, col0 = nt * 128;
  const u16* W = (const u16*)(p.ws + O_WT) + (size_t)l * W_LAYER + W_FG;
  f32x4 acc[4][4];
  zero_acc<4>(acc);
  gemm_core<4>((const u16*)(p.ws + O_XN) + (size_t)row0 * 1024, 1024, W + (size_t)col0 * 1024, 1024, 1024, acc, smem);
  const int tid = TID(), lane = tid & 63, wid = tid >> 6, wr = wid >> 1, wc = wid & 1, fr = lane & 15, fq = lane >> 4;
  u16* GU = (u16*)(p.ws + O_GU);
  const bool isS = row0 >= MP;
#pragma unroll
  for (int m = 0; m < 4; ++m)
#pragma unroll
    for (int n = 0; n < 4; ++n)
#pragma unroll
      for (int j = 0; j < 4; ++j) {
        const int row = row0 + wr * 64 + m * 16 + fq * 4 + j, col = col0 + wc * 64 + n * 16 + fr;
        const float v = acc[m][n][j];
        GU[(size_t)row * DFF + col] = f2bf(v);
        if (isS) {
          const int rs = row - MP, b = rs >> 5, t = rs & 31;
          if (t >= STT - 2) p.out[FC_S + (((size_t)l * SBT + b) * 2 + (t - (STT - 2))) * DFF + col] = v;
        } else {
          const int b = row >> 13, t = row & 8191;
          if (t >= PT - 2) p.out[FC_P + (((size_t)l * PB + b) * 2 + (t - (PT - 2))) * DFF + col] = v;
        }
      }
}
DI void ffup_tile(const Params& p, int l, int mt, int nt, char* smem) {
  const int row0 = mt * 128, col0 = nt * 128;
  const u16* W = (const u16*)(p.ws + O_WT) + (size_t)l * W_LAYER + W_FU;
  f32x4 acc[4][4];
  zero_acc<4>(acc);
  gemm_core<4>((const u16*)(p.ws + O_XN) + (size_t)row0 * 1024, 1024, W + (size_t)col0 * 1024, 1024, 1024, acc, smem);
  const int tid = TID(), lane = tid & 63, wid = tid >> 6, wr = wid >> 1, wc = wid & 1, fr = lane & 15, fq = lane >> 4;
  const u16* GU = (const u16*)(p.ws + O_GU);
  u16* FF = (u16*)(p.ws + O_FF);
  const bool isS = row0 >= MP;
#pragma unroll
  for (int n = 0; n < 4; ++n) {
    const int col = col0 + wc * 64 + n * 16 + fr;
    const float* cw = p.in[30] + (size_t)l * 3 * DFF + col;
    const float w0 = cw[0], w1 = cw[DFF], w2 = cw[2 * DFF], cb = p.in[31][(size_t)l * DFF + col];
#pragma unroll
    for (int m = 0; m < 4; ++m) {
      const int rowb = row0 + wr * 64 + m * 16 + fq * 4;
      int b, t;
      if (isS) { int rs = rowb - MP; b = rs >> 5; t = rs & 31; } else { b = rowb >> 13; t = rowb & 8191; }
      float g[6];
#pragma unroll
      for (int d = 0; d < 6; ++d) {
        const int tt = t - 2 + d;
        if (tt >= 0) g[d] = bf2f(GU[(size_t)(rowb - 2 + d) * DFF + col]);
        else g[d] = isS ? p.in[7][(((size_t)l * SBT + b) * 2 + (2 + tt)) * DFF + col] : 0.f;
      }
#pragma unroll
      for (int j = 0; j < 4; ++j) {
        const float gc = cb + w0 * g[j] + w1 * g[j + 1] + w2 * g[j + 2];
        FF[(size_t)(rowb + j) * DFF + col] = f2bf(gelu_tanh(gc) * acc[m][n][j]);
      }
    }
  }
}

#ifndef ONLY
#define ONLY -1
#endif
__global__ void __launch_bounds__(256, 2) mega(Params p) {
  cg::grid_group grid = cg::this_grid();
  extern __shared__ __attribute__((aligned(16))) char smem[];
  const int G = gridDim.x, B = blockIdx.x;
  if (ONLY < 0 || ONLY == 0) for (int it = B; it < PREP_ITEMS; it += G) prep_item(p, it, smem);
  grid.sync();
  for (int l = 0; l < NL; ++l) {
    const u16* W = (const u16*)(p.ws + O_WT) + (size_t)l * W_LAYER;
    if (ONLY < 0 || ONLY == 1) for (int it = B; it < MT / 4; it += G) norm_item(p, it, p.in[8] + (size_t)l * 1024, false);
    grid.sync();
    if (ONLY < 0 || ONLY == 2) { int mt, nt; for (int k = 0; xcd_tile(B, G, k, 260, 33, mt, nt); ++k) projin_tile(p, l, mt, nt, smem); for (int it = B; it < PB_KC + PB_VC; it += G) cache_conv_item(p, l, it, smem); }
    grid.sync();
    if (ONLY < 0 || ONLY == 3) for (int it = B; it < 2112; it += G) attn_item(p, l, it, smem);
    if (ONLY < 0 || ONLY == 13) for (int it = B; it < NGI; it += G) gla1_item(p, l, it, smem);
    if (ONLY < 0 || ONLY == 14) for (int it = B; it < L1_ITEMS; it += G) lru1_item(p, l, it, smem);
    grid.sync();
    if (ONLY < 0 || ONLY == 4) for (int it = B; it < G2_ITEMS + L2_ITEMS; it += G) { if (it < G2_ITEMS) gla2_item(p, l, it); else lru2_item(p, l, it - G2_ITEMS); }
    grid.sync();
    if (ONLY < 0 || ONLY == 5) for (int it = B; it < NGI + L3_ITEMS; it += G) { if (it < NGI) gla3_item(p, l, it, smem); else lru3_item(p, it - NGI); }
    grid.sync();
    if (ONLY < 0 || ONLY == 6) { int mt, nt; for (int k = 0; xcd_tile(B, G, k, 260, 16, mt, nt); ++k) merge_tile(p, l, mt, nt, smem); }
    grid.sync();
    if (ONLY < 0 || ONLY == 7) { int mt, nt; for (int k = 0; xcd_tile(B, G, k, 260, 8, mt, nt); ++k) resid_tile(p, (const u16*)(p.ws + O_MG), 1024, W + W_OUT, mt, nt, smem); }
    grid.sync();
    if (ONLY < 0 || ONLY == 8) for (int it = B; it < MT / 4; it += G) norm_item(p, it, p.in[28] + (size_t)l * 1024, false);
    grid.sync();
    if (ONLY < 0 || ONLY == 9) { int mt, nt; for (int k = 0; xcd_tile(B, G, k, 260, 22, mt, nt); ++k) ffgate_tile(p, l, mt, nt, smem); }
    grid.sync();
    if (ONLY < 0 || ONLY == 10) { int mt, nt; for (int k = 0; xcd_tile(B, G, k, 260, 22, mt, nt); ++k) ffup_tile(p, l, mt, nt, smem); }
    grid.sync();
    if (ONLY < 0 || ONLY == 11) { int mt, nt; for (int k = 0; xcd_tile(B, G, k, 260, 8, mt, nt); ++k) resid_tile(p, (const u16*)(p.ws + O_FF), DFF, W + W_FD, mt, nt, smem); }
    grid.sync();
  }
  if (ONLY < 0 || ONLY == 12) for (int it = B; it < MT / 4; it += G) norm_item(p, it, p.in[34], true);
}

constexpr int SMEM_BYTES = 73728;

extern "C" void kernel_launch(void* const* d_in, const int* in_sizes, int n_in, void* d_out, int out_size, void* d_ws, size_t ws_size,
                              hipStream_t stream) {
  static int grid_blocks = 0;
  if (!grid_blocks) {
    int dev = 0, cus = 0, per = 0;
    (void)hipGetDevice(&dev);
    (void)hipDeviceGetAttribute(&cus, hipDeviceAttributeMultiprocessorCount, dev);
    (void)hipFuncSetAttribute((const void*)mega, hipFuncAttributeMaxDynamicSharedMemorySize, SMEM_BYTES);
    (void)hipOccupancyMaxActiveBlocksPerMultiprocessor(&per, mega, 256, SMEM_BYTES);
    if (per > 2) per = 2;
    if (per < 1) per = 1;
    grid_blocks = cus * per;
  }
  if (ws_size < WS_NEED) fprintf(stderr, "workspace too small: %zu < %zu\n", ws_size, (size_t)WS_NEED);
  Params p{};
  for (int i = 0; i < 35; ++i) p.in[i] = (const float*)d_in[i];
  p.out = (float*)d_out;
  p.ws = (char*)d_ws;
  void* args[] = {&p};
  hipError_t e = hipLaunchCooperativeKernel((void*)mega, dim3(grid_blocks), dim3(256), args, SMEM_BYTES, stream);
  if (e != hipSuccess) fprintf(stderr, "cooperative launch failed: %s (grid %d)\n", hipGetErrorString(e), grid_blocks);
}
```

```cpp
#include <hip/hip_runtime.h>
#include <hip/hip_cooperative_groups.h>
#include <cstdio>
namespace cg = cooperative_groups;

#define DI __device__ __forceinline__
typedef unsigned short u16;
using bf16x8 = __attribute__((ext_vector_type(8))) short;
using f32x4 = __attribute__((ext_vector_type(4))) float;
using u32x4 = __attribute__((ext_vector_type(4))) unsigned;
#define MFMA16(a, b, c) __builtin_amdgcn_mfma_f32_16x16x32_bf16((a), (b), (c), 0, 0, 0)

constexpr int DM = 1024, PB = 4, PT = 8192, SBT = 16, STT = 32, PAST = 2048, NL = 4;
constexpr int MP = PB * PT, MS = SBT * STT, MT = MP + MS;
constexpr int SKP = 2112;
constexpr int SKV = PAST + STT;
constexpr int DFF = 2816, PW = 4112, PWP = 4224;
constexpr int NGI = PB * 4 * 128 + SBT * 4;
constexpr int NLC = MP / 64 + SBT;
constexpr float EPS = 1e-6f;
constexpr int LDK = 1088;

constexpr size_t W_IN = 0, W_MG = W_IN + (size_t)4096 * LDK, W_BR = W_MG + (size_t)3072 * LDK, W_OUT = W_BR + (size_t)3 * 1024 * 512,
                 W_FG = W_OUT + (size_t)1024 * 3072, W_FU = W_FG + (size_t)DFF * LDK, W_FD = W_FU + (size_t)DFF * LDK,
                 W_WA = W_FD + (size_t)1024 * DFF, W_WX = W_WA + 32768, W_LAYER = W_WX + 32768;

struct Params {
  const float* in[35];
  float* out;
  char* ws;
};

constexpr size_t al(size_t x) { return (x + 255) & ~(size_t)255; }
constexpr size_t O_WT = 0;
constexpr size_t O_ROPE = al(O_WT + W_LAYER * NL * 2);
constexpr size_t O_LAM = al(O_ROPE + 2 * 8192 * 8 * 4);
constexpr size_t O_XN = al(O_LAM + 256);
constexpr size_t O_REG = al(O_XN + (size_t)MT * LDK * 2);
constexpr size_t O_QB = O_REG;
constexpr size_t O_KB = al(O_QB + (size_t)MT * 512 * 2);
constexpr size_t O_KS = al(O_KB + (size_t)MP * 512 * 2);
constexpr size_t O_VT = al(O_KS + (size_t)SBT * SKP * 512 * 2);
constexpr size_t O_VTS = al(O_VT + (size_t)MP * 512 * 2);
constexpr size_t O_GQ = al(O_VTS + (size_t)SBT * SKP * 512 * 2);
constexpr size_t O_GK = al(O_GQ + (size_t)MT * 256 * 2);
constexpr size_t O_GV = al(O_GK + (size_t)MT * 256 * 2);
constexpr size_t O_GR = al(O_GV + (size_t)MT * 512 * 2);
constexpr size_t O_GA = al(O_GR + (size_t)MT * 512 * 2);
constexpr size_t O_LX = al(O_GA + (size_t)MT * 16 * 4);
constexpr size_t O_LG = al(O_LX + (size_t)MT * 512 * 4);
constexpr size_t O_KVT = al(O_LG + (size_t)MT * 512 * 2);
constexpr size_t O_DEC = al(O_KVT + (size_t)NGI * 8192 * 2);
constexpr size_t O_HL = al(O_DEC + (size_t)NGI * 64 * 4);
constexpr size_t O_PP = al(O_HL + (size_t)MT * 512 * 2);
constexpr size_t O_CA = al(O_PP + (size_t)MT * 512 * 2);
constexpr size_t O_CH = al(O_CA + (size_t)NLC * 512 * 4);
constexpr size_t O_HS = al(O_CH + (size_t)NLC * 512 * 4);
constexpr size_t O_OA = al(O_HS + (size_t)NLC * 512 * 4);
constexpr size_t O_OG = al(O_OA + (size_t)MT * 512 * 2);
constexpr size_t O_OL = al(O_OG + (size_t)MT * 512 * 2);
constexpr size_t O_END1 = al(O_OL + (size_t)MT * 512 * 2);
constexpr size_t O_YP = O_QB;
static_assert(O_YP + (size_t)MT * 3072 * 2 <= O_OA, "Y buffer overlaps live mixer outputs");
constexpr size_t O_GU = O_REG;
constexpr size_t O_FF = al(O_GU + (size_t)MT * DFF * 2);
constexpr size_t O_END2 = al(O_FF + (size_t)MT * DFF * 2);
constexpr size_t WS_NEED = O_END1 > O_END2 ? O_END1 : O_END2;

constexpr size_t Y_P = 0, Y_S = Y_P + (size_t)MP * 1024, K_P = Y_S + (size_t)MS * 1024, V_P = K_P + (size_t)NL * MP * 512,
                 GLA_P = V_P + (size_t)NL * MP * 512, LC_P = GLA_P + (size_t)NL * PB * 32768, LH_P = LC_P + (size_t)NL * PB * 3 * 512,
                 FC_P = LH_P + (size_t)NL * PB * 512, K_S = FC_P + (size_t)NL * PB * 2 * DFF, V_S = K_S + (size_t)NL * MS * 512,
                 GLA_S = V_S + (size_t)NL * MS * 512, LC_S = GLA_S + (size_t)NL * SBT * 32768, LH_S = LC_S + (size_t)NL * SBT * 3 * 512,
                 FC_S = LH_S + (size_t)NL * SBT * 512, OUT_TOTAL = FC_S + (size_t)NL * SBT * 2 * DFF;

DI int TID() { int t = threadIdx.x & 255; asm volatile("" : "+v"(t)); return t; }
DI int TID512() { int t = threadIdx.x; asm volatile("" : "+v"(t)); return t; }
DI u16 f2bf(float x) { __bf16 h = (__bf16)x; return __builtin_bit_cast(u16, h); }
DI float bf2f(u16 h) { return __uint_as_float(((unsigned)h) << 16); }
typedef __bf16 bf16v2_t __attribute__((ext_vector_type(2)));
typedef float f32v2_t __attribute__((ext_vector_type(2)));
DI unsigned pack2(float a, float b) { f32v2_t v = {a, b}; bf16v2_t r = __builtin_convertvector(v, bf16v2_t); return __builtin_bit_cast(unsigned, r); }
DI float sigmoidf_(float x) { return __builtin_amdgcn_rcpf(1.f + __expf(-x)); }
DI float gelu_tanh(float x) { float u = 0.7978845608028654f * (x + 0.044715f * x * x * x); return x * sigmoidf_(2.f * u); }
DI float softplusf_(float x) { return fmaxf(x, 0.f) + __logf(1.f + __expf(-fabsf(x))); }
DI float wave_sum(float v) {
  for (int o = 32; o > 0; o >>= 1) v += __shfl_xor(v, o);
  return v;
}

DI void gemm512(const u16* __restrict__ A, int lda, const u16* __restrict__ B, int ldb, int K, f32x4 (&acc)[8][4], char* smem) {
  const int tid = TID512(), lane = tid & 63, wid = tid >> 6, wr = wid >> 2, wc = wid & 3, fr = lane & 15, fq = lane >> 4;
  const int lrow = tid >> 3;
  const int gch = (tid & 7) ^ ((lrow >> 1) & 7);
  const unsigned aov = (unsigned)(lrow * lda + gch * 8);
  const unsigned bov = (unsigned)(lrow * ldb + gch * 8);
  const int soff = tid * 16;
  const int sw = (fr >> 1) & 7;
  const int aoff = (wr * 128 + fr) * 128, boff = 32768 + (wc * 64 + fr) * 128;
  const int nk = K >> 6;
  asm volatile("s_waitcnt vmcnt(0) lgkmcnt(0)" ::: "memory");
  __builtin_amdgcn_s_barrier();
#pragma unroll
  for (int i = 0; i < 4; ++i) {
    __builtin_amdgcn_global_load_lds((const unsigned*)((A + (size_t)i * 64 * lda) + aov), (unsigned*)(smem + soff + i * 8192), 16, 0, 0);
    __builtin_amdgcn_global_load_lds((const unsigned*)((B + (size_t)i * 64 * ldb) + bov), (unsigned*)(smem + 32768 + soff + i * 8192), 16, 0, 0);
  }
  asm volatile("s_waitcnt vmcnt(0)" ::: "memory");
  __builtin_amdgcn_s_barrier();
  for (int kt = 0; kt < nk; ++kt) {
    const int buf = kt & 1;
    if (kt + 1 < nk) {
      char* st = smem + (buf ^ 1) * 65536 + soff;
      const u16* An = A + (kt + 1) * 64;
      const u16* Bn = B + (kt + 1) * 64;
#pragma unroll
      for (int i = 0; i < 4; ++i) {
        __builtin_amdgcn_global_load_lds((const unsigned*)((An + (size_t)i * 64 * lda) + aov), (unsigned*)(st + i * 8192), 16, 0, 0);
        __builtin_amdgcn_global_load_lds((const unsigned*)((Bn + (size_t)i * 64 * ldb) + bov), (unsigned*)(st + 32768 + i * 8192), 16, 0, 0);
      }
    }
    const char* Sb = smem + buf * 65536;
#pragma unroll
    for (int ks = 0; ks < 2; ++ks) {
      const int co = ((ks * 4 + fq) ^ sw) << 4;
      bf16x8 bfr[4];
#pragma unroll
      for (int n = 0; n < 4; ++n) bfr[n] = *(const bf16x8*)(Sb + boff + n * 2048 + co);
#pragma unroll
      for (int mh = 0; mh < 2; ++mh) {
        bf16x8 af[4];
#pragma unroll
        for (int m = 0; m < 4; ++m) af[m] = *(const bf16x8*)(Sb + aoff + (mh * 4 + m) * 2048 + co);
#pragma unroll
        for (int m = 0; m < 4; ++m)
#pragma unroll
          for (int n = 0; n < 4; ++n) acc[mh * 4 + m][n] = MFMA16(af[m], bfr[n], acc[mh * 4 + m][n]);
      }
    }
    asm volatile("s_waitcnt vmcnt(0) lgkmcnt(0)" ::: "memory");
    __builtin_amdgcn_s_barrier();
  }
}
DI void zero_acc8(f32x4 (&acc)[8][4]) {
#pragma unroll
  for (int m = 0; m < 8; ++m)
#pragma unroll
    for (int n = 0; n < 4; ++n) acc[m][n] = f32x4{0.f, 0.f, 0.f, 0.f};
}
#define EPI_IDS const int tid = TID512(), lane = tid & 63, wid = tid >> 6, wr = wid >> 2, wc = wid & 3, fr = lane & 15, fq = lane >> 4


constexpr int IMG_LD = 264;
constexpr int IMGF_LD = 260;
DI void img_barrier() { asm volatile("s_waitcnt vmcnt(0) lgkmcnt(0)" ::: "memory"); __builtin_amdgcn_s_barrier(); }
template <bool ROPE>
DI float epi_val(const f32x4 (&acc)[8][4], int m, int n, int j, const float* cs4, const float* sn4, int fr) {
  float v = acc[m][n][j];
  if (ROPE && n == 0) {
    const float pr = __shfl_xor(v, 8);
    v = (fr < 8) ? v * cs4[j] - pr * sn4[j] : v * cs4[j] + pr * sn4[j];
  }
  return v;
}
template <bool ROPE>
DI void img_put_bf16(const f32x4 (&acc)[8][4], char* smem, int rowoff, float scale, int prow0, const float* cosT) {
  EPI_IDS;
  u16* img = (u16*)smem + (wr * 128 + fq * 4 + rowoff) * IMG_LD + wc * 64 + fr;
#pragma unroll
  for (int m = 0; m < 8; ++m) {
    float cs4[4] = {0.f, 0.f, 0.f, 0.f}, sn4[4] = {0.f, 0.f, 0.f, 0.f};
    if (ROPE) {
#pragma unroll
      for (int j = 0; j < 4; ++j) { const int pos = prow0 + wr * 128 + m * 16 + fq * 4 + j; cs4[j] = cosT[pos * 8 + (fr & 7)]; sn4[j] = cosT[8192 * 8 + pos * 8 + (fr & 7)]; }
    }
#pragma unroll
    for (int n = 0; n < 4; ++n)
#pragma unroll
      for (int j = 0; j < 4; ++j) img[(m * 16 + j) * IMG_LD + n * 16] = f2bf(epi_val<ROPE>(acc, m, n, j, cs4, sn4, fr) * scale);
  }
}
DI void img_store_bf16(u16* dst, int ld, const char* smem, int rowoff) {
  const int tid = TID512();
#pragma unroll
  for (int q = 0; q < 16; ++q) {
    const int slot = tid + q * 512, row = slot >> 5, c16 = slot & 31;
    *(u32x4*)(dst + (size_t)row * ld + c16 * 8) = *(const u32x4*)(smem + (row + rowoff) * (IMG_LD * 2) + c16 * 16);
  }
}
DI void img_load_bf16(const u16* src, int ld, char* smem, int nrows, int rowoff) {
  for (int slot = TID512(); slot < nrows * 32; slot += 512) {
    const int row = slot >> 5, c16 = slot & 31;
    *(u32x4*)(smem + (row + rowoff) * (IMG_LD * 2) + c16 * 16) = *(const u32x4*)(src + (size_t)row * ld + c16 * 8);
  }
}
template <bool ROPE>
DI void imgf_put(const f32x4 (&acc)[8][4], int h, char* smem, int prow0, const float* cosT) {
  EPI_IDS;
  if (wr == h) {
    float* f = (float*)smem + (fq * 4) * IMGF_LD + wc * 64 + fr;
#pragma unroll
    for (int m = 0; m < 8; ++m) {
      float cs4[4] = {0.f, 0.f, 0.f, 0.f}, sn4[4] = {0.f, 0.f, 0.f, 0.f};
      if (ROPE) {
#pragma unroll
        for (int j = 0; j < 4; ++j) { const int pos = prow0 + wr * 128 + m * 16 + fq * 4 + j; cs4[j] = cosT[pos * 8 + (fr & 7)]; sn4[j] = cosT[8192 * 8 + pos * 8 + (fr & 7)]; }
      }
#pragma unroll
      for (int n = 0; n < 4; ++n)
#pragma unroll
        for (int j = 0; j < 4; ++j) f[(m * 16 + j) * IMGF_LD + n * 16] = epi_val<ROPE>(acc, m, n, j, cs4, sn4, fr);
    }
  }
}
template <bool ADD>
DI void imgf_store(float* dst, int ld, const char* smem) {
  const int tid = TID512();
  const unsigned o0 = (unsigned)((tid >> 6) * ld + (tid & 63) * 4);
  const char* src = smem + (tid >> 6) * (IMGF_LD * 4) + (tid & 63) * 16;
#pragma unroll
  for (int q = 0; q < 16; ++q) {
    if ((q & 3) == 0) asm volatile("" ::: "memory");
    float4 v = *(const float4*)(src + q * 8 * (IMGF_LD * 4));
    float4* d = (float4*)(dst + (o0 + (unsigned)(q * 8 * ld)));
    if (ADD) { const float4 x = *d; v.x += x.x; v.y += x.y; v.z += x.z; v.w += x.w; }
    *d = v;
  }
}
template <bool ADD, bool ROPE>
DI void tile_out_f32(const f32x4 (&acc)[8][4], float* dst, int ld, char* smem, int prow0, const float* cosT) {
#pragma unroll 1
  for (int h = 0; h < 2; ++h) {
    img_barrier();
    imgf_put<ROPE>(acc, h, smem, prow0, cosT);
    img_barrier();
    imgf_store<ADD>(dst + (size_t)h * 128 * ld, ld, smem);
  }
}
template <bool ROPE>
DI void tile_out_bf16(const f32x4 (&acc)[8][4], u16* dst, int ld, char* smem, float scale, int prow0, const float* cosT) {
  img_barrier();
  img_put_bf16<ROPE>(acc, smem, 0, scale, prow0, cosT);
  img_barrier();
  img_store_bf16(dst, ld, smem, 0);
}

template <int KS>
DI f32x4 lds_mm(const u16* As, int lsa, int arow, const u16* Bs, int lsb, int brow, f32x4 acc) {
  const int lane = TID() & 63, fr = lane & 15, fq = lane >> 4;
#pragma unroll
  for (int ks = 0; ks < KS; ++ks) {
    bf16x8 a = *(const bf16x8*)(As + (arow + fr) * lsa + ks * 32 + fq * 8);
    bf16x8 b = *(const bf16x8*)(Bs + (brow + fr) * lsb + ks * 32 + fq * 8);
    acc = MFMA16(a, b, acc);
  }
  return acc;
}

constexpr int PREP_T_PER_LAYER = 64 * 16 + 48 * 16 + 3 * 128 + 3 * 256 + 3 * 704 + 16;
constexpr int PREP_T = PREP_T_PER_LAYER * NL;
constexpr int PREP_COPY = MT * 1024 / 4096;
constexpr int PREP_ROPE = 8192 * 8 / 256;
constexpr int PREP_ITEMS = PREP_T + PREP_COPY + PREP_ROPE + 2;

DI void transpose_tile(const float* src, int lds_, int k0, int c0, int ncols_valid, u16* dst, int ldd, int n0, float* tile) {
  const int tid = TID();
  __syncthreads();
#pragma unroll
  for (int i = 0; i < 16; ++i) {
    int e = tid + i * 256, r = e >> 6, c = e & 63;
    tile[r * 65 + c] = (c < ncols_valid) ? src[(size_t)(k0 + r) * lds_ + c0 + c] : 0.f;
  }
  __syncthreads();
#pragma unroll
  for (int i = 0; i < 16; ++i) {
    int e = tid + i * 256, c = e >> 6, r = e & 63;
    dst[(size_t)(n0 + c) * ldd + k0 + r] = f2bf(tile[r * 65 + c]);
  }
}

DI void prep_item(const Params& p, int it, char* smem) {
  const int tid = TID();
  if (it < PREP_T) {
    const int l = it / PREP_T_PER_LAYER;
    int t = it % PREP_T_PER_LAYER;
    u16* W = (u16*)(p.ws + O_WT) + (size_t)l * W_LAYER;
    float* tile = (float*)smem;
    if (t < 64 * 16) {
      int nt = t / 16, kt = t % 16, n0 = nt * 64;
      const int c0 = n0 < 3072 ? n0 : n0 + 16;
      transpose_tile(p.in[9] + (size_t)l * 1024 * PW, PW, kt * 64, c0, 64, W + W_IN, LDK, n0, tile);
      return;
    }
    t -= 64 * 16;
    if (t < 48 * 16) { transpose_tile(p.in[25] + (size_t)l * 1024 * 3072, 3072, (t % 16) * 64, (t / 16) * 64, 64, W + W_MG, LDK, (t / 16) * 64, tile); return; }
    t -= 48 * 16;
    if (t < 3 * 128) {
      int br = t / 128, tt = t % 128;
      transpose_tile(p.in[22 + br] + (size_t)l * 512 * 1024, 1024, (tt % 8) * 64, (tt / 8) * 64, 64, W + W_BR + (size_t)br * 1024 * 512, 512, (tt / 8) * 64, tile);
      return;
    }
    t -= 3 * 128;
    if (t < 768) { const int cp = t / 256, tt = t % 256; transpose_tile(p.in[27] + (size_t)l * 1024 * 1024, 1024, (tt % 16) * 64, (tt / 16) * 64, 64, W + W_OUT + cp * 1024, 3072, (tt / 16) * 64, tile); return; }
    t -= 768;
    if (t < 704) { transpose_tile(p.in[29] + (size_t)l * 1024 * DFF, DFF, (t % 16) * 64, (t / 16) * 64, 64, W + W_FG, LDK, (t / 16) * 64, tile); return; }
    t -= 704;
    if (t < 704) { transpose_tile(p.in[32] + (size_t)l * 1024 * DFF, DFF, (t % 16) * 64, (t / 16) * 64, 64, W + W_FU, LDK, (t / 16) * 64, tile); return; }
    t -= 704;
    if (t < 704) { transpose_tile(p.in[33] + (size_t)l * DFF * 1024, 1024, (t % 44) * 64, (t / 44) * 64, 64, W + W_FD, DFF, (t / 44) * 64, tile); return; }
    t -= 704;
    if (t < 8) { transpose_tile(p.in[17] + (size_t)l * 32768 + t * 4096, 64, 0, 0, 64, W + W_WA + t * 4096, 64, 0, tile); return; }
    t -= 8;
    transpose_tile(p.in[19] + (size_t)l * 32768 + t * 4096, 64, 0, 0, 64, W + W_WX + t * 4096, 64, 0, tile);
    return;
  }
  it -= PREP_T;
  if (it < PREP_COPY) {
    size_t base = (size_t)it * 4096;
    float* X = p.out;
#pragma unroll
    for (int i = 0; i < 4; ++i) {
      size_t e = base + (size_t)(tid + i * 256) * 4;
      float4 v = (e < (size_t)MP * 1024) ? *(const float4*)(p.in[0] + e) : *(const float4*)(p.in[1] + (e - (size_t)MP * 1024));
      *(float4*)(X + e) = v;
    }
    return;
  }
  it -= PREP_COPY;
  if (it < PREP_ROPE) {
    int e = it * 256 + tid, pos = e >> 3, i = e & 7;
    double inv = pow(500000.0, -(double)i / 8.0);
    double ang = (double)pos * inv;
    double kq = rint(ang * 0.15915494309189535);
    double r = ang - kq * 6.283185307179586;
    float rf = (float)r;
    float* cs = (float*)(p.ws + O_ROPE);
    cs[e] = cosf(rf);
    cs[8192 * 8 + e] = sinf(rf);
    return;
  }
  if (it == PREP_ROPE && tid < 64 * NL) {
    int l = tid >> 6, i = tid & 63;
    const float* lq = p.in[10] + (size_t)l * 256;
    float a = lq[i] * lq[64 + i], b = lq[128 + i] * lq[192 + i];
    a = wave_sum(a); b = wave_sum(b);
    if (i == 0) {
      float lam_init = 0.8f - 0.6f * __expf(-0.3f * (float)l);
      ((float*)(p.ws + O_LAM))[l] = __expf(a) - __expf(b) + lam_init;
    }
  }
}

DI bool xcd_tile(int B, int G, int iter, int MTILES, int NT, int& mt, int& nt) {
  const int nxb = G >> 3;
  const int x = B & 7, lb = B >> 3;
  const int q = MTILES >> 3, r = MTILES & 7;
  const int mx = q + (x < r ? 1 : 0);
  const int mbase = x * q + (x < r ? x : r);
  const int j = lb + iter * nxb;
  if (j >= mx * NT) return false;
  const int band = j / (8 * NT);
  const int rem = j - band * 8 * NT;
  const int nb = (mx - band * 8) < 8 ? (mx - band * 8) : 8;
  mt = mbase + band * 8 + rem % nb;
  nt = rem / nb;
  return true;
}

constexpr int PB_KC = SBT * PAST * 512 / 4096;
constexpr int PB_VC = SBT * 32 * 8;

DI void projin_tile(const Params& p, int l, int mt, int nt, char* smem) {
  const int row0 = mt * 256, col0 = nt * 256;
  const u16* W = (const u16*)(p.ws + O_WT) + (size_t)l * W_LAYER + W_IN;
  const u16* XN = (const u16*)(p.ws + O_XN);
  f32x4 acc[8][4];
  zero_acc8(acc);
  gemm512(XN + (size_t)row0 * LDK, LDK, W + (size_t)col0 * LDK, LDK, 1024, acc, smem);
  const float* cosT = (const float*)(p.ws + O_ROPE);
  const float* sinT = cosT + 8192 * 8;
  if (mt < 128) {
    const int prow0 = row0 & 8191;
    if (nt < 2) {
      tile_out_bf16<true>(acc, (u16*)(p.ws + O_QB) + (size_t)row0 * 512 + col0, 512, smem, 0.125f, prow0, cosT);
    } else if (nt < 4) {
      tile_out_f32<false, true>(acc, p.out + K_P + ((size_t)l * MP + row0) * 512 + (col0 - 512), 512, smem, prow0, cosT);
      tile_out_bf16<true>(acc, (u16*)(p.ws + O_KB) + (size_t)row0 * 512 + (col0 - 512), 512, smem, 1.f, prow0, cosT);
    } else if (nt < 6) {
      tile_out_f32<false, false>(acc, p.out + V_P + ((size_t)l * MP + row0) * 512 + (col0 - 1024), 512, smem, 0, nullptr);
      EPI_IDS;
      u16* VT = (u16*)(p.ws + O_VT);
      const unsigned vb = (unsigned)((row0 >> 13) * 512 + (col0 - 1024) + wc * 64 + fr) * (unsigned)PT + (unsigned)((row0 & 8191) + wr * 128 + fq * 4);
#pragma unroll
      for (int m = 0; m < 8; ++m) {
        asm volatile("" ::: "memory");
#pragma unroll
        for (int n = 0; n < 4; ++n) {
          const uint2 pk = {pack2(acc[m][n][0], acc[m][n][1]), pack2(acc[m][n][2], acc[m][n][3])};
          *(uint2*)(VT + (vb + (unsigned)(n * 16 * PT + m * 16))) = pk;
        }
      }
    } else if (nt >= 12 && nt < 14) {
      tile_out_f32<false, false>(acc, (float*)(p.ws + O_LX) + (size_t)row0 * 512 + (col0 - 3072), 512, smem, 0, nullptr);
    } else {
      u16* dst; int ld = 512, cbase;
      if (nt == 6) { dst = (u16*)(p.ws + O_GQ); ld = 256; cbase = 1536; }
      else if (nt == 7) { dst = (u16*)(p.ws + O_GK); ld = 256; cbase = 1792; }
      else if (nt < 10) { dst = (u16*)(p.ws + O_GV); cbase = 2048; }
      else if (nt < 12) { dst = (u16*)(p.ws + O_GR); cbase = 2560; }
      else { dst = (u16*)(p.ws + O_LG); cbase = 3584; }
      tile_out_bf16<false>(acc, dst + (size_t)row0 * ld + (col0 - cbase), ld, smem, nt == 6 ? 0.125f : 1.f, 0, nullptr);
    }
    return;
  }
  EPI_IDS;
  const bool isS = row0 >= MP;
  if (nt < 4) {
    const bool isq = nt < 2;
    u16* QB = (u16*)(p.ws + O_QB);
    u16* KB = (u16*)(p.ws + O_KB);
    u16* KS = (u16*)(p.ws + O_KS);
#pragma unroll
    for (int m = 0; m < 8; ++m) {
      asm volatile("" ::: "memory");
#pragma unroll
      for (int n = 0; n < 4; ++n)
#pragma unroll
        for (int j = 0; j < 4; ++j) {
          const int row = row0 + wr * 128 + m * 16 + fq * 4 + j;
          const int col = col0 + wc * 64 + n * 16 + fr;
          float v = acc[m][n][j];
          int b, t;
          if (isS) { int rs = row - MP; b = rs >> 5; t = rs & 31; } else { b = row >> 13; t = row & 8191; }
          const int pos = isS ? PAST + t : t;
          if (n == 0) {
            float pr = __shfl_xor(v, 8);
            float cs = cosT[pos * 8 + (fr & 7)], sn = sinT[pos * 8 + (fr & 7)];
            v = (fr < 8) ? v * cs - pr * sn : v * cs + pr * sn;
          }
          if (isq) {
            QB[(size_t)row * 512 + col] = f2bf(v * 0.125f);
          } else {
            const int ck = col - 512;
            if (isS) {
              p.out[K_S + ((size_t)l * MS + (row - MP)) * 512 + ck] = v;
              KS[((size_t)b * SKP + PAST + t) * 512 + ck] = f2bf(v);
            } else {
              p.out[K_P + ((size_t)l * MP + row) * 512 + ck] = v;
              KB[(size_t)row * 512 + ck] = f2bf(v);
            }
          }
        }
    }
  } else if (nt < 6) {
    u16* VT = (u16*)(p.ws + O_VT);
    u16* VTS = (u16*)(p.ws + O_VTS);
#pragma unroll
    for (int m = 0; m < 8; ++m) {
      asm volatile("" ::: "memory");
#pragma unroll
      for (int n = 0; n < 4; ++n) {
        const int rowb = row0 + wr * 128 + m * 16 + fq * 4;
        const int cv = col0 - 1024 + wc * 64 + n * 16 + fr;
        const int h = cv >> 7, vd = cv & 127;
        int b, t;
        if (isS) { int rs = rowb - MP; b = rs >> 5; t = rs & 31; } else { b = rowb >> 13; t = rowb & 8191; }
#pragma unroll
        for (int j = 0; j < 4; ++j) {
          if (isS) p.out[V_S + ((size_t)l * MS + (rowb + j - MP)) * 512 + cv] = acc[m][n][j];
          else p.out[V_P + ((size_t)l * MP + rowb + j) * 512 + cv] = acc[m][n][j];
        }
        uint2 pk = {pack2(acc[m][n][0], acc[m][n][1]), pack2(acc[m][n][2], acc[m][n][3])};
        if (isS) *(uint2*)(VTS + ((size_t)(b * 4 + h) * 128 + vd) * SKP + PAST + t) = pk;
        else *(uint2*)(VT + ((size_t)(b * 4 + h) * 128 + vd) * PT + t) = pk;
      }
    }
  } else {
    u16* dst16 = nullptr; float* dst32 = nullptr; int ld = 512, cbase = 0; float scale = 1.f;
    if (nt == 6) { dst16 = (u16*)(p.ws + O_GQ); ld = 256; cbase = 1536; scale = 0.125f; }
    else if (nt == 7) { dst16 = (u16*)(p.ws + O_GK); ld = 256; cbase = 1792; }
    else if (nt < 10) { dst16 = (u16*)(p.ws + O_GV); cbase = 2048; }
    else if (nt < 12) { dst16 = (u16*)(p.ws + O_GR); cbase = 2560; }
    else if (nt < 14) { dst32 = (float*)(p.ws + O_LX); cbase = 3072; }
    else { dst16 = (u16*)(p.ws + O_LG); cbase = 3584; }
#pragma unroll
    for (int m = 0; m < 8; ++m) {
      asm volatile("" ::: "memory");
#pragma unroll
      for (int n = 0; n < 4; ++n)
#pragma unroll
        for (int j = 0; j < 4; ++j) {
          const int row = row0 + wr * 128 + m * 16 + fq * 4 + j;
          const int c = col0 + wc * 64 + n * 16 + fr - cbase;
          const float v = acc[m][n][j] * scale;
          if (dst16) dst16[(size_t)row * ld + c] = f2bf(v);
          else dst32[(size_t)row * ld + c] = v;
        }
    }
  }
}

DI void cache_conv_item(const Params& p, int l, int it, char* smem) {
  const int tid = TID();
  if (it < PB_KC) {
    const float* src = p.in[2] + (size_t)l * SBT * PAST * 512;
    u16* KS = (u16*)(p.ws + O_KS);
#pragma unroll
    for (int i = 0; i < 4; ++i) {
      size_t e = (size_t)it * 4096 + (size_t)(tid + i * 256) * 4;
      float4 v = *(const float4*)(src + e);
      size_t b = e / ((size_t)PAST * 512), r = e % ((size_t)PAST * 512);
      *(uint2*)(KS + b * SKP * 512 + r) = uint2{pack2(v.x, v.y), pack2(v.z, v.w)};
    }
    return;
  }
  it -= PB_KC;
  const int b = it / 256, r = it % 256, ptile = r / 8, ctile = r % 8;
  const float* src = p.in[3] + ((size_t)l * SBT + b) * PAST * 512;
  u16* VTS = (u16*)(p.ws + O_VTS);
  transpose_tile(src, 512, ptile * 64, ctile * 64, 64, VTS + (size_t)b * 512 * SKP, SKP, ctile * 64, (float*)smem);
}

DI int kswz(int key) { return (((key >> 3) & 3) << 2) | (key & 3); }

DI void attn_item(const Params& p, int l, int idx, char* smem) {
  const int tid = TID512(), lane = tid & 63, wid = tid >> 6, fr = lane & 15, fq = lane >> 4;
  bool isS; int b, h, cp;
  if (idx < 1024) {
    isS = false;
    const int r = idx >> 8, pos = idx & 255, q = pos >> 4, base = 63 - 16 * r;
    cp = (r & 1) ? base - 15 + q : base - q;
    b = (pos & 15) >> 2; h = pos & 3;
  } else { isS = true; const int s = idx - 1024; b = s >> 2; h = s & 3; cp = 0; }
  const int nkt = isS ? 33 : 2 * cp + 2;
  const int klen = isS ? SKV : nkt * 64;
  const int mykt = isS ? 33 : (wid < 4 ? 2 * cp + 1 : 2 * cp + 2);
  const u16* QB = (const u16*)(p.ws + O_QB);
  const u16* Kg = isS ? (const u16*)(p.ws + O_KS) + (size_t)b * SKP * 512 + h * 128 : (const u16*)(p.ws + O_KB) + (size_t)b * PT * 512 + h * 128;
  const int vstride = isS ? SKP : PT;
  const u16* Vg = (isS ? (const u16*)(p.ws + O_VTS) : (const u16*)(p.ws + O_VT)) + (size_t)(b * 4 + h) * 128 * vstride;
  const int qrow0 = isS ? MP + b * 32 : b * PT + cp * 128;
  const bool wactive = isS ? (wid < 2) : true;
  const int qrow = qrow0 + wid * 16 + fr;
  bf16x8 qf[2][2];
#pragma unroll
  for (int mp = 0; mp < 2; ++mp)
#pragma unroll
    for (int ks = 0; ks < 2; ++ks)
      qf[mp][ks] = wactive ? *(const bf16x8*)(QB + (size_t)qrow * 512 + h * 128 + mp * 64 + ks * 32 + fq * 8) : bf16x8{0, 0, 0, 0, 0, 0, 0, 0};
  f32x4 ot[2][8];
#pragma unroll
  for (int mp = 0; mp < 2; ++mp)
#pragma unroll
    for (int n = 0; n < 8; ++n) ot[mp][n] = f32x4{0.f, 0.f, 0.f, 0.f};
  float mrun[2] = {-INFINITY, -INFINITY}, lrun[2] = {0.f, 0.f};
  char* Ks = smem;
  char* Vs = smem + 32768;
  const int kkey = tid >> 4, vvd = tid >> 3;
  const int kgch = (tid & 15) ^ kswz(kkey);
  const int vgch = (tid & 7) ^ ((vvd >> 1) & 7);
  const int soff = tid * 16;
  asm volatile("s_waitcnt vmcnt(0) lgkmcnt(0)" ::: "memory");
  __builtin_amdgcn_s_barrier();
#pragma unroll
  for (int i = 0; i < 2; ++i) {
    __builtin_amdgcn_global_load_lds((const unsigned*)(Kg + (size_t)(kkey + i * 32) * 512 + kgch * 8), (unsigned*)(Ks + soff + i * 8192), 16, 0, 0);
    __builtin_amdgcn_global_load_lds((const unsigned*)(Vg + (size_t)(vvd + i * 64) * vstride + vgch * 8), (unsigned*)(Vs + soff + i * 8192), 16, 0, 0);
  }
  asm volatile("s_waitcnt vmcnt(0)" ::: "memory");
  __builtin_amdgcn_s_barrier();
  for (int kt = 0; kt < nkt; ++kt) {
    const int buf = kt & 1;
    const bool more = kt + 1 < nkt;
    if (more) {
      const int nb = buf ^ 1;
#pragma unroll
      for (int i = 0; i < 2; ++i) {
        __builtin_amdgcn_global_load_lds((const unsigned*)(Kg + (size_t)((kt + 1) * 64 + kkey + i * 32) * 512 + kgch * 8), (unsigned*)(Ks + nb * 16384 + soff + i * 8192), 16, 0, 0);
        __builtin_amdgcn_global_load_lds((const unsigned*)(Vg + (size_t)(vvd + i * 64) * vstride + (kt + 1) * 64 + vgch * 8), (unsigned*)(Vs + nb * 16384 + soff + i * 8192), 16, 0, 0);
      }
    }
    const bool active = wactive && kt < mykt;
    if (active) {
      const char* Kb = Ks + buf * 16384;
      const char* Vb = Vs + buf * 16384;
      f32x4 st[2][4];
#pragma unroll
      for (int mp = 0; mp < 2; ++mp)
#pragma unroll
        for (int mt = 0; mt < 4; ++mt) {
          const int key = 32 * (mt >> 1) + 8 * (fr >> 2) + 4 * (mt & 1) + (fr & 3);
          f32x4 a = {0.f, 0.f, 0.f, 0.f};
#pragma unroll
          for (int ks = 0; ks < 2; ++ks) {
            bf16x8 kf = *(const bf16x8*)(Kb + key * 256 + (((mp * 8 + ks * 4 + fq) ^ kswz(key)) << 4));
            a = MFMA16(kf, qf[mp][ks], a);
          }
          st[mp][mt] = a;
        }
      const bool needmask = (kt + 1) * 64 > klen;
#pragma unroll
      for (int mp = 0; mp < 2; ++mp) {
        if (needmask) {
#pragma unroll
          for (int mt = 0; mt < 4; ++mt)
#pragma unroll
            for (int j = 0; j < 4; ++j) {
              const int key = kt * 64 + 32 * (mt >> 1) + 8 * fq + 4 * (mt & 1) + j;
              if (key >= klen) st[mp][mt][j] = -INFINITY;
            }
        }
        float mx = -INFINITY;
#pragma unroll
        for (int mt = 0; mt < 4; ++mt)
#pragma unroll
          for (int j = 0; j < 4; ++j) mx = fmaxf(mx, st[mp][mt][j]);
        mx = fmaxf(mx, __shfl_xor(mx, 16));
        mx = fmaxf(mx, __shfl_xor(mx, 32));
        const float mnew = fmaxf(mrun[mp], mx);
        const float alpha = __expf(mrun[mp] - mnew);
        mrun[mp] = mnew;
        float ps = 0.f;
#pragma unroll
        for (int mt = 0; mt < 4; ++mt)
#pragma unroll
          for (int j = 0; j < 4; ++j) { float e = __expf(st[mp][mt][j] - mnew); st[mp][mt][j] = e; ps += e; }
        lrun[mp] = lrun[mp] * alpha + ps;
#pragma unroll
        for (int n = 0; n < 8; ++n) { ot[mp][n][0] *= alpha; ot[mp][n][1] *= alpha; ot[mp][n][2] *= alpha; ot[mp][n][3] *= alpha; }
      }
      bf16x8 pf[2][2];
#pragma unroll
      for (int mp = 0; mp < 2; ++mp)
#pragma unroll
        for (int s = 0; s < 2; ++s) {
          uint4 u = {pack2(st[mp][2 * s][0], st[mp][2 * s][1]), pack2(st[mp][2 * s][2], st[mp][2 * s][3]),
                     pack2(st[mp][2 * s + 1][0], st[mp][2 * s + 1][1]), pack2(st[mp][2 * s + 1][2], st[mp][2 * s + 1][3])};
          pf[mp][s] = __builtin_bit_cast(bf16x8, u);
        }
#pragma unroll
      for (int n = 0; n < 8; ++n) {
        const int vd = n * 16 + fr;
#pragma unroll
        for (int s = 0; s < 2; ++s) {
          bf16x8 vf = *(const bf16x8*)(Vb + vd * 128 + (((s * 4 + fq) ^ ((vd >> 1) & 7)) << 4));
          ot[0][n] = MFMA16(vf, pf[0][s], ot[0][n]);
          ot[1][n] = MFMA16(vf, pf[1][s], ot[1][n]);
        }
      }
    }
    asm volatile("s_waitcnt vmcnt(0) lgkmcnt(0)" ::: "memory");
    __builtin_amdgcn_s_barrier();
  }
  if (wactive) {
    float l0 = lrun[0], l1 = lrun[1];
    l0 += __shfl_xor(l0, 16); l0 += __shfl_xor(l0, 32);
    l1 += __shfl_xor(l1, 16); l1 += __shfl_xor(l1, 32);
    const float lam = ((const float*)(p.ws + O_LAM))[l];
    const float lam_init = 0.8f - 0.6f * __expf(-0.3f * (float)l);
    const float i0 = 1.f / l0, i1 = lam / l1;
    float ss = 0.f;
#pragma unroll
    for (int n = 0; n < 8; ++n)
#pragma unroll
      for (int j = 0; j < 4; ++j) { float o = ot[0][n][j] * i0 - ot[1][n][j] * i1; ot[0][n][j] = o; ss += o * o; }
    ss += __shfl_xor(ss, 16); ss += __shfl_xor(ss, 32);
    const float rs = rsqrtf(ss * (1.f / 128.f) + EPS) * (1.f - lam_init);
    const float* g = p.in[11] + (size_t)l * 128;
    u16* OA = (u16*)(p.ws + O_OA) + (size_t)qrow * 512 + h * 128;
#pragma unroll
    for (int n = 0; n < 8; ++n) {
      const int vd = n * 16 + fq * 4;
      float4 gg = *(const float4*)(g + vd);
      *(uint2*)(OA + vd) = uint2{pack2(ot[0][n][0] * rs * gg.x, ot[0][n][1] * rs * gg.y), pack2(ot[0][n][2] * rs * gg.z, ot[0][n][3] * rs * gg.w)};
    }
  }
}

constexpr int LP = 72;
constexpr int BCS = 68;
DI void gla_decode(int gi, bool& isS, int& b, int& h, int& c, int& row0, int& Lc) {
  if (gi < PB * 4 * 128) { isS = false; c = gi & 127; h = (gi >> 7) & 3; b = gi >> 9; row0 = b * PT + c * 64; Lc = 64; }
  else { isS = true; int s = gi - PB * 4 * 128; b = s >> 2; h = s & 3; c = 0; row0 = MP + b * 32; Lc = 32; }
}
DI void gla_bcum(const Params& p, int l, int row0, int Lc, int h, float* bc, float* tot, float* gas) {
  const int tid = TID(), kd = tid & 63, tq = tid >> 6;
  const float* W2 = p.in[12] + (size_t)l * 16 * 256 + h * 64 + kd;
  const float b2 = p.in[13][(size_t)l * 256 + h * 64 + kd];
  const float* GA = (const float*)(p.ws + O_GA);
  {
    const int r = tid >> 2, part = tid & 3;
    float4 v = {0.f, 0.f, 0.f, 0.f};
    if (r < Lc) v = *(const float4*)(GA + (size_t)(row0 + r) * 16 + part * 4);
    *(float4*)(gas + r * 16 + part * 4) = v;
  }
  float w[16];
#pragma unroll
  for (int r = 0; r < 16; ++r) w[r] = W2[r * 256];
  __syncthreads();
  float run = 0.f;
#pragma unroll
  for (int i = 0; i < 16; ++i) {
    const int t = tq * 16 + i;
    const float4* ga = (const float4*)(gas + t * 16);
    const float4 g0 = ga[0], g1 = ga[1], g2 = ga[2], g3 = ga[3];
    const float x = b2 + g0.x * w[0] + g0.y * w[1] + g0.z * w[2] + g0.w * w[3] + g1.x * w[4] + g1.y * w[5] + g1.z * w[6] + g1.w * w[7] +
                    g2.x * w[8] + g2.y * w[9] + g2.z * w[10] + g2.w * w[11] + g3.x * w[12] + g3.y * w[13] + g3.z * w[14] + g3.w * w[15];
    const float la = (t < Lc) ? -softplusf_(-x) * (1.f / 16.f) : 0.f;
    run += la;
    bc[t * BCS + kd] = run;
  }
  tot[tq * 64 + kd] = run;
  __syncthreads();
  float off = 0.f;
  for (int g = 0; g < tq; ++g) off += tot[g * 64 + kd];
#pragma unroll
  for (int i = 0; i < 16; ++i) bc[(tq * 16 + i) * BCS + kd] += off;
  __syncthreads();
}
DI void gla_load_vt(const Params& p, int row0, int Lc, int h, u16* vt) {
  const int tid = TID(), s = tid & 63, cg4 = tid >> 6;
  const u16* GV = (const u16*)(p.ws + O_GV) + (size_t)(row0 + s) * 512 + h * 128;
  u32x4 v[4];
#pragma unroll
  for (int i = 0; i < 4; ++i) v[i] = (s < Lc) ? *(const u32x4*)(GV + (cg4 + 4 * i) * 8) : u32x4{0u, 0u, 0u, 0u};
#pragma unroll
  for (int i = 0; i < 4; ++i) {
    const int vd0 = (cg4 + 4 * i) * 8;
#pragma unroll
    for (int e = 0; e < 4; ++e) {
      vt[(vd0 + 2 * e) * LP + s] = (u16)(v[i][e] & 0xffffu);
      vt[(vd0 + 2 * e + 1) * LP + s] = (u16)(v[i][e] >> 16);
    }
  }
}

DI void gla1_item(const Params& p, int l, int gi, char* smem) {
  bool isS; int b, h, c, row0, Lc;
  gla_decode(gi, isS, b, h, c, row0, Lc);
  const int tid = TID(), lane = tid & 63, wid = tid >> 6, fr = lane & 15, fq = lane >> 4;
  float* bc = (float*)smem;
  float* tot = (float*)(smem + 17408);
  u16* kh = (u16*)(smem + 18432);
  u16* vt = (u16*)(smem + 18432 + 9216);
  __syncthreads();
  gla_bcum(p, l, row0, Lc, h, bc, tot, (float*)kh);
  {
    const int s = tid & 63, c2 = tid >> 6;
    const u16* GK = (const u16*)(p.ws + O_GK) + (size_t)(row0 + s) * 256 + h * 64;
    u32x4 kv[2];
#pragma unroll
    for (int i = 0; i < 2; ++i) kv[i] = (s < Lc) ? *(const u32x4*)(GK + (c2 + 4 * i) * 8) : u32x4{0u, 0u, 0u, 0u};
#pragma unroll
    for (int i = 0; i < 2; ++i) {
      const int kd0 = (c2 + 4 * i) * 8;
#pragma unroll
      for (int e = 0; e < 8; ++e) {
        const unsigned w = kv[i][e >> 1];
        const float kf = bf2f((u16)((e & 1) ? (w >> 16) : (w & 0xffffu)));
        const float bl = bc[63 * BCS + kd0 + e];
        kh[(kd0 + e) * LP + s] = f2bf(kf * __expf(bl - bc[s * BCS + kd0 + e]));
      }
    }
    if (tid < 64) ((float*)(p.ws + O_DEC))[(size_t)gi * 64 + tid] = __expf(bc[63 * BCS + tid]);
  }
  gla_load_vt(p, row0, Lc, h, vt);
  __syncthreads();
  u16* KVT = (u16*)(p.ws + O_KVT) + (size_t)gi * 8192;
#pragma unroll
  for (int mi = 0; mi < 2; ++mi)
#pragma unroll
    for (int n = 0; n < 4; ++n) {
      const int m = wid * 2 + mi;
      f32x4 a = lds_mm<2>(vt, LP, m * 16, kh, LP, n * 16, f32x4{0.f, 0.f, 0.f, 0.f});
#pragma unroll
      for (int j = 0; j < 4; ++j) KVT[(m * 16 + fq * 4 + j) * 64 + n * 16 + fr] = f2bf(a[j]);
    }
}

constexpr int G2_ITEMS = (PB * 4 + SBT * 4) * 32;
DI void gla2_item(const Params& p, int l, int it) {
  const int seq = it >> 5, e = (it & 31) * 256 + TID();
  const int vd = e >> 6, kd = e & 63;
  u16* KVT = (u16*)(p.ws + O_KVT);
  const float* DEC = (const float*)(p.ws + O_DEC);
  if (seq < PB * 4) {
    float S = 0.f;
    const int gi0 = seq * 128;
    for (int c0 = 0; c0 < 128; c0 += 16) {
      u16 kvv[16]; float dd[16];
#pragma unroll
      for (int c = 0; c < 16; ++c) { kvv[c] = KVT[(size_t)(gi0 + c0 + c) * 8192 + e]; dd[c] = DEC[(size_t)(gi0 + c0 + c) * 64 + kd]; }
#pragma unroll
      for (int c = 0; c < 16; ++c) { KVT[(size_t)(gi0 + c0 + c) * 8192 + e] = f2bf(S); S = dd[c] * S + bf2f(kvv[c]); }
    }
    p.out[GLA_P + ((size_t)l * PB * 4 + seq) * 8192 + kd * 128 + vd] = S;
  } else {
    const int s = seq - PB * 4, gi = PB * 4 * 128 + s;
    const float S0 = p.in[4][((size_t)l * SBT * 4 + s) * 8192 + kd * 128 + vd];
    u16* q = KVT + (size_t)gi * 8192 + e;
    const float kv = bf2f(*q);
    const float d = DEC[(size_t)gi * 64 + kd];
    *q = f2bf(S0);
    p.out[GLA_S + ((size_t)l * SBT * 4 + s) * 8192 + kd * 128 + vd] = d * S0 + kv;
  }
}

DI void gla3_item(const Params& p, int l, int gi, char* smem) {
  bool isS; int b, h, c, row0, Lc;
  gla_decode(gi, isS, b, h, c, row0, Lc);
  const int tid = TID(), lane = tid & 63, wid = tid >> 6, fr = lane & 15, fq = lane >> 4;
  float* bc = (float*)smem;
  u16* att = (u16*)smem;
  float* tot = (float*)(smem + 17408);
  u16* qt = (u16*)(smem + 18432);
  u16* kt_ = (u16*)(smem + 18432 + 9216);
  u16* vt = (u16*)(smem + 18432 + 2 * 9216);
  u16* st = (u16*)(smem + 18432 + 2 * 9216 + 18432);
  __syncthreads();
  gla_bcum(p, l, row0, Lc, h, bc, tot, (float*)qt);
  const u16* KVT = (const u16*)(p.ws + O_KVT) + (size_t)gi * 8192;
  {
    const int s = tid & 63, c2 = tid >> 6;
    const u16* GQ = (const u16*)(p.ws + O_GQ) + (size_t)(row0 + s) * 256 + h * 64;
    const u16* GK = (const u16*)(p.ws + O_GK) + (size_t)(row0 + s) * 256 + h * 64;
    u32x4 qv[2], kv[2], sv[4];
#pragma unroll
    for (int i = 0; i < 2; ++i) {
      qv[i] = (s < Lc) ? *(const u32x4*)(GQ + (c2 + 4 * i) * 8) : u32x4{0u, 0u, 0u, 0u};
      kv[i] = (s < Lc) ? *(const u32x4*)(GK + (c2 + 4 * i) * 8) : u32x4{0u, 0u, 0u, 0u};
    }
#pragma unroll
    for (int i = 0; i < 4; ++i) { const int id = tid + i * 256; sv[i] = *(const u32x4*)(KVT + (id >> 3) * 64 + (id & 7) * 8); }
#pragma unroll
    for (int i = 0; i < 2; ++i) {
      const int kd0 = (c2 + 4 * i) * 8;
      u32x4 qo, ko;
#pragma unroll
      for (int e2 = 0; e2 < 4; ++e2) {
        const float b0 = bc[s * BCS + kd0 + 2 * e2], b1 = bc[s * BCS + kd0 + 2 * e2 + 1];
        const float e0 = __expf(b0), e1 = __expf(b1);
        const float q0 = bf2f((u16)(qv[i][e2] & 0xffffu)) * e0, q1 = bf2f((u16)(qv[i][e2] >> 16)) * e1;
        const float k0 = bf2f((u16)(kv[i][e2] & 0xffffu)) / e0, k1 = bf2f((u16)(kv[i][e2] >> 16)) / e1;
        qo[e2] = pack2(q0, q1);
        ko[e2] = pack2(k0, k1);
      }
      *(u32x4*)(qt + s * LP + kd0) = qo;
      *(u32x4*)(kt_ + s * LP + kd0) = ko;
    }
#pragma unroll
    for (int i = 0; i < 4; ++i) { const int id = tid + i * 256; *(u32x4*)(st + (id >> 3) * LP + (id & 7) * 8) = sv[i]; }
  }
  gla_load_vt(p, row0, Lc, h, vt);
  __syncthreads();
  {
    f32x4 a[4];
#pragma unroll
    for (int n = 0; n < 4; ++n) a[n] = lds_mm<2>(qt, LP, wid * 16, kt_, LP, n * 16, f32x4{0.f, 0.f, 0.f, 0.f});
#pragma unroll
    for (int n = 0; n < 4; ++n)
#pragma unroll
      for (int j = 0; j < 4; ++j) {
        const int t = wid * 16 + fq * 4 + j, s = n * 16 + fr;
        att[t * LP + s] = f2bf(t >= s ? a[n][j] : 0.f);
      }
  }
  __syncthreads();
  f32x4 o[8];
#pragma unroll
  for (int n = 0; n < 8; ++n) {
    f32x4 a = lds_mm<2>(att, LP, wid * 16, vt, LP, n * 16, f32x4{0.f, 0.f, 0.f, 0.f});
    o[n] = lds_mm<2>(qt, LP, wid * 16, st, LP, n * 16, a);
  }
  const float* gn = p.in[14] + (size_t)l * 128;
  const u16* GR = (const u16*)(p.ws + O_GR);
  u16* OG = (u16*)(p.ws + O_OG);
  float gnv[8];
#pragma unroll
  for (int n = 0; n < 8; ++n) gnv[n] = gn[n * 16 + fr];
#pragma unroll
  for (int j = 0; j < 4; ++j) {
    float ss = 0.f;
#pragma unroll
    for (int n = 0; n < 8; ++n) ss += o[n][j] * o[n][j];
    ss += __shfl_xor(ss, 1); ss += __shfl_xor(ss, 2); ss += __shfl_xor(ss, 4); ss += __shfl_xor(ss, 8);
    const float rs = rsqrtf(ss * (1.f / 128.f) + EPS);
    const int t = wid * 16 + fq * 4 + j;
    if (t < Lc) {
      const size_t ro = (size_t)(row0 + t) * 512 + h * 128;
      u16 grv[8];
#pragma unroll
      for (int n = 0; n < 8; ++n) grv[n] = GR[ro + n * 16 + fr];
#pragma unroll
      for (int n = 0; n < 8; ++n) {
        const float gr = bf2f(grv[n]);
        OG[ro + n * 16 + fr] = f2bf(o[n][j] * rs * gnv[n] * gr * sigmoidf_(gr));
      }
    }
  }
}

constexpr int L1_ITEMS = NLC * 8;
DI void lru_decode(int ci, bool& isS, int& b, int& row0, int& Lc, int& t0) {
  if (ci < MP / 64) { isS = false; b = ci >> 7; t0 = (ci & 127) * 64; row0 = ci * 64; Lc = 64; }
  else { isS = true; b = ci - MP / 64; t0 = 0; row0 = MP + b * 32; Lc = 32; }
}
DI void lru1_item(const Params& p, int l, int it, char* smem) {
  const int ci = it >> 3, nb = it & 7;
  bool isS; int b, row0, Lc, t0;
  lru_decode(ci, isS, b, row0, Lc, t0);
  const int tid = TID(), lane = tid & 63, wid = tid >> 6, fr = lane & 15, fq = lane >> 4;
  u16* xcs = (u16*)smem;
  u16* was = (u16*)(smem + 9216);
  u16* wxs = (u16*)(smem + 2 * 9216);
  float* as_ = (float*)(smem + 3 * 9216);
  float* us_ = (float*)(smem + 3 * 9216 + 16384);
  float* segP = (float*)(smem + 3 * 9216 + 32768);
  float* segH = (float*)(smem + 3 * 9216 + 32768 + 1024);
  const float* LX = (const float*)(p.ws + O_LX);
  const u16* Wl = (const u16*)(p.ws + O_WT) + (size_t)l * W_LAYER;
  const int i = tid & 63, tq = tid >> 6, ch = nb * 64 + i;
  __syncthreads();
  {
    const float* cw = p.in[15] + (size_t)l * 4 * 512 + ch;
    const float w0 = cw[0], w1 = cw[512], w2 = cw[1024], w3 = cw[1536], cb = p.in[16][(size_t)l * 512 + ch];
    const float* buf = isS ? p.in[5] + ((size_t)l * SBT + b) * 3 * 512 + ch : nullptr;
    float x[19];
#pragma unroll
    for (int j = 0; j < 19; ++j) {
      const int tl = tq * 16 - 3 + j;
      const int tt = t0 + tl;
      float v = 0.f;
      if (tl < Lc) {
        if (tt >= 0) v = LX[(size_t)(row0 + tl) * 512 + ch];
        else if (isS) v = buf[(3 + tt) * 512];
      }
      x[j] = v;
    }
#pragma unroll
    for (int k = 0; k < 16; ++k) {
      const int t = tq * 16 + k;
      const float xv = (t < Lc) ? cb + w0 * x[k] + w1 * x[k + 1] + w2 * x[k + 2] + w3 * x[k + 3] : 0.f;
      xcs[t * LP + i] = f2bf(xv);
    }
#pragma unroll
    for (int k = 0; k < 2; ++k) {
      const int id = tid + k * 256, r = id >> 3, c8 = id & 7;
      *(uint4*)(was + r * LP + c8 * 8) = *(const uint4*)(Wl + W_WA + nb * 4096 + r * 64 + c8 * 8);
      *(uint4*)(wxs + r * LP + c8 * 8) = *(const uint4*)(Wl + W_WX + nb * 4096 + r * 64 + c8 * 8);
    }
    const int T = isS ? STT : PT;
    if (t0 + Lc == T && tid < 192) {
      const int k = tid >> 6;
      const float v = LX[(size_t)(row0 + Lc - 3 + k) * 512 + ch];
      if (isS) p.out[LC_S + (((size_t)l * SBT + b) * 3 + k) * 512 + ch] = v;
      else p.out[LC_P + (((size_t)l * PB + b) * 3 + k) * 512 + ch] = v;
    }
  }
  __syncthreads();
  {
    const float* ba = p.in[18] + (size_t)l * 512 + nb * 64;
    const float* bx = p.in[20] + (size_t)l * 512 + nb * 64;
    const float* lm = p.in[21] + (size_t)l * 512 + nb * 64;
#pragma unroll
    for (int n = 0; n < 4; ++n) {
      f32x4 r = lds_mm<2>(xcs, LP, wid * 16, was, LP, n * 16, f32x4{0.f, 0.f, 0.f, 0.f});
      f32x4 g = lds_mm<2>(xcs, LP, wid * 16, wxs, LP, n * 16, f32x4{0.f, 0.f, 0.f, 0.f});
      const int j = n * 16 + fr;
      const float sp = softplusf_(-lm[j]), bav = ba[j], bxv = bx[j];
#pragma unroll
      for (int q = 0; q < 4; ++q) {
        const int t = wid * 16 + fq * 4 + q;
        const float rr = sigmoidf_(r[q] + bav), ii = sigmoidf_(g[q] + bxv);
        const float la = -8.f * rr * sp;
        const float a = __expf(la);
        const float x2 = 2.f * la;
        const float om = (x2 > -0.01f) ? -x2 * (1.f + x2 * (0.5f + x2 * (1.f / 6.f))) : 1.f - __expf(x2);
        const float u = sqrtf(om) * ii * bf2f(xcs[t * LP + j]);
        as_[t * 64 + j] = a;
        us_[t * 64 + j] = u;
      }
    }
  }
  __syncthreads();
  {
    float av[16], uv[16];
#pragma unroll
    for (int k = 0; k < 16; ++k) { av[k] = as_[(tq * 16 + k) * 64 + i]; uv[k] = us_[(tq * 16 + k) * 64 + i]; }
    float P = 1.f, hh = 0.f;
#pragma unroll
    for (int k = 0; k < 16; ++k) { P *= av[k]; hh = av[k] * hh + uv[k]; }
    segP[tq * 64 + i] = P; segH[tq * 64 + i] = hh;
    __syncthreads();
    float Pin = 1.f, hin = 0.f;
    for (int g = 0; g < tq; ++g) { const float pg = segP[g * 64 + i], hg = segH[g * 64 + i]; hin = pg * hin + hg; Pin *= pg; }
    u16* HL = (u16*)(p.ws + O_HL);
    u16* PPp = (u16*)(p.ws + O_PP);
    P = Pin; hh = hin;
#pragma unroll
    for (int k = 0; k < 16; ++k) {
      const int t = tq * 16 + k;
      P *= av[k]; hh = av[k] * hh + uv[k];
      if (t < Lc) {
        HL[(size_t)(row0 + t) * 512 + ch] = f2bf(hh);
        PPp[(size_t)(row0 + t) * 512 + ch] = f2bf(P);
      }
    }
    if (tq * 16 + 16 == Lc) {
      ((float*)(p.ws + O_CA))[(size_t)ci * 512 + ch] = P;
      ((float*)(p.ws + O_CH))[(size_t)ci * 512 + ch] = hh;
    }
  }
}
constexpr int L2_ITEMS = 8 + 32;
DI void lru2_item(const Params& p, int l, int it) {
  const float* CA = (const float*)(p.ws + O_CA);
  const float* CH = (const float*)(p.ws + O_CH);
  float* HS = (float*)(p.ws + O_HS);
  if (it < 8) {
    const int e = it * 256 + TID(), b = e >> 9, ch = e & 511;
    float hh = 0.f;
    for (int c0 = 0; c0 < 128; c0 += 16) {
      float ca[16], chv[16];
#pragma unroll
      for (int c = 0; c < 16; ++c) { const size_t o = (size_t)(b * 128 + c0 + c) * 512 + ch; ca[c] = CA[o]; chv[c] = CH[o]; }
#pragma unroll
      for (int c = 0; c < 16; ++c) { const size_t o = (size_t)(b * 128 + c0 + c) * 512 + ch; HS[o] = hh; hh = ca[c] * hh + chv[c]; }
    }
    p.out[LH_P + ((size_t)l * PB + b) * 512 + ch] = hh;
  } else {
    const int e = (it - 8) * 256 + TID(), b = e >> 9, ch = e & 511;
    const float h0 = p.in[6][((size_t)l * SBT + b) * 512 + ch];
    const size_t o = (size_t)(MP / 64 + b) * 512 + ch;
    HS[o] = h0;
    p.out[LH_S + ((size_t)l * SBT + b) * 512 + ch] = CA[o] * h0 + CH[o];
  }
}
constexpr int L3_ITEMS = MT / 8;
DI void lru3_item(const Params& p, int it) {
  const u16* HL = (const u16*)(p.ws + O_HL);
  const u16* PPp = (const u16*)(p.ws + O_PP);
  const u16* LG = (const u16*)(p.ws + O_LG);
  const float* HS = (const float*)(p.ws + O_HS);
  u16* OL = (u16*)(p.ws + O_OL);
#pragma unroll
  for (int i = 0; i < 4; ++i) {
    const int id = TID() + i * 256;
    const int row = it * 8 + (id >> 7), c4 = (id & 127) * 4;
    const int ci = row < MP ? (row >> 6) : MP / 64 + ((row - MP) >> 5);
    const size_t o = (size_t)row * 512 + c4;
    const uint2 hl = *(const uint2*)(HL + o), pp = *(const uint2*)(PPp + o), lg = *(const uint2*)(LG + o);
    const float4 hs = *(const float4*)(HS + (size_t)ci * 512 + c4);
    float y0 = (bf2f(hl.x & 0xffff) + bf2f(pp.x & 0xffff) * hs.x) * gelu_tanh(bf2f(lg.x & 0xffff));
    float y1 = (bf2f(hl.x >> 16) + bf2f(pp.x >> 16) * hs.y) * gelu_tanh(bf2f(lg.x >> 16));
    float y2 = (bf2f(hl.y & 0xffff) + bf2f(pp.y & 0xffff) * hs.z) * gelu_tanh(bf2f(lg.y & 0xffff));
    float y3 = (bf2f(hl.y >> 16) + bf2f(pp.y >> 16) * hs.w) * gelu_tanh(bf2f(lg.y >> 16));
    *(uint2*)(OL + o) = uint2{pack2(y0, y1), pack2(y2, y3)};
  }
}

DI void ybr_tile(const Params& p, int l, int mt, int nt, char* smem) {
  const int row0 = mt * 256, col0 = nt * 256, br = nt >> 2;
  const u16* W = (const u16*)(p.ws + O_WT) + (size_t)l * W_LAYER + W_BR + (size_t)br * 1024 * 512 + (size_t)((nt & 3) * 256) * 512;
  const u16* O = (const u16*)(p.ws + (br == 0 ? O_OA : (br == 1 ? O_OG : O_OL))) + (size_t)row0 * 512;
  f32x4 acc[8][4];
  zero_acc8(acc);
  gemm512(O, 512, W, 512, 512, acc, smem);
  tile_out_bf16<false>(acc, (u16*)(p.ws + O_YP) + (size_t)row0 * 3072 + col0, 3072, smem, 1.f, 0, nullptr);
}
DI void gate_tile(const Params& p, int l, int mt, int nt, char* smem) {
  const int row0 = mt * 256, col0 = nt * 256;
  const u16* W = (const u16*)(p.ws + O_WT) + (size_t)l * W_LAYER + W_MG + (size_t)col0 * LDK;
  f32x4 acc[8][4];
  zero_acc8(acc);
  gemm512((const u16*)(p.ws + O_XN) + (size_t)row0 * LDK, LDK, W, LDK, 1024, acc, smem);
  EPI_IDS;
  u16* Y = (u16*)(p.ws + O_YP) + (size_t)row0 * 3072 + col0;
  const float* bm = p.in[26] + (size_t)l * 3072 + col0 + wc * 64 + fr;
  img_load_bf16(Y, 3072, smem, 256, 0);
  img_barrier();
  u16* img = (u16*)smem + (wr * 128 + fq * 4) * IMG_LD + wc * 64 + fr;
#pragma unroll
  for (int n = 0; n < 4; ++n) {
    const float bv = bm[n * 16];
#pragma unroll
    for (int m = 0; m < 8; ++m)
#pragma unroll
      for (int j = 0; j < 4; ++j) {
        u16* q = img + (m * 16 + j) * IMG_LD + n * 16;
        *q = f2bf(sigmoidf_(acc[m][n][j] + bv) * bf2f(*q));
      }
  }
  img_barrier();
  img_store_bf16(Y, 3072, smem, 0);
}
DI void resid_tile(const Params& p, const u16* A, int ldk, const u16* W, int mt, int nt, int k0, int klen, bool atomic, char* smem) {
  const int row0 = mt * 256, col0 = nt * 256;
  f32x4 acc[8][4];
  zero_acc8(acc);
  gemm512(A + (size_t)row0 * ldk + k0, ldk, W + (size_t)col0 * ldk + k0, ldk, klen, acc, smem);
  if (!atomic) { tile_out_f32<true, false>(acc, p.out + (size_t)row0 * 1024 + col0, 1024, smem, 0, nullptr); return; }
  EPI_IDS;
#pragma unroll
  for (int m = 0; m < 8; ++m) {
    asm volatile("" ::: "memory");
#pragma unroll
    for (int n = 0; n < 4; ++n)
#pragma unroll
      for (int j = 0; j < 4; ++j) {
        const int row = row0 + wr * 128 + m * 16 + fq * 4 + j, col = col0 + wc * 64 + n * 16 + fr;
        float* q = p.out + (size_t)row * 1024 + col;
        if (atomic) unsafeAtomicAdd(q, acc[m][n][j]); else *q += acc[m][n][j];
      }
  }
}
DI void resid_phase(const Params& p, const u16* A, int ldk, const u16* W, int B, int G, char* smem) {
  const int ns = ldk / 256;
  int k = 0, u = B;
  while (true) {
    int mt, nt, k0 = 0, kl = ldk;
    bool at = false;
    if (xcd_tile(B, G, k, 128, 4, mt, nt)) { ++k; }
    else if (u < 8 * ns) { const int t = u / ns, sl = u - t * ns; mt = 128 + (t >> 2); nt = t & 3; k0 = sl * 256; kl = 256; at = true; u += G; }
    else break;
    asm volatile("" : "+s"(kl));
    resid_tile(p, A, ldk, W, mt, nt, k0, kl, at, smem);
  }
}

DI void ffgate_tile(const Params& p, int l, int mt, int nt, char* smem) {
  const int row0 = mt * 256, col0 = nt * 256;
  const u16* W = (const u16*)(p.ws + O_WT) + (size_t)l * W_LAYER + W_FG;
  f32x4 acc[8][4];
  zero_acc8(acc);
  gemm512((const u16*)(p.ws + O_XN) + (size_t)row0 * LDK, LDK, W + (size_t)col0 * LDK, LDK, 1024, acc, smem);
  if (mt < 128) {
    EPI_IDS;
    tile_out_bf16<false>(acc, (u16*)(p.ws + O_GU) + (size_t)row0 * DFF + col0, DFF, smem, 1.f, 0, nullptr);
    if (((row0 + 256) & 8191) == 0 && wr == 1 && fq == 3) {
      const int b = row0 >> 13;
#pragma unroll
      for (int n = 0; n < 4; ++n) {
        const int col = col0 + wc * 64 + n * 16 + fr;
        p.out[FC_P + (((size_t)l * PB + b) * 2 + 0) * DFF + col] = acc[7][n][2];
        p.out[FC_P + (((size_t)l * PB + b) * 2 + 1) * DFF + col] = acc[7][n][3];
      }
    }
    return;
  }
  EPI_IDS;
  u16* GU = (u16*)(p.ws + O_GU);
  const bool isS = row0 >= MP;
#pragma unroll
  for (int m = 0; m < 8; ++m) {
    asm volatile("" ::: "memory");
#pragma unroll
    for (int n = 0; n < 4; ++n)
#pragma unroll
      for (int j = 0; j < 4; ++j) {
        const int row = row0 + wr * 128 + m * 16 + fq * 4 + j, col = col0 + wc * 64 + n * 16 + fr;
        const float v = acc[m][n][j];
        GU[(size_t)row * DFF + col] = f2bf(v);
        if (isS) {
          const int rs = row - MP, b = rs >> 5, t = rs & 31;
          if (t >= STT - 2) p.out[FC_S + (((size_t)l * SBT + b) * 2 + (t - (STT - 2))) * DFF + col] = v;
        } else {
          const int b = row >> 13, t = row & 8191;
          if (t >= PT - 2) p.out[FC_P + (((size_t)l * PB + b) * 2 + (t - (PT - 2))) * DFF + col] = v;
        }
      }
  }
}
DI void ffup_tile(const Params& p, int l, int mt, int nt, char* smem) {
  const int row0 = mt * 256, col0 = nt * 256;
  const u16* W = (const u16*)(p.ws + O_WT) + (size_t)l * W_LAYER + W_FU;
  f32x4 acc[8][4];
  zero_acc8(acc);
  gemm512((const u16*)(p.ws + O_XN) + (size_t)row0 * LDK, LDK, W + (size_t)col0 * LDK, LDK, 1024, acc, smem);
  if (mt < 128) {
    EPI_IDS;
    const u16* GUt = (const u16*)(p.ws + O_GU) + (size_t)row0 * DFF + col0;
    if (row0 >= 2) img_load_bf16(GUt - 2 * DFF, DFF, smem, 258, 0); else img_load_bf16(GUt, DFF, smem, 256, 2);
    img_barrier();
    const u16* img = (const u16*)smem + (wr * 128 + fq * 4) * IMG_LD + wc * 64 + fr;
#pragma unroll
    for (int n = 0; n < 4; ++n) {
      const int col = col0 + wc * 64 + n * 16 + fr;
      const float* cw = p.in[30] + (size_t)l * 3 * DFF + col;
      const float w0 = cw[0], w1 = cw[DFF], w2 = cw[2 * DFF], cb = p.in[31][(size_t)l * DFF + col];
#pragma unroll
      for (int m = 0; m < 8; ++m) {
        if ((m & 1) == 0) asm volatile("" ::: "memory");
        const int t = (row0 + wr * 128 + m * 16 + fq * 4) & 8191;
        float g[6];
#pragma unroll
        for (int d = 0; d < 6; ++d) { const float gv = bf2f(img[(m * 16 + d) * IMG_LD + n * 16]); g[d] = (d >= 2 || t - 2 + d >= 0) ? gv : 0.f; }
#pragma unroll
        for (int j = 0; j < 4; ++j) acc[m][n][j] *= gelu_tanh(cb + w0 * g[j] + w1 * g[j + 1] + w2 * g[j + 2]);
      }
    }
    img_barrier();
    img_put_bf16<false>(acc, smem, 2, 1.f, 0, nullptr);
    img_barrier();
    img_store_bf16((u16*)(p.ws + O_FF) + (size_t)row0 * DFF + col0, DFF, smem, 2);
    return;
  }
  EPI_IDS;
  const u16* GU = (const u16*)(p.ws + O_GU);
  u16* FF = (u16*)(p.ws + O_FF);
  const bool isS = row0 >= MP;
  const int rowq = row0 + wr * 128 + fq * 4;
  const unsigned gbase = (unsigned)rowq * (unsigned)DFF + (unsigned)(col0 + wc * 64 + fr);
#pragma unroll
  for (int n = 0; n < 4; ++n) {
    const int col = col0 + wc * 64 + n * 16 + fr;
    const float* cw = p.in[30] + (size_t)l * 3 * DFF + col;
    const float w0 = cw[0], w1 = cw[DFF], w2 = cw[2 * DFF], cb = p.in[31][(size_t)l * DFF + col];
#pragma unroll
    for (int mh = 0; mh < 2; ++mh) {
      asm volatile("" ::: "memory");
      float g[4][6];
#pragma unroll
      for (int m = 0; m < 4; ++m) {
        const int rowb = rowq + (mh * 4 + m) * 16;
        int b, t;
        if (isS) { int rs = rowb - MP; b = rs >> 5; t = rs & 31; } else { b = rowb >> 13; t = rowb & 8191; }
#pragma unroll
        for (int d = 0; d < 6; ++d) {
          const int tt = t - 2 + d;
          if (tt >= 0) g[m][d] = bf2f(GU[gbase + (unsigned)((((mh * 4 + m) * 16 + d) * DFF) + n * 16) - 2u * (unsigned)DFF]);
          else g[m][d] = isS ? p.in[7][(((size_t)l * SBT + b) * 2 + (2 + tt)) * DFF + col] : 0.f;
        }
      }
#pragma unroll
      for (int m = 0; m < 4; ++m)
#pragma unroll
        for (int j = 0; j < 4; ++j) {
          const float gc = cb + w0 * g[m][j] + w1 * g[m][j + 1] + w2 * g[m][j + 2];
          FF[gbase + (unsigned)((((mh * 4 + m) * 16 + j) * DFF) + n * 16)] = f2bf(gelu_tanh(gc) * acc[mh * 4 + m][n][j]);
        }
    }
  }
}

DI void norm_phase(const Params& p, int l, int mode, int B, int G, char* smem) {
  const int tid = TID512(), lane = tid & 63, wid = tid >> 6;
  const float* gamma = mode == 0 ? p.in[8] + (size_t)l * 1024 : (mode == 1 ? p.in[28] + (size_t)l * 1024 : p.in[34]);
  float* wga = (float*)smem;
  if (mode == 0) {
    __syncthreads();
    const float* src = p.in[9] + (size_t)l * 1024 * PW + 3072;
#pragma unroll
    for (int i = 0; i < 8; ++i) {
      const int id = tid + i * 512, k = id >> 2, part = id & 3;
      ((float4*)wga)[(((k >> 8) * 4 + (k & 3)) * 4 + part) * 64 + ((k >> 2) & 63)] = *(const float4*)(src + (size_t)k * PW + part * 4);
    }
    __syncthreads();
  }
  float4 g[4];
#pragma unroll
  for (int i = 0; i < 4; ++i) g[i] = *(const float4*)(gamma + i * 256 + lane * 4);
  for (int row = B * 8 + wid; row < MT; row += G * 8) {
    float* X = p.out + (size_t)row * 1024;
    float4 v[4];
    float ss = 0.f;
#pragma unroll
    for (int i = 0; i < 4; ++i) { v[i] = *(const float4*)(X + i * 256 + lane * 4); ss += v[i].x * v[i].x + v[i].y * v[i].y + v[i].z * v[i].z + v[i].w * v[i].w; }
    ss = wave_sum(ss);
    const float rs = rsqrtf(ss * (1.f / 1024.f) + EPS);
    u16* XN = (u16*)(p.ws + O_XN) + (size_t)row * LDK;
#pragma unroll
    for (int i = 0; i < 4; ++i) {
      v[i] = float4{v[i].x * rs * g[i].x, v[i].y * rs * g[i].y, v[i].z * rs * g[i].z, v[i].w * rs * g[i].w};
      if (mode == 2) *(float4*)(X + i * 256 + lane * 4) = v[i];
      else *(uint2*)(XN + i * 256 + lane * 4) = uint2{pack2(v[i].x, v[i].y), pack2(v[i].z, v[i].w)};
    }
    if (mode == 0) {
      float ga[16];
#pragma unroll
      for (int r = 0; r < 16; ++r) ga[r] = 0.f;
#pragma unroll
      for (int i = 0; i < 4; ++i) {
        const float xv[4] = {v[i].x, v[i].y, v[i].z, v[i].w};
#pragma unroll
        for (int e = 0; e < 4; ++e) {
          asm volatile("" ::: "memory");
#pragma unroll
          for (int q = 0; q < 4; ++q) {
            const float4 w = ((const float4*)wga)[((i * 4 + e) * 4 + q) * 64 + lane];
            ga[q * 4 + 0] += xv[e] * w.x; ga[q * 4 + 1] += xv[e] * w.y; ga[q * 4 + 2] += xv[e] * w.z; ga[q * 4 + 3] += xv[e] * w.w;
          }
        }
      }
      float mine = 0.f;
#pragma unroll
      for (int r = 0; r < 16; ++r) { const float s = wave_sum(ga[r]); if (lane == r) mine = s; }
      if (lane < 16) ((float*)(p.ws + O_GA))[(size_t)row * 16 + lane] = mine;
    }
  }
}

#ifndef ONLY
#define ONLY -1
#endif
constexpr int HALF_LDS = 73728;
constexpr int SMEM_BYTES = 2 * HALF_LDS;
#define VB() (2 * B + (TID512() >> 8))
#define HS() (smem + (TID512() >> 8) * HALF_LDS)
__global__ void __launch_bounds__(512, 2) mega(Params p) {
  cg::grid_group grid = cg::this_grid();
  extern __shared__ __attribute__((aligned(16))) char smem[];
  const int G = gridDim.x, B = blockIdx.x;
  const int vG = 2 * G;
  if (ONLY < 0 || ONLY == 0) for (int it = VB(); it < PREP_ITEMS; it += vG) prep_item(p, it, HS());
  grid.sync();
  for (int l = 0; l < NL; ++l) {
    const u16* W = (const u16*)(p.ws + O_WT) + (size_t)l * W_LAYER;
    if (ONLY < 0 || ONLY == 1) norm_phase(p, l, 0, B, G, smem);
    grid.sync();
    if (ONLY < 0 || ONLY == 2) { int mt, nt; for (int k = 0; xcd_tile(B, G, k, 130, 16, mt, nt); ++k) projin_tile(p, l, mt, nt, smem); for (int it = VB(); it < PB_KC + PB_VC; it += vG) cache_conv_item(p, l, it, HS()); }
    grid.sync();
    if (ONLY < 0 || ONLY == 3) for (int it = B; it < 1024 + 64; it += G) attn_item(p, l, it, smem);
    if (ONLY < 0 || ONLY == 13) for (int it = VB(); it < NGI; it += vG) gla1_item(p, l, it, HS());
    if (ONLY < 0 || ONLY == 14) for (int it = VB(); it < L1_ITEMS; it += vG) lru1_item(p, l, it, HS());
    grid.sync();
    if (ONLY < 0 || ONLY == 4) for (int it = VB(); it < G2_ITEMS + L2_ITEMS; it += vG) { if (it < G2_ITEMS) gla2_item(p, l, it); else lru2_item(p, l, it - G2_ITEMS); }
    grid.sync();
    if (ONLY < 0 || ONLY == 5) { for (int it = VB(); it < NGI; it += vG) gla3_item(p, l, it, HS()); for (int it = VB(); it < L3_ITEMS; it += vG) lru3_item(p, it); }
    grid.sync();
    if (ONLY < 0 || ONLY == 6) { int mt, nt; for (int k = 0; xcd_tile(B, G, k, 130, 12, mt, nt); ++k) ybr_tile(p, l, mt, nt, smem); }
    grid.sync();
    if (ONLY < 0 || ONLY == 7) { int mt, nt; for (int k = 0; xcd_tile(B, G, k, 130, 12, mt, nt); ++k) gate_tile(p, l, mt, nt, smem); }
    grid.sync();
    if (ONLY < 0 || ONLY == 8) resid_phase(p, (const u16*)(p.ws + O_YP), 3072, W + W_OUT, B, G, smem);
    grid.sync();
    if (ONLY < 0 || ONLY == 9) norm_phase(p, l, 1, B, G, smem);
    grid.sync();
    if (ONLY < 0 || ONLY == 10) { int mt, nt; for (int k = 0; xcd_tile(B, G, k, 130, 11, mt, nt); ++k) ffgate_tile(p, l, mt, nt, smem); }
    grid.sync();
    if (ONLY < 0 || ONLY == 11) { int mt, nt; for (int k = 0; xcd_tile(B, G, k, 130, 11, mt, nt); ++k) ffup_tile(p, l, mt, nt, smem); }
    grid.sync();
    if (ONLY < 0 || ONLY == 12) resid_phase(p, (const u16*)(p.ws + O_FF), DFF, W + W_FD, B, G, smem);
    grid.sync();
  }
  if (ONLY < 0 || ONLY == 15) norm_phase(p, 0, 2, B, G, smem);
}

extern "C" void kernel_launch(void* const* d_in, const int* in_sizes, int n_in, void* d_out, int out_size, void* d_ws, size_t ws_size,
                              hipStream_t stream) {
  static int grid_blocks = 0;
  if (!grid_blocks) {
    int dev = 0, cus = 0, per = 0;
    (void)hipGetDevice(&dev);
    (void)hipDeviceGetAttribute(&cus, hipDeviceAttributeMultiprocessorCount, dev);
    (void)hipFuncSetAttribute((const void*)mega, hipFuncAttributeMaxDynamicSharedMemorySize, SMEM_BYTES);
    (void)hipOccupancyMaxActiveBlocksPerMultiprocessor(&per, mega, 512, SMEM_BYTES);
    if (per < 1) per = 1;
    grid_blocks = cus;
  }
  if (ws_size < WS_NEED) fprintf(stderr, "workspace too small: %zu < %zu\n", ws_size, (size_t)WS_NEED);
  Params p{};
  for (int i = 0; i < 35; ++i) p.in[i] = (const float*)d_in[i];
  p.out = (float*)d_out;
  p.ws = (char*)d_ws;
  void* args[] = {&p};
  hipError_t e = hipLaunchCooperativeKernel((void*)mega, dim3(grid_blocks), dim3(512), args, SMEM_BYTES, stream);
  if (e != hipSuccess) fprintf(stderr, "cooperative launch failed: %s (grid %d)\n", hipGetErrorString(e), grid_blocks);
}
```

```cpp
#include <hip/hip_runtime.h>
#include <hip/hip_cooperative_groups.h>
#include <cstdio>
namespace cg = cooperative_groups;

#define DI __device__ __forceinline__
typedef unsigned short u16;
using bf16x8 = __attribute__((ext_vector_type(8))) short;
using f32x4 = __attribute__((ext_vector_type(4))) float;
using u32x4 = __attribute__((ext_vector_type(4))) unsigned;
#define MFMA16(a, b, c) __builtin_amdgcn_mfma_f32_16x16x32_bf16((a), (b), (c), 0, 0, 0)

constexpr int DM = 1024, PB = 4, PT = 8192, SBT = 16, STT = 32, PAST = 2048, NL = 4;
constexpr int MP = PB * PT, MS = SBT * STT, MT = MP + MS;
constexpr int SKP = 2112;
constexpr int SKV = PAST + STT;
constexpr int DFF = 2816, PW = 4112, PWP = 4224;
constexpr int NGI = PB * 4 * 128 + SBT * 4;
constexpr int NLC = MP / 64 + SBT;
constexpr float EPS = 1e-6f;
constexpr float QSCALE = 0.125f * 1.4426950408889634f;
constexpr int LDK = 1088;

constexpr size_t W_IN = 0, W_MG = W_IN + (size_t)4096 * LDK, W_BR = W_MG + (size_t)3072 * LDK, W_OUT = W_BR + (size_t)3 * 1024 * 512,
                 W_FG = W_OUT + (size_t)1024 * 3072, W_FU = W_FG + (size_t)DFF * LDK, W_FD = W_FU + (size_t)DFF * LDK,
                 W_WA = W_FD + (size_t)1024 * DFF, W_WX = W_WA + 32768, W_LAYER = W_WX + 32768;

struct Params {
  const float* in[35];
  float* out;
  char* ws;
};

constexpr size_t al(size_t x) { return (x + 255) & ~(size_t)255; }
constexpr size_t O_WT = 0;
constexpr size_t O_ROPE = al(O_WT + W_LAYER * NL * 2);
constexpr size_t O_LAM = al(O_ROPE + 2 * 8192 * 8 * 4);
constexpr size_t O_XN = al(O_LAM + 256);
constexpr size_t O_REG = al(O_XN + (size_t)MT * LDK * 2);
constexpr size_t O_QB = O_REG;
constexpr size_t O_KB = al(O_QB + (size_t)MT * 512 * 2);
constexpr size_t O_KS = al(O_KB + (size_t)MP * 512 * 2);
constexpr size_t O_VT = al(O_KS + (size_t)SBT * SKP * 512 * 2);
constexpr size_t O_VTS = al(O_VT + (size_t)MP * 512 * 2);
constexpr size_t O_GQ = al(O_VTS + (size_t)SBT * SKP * 512 * 2);
constexpr size_t O_GK = al(O_GQ + (size_t)MT * 256 * 2);
constexpr size_t O_GV = al(O_GK + (size_t)MT * 256 * 2);
constexpr size_t O_GR = al(O_GV + (size_t)MT * 512 * 2);
constexpr size_t O_GA = al(O_GR + (size_t)MT * 512 * 2);
constexpr size_t O_LX = al(O_GA + (size_t)MT * 16 * 4);
constexpr size_t O_LG = al(O_LX + (size_t)MT * 512 * 4);
constexpr size_t O_KVT = al(O_LG + (size_t)MT * 512 * 2);
constexpr size_t O_DEC = al(O_KVT + (size_t)NGI * 8192 * 2);
constexpr size_t O_HL = al(O_DEC + (size_t)NGI * 64 * 4);
constexpr size_t O_PP = al(O_HL + (size_t)MT * 512 * 2);
constexpr size_t O_CA = al(O_PP + (size_t)MT * 512 * 2);
constexpr size_t O_CH = al(O_CA + (size_t)NLC * 512 * 4);
constexpr size_t O_HS = al(O_CH + (size_t)NLC * 512 * 4);
constexpr size_t O_OA = al(O_HS + (size_t)NLC * 512 * 4);
constexpr size_t O_OG = al(O_OA + (size_t)MT * 512 * 2);
constexpr size_t O_OL = al(O_OG + (size_t)MT * 512 * 2);
constexpr size_t O_END1 = al(O_OL + (size_t)MT * 512 * 2);
constexpr size_t O_YP = O_QB;
static_assert(O_YP + (size_t)MT * 3072 * 2 <= O_OA, "Y buffer overlaps live mixer outputs");
constexpr size_t O_GU = O_REG;
constexpr size_t O_FF = al(O_GU + (size_t)MT * DFF * 2);
constexpr size_t O_END2 = al(O_FF + (size_t)MT * DFF * 2);
constexpr size_t WS_NEED = O_END1 > O_END2 ? O_END1 : O_END2;

constexpr size_t Y_P = 0, Y_S = Y_P + (size_t)MP * 1024, K_P = Y_S + (size_t)MS * 1024, V_P = K_P + (size_t)NL * MP * 512,
                 GLA_P = V_P + (size_t)NL * MP * 512, LC_P = GLA_P + (size_t)NL * PB * 32768, LH_P = LC_P + (size_t)NL * PB * 3 * 512,
                 FC_P = LH_P + (size_t)NL * PB * 512, K_S = FC_P + (size_t)NL * PB * 2 * DFF, V_S = K_S + (size_t)NL * MS * 512,
                 GLA_S = V_S + (size_t)NL * MS * 512, LC_S = GLA_S + (size_t)NL * SBT * 32768, LH_S = LC_S + (size_t)NL * SBT * 3 * 512,
                 FC_S = LH_S + (size_t)NL * SBT * 512, OUT_TOTAL = FC_S + (size_t)NL * SBT * 2 * DFF;

DI int TID() { int t = threadIdx.x & 255; asm volatile("" : "+v"(t)); return t; }
DI int TID512() { int t = threadIdx.x; asm volatile("" : "+v"(t)); return t; }
DI u16 f2bf(float x) { __bf16 h = (__bf16)x; return __builtin_bit_cast(u16, h); }
DI float bf2f(u16 h) { return __uint_as_float(((unsigned)h) << 16); }
typedef __bf16 bf16v2_t __attribute__((ext_vector_type(2)));
typedef float f32v2_t __attribute__((ext_vector_type(2)));
DI unsigned pack2(float a, float b) { f32v2_t v = {a, b}; bf16v2_t r = __builtin_convertvector(v, bf16v2_t); return __builtin_bit_cast(unsigned, r); }
DI float sigmoidf_(float x) { return __builtin_amdgcn_rcpf(1.f + __expf(-x)); }
DI float gelu_tanh(float x) { float u = 0.7978845608028654f * (x + 0.044715f * x * x * x); return x * sigmoidf_(2.f * u); }
DI float softplusf_(float x) { return fmaxf(x, 0.f) + __logf(1.f + __expf(-fabsf(x))); }
DI float quad_max(float v) {
  auto a = __builtin_amdgcn_permlane16_swap(__float_as_uint(v), __float_as_uint(v), false, false);
  v = fmaxf(__uint_as_float(a[0]), __uint_as_float(a[1]));
  auto b = __builtin_amdgcn_permlane32_swap(__float_as_uint(v), __float_as_uint(v), false, false);
  return fmaxf(__uint_as_float(b[0]), __uint_as_float(b[1]));
}
DI float wave_sum(float v) {
  for (int o = 32; o > 0; o >>= 1) v += __shfl_xor(v, o);
  return v;
}

DI void gemm512(const u16* __restrict__ A, int lda, const u16* __restrict__ B, int ldb, int K, f32x4 (&acc)[8][4], char* smem) {
  const int tid = TID512(), lane = tid & 63, wid = tid >> 6, wr = wid >> 2, wc = wid & 3, fr = lane & 15, fq = lane >> 4;
  const int lrow = tid >> 3;
  const int gch = (tid & 7) ^ ((lrow >> 1) & 7);
  const unsigned aov = (unsigned)(lrow * lda + gch * 8);
  const unsigned bov = (unsigned)(lrow * ldb + gch * 8);
  const int soff = tid * 16;
  const int sw = (fr >> 1) & 7;
  const int aoff = (wr * 128 + fr) * 128, boff = 32768 + (wc * 64 + fr) * 128;
  const int nk = K >> 6;
  asm volatile("s_waitcnt vmcnt(0) lgkmcnt(0)" ::: "memory");
  __builtin_amdgcn_s_barrier();
#pragma unroll
  for (int i = 0; i < 4; ++i) {
    __builtin_amdgcn_global_load_lds((const unsigned*)((A + (size_t)i * 64 * lda) + aov), (unsigned*)(smem + soff + i * 8192), 16, 0, 0);
    __builtin_amdgcn_global_load_lds((const unsigned*)((B + (size_t)i * 64 * ldb) + bov), (unsigned*)(smem + 32768 + soff + i * 8192), 16, 0, 0);
  }
  asm volatile("s_waitcnt vmcnt(0)" ::: "memory");
  __builtin_amdgcn_s_barrier();
  for (int kt = 0; kt < nk; ++kt) {
    const int buf = kt & 1;
    if (kt + 1 < nk) {
      char* st = smem + (buf ^ 1) * 65536 + soff;
      const u16* An = A + (kt + 1) * 64;
      const u16* Bn = B + (kt + 1) * 64;
#pragma unroll
      for (int i = 0; i < 4; ++i) {
        __builtin_amdgcn_global_load_lds((const unsigned*)((An + (size_t)i * 64 * lda) + aov), (unsigned*)(st + i * 8192), 16, 0, 0);
        __builtin_amdgcn_global_load_lds((const unsigned*)((Bn + (size_t)i * 64 * ldb) + bov), (unsigned*)(st + 32768 + i * 8192), 16, 0, 0);
      }
    }
    const char* Sb = smem + buf * 65536;
#pragma unroll
    for (int ks = 0; ks < 2; ++ks) {
      const int co = ((ks * 4 + fq) ^ sw) << 4;
      bf16x8 bfr[4], af[8];
#pragma unroll
      for (int n = 0; n < 4; ++n) bfr[n] = *(const bf16x8*)(Sb + boff + n * 2048 + co);
#pragma unroll
      for (int m = 0; m < 8; ++m) af[m] = *(const bf16x8*)(Sb + aoff + m * 2048 + co);
      __builtin_amdgcn_sched_barrier(0);
#pragma unroll
      for (int m = 0; m < 8; ++m)
#pragma unroll
        for (int n = 0; n < 4; ++n) acc[m][n] = MFMA16(af[m], bfr[n], acc[m][n]);
      __builtin_amdgcn_sched_barrier(0);
    }
    asm volatile("s_waitcnt vmcnt(0) lgkmcnt(0)" ::: "memory");
    __builtin_amdgcn_s_barrier();
  }
}
DI void zero_acc8(f32x4 (&acc)[8][4]) {
#pragma unroll
  for (int m = 0; m < 8; ++m)
#pragma unroll
    for (int n = 0; n < 4; ++n) acc[m][n] = f32x4{0.f, 0.f, 0.f, 0.f};
}
#define EPI_IDS const int tid = TID512(), lane = tid & 63, wid = tid >> 6, wr = wid >> 2, wc = wid & 3, fr = lane & 15, fq = lane >> 4


constexpr int IMG_LD = 264;
constexpr int IMGF_LD = 260;
DI void img_barrier() { asm volatile("s_waitcnt vmcnt(0) lgkmcnt(0)" ::: "memory"); __builtin_amdgcn_s_barrier(); }
template <bool ROPE>
DI float epi_val(const f32x4 (&acc)[8][4], int m, int n, int j, const float* cs4, const float* sn4, int fr) {
  float v = acc[m][n][j];
  if (ROPE && n == 0) {
    const float pr = __shfl_xor(v, 8);
    v = (fr < 8) ? v * cs4[j] - pr * sn4[j] : v * cs4[j] + pr * sn4[j];
  }
  return v;
}
template <bool ROPE>
DI void img_put_bf16(const f32x4 (&acc)[8][4], char* smem, int rowoff, float scale, int prow0, const float* cosT) {
  EPI_IDS;
  u16* img = (u16*)smem + (wr * 128 + fq * 4 + rowoff) * IMG_LD + wc * 64 + fr;
#pragma unroll
  for (int m = 0; m < 8; ++m) {
    float cs4[4] = {0.f, 0.f, 0.f, 0.f}, sn4[4] = {0.f, 0.f, 0.f, 0.f};
    if (ROPE) {
#pragma unroll
      for (int j = 0; j < 4; ++j) { const int pos = prow0 + wr * 128 + m * 16 + fq * 4 + j; cs4[j] = cosT[pos * 8 + (fr & 7)]; sn4[j] = cosT[8192 * 8 + pos * 8 + (fr & 7)]; }
    }
#pragma unroll
    for (int n = 0; n < 4; ++n)
#pragma unroll
      for (int j = 0; j < 4; ++j) img[(m * 16 + j) * IMG_LD + n * 16] = f2bf(epi_val<ROPE>(acc, m, n, j, cs4, sn4, fr) * scale);
  }
}
DI void img_store_bf16(u16* dst, int ld, const char* smem, int rowoff) {
  const int tid = TID512();
#pragma unroll
  for (int q = 0; q < 16; ++q) {
    const int slot = tid + q * 512, row = slot >> 5, c16 = slot & 31;
    *(u32x4*)(dst + (size_t)row * ld + c16 * 8) = *(const u32x4*)(smem + (row + rowoff) * (IMG_LD * 2) + c16 * 16);
  }
}
DI void img_load_bf16(const u16* src, int ld, char* smem, int nrows, int rowoff) {
  for (int slot = TID512(); slot < nrows * 32; slot += 512) {
    const int row = slot >> 5, c16 = slot & 31;
    *(u32x4*)(smem + (row + rowoff) * (IMG_LD * 2) + c16 * 16) = *(const u32x4*)(src + (size_t)row * ld + c16 * 8);
  }
}
template <bool ROPE>
DI void imgf_put(const f32x4 (&acc)[8][4], int h, char* smem, int prow0, const float* cosT) {
  EPI_IDS;
  if (wr == h) {
    float* f = (float*)smem + (fq * 4) * IMGF_LD + wc * 64 + fr;
#pragma unroll
    for (int m = 0; m < 8; ++m) {
      float cs4[4] = {0.f, 0.f, 0.f, 0.f}, sn4[4] = {0.f, 0.f, 0.f, 0.f};
      if (ROPE) {
#pragma unroll
        for (int j = 0; j < 4; ++j) { const int pos = prow0 + wr * 128 + m * 16 + fq * 4 + j; cs4[j] = cosT[pos * 8 + (fr & 7)]; sn4[j] = cosT[8192 * 8 + pos * 8 + (fr & 7)]; }
      }
#pragma unroll
      for (int n = 0; n < 4; ++n)
#pragma unroll
        for (int j = 0; j < 4; ++j) f[(m * 16 + j) * IMGF_LD + n * 16] = epi_val<ROPE>(acc, m, n, j, cs4, sn4, fr);
    }
  }
}
template <bool ADD>
DI void imgf_store(float* dst, int ld, const char* smem) {
  const int tid = TID512();
  const unsigned o0 = (unsigned)((tid >> 6) * ld + (tid & 63) * 4);
  const char* src = smem + (tid >> 6) * (IMGF_LD * 4) + (tid & 63) * 16;
#pragma unroll
  for (int q = 0; q < 16; ++q) {
    if ((q & 3) == 0) asm volatile("" ::: "memory");
    float4 v = *(const float4*)(src + q * 8 * (IMGF_LD * 4));
    float4* d = (float4*)(dst + (o0 + (unsigned)(q * 8 * ld)));
    if (ADD) { const float4 x = *d; v.x += x.x; v.y += x.y; v.z += x.z; v.w += x.w; }
    *d = v;
  }
}
template <bool ADD, bool ROPE>
DI void tile_out_f32(const f32x4 (&acc)[8][4], float* dst, int ld, char* smem, int prow0, const float* cosT) {
#pragma unroll 1
  for (int h = 0; h < 2; ++h) {
    img_barrier();
    imgf_put<ROPE>(acc, h, smem, prow0, cosT);
    img_barrier();
    imgf_store<ADD>(dst + (size_t)h * 128 * ld, ld, smem);
  }
}
template <bool ROPE>
DI void tile_out_bf16(const f32x4 (&acc)[8][4], u16* dst, int ld, char* smem, float scale, int prow0, const float* cosT) {
  img_barrier();
  img_put_bf16<ROPE>(acc, smem, 0, scale, prow0, cosT);
  img_barrier();
  img_store_bf16(dst, ld, smem, 0);
}

template <int KS>
DI f32x4 lds_mm(const u16* As, int lsa, int arow, const u16* Bs, int lsb, int brow, f32x4 acc) {
  const int lane = TID() & 63, fr = lane & 15, fq = lane >> 4;
#pragma unroll
  for (int ks = 0; ks < KS; ++ks) {
    bf16x8 a = *(const bf16x8*)(As + (arow + fr) * lsa + ks * 32 + fq * 8);
    bf16x8 b = *(const bf16x8*)(Bs + (brow + fr) * lsb + ks * 32 + fq * 8);
    acc = MFMA16(a, b, acc);
  }
  return acc;
}

constexpr int PREP_T_PER_LAYER = 64 * 16 + 48 * 16 + 3 * 128 + 3 * 256 + 3 * 704 + 16;
constexpr int PREP_T = PREP_T_PER_LAYER * NL;
constexpr int PREP_COPY = MT * 1024 / 4096;
constexpr int PREP_ROPE = 8192 * 8 / 256;
constexpr int PREP_ITEMS = PREP_T + PREP_COPY + PREP_ROPE + 2;

DI void transpose_tile(const float* src, int lds_, int k0, int c0, int ncols_valid, u16* dst, int ldd, int n0, float* tile) {
  const int tid = TID();
  __syncthreads();
#pragma unroll
  for (int i = 0; i < 16; ++i) {
    int e = tid + i * 256, r = e >> 6, c = e & 63;
    tile[r * 65 + c] = (c < ncols_valid) ? src[(size_t)(k0 + r) * lds_ + c0 + c] : 0.f;
  }
  __syncthreads();
#pragma unroll
  for (int i = 0; i < 16; ++i) {
    int e = tid + i * 256, c = e >> 6, r = e & 63;
    dst[(size_t)(n0 + c) * ldd + k0 + r] = f2bf(tile[r * 65 + c]);
  }
}

DI void prep_item(const Params& p, int it, char* smem) {
  const int tid = TID();
  if (it < PREP_T) {
    const int l = it / PREP_T_PER_LAYER;
    int t = it % PREP_T_PER_LAYER;
    u16* W = (u16*)(p.ws + O_WT) + (size_t)l * W_LAYER;
    float* tile = (float*)smem;
    if (t < 64 * 16) {
      int nt = t / 16, kt = t % 16, n0 = nt * 64;
      const int c0 = n0 < 3072 ? n0 : n0 + 16;
      transpose_tile(p.in[9] + (size_t)l * 1024 * PW, PW, kt * 64, c0, 64, W + W_IN, LDK, n0, tile);
      return;
    }
    t -= 64 * 16;
    if (t < 48 * 16) { transpose_tile(p.in[25] + (size_t)l * 1024 * 3072, 3072, (t % 16) * 64, (t / 16) * 64, 64, W + W_MG, LDK, (t / 16) * 64, tile); return; }
    t -= 48 * 16;
    if (t < 3 * 128) {
      int br = t / 128, tt = t % 128;
      transpose_tile(p.in[22 + br] + (size_t)l * 512 * 1024, 1024, (tt % 8) * 64, (tt / 8) * 64, 64, W + W_BR + (size_t)br * 1024 * 512, 512, (tt / 8) * 64, tile);
      return;
    }
    t -= 3 * 128;
    if (t < 768) { const int cp = t / 256, tt = t % 256; transpose_tile(p.in[27] + (size_t)l * 1024 * 1024, 1024, (tt % 16) * 64, (tt / 16) * 64, 64, W + W_OUT + cp * 1024, 3072, (tt / 16) * 64, tile); return; }
    t -= 768;
    if (t < 704) { transpose_tile(p.in[29] + (size_t)l * 1024 * DFF, DFF, (t % 16) * 64, (t / 16) * 64, 64, W + W_FG, LDK, (t / 16) * 64, tile); return; }
    t -= 704;
    if (t < 704) { transpose_tile(p.in[32] + (size_t)l * 1024 * DFF, DFF, (t % 16) * 64, (t / 16) * 64, 64, W + W_FU, LDK, (t / 16) * 64, tile); return; }
    t -= 704;
    if (t < 704) { transpose_tile(p.in[33] + (size_t)l * DFF * 1024, 1024, (t % 44) * 64, (t / 44) * 64, 64, W + W_FD, DFF, (t / 44) * 64, tile); return; }
    t -= 704;
    if (t < 8) { transpose_tile(p.in[17] + (size_t)l * 32768 + t * 4096, 64, 0, 0, 64, W + W_WA + t * 4096, 64, 0, tile); return; }
    t -= 8;
    transpose_tile(p.in[19] + (size_t)l * 32768 + t * 4096, 64, 0, 0, 64, W + W_WX + t * 4096, 64, 0, tile);
    return;
  }
  it -= PREP_T;
  if (it < PREP_COPY) {
    size_t base = (size_t)it * 4096;
    float* X = p.out;
#pragma unroll
    for (int i = 0; i < 4; ++i) {
      size_t e = base + (size_t)(tid + i * 256) * 4;
      float4 v = (e < (size_t)MP * 1024) ? *(const float4*)(p.in[0] + e) : *(const float4*)(p.in[1] + (e - (size_t)MP * 1024));
      *(float4*)(X + e) = v;
    }
    return;
  }
  it -= PREP_COPY;
  if (it < PREP_ROPE) {
    int e = it * 256 + tid, pos = e >> 3, i = e & 7;
    double inv = pow(500000.0, -(double)i / 8.0);
    double ang = (double)pos * inv;
    double kq = rint(ang * 0.15915494309189535);
    double r = ang - kq * 6.283185307179586;
    float rf = (float)r;
    float* cs = (float*)(p.ws + O_ROPE);
    cs[e] = cosf(rf);
    cs[8192 * 8 + e] = sinf(rf);
    return;
  }
  if (it == PREP_ROPE && tid < 64 * NL) {
    int l = tid >> 6, i = tid & 63;
    const float* lq = p.in[10] + (size_t)l * 256;
    float a = lq[i] * lq[64 + i], b = lq[128 + i] * lq[192 + i];
    a = wave_sum(a); b = wave_sum(b);
    if (i == 0) {
      float lam_init = 0.8f - 0.6f * __expf(-0.3f * (float)l);
      ((float*)(p.ws + O_LAM))[l] = __expf(a) - __expf(b) + lam_init;
    }
  }
}

DI bool xcd_tile(int B, int G, int iter, int MTILES, int NT, int& mt, int& nt) {
  const int nxb = G >> 3;
  const int x = B & 7, lb = B >> 3;
  const int q = MTILES >> 3, r = MTILES & 7;
  const int mx = q + (x < r ? 1 : 0);
  const int mbase = x * q + (x < r ? x : r);
  const int j = lb + iter * nxb;
  if (j >= mx * NT) return false;
  const int band = j / (8 * NT);
  const int rem = j - band * 8 * NT;
  const int nb = (mx - band * 8) < 8 ? (mx - band * 8) : 8;
  mt = mbase + band * 8 + rem % nb;
  nt = rem / nb;
  return true;
}

constexpr int PB_KC = SBT * PAST * 512 / 4096;
constexpr int PB_VC = SBT * 32 * 8;

DI void projin_tile(const Params& p, int l, int mt, int nt, char* smem) {
  const int row0 = mt * 256, col0 = nt * 256;
  const u16* W = (const u16*)(p.ws + O_WT) + (size_t)l * W_LAYER + W_IN;
  const u16* XN = (const u16*)(p.ws + O_XN);
  f32x4 acc[8][4];
  zero_acc8(acc);
  gemm512(XN + (size_t)row0 * LDK, LDK, W + (size_t)col0 * LDK, LDK, 1024, acc, smem);
  const float* cosT = (const float*)(p.ws + O_ROPE);
  const float* sinT = cosT + 8192 * 8;
  if (mt < 128) {
    const int prow0 = row0 & 8191;
    if (nt < 2) {
      tile_out_bf16<true>(acc, (u16*)(p.ws + O_QB) + (size_t)row0 * 512 + col0, 512, smem, QSCALE, prow0, cosT);
    } else if (nt < 4) {
      tile_out_f32<false, true>(acc, p.out + K_P + ((size_t)l * MP + row0) * 512 + (col0 - 512), 512, smem, prow0, cosT);
      tile_out_bf16<true>(acc, (u16*)(p.ws + O_KB) + (size_t)row0 * 512 + (col0 - 512), 512, smem, 1.f, prow0, cosT);
    } else if (nt < 6) {
      tile_out_f32<false, false>(acc, p.out + V_P + ((size_t)l * MP + row0) * 512 + (col0 - 1024), 512, smem, 0, nullptr);
      EPI_IDS;
      u16* VT = (u16*)(p.ws + O_VT);
      const unsigned vb = (unsigned)((row0 >> 13) * 512 + (col0 - 1024) + wc * 64 + fr) * (unsigned)PT + (unsigned)((row0 & 8191) + wr * 128 + fq * 4);
#pragma unroll
      for (int m = 0; m < 8; ++m) {
        asm volatile("" ::: "memory");
#pragma unroll
        for (int n = 0; n < 4; ++n) {
          const uint2 pk = {pack2(acc[m][n][0], acc[m][n][1]), pack2(acc[m][n][2], acc[m][n][3])};
          *(uint2*)(VT + (vb + (unsigned)(n * 16 * PT + m * 16))) = pk;
        }
      }
    } else if (nt >= 12 && nt < 14) {
      tile_out_f32<false, false>(acc, (float*)(p.ws + O_LX) + (size_t)row0 * 512 + (col0 - 3072), 512, smem, 0, nullptr);
    } else {
      u16* dst; int ld = 512, cbase;
      if (nt == 6) { dst = (u16*)(p.ws + O_GQ); ld = 256; cbase = 1536; }
      else if (nt == 7) { dst = (u16*)(p.ws + O_GK); ld = 256; cbase = 1792; }
      else if (nt < 10) { dst = (u16*)(p.ws + O_GV); cbase = 2048; }
      else if (nt < 12) { dst = (u16*)(p.ws + O_GR); cbase = 2560; }
      else { dst = (u16*)(p.ws + O_LG); cbase = 3584; }
      tile_out_bf16<false>(acc, dst + (size_t)row0 * ld + (col0 - cbase), ld, smem, nt == 6 ? 0.125f : 1.f, 0, nullptr);
    }
    return;
  }
  EPI_IDS;
  const bool isS = row0 >= MP;
  if (nt < 4) {
    const bool isq = nt < 2;
    u16* QB = (u16*)(p.ws + O_QB);
    u16* KB = (u16*)(p.ws + O_KB);
    u16* KS = (u16*)(p.ws + O_KS);
#pragma unroll
    for (int m = 0; m < 8; ++m) {
      asm volatile("" ::: "memory");
#pragma unroll
      for (int n = 0; n < 4; ++n)
#pragma unroll
        for (int j = 0; j < 4; ++j) {
          const int row = row0 + wr * 128 + m * 16 + fq * 4 + j;
          const int col = col0 + wc * 64 + n * 16 + fr;
          float v = acc[m][n][j];
          int b, t;
          if (isS) { int rs = row - MP; b = rs >> 5; t = rs & 31; } else { b = row >> 13; t = row & 8191; }
          const int pos = isS ? PAST + t : t;
          if (n == 0) {
            float pr = __shfl_xor(v, 8);
            float cs = cosT[pos * 8 + (fr & 7)], sn = sinT[pos * 8 + (fr & 7)];
            v = (fr < 8) ? v * cs - pr * sn : v * cs + pr * sn;
          }
          if (isq) {
            QB[(size_t)row * 512 + col] = f2bf(v * QSCALE);
          } else {
            const int ck = col - 512;
            if (isS) {
              p.out[K_S + ((size_t)l * MS + (row - MP)) * 512 + ck] = v;
              KS[((size_t)b * SKP + PAST + t) * 512 + ck] = f2bf(v);
            } else {
              p.out[K_P + ((size_t)l * MP + row) * 512 + ck] = v;
              KB[(size_t)row * 512 + ck] = f2bf(v);
            }
          }
        }
    }
  } else if (nt < 6) {
    u16* VT = (u16*)(p.ws + O_VT);
    u16* VTS = (u16*)(p.ws + O_VTS);
#pragma unroll
    for (int m = 0; m < 8; ++m) {
      asm volatile("" ::: "memory");
#pragma unroll
      for (int n = 0; n < 4; ++n) {
        const int rowb = row0 + wr * 128 + m * 16 + fq * 4;
        const int cv = col0 - 1024 + wc * 64 + n * 16 + fr;
        const int h = cv >> 7, vd = cv & 127;
        int b, t;
        if (isS) { int rs = rowb - MP; b = rs >> 5; t = rs & 31; } else { b = rowb >> 13; t = rowb & 8191; }
#pragma unroll
        for (int j = 0; j < 4; ++j) {
          if (isS) p.out[V_S + ((size_t)l * MS + (rowb + j - MP)) * 512 + cv] = acc[m][n][j];
          else p.out[V_P + ((size_t)l * MP + rowb + j) * 512 + cv] = acc[m][n][j];
        }
        uint2 pk = {pack2(acc[m][n][0], acc[m][n][1]), pack2(acc[m][n][2], acc[m][n][3])};
        if (isS) *(uint2*)(VTS + ((size_t)(b * 4 + h) * 128 + vd) * SKP + PAST + t) = pk;
        else *(uint2*)(VT + ((size_t)(b * 4 + h) * 128 + vd) * PT + t) = pk;
      }
    }
  } else {
    u16* dst16 = nullptr; float* dst32 = nullptr; int ld = 512, cbase = 0; float scale = 1.f;
    if (nt == 6) { dst16 = (u16*)(p.ws + O_GQ); ld = 256; cbase = 1536; scale = 0.125f; }
    else if (nt == 7) { dst16 = (u16*)(p.ws + O_GK); ld = 256; cbase = 1792; }
    else if (nt < 10) { dst16 = (u16*)(p.ws + O_GV); cbase = 2048; }
    else if (nt < 12) { dst16 = (u16*)(p.ws + O_GR); cbase = 2560; }
    else if (nt < 14) { dst32 = (float*)(p.ws + O_LX); cbase = 3072; }
    else { dst16 = (u16*)(p.ws + O_LG); cbase = 3584; }
#pragma unroll
    for (int m = 0; m < 8; ++m) {
      asm volatile("" ::: "memory");
#pragma unroll
      for (int n = 0; n < 4; ++n)
#pragma unroll
        for (int j = 0; j < 4; ++j) {
          const int row = row0 + wr * 128 + m * 16 + fq * 4 + j;
          const int c = col0 + wc * 64 + n * 16 + fr - cbase;
          const float v = acc[m][n][j] * scale;
          if (dst16) dst16[(size_t)row * ld + c] = f2bf(v);
          else dst32[(size_t)row * ld + c] = v;
        }
    }
  }
}

DI void cache_conv_item(const Params& p, int l, int it, char* smem) {
  const int tid = TID();
  if (it < PB_KC) {
    const float* src = p.in[2] + (size_t)l * SBT * PAST * 512;
    u16* KS = (u16*)(p.ws + O_KS);
#pragma unroll
    for (int i = 0; i < 4; ++i) {
      size_t e = (size_t)it * 4096 + (size_t)(tid + i * 256) * 4;
      float4 v = *(const float4*)(src + e);
      size_t b = e / ((size_t)PAST * 512), r = e % ((size_t)PAST * 512);
      *(uint2*)(KS + b * SKP * 512 + r) = uint2{pack2(v.x, v.y), pack2(v.z, v.w)};
    }
    return;
  }
  it -= PB_KC;
  const int b = it / 256, r = it % 256, ptile = r / 8, ctile = r % 8;
  const float* src = p.in[3] + ((size_t)l * SBT + b) * PAST * 512;
  u16* VTS = (u16*)(p.ws + O_VTS);
  transpose_tile(src, 512, ptile * 64, ctile * 64, 64, VTS + (size_t)b * 512 * SKP, SKP, ctile * 64, (float*)smem);
}

DI int kswz(int key) { return (((key >> 3) & 3) << 2) | (key & 3); }

DI void attn_item(const Params& p, int l, int idx, char* smem) {
  const int tid = TID512(), lane = tid & 63, wid = tid >> 6, fr = lane & 15, fq = lane >> 4;
  bool isS; int b, h, cp;
  if (idx < 1024) {
    isS = false;
    const int r = idx >> 8, pos = idx & 255, q = pos >> 4, base = 63 - 16 * r;
    cp = (r & 1) ? base - 15 + q : base - q;
    b = (pos & 15) >> 2; h = pos & 3;
  } else { isS = true; const int s = idx - 1024; b = s >> 2; h = s & 3; cp = 0; }
  const int nkt = isS ? 33 : 2 * cp + 2;
  const int klen = isS ? SKV : nkt * 64;
  const int mykt = isS ? 33 : (wid < 4 ? 2 * cp + 1 : 2 * cp + 2);
  const u16* QB = (const u16*)(p.ws + O_QB);
  const u16* Kg = isS ? (const u16*)(p.ws + O_KS) + (size_t)b * SKP * 512 + h * 128 : (const u16*)(p.ws + O_KB) + (size_t)b * PT * 512 + h * 128;
  const int vstride = isS ? SKP : PT;
  const u16* Vg = (isS ? (const u16*)(p.ws + O_VTS) : (const u16*)(p.ws + O_VT)) + (size_t)(b * 4 + h) * 128 * vstride;
  const int qrow0 = isS ? MP + b * 32 : b * PT + cp * 128;
  const bool wactive = isS ? (wid < 2) : true;
  const int qrow = qrow0 + wid * 16 + fr;
  bf16x8 qf[2][2];
#pragma unroll
  for (int mp = 0; mp < 2; ++mp)
#pragma unroll
    for (int ks = 0; ks < 2; ++ks)
      qf[mp][ks] = wactive ? *(const bf16x8*)(QB + (size_t)qrow * 512 + h * 128 + mp * 64 + ks * 32 + fq * 8) : bf16x8{0, 0, 0, 0, 0, 0, 0, 0};
  f32x4 ot[2][8];
#pragma unroll
  for (int mp = 0; mp < 2; ++mp)
#pragma unroll
    for (int n = 0; n < 8; ++n) ot[mp][n] = f32x4{0.f, 0.f, 0.f, 0.f};
  float mrun[2] = {-INFINITY, -INFINITY}, lrun[2] = {0.f, 0.f};
  char* Ks = smem;
  char* Vs = smem + 32768;
  const int kkey = tid >> 4, vvd = tid >> 3;
  const int kgch = (tid & 15) ^ kswz(kkey);
  const int vgch = (tid & 7) ^ ((vvd >> 1) & 7);
  const int soff = tid * 16;
  asm volatile("s_waitcnt vmcnt(0) lgkmcnt(0)" ::: "memory");
  __builtin_amdgcn_s_barrier();
#pragma unroll
  for (int i = 0; i < 2; ++i) {
    __builtin_amdgcn_global_load_lds((const unsigned*)(Kg + (size_t)(kkey + i * 32) * 512 + kgch * 8), (unsigned*)(Ks + soff + i * 8192), 16, 0, 0);
    __builtin_amdgcn_global_load_lds((const unsigned*)(Vg + (size_t)(vvd + i * 64) * vstride + vgch * 8), (unsigned*)(Vs + soff + i * 8192), 16, 0, 0);
  }
  asm volatile("s_waitcnt vmcnt(0)" ::: "memory");
  asm volatile("" ::"v"(qf[0][0]), "v"(qf[0][1]), "v"(qf[1][0]), "v"(qf[1][1]));
  __builtin_amdgcn_s_barrier();
  for (int kt = 0; kt < nkt; ++kt) {
    const int buf = kt & 1;
    const bool more = kt + 1 < nkt;
    if (more) {
      const int nb = buf ^ 1;
#pragma unroll
      for (int i = 0; i < 2; ++i) {
        __builtin_amdgcn_global_load_lds((const unsigned*)(Kg + (size_t)((kt + 1) * 64 + kkey + i * 32) * 512 + kgch * 8), (unsigned*)(Ks + nb * 16384 + soff + i * 8192), 16, 0, 0);
        __builtin_amdgcn_global_load_lds((const unsigned*)(Vg + (size_t)(vvd + i * 64) * vstride + (kt + 1) * 64 + vgch * 8), (unsigned*)(Vs + nb * 16384 + soff + i * 8192), 16, 0, 0);
      }
    }
    const bool active = wactive && kt < mykt;
    if (active) {
      const char* Kb = Ks + buf * 16384;
      const char* Vb = Vs + buf * 16384;
      f32x4 st[2][4];
      {
        bf16x8 kf[2][4][2];
#pragma unroll
        for (int mp = 0; mp < 2; ++mp)
#pragma unroll
          for (int mt = 0; mt < 4; ++mt) {
            const int key = 32 * (mt >> 1) + 8 * (fr >> 2) + 4 * (mt & 1) + (fr & 3);
#pragma unroll
            for (int ks = 0; ks < 2; ++ks) kf[mp][mt][ks] = *(const bf16x8*)(Kb + key * 256 + (((mp * 8 + ks * 4 + fq) ^ kswz(key)) << 4));
          }
#pragma unroll
        for (int mp = 0; mp < 2; ++mp)
#pragma unroll
          for (int mt = 0; mt < 4; ++mt) {
            f32x4 a = MFMA16(kf[mp][mt][0], qf[mp][0], (f32x4{0.f, 0.f, 0.f, 0.f}));
            st[mp][mt] = MFMA16(kf[mp][mt][1], qf[mp][1], a);
          }
      }
      const bool needmask = (kt + 1) * 64 > klen;
#pragma unroll
      for (int mp = 0; mp < 2; ++mp) {
        if (needmask) {
#pragma unroll
          for (int mt = 0; mt < 4; ++mt)
#pragma unroll
            for (int j = 0; j < 4; ++j) {
              const int key = kt * 64 + 32 * (mt >> 1) + 8 * fq + 4 * (mt & 1) + j;
              if (key >= klen) st[mp][mt][j] = -INFINITY;
            }
        }
        float mx = -INFINITY;
#pragma unroll
        for (int mt = 0; mt < 4; ++mt)
#pragma unroll
          for (int j = 0; j < 4; ++j) mx = fmaxf(mx, st[mp][mt][j]);
        mx = quad_max(mx);
        const float mold = mrun[mp];
        const float mnew = fmaxf(mold, mx);
        mrun[mp] = mnew;
        float ps = 0.f;
#pragma unroll
        for (int mt = 0; mt < 4; ++mt)
#pragma unroll
          for (int j = 0; j < 4; ++j) { float e = __builtin_amdgcn_exp2f(st[mp][mt][j] - mnew); st[mp][mt][j] = e; ps += e; }
        if (__any(mnew > mold)) {
          const float alpha = __builtin_amdgcn_exp2f(mold - mnew);
          lrun[mp] *= alpha;
#pragma unroll
          for (int n = 0; n < 8; ++n) { ot[mp][n][0] *= alpha; ot[mp][n][1] *= alpha; ot[mp][n][2] *= alpha; ot[mp][n][3] *= alpha; }
        }
        lrun[mp] += ps;
      }
      bf16x8 pf[2][2];
#pragma unroll
      for (int mp = 0; mp < 2; ++mp)
#pragma unroll
        for (int s = 0; s < 2; ++s) {
          uint4 u = {pack2(st[mp][2 * s][0], st[mp][2 * s][1]), pack2(st[mp][2 * s][2], st[mp][2 * s][3]),
                     pack2(st[mp][2 * s + 1][0], st[mp][2 * s + 1][1]), pack2(st[mp][2 * s + 1][2], st[mp][2 * s + 1][3])};
          pf[mp][s] = __builtin_bit_cast(bf16x8, u);
        }
#pragma unroll
      for (int nh = 0; nh < 2; ++nh) {
        bf16x8 vf[4][2];
#pragma unroll
        for (int n = 0; n < 4; ++n) {
          const int vd = (nh * 4 + n) * 16 + fr;
#pragma unroll
          for (int s = 0; s < 2; ++s) vf[n][s] = *(const bf16x8*)(Vb + vd * 128 + (((s * 4 + fq) ^ ((vd >> 1) & 7)) << 4));
        }
#pragma unroll
        for (int n = 0; n < 4; ++n)
#pragma unroll
          for (int s = 0; s < 2; ++s) {
            ot[0][nh * 4 + n] = MFMA16(vf[n][s], pf[0][s], ot[0][nh * 4 + n]);
            ot[1][nh * 4 + n] = MFMA16(vf[n][s], pf[1][s], ot[1][nh * 4 + n]);
          }
      }
    }
    asm volatile("s_waitcnt vmcnt(0) lgkmcnt(0)" ::: "memory");
    __builtin_amdgcn_s_barrier();
  }
  if (wactive) {
    float l0 = lrun[0], l1 = lrun[1];
    l0 += __shfl_xor(l0, 16); l0 += __shfl_xor(l0, 32);
    l1 += __shfl_xor(l1, 16); l1 += __shfl_xor(l1, 32);
    const float lam = ((const float*)(p.ws + O_LAM))[l];
    const float lam_init = 0.8f - 0.6f * __expf(-0.3f * (float)l);
    const float i0 = 1.f / l0, i1 = lam / l1;
    float ss = 0.f;
#pragma unroll
    for (int n = 0; n < 8; ++n)
#pragma unroll
      for (int j = 0; j < 4; ++j) { float o = ot[0][n][j] * i0 - ot[1][n][j] * i1; ot[0][n][j] = o; ss += o * o; }
    ss += __shfl_xor(ss, 16); ss += __shfl_xor(ss, 32);
    const float rs = rsqrtf(ss * (1.f / 128.f) + EPS) * (1.f - lam_init);
    const float* g = p.in[11] + (size_t)l * 128;
    u16* OA = (u16*)(p.ws + O_OA) + (size_t)qrow * 512 + h * 128;
#pragma unroll
    for (int n = 0; n < 8; ++n) {
      const int vd = n * 16 + fq * 4;
      float4 gg = *(const float4*)(g + vd);
      *(uint2*)(OA + vd) = uint2{pack2(ot[0][n][0] * rs * gg.x, ot[0][n][1] * rs * gg.y), pack2(ot[0][n][2] * rs * gg.z, ot[0][n][3] * rs * gg.w)};
    }
  }
}

constexpr int LP = 72;
constexpr int BCS = 68;
DI void gla_decode(int gi, bool& isS, int& b, int& h, int& c, int& row0, int& Lc) {
  if (gi < PB * 4 * 128) { isS = false; c = gi & 127; h = (gi >> 7) & 3; b = gi >> 9; row0 = b * PT + c * 64; Lc = 64; }
  else { isS = true; int s = gi - PB * 4 * 128; b = s >> 2; h = s & 3; c = 0; row0 = MP + b * 32; Lc = 32; }
}
DI void gla_bcum(const Params& p, int l, int row0, int Lc, int h, float* bc, float* tot, float* gas) {
  const int tid = TID(), kd = tid & 63, tq = tid >> 6;
  const float* W2 = p.in[12] + (size_t)l * 16 * 256 + h * 64 + kd;
  const float b2 = p.in[13][(size_t)l * 256 + h * 64 + kd];
  const float* GA = (const float*)(p.ws + O_GA);
  {
    const int r = tid >> 2, part = tid & 3;
    float4 v = {0.f, 0.f, 0.f, 0.f};
    if (r < Lc) v = *(const float4*)(GA + (size_t)(row0 + r) * 16 + part * 4);
    *(float4*)(gas + r * 16 + part * 4) = v;
  }
  float w[16];
#pragma unroll
  for (int r = 0; r < 16; ++r) w[r] = W2[r * 256];
  __syncthreads();
  float run = 0.f;
#pragma unroll
  for (int i = 0; i < 16; ++i) {
    const int t = tq * 16 + i;
    const float4* ga = (const float4*)(gas + t * 16);
    const float4 g0 = ga[0], g1 = ga[1], g2 = ga[2], g3 = ga[3];
    const float x = b2 + g0.x * w[0] + g0.y * w[1] + g0.z * w[2] + g0.w * w[3] + g1.x * w[4] + g1.y * w[5] + g1.z * w[6] + g1.w * w[7] +
                    g2.x * w[8] + g2.y * w[9] + g2.z * w[10] + g2.w * w[11] + g3.x * w[12] + g3.y * w[13] + g3.z * w[14] + g3.w * w[15];
    const float la = (t < Lc) ? -softplusf_(-x) * (1.f / 16.f) : 0.f;
    run += la;
    bc[t * BCS + kd] = run;
  }
  tot[tq * 64 + kd] = run;
  __syncthreads();
  float off = 0.f;
  for (int g = 0; g < tq; ++g) off += tot[g * 64 + kd];
#pragma unroll
  for (int i = 0; i < 16; ++i) bc[(tq * 16 + i) * BCS + kd] += off;
  __syncthreads();
}
DI void gla_load_vt(const Params& p, int row0, int Lc, int h, u16* vt) {
  const int tid = TID(), s = tid & 63, cg4 = tid >> 6;
  const u16* GV = (const u16*)(p.ws + O_GV) + (size_t)(row0 + s) * 512 + h * 128;
  u32x4 v[4];
#pragma unroll
  for (int i = 0; i < 4; ++i) v[i] = (s < Lc) ? *(const u32x4*)(GV + (cg4 + 4 * i) * 8) : u32x4{0u, 0u, 0u, 0u};
#pragma unroll
  for (int i = 0; i < 4; ++i) {
    const int vd0 = (cg4 + 4 * i) * 8;
#pragma unroll
    for (int e = 0; e < 4; ++e) {
      vt[(vd0 + 2 * e) * LP + s] = (u16)(v[i][e] & 0xffffu);
      vt[(vd0 + 2 * e + 1) * LP + s] = (u16)(v[i][e] >> 16);
    }
  }
}

DI void gla1_item(const Params& p, int l, int gi, char* smem) {
  bool isS; int b, h, c, row0, Lc;
  gla_decode(gi, isS, b, h, c, row0, Lc);
  const int tid = TID(), lane = tid & 63, wid = tid >> 6, fr = lane & 15, fq = lane >> 4;
  float* bc = (float*)smem;
  float* tot = (float*)(smem + 17408);
  u16* kh = (u16*)(smem + 18432);
  u16* vt = (u16*)(smem + 18432 + 9216);
  __syncthreads();
  gla_bcum(p, l, row0, Lc, h, bc, tot, (float*)kh);
  {
    const int s = tid & 63, c2 = tid >> 6;
    const u16* GK = (const u16*)(p.ws + O_GK) + (size_t)(row0 + s) * 256 + h * 64;
    u32x4 kv[2];
#pragma unroll
    for (int i = 0; i < 2; ++i) kv[i] = (s < Lc) ? *(const u32x4*)(GK + (c2 + 4 * i) * 8) : u32x4{0u, 0u, 0u, 0u};
#pragma unroll
    for (int i = 0; i < 2; ++i) {
      const int kd0 = (c2 + 4 * i) * 8;
#pragma unroll
      for (int e = 0; e < 8; ++e) {
        const unsigned w = kv[i][e >> 1];
        const float kf = bf2f((u16)((e & 1) ? (w >> 16) : (w & 0xffffu)));
        const float bl = bc[63 * BCS + kd0 + e];
        kh[(kd0 + e) * LP + s] = f2bf(kf * __expf(bl - bc[s * BCS + kd0 + e]));
      }
    }
    if (tid < 64) ((float*)(p.ws + O_DEC))[(size_t)gi * 64 + tid] = __expf(bc[63 * BCS + tid]);
  }
  gla_load_vt(p, row0, Lc, h, vt);
  __syncthreads();
  u16* KVT = (u16*)(p.ws + O_KVT) + (size_t)gi * 8192;
#pragma unroll
  for (int mi = 0; mi < 2; ++mi)
#pragma unroll
    for (int n = 0; n < 4; ++n) {
      const int m = wid * 2 + mi;
      f32x4 a = lds_mm<2>(vt, LP, m * 16, kh, LP, n * 16, f32x4{0.f, 0.f, 0.f, 0.f});
#pragma unroll
      for (int j = 0; j < 4; ++j) KVT[(m * 16 + fq * 4 + j) * 64 + n * 16 + fr] = f2bf(a[j]);
    }
}

constexpr int G2_ITEMS = (PB * 4 + SBT * 4) * 32;
DI void gla2_item(const Params& p, int l, int it) {
  const int seq = it >> 5, e = (it & 31) * 256 + TID();
  const int vd = e >> 6, kd = e & 63;
  u16* KVT = (u16*)(p.ws + O_KVT);
  const float* DEC = (const float*)(p.ws + O_DEC);
  if (seq < PB * 4) {
    float S = 0.f;
    const int gi0 = seq * 128;
    for (int c0 = 0; c0 < 128; c0 += 32) {
      u16 kvv[32]; float dd[32];
#pragma unroll
      for (int c = 0; c < 32; ++c) { kvv[c] = KVT[(size_t)(gi0 + c0 + c) * 8192 + e]; dd[c] = DEC[(size_t)(gi0 + c0 + c) * 64 + kd]; }
#pragma unroll
      for (int c = 0; c < 32; ++c) { KVT[(size_t)(gi0 + c0 + c) * 8192 + e] = f2bf(S); S = dd[c] * S + bf2f(kvv[c]); }
    }
    p.out[GLA_P + ((size_t)l * PB * 4 + seq) * 8192 + kd * 128 + vd] = S;
  } else {
    const int s = seq - PB * 4, gi = PB * 4 * 128 + s;
    const float S0 = p.in[4][((size_t)l * SBT * 4 + s) * 8192 + kd * 128 + vd];
    u16* q = KVT + (size_t)gi * 8192 + e;
    const float kv = bf2f(*q);
    const float d = DEC[(size_t)gi * 64 + kd];
    *q = f2bf(S0);
    p.out[GLA_S + ((size_t)l * SBT * 4 + s) * 8192 + kd * 128 + vd] = d * S0 + kv;
  }
}

DI void gla3_item(const Params& p, int l, int gi, char* smem) {
  bool isS; int b, h, c, row0, Lc;
  gla_decode(gi, isS, b, h, c, row0, Lc);
  const int tid = TID(), lane = tid & 63, wid = tid >> 6, fr = lane & 15, fq = lane >> 4;
  float* bc = (float*)smem;
  u16* att = (u16*)smem;
  float* tot = (float*)(smem + 17408);
  u16* qt = (u16*)(smem + 18432);
  u16* kt_ = (u16*)(smem + 18432 + 9216);
  u16* vt = (u16*)(smem + 18432 + 2 * 9216);
  u16* st = (u16*)(smem + 18432 + 2 * 9216 + 18432);
  __syncthreads();
  gla_bcum(p, l, row0, Lc, h, bc, tot, (float*)qt);
  const u16* KVT = (const u16*)(p.ws + O_KVT) + (size_t)gi * 8192;
  {
    const int s = tid & 63, c2 = tid >> 6;
    const u16* GQ = (const u16*)(p.ws + O_GQ) + (size_t)(row0 + s) * 256 + h * 64;
    const u16* GK = (const u16*)(p.ws + O_GK) + (size_t)(row0 + s) * 256 + h * 64;
    u32x4 qv[2], kv[2], sv[4];
#pragma unroll
    for (int i = 0; i < 2; ++i) {
      qv[i] = (s < Lc) ? *(const u32x4*)(GQ + (c2 + 4 * i) * 8) : u32x4{0u, 0u, 0u, 0u};
      kv[i] = (s < Lc) ? *(const u32x4*)(GK + (c2 + 4 * i) * 8) : u32x4{0u, 0u, 0u, 0u};
    }
#pragma unroll
    for (int i = 0; i < 4; ++i) { const int id = tid + i * 256; sv[i] = *(const u32x4*)(KVT + (id >> 3) * 64 + (id & 7) * 8); }
#pragma unroll
    for (int i = 0; i < 2; ++i) {
      const int kd0 = (c2 + 4 * i) * 8;
      u32x4 qo, ko;
#pragma unroll
      for (int e2 = 0; e2 < 4; ++e2) {
        const float b0 = bc[s * BCS + kd0 + 2 * e2], b1 = bc[s * BCS + kd0 + 2 * e2 + 1];
        const float e0 = __expf(b0), e1 = __expf(b1);
        const float q0 = bf2f((u16)(qv[i][e2] & 0xffffu)) * e0, q1 = bf2f((u16)(qv[i][e2] >> 16)) * e1;
        const float k0 = bf2f((u16)(kv[i][e2] & 0xffffu)) / e0, k1 = bf2f((u16)(kv[i][e2] >> 16)) / e1;
        qo[e2] = pack2(q0, q1);
        ko[e2] = pack2(k0, k1);
      }
      *(u32x4*)(qt + s * LP + kd0) = qo;
      *(u32x4*)(kt_ + s * LP + kd0) = ko;
    }
#pragma unroll
    for (int i = 0; i < 4; ++i) { const int id = tid + i * 256; *(u32x4*)(st + (id >> 3) * LP + (id & 7) * 8) = sv[i]; }
  }
  gla_load_vt(p, row0, Lc, h, vt);
  __syncthreads();
  {
    f32x4 a[4];
#pragma unroll
    for (int n = 0; n < 4; ++n) a[n] = lds_mm<2>(qt, LP, wid * 16, kt_, LP, n * 16, f32x4{0.f, 0.f, 0.f, 0.f});
#pragma unroll
    for (int n = 0; n < 4; ++n)
#pragma unroll
      for (int j = 0; j < 4; ++j) {
        const int t = wid * 16 + fq * 4 + j, s = n * 16 + fr;
        att[t * LP + s] = f2bf(t >= s ? a[n][j] : 0.f);
      }
  }
  __syncthreads();
  f32x4 o[8];
#pragma unroll
  for (int n = 0; n < 8; ++n) {
    f32x4 a = lds_mm<2>(att, LP, wid * 16, vt, LP, n * 16, f32x4{0.f, 0.f, 0.f, 0.f});
    o[n] = lds_mm<2>(qt, LP, wid * 16, st, LP, n * 16, a);
  }
  const float* gn = p.in[14] + (size_t)l * 128;
  const u16* GR = (const u16*)(p.ws + O_GR);
  u16* OG = (u16*)(p.ws + O_OG);
  float gnv[8];
#pragma unroll
  for (int n = 0; n < 8; ++n) gnv[n] = gn[n * 16 + fr];
#pragma unroll
  for (int j = 0; j < 4; ++j) {
    float ss = 0.f;
#pragma unroll
    for (int n = 0; n < 8; ++n) ss += o[n][j] * o[n][j];
    ss += __shfl_xor(ss, 1); ss += __shfl_xor(ss, 2); ss += __shfl_xor(ss, 4); ss += __shfl_xor(ss, 8);
    const float rs = rsqrtf(ss * (1.f / 128.f) + EPS);
    const int t = wid * 16 + fq * 4 + j;
    if (t < Lc) {
      const size_t ro = (size_t)(row0 + t) * 512 + h * 128;
      u16 grv[8];
#pragma unroll
      for (int n = 0; n < 8; ++n) grv[n] = GR[ro + n * 16 + fr];
#pragma unroll
      for (int n = 0; n < 8; ++n) {
        const float gr = bf2f(grv[n]);
        OG[ro + n * 16 + fr] = f2bf(o[n][j] * rs * gnv[n] * gr * sigmoidf_(gr));
      }
    }
  }
}

constexpr int L1_ITEMS = NLC * 8;
DI void lru_decode(int ci, bool& isS, int& b, int& row0, int& Lc, int& t0) {
  if (ci < MP / 64) { isS = false; b = ci >> 7; t0 = (ci & 127) * 64; row0 = ci * 64; Lc = 64; }
  else { isS = true; b = ci - MP / 64; t0 = 0; row0 = MP + b * 32; Lc = 32; }
}
DI void lru1_item(const Params& p, int l, int it, char* smem) {
  const int ci = it >> 3, nb = it & 7;
  bool isS; int b, row0, Lc, t0;
  lru_decode(ci, isS, b, row0, Lc, t0);
  const int tid = TID(), lane = tid & 63, wid = tid >> 6, fr = lane & 15, fq = lane >> 4;
  u16* xcs = (u16*)smem;
  u16* was = (u16*)(smem + 9216);
  u16* wxs = (u16*)(smem + 2 * 9216);
  float* as_ = (float*)(smem + 3 * 9216);
  float* us_ = (float*)(smem + 3 * 9216 + 16384);
  float* segP = (float*)(smem + 3 * 9216 + 32768);
  float* segH = (float*)(smem + 3 * 9216 + 32768 + 1024);
  const float* LX = (const float*)(p.ws + O_LX);
  const u16* Wl = (const u16*)(p.ws + O_WT) + (size_t)l * W_LAYER;
  const int i = tid & 63, tq = tid >> 6, ch = nb * 64 + i;
  __syncthreads();
  {
    const float* cw = p.in[15] + (size_t)l * 4 * 512 + ch;
    const float w0 = cw[0], w1 = cw[512], w2 = cw[1024], w3 = cw[1536], cb = p.in[16][(size_t)l * 512 + ch];
    const float* buf = isS ? p.in[5] + ((size_t)l * SBT + b) * 3 * 512 + ch : nullptr;
    float x[19];
#pragma unroll
    for (int j = 0; j < 19; ++j) {
      const int tl = tq * 16 - 3 + j;
      const int tt = t0 + tl;
      float v = 0.f;
      if (tl < Lc) {
        if (tt >= 0) v = LX[(size_t)(row0 + tl) * 512 + ch];
        else if (isS) v = buf[(3 + tt) * 512];
      }
      x[j] = v;
    }
#pragma unroll
    for (int k = 0; k < 16; ++k) {
      const int t = tq * 16 + k;
      const float xv = (t < Lc) ? cb + w0 * x[k] + w1 * x[k + 1] + w2 * x[k + 2] + w3 * x[k + 3] : 0.f;
      xcs[t * LP + i] = f2bf(xv);
    }
#pragma unroll
    for (int k = 0; k < 2; ++k) {
      const int id = tid + k * 256, r = id >> 3, c8 = id & 7;
      *(uint4*)(was + r * LP + c8 * 8) = *(const uint4*)(Wl + W_WA + nb * 4096 + r * 64 + c8 * 8);
      *(uint4*)(wxs + r * LP + c8 * 8) = *(const uint4*)(Wl + W_WX + nb * 4096 + r * 64 + c8 * 8);
    }
    const int T = isS ? STT : PT;
    if (t0 + Lc == T && tid < 192) {
      const int k = tid >> 6;
      const float v = LX[(size_t)(row0 + Lc - 3 + k) * 512 + ch];
      if (isS) p.out[LC_S + (((size_t)l * SBT + b) * 3 + k) * 512 + ch] = v;
      else p.out[LC_P + (((size_t)l * PB + b) * 3 + k) * 512 + ch] = v;
    }
  }
  __syncthreads();
  {
    const float* ba = p.in[18] + (size_t)l * 512 + nb * 64;
    const float* bx = p.in[20] + (size_t)l * 512 + nb * 64;
    const float* lm = p.in[21] + (size_t)l * 512 + nb * 64;
#pragma unroll
    for (int n = 0; n < 4; ++n) {
      f32x4 r = lds_mm<2>(xcs, LP, wid * 16, was, LP, n * 16, f32x4{0.f, 0.f, 0.f, 0.f});
      f32x4 g = lds_mm<2>(xcs, LP, wid * 16, wxs, LP, n * 16, f32x4{0.f, 0.f, 0.f, 0.f});
      const int j = n * 16 + fr;
      const float sp = softplusf_(-lm[j]), bav = ba[j], bxv = bx[j];
#pragma unroll
      for (int q = 0; q < 4; ++q) {
        const int t = wid * 16 + fq * 4 + q;
        const float rr = sigmoidf_(r[q] + bav), ii = sigmoidf_(g[q] + bxv);
        const float la = -8.f * rr * sp;
        const float a = __expf(la);
        const float x2 = 2.f * la;
        const float om = (x2 > -0.01f) ? -x2 * (1.f + x2 * (0.5f + x2 * (1.f / 6.f))) : 1.f - __expf(x2);
        const float u = sqrtf(om) * ii * bf2f(xcs[t * LP + j]);
        as_[t * 64 + j] = a;
        us_[t * 64 + j] = u;
      }
    }
  }
  __syncthreads();
  {
    float av[16], uv[16];
#pragma unroll
    for (int k = 0; k < 16; ++k) { av[k] = as_[(tq * 16 + k) * 64 + i]; uv[k] = us_[(tq * 16 + k) * 64 + i]; }
    float P = 1.f, hh = 0.f;
#pragma unroll
    for (int k = 0; k < 16; ++k) { P *= av[k]; hh = av[k] * hh + uv[k]; }
    segP[tq * 64 + i] = P; segH[tq * 64 + i] = hh;
    __syncthreads();
    float Pin = 1.f, hin = 0.f;
    for (int g = 0; g < tq; ++g) { const float pg = segP[g * 64 + i], hg = segH[g * 64 + i]; hin = pg * hin + hg; Pin *= pg; }
    u16* HL = (u16*)(p.ws + O_HL);
    u16* PPp = (u16*)(p.ws + O_PP);
    P = Pin; hh = hin;
#pragma unroll
    for (int k = 0; k < 16; ++k) {
      const int t = tq * 16 + k;
      P *= av[k]; hh = av[k] * hh + uv[k];
      if (t < Lc) {
        HL[(size_t)(row0 + t) * 512 + ch] = f2bf(hh);
        PPp[(size_t)(row0 + t) * 512 + ch] = f2bf(P);
      }
    }
    if (tq * 16 + 16 == Lc) {
      ((float*)(p.ws + O_CA))[(size_t)ci * 512 + ch] = P;
      ((float*)(p.ws + O_CH))[(size_t)ci * 512 + ch] = hh;
    }
  }
}
constexpr int L2_ITEMS = 8 + 32;
DI void lru2_item(const Params& p, int l, int it) {
  const float* CA = (const float*)(p.ws + O_CA);
  const float* CH = (const float*)(p.ws + O_CH);
  float* HS = (float*)(p.ws + O_HS);
  if (it < 8) {
    const int e = it * 256 + TID(), b = e >> 9, ch = e & 511;
    float hh = 0.f;
    for (int c0 = 0; c0 < 128; c0 += 16) {
      float ca[16], chv[16];
#pragma unroll
      for (int c = 0; c < 16; ++c) { const size_t o = (size_t)(b * 128 + c0 + c) * 512 + ch; ca[c] = CA[o]; chv[c] = CH[o]; }
#pragma unroll
      for (int c = 0; c < 16; ++c) { const size_t o = (size_t)(b * 128 + c0 + c) * 512 + ch; HS[o] = hh; hh = ca[c] * hh + chv[c]; }
    }
    p.out[LH_P + ((size_t)l * PB + b) * 512 + ch] = hh;
  } else {
    const int e = (it - 8) * 256 + TID(), b = e >> 9, ch = e & 511;
    const float h0 = p.in[6][((size_t)l * SBT + b) * 512 + ch];
    const size_t o = (size_t)(MP / 64 + b) * 512 + ch;
    HS[o] = h0;
    p.out[LH_S + ((size_t)l * SBT + b) * 512 + ch] = CA[o] * h0 + CH[o];
  }
}
constexpr int L3_ITEMS = MT / 8;
DI void lru3_item(const Params& p, int it) {
  const u16* HL = (const u16*)(p.ws + O_HL);
  const u16* PPp = (const u16*)(p.ws + O_PP);
  const u16* LG = (const u16*)(p.ws + O_LG);
  const float* HS = (const float*)(p.ws + O_HS);
  u16* OL = (u16*)(p.ws + O_OL);
#pragma unroll
  for (int i = 0; i < 4; ++i) {
    const int id = TID() + i * 256;
    const int row = it * 8 + (id >> 7), c4 = (id & 127) * 4;
    const int ci = row < MP ? (row >> 6) : MP / 64 + ((row - MP) >> 5);
    const size_t o = (size_t)row * 512 + c4;
    const uint2 hl = *(const uint2*)(HL + o), pp = *(const uint2*)(PPp + o), lg = *(const uint2*)(LG + o);
    const float4 hs = *(const float4*)(HS + (size_t)ci * 512 + c4);
    float y0 = (bf2f(hl.x & 0xffff) + bf2f(pp.x & 0xffff) * hs.x) * gelu_tanh(bf2f(lg.x & 0xffff));
    float y1 = (bf2f(hl.x >> 16) + bf2f(pp.x >> 16) * hs.y) * gelu_tanh(bf2f(lg.x >> 16));
    float y2 = (bf2f(hl.y & 0xffff) + bf2f(pp.y & 0xffff) * hs.z) * gelu_tanh(bf2f(lg.y & 0xffff));
    float y3 = (bf2f(hl.y >> 16) + bf2f(pp.y >> 16) * hs.w) * gelu_tanh(bf2f(lg.y >> 16));
    *(uint2*)(OL + o) = uint2{pack2(y0, y1), pack2(y2, y3)};
  }
}

DI void ybr_tile(const Params& p, int l, int mt, int nt, char* smem) {
  const int row0 = mt * 256, col0 = nt * 256, br = nt >> 2;
  const u16* W = (const u16*)(p.ws + O_WT) + (size_t)l * W_LAYER + W_BR + (size_t)br * 1024 * 512 + (size_t)((nt & 3) * 256) * 512;
  const u16* O = (const u16*)(p.ws + (br == 0 ? O_OA : (br == 1 ? O_OG : O_OL))) + (size_t)row0 * 512;
  f32x4 acc[8][4];
  zero_acc8(acc);
  gemm512(O, 512, W, 512, 512, acc, smem);
  tile_out_bf16<false>(acc, (u16*)(p.ws + O_YP) + (size_t)row0 * 3072 + col0, 3072, smem, 1.f, 0, nullptr);
}
DI void gate_tile(const Params& p, int l, int mt, int nt, char* smem) {
  const int row0 = mt * 256, col0 = nt * 256;
  const u16* W = (const u16*)(p.ws + O_WT) + (size_t)l * W_LAYER + W_MG + (size_t)col0 * LDK;
  f32x4 acc[8][4];
  zero_acc8(acc);
  gemm512((const u16*)(p.ws + O_XN) + (size_t)row0 * LDK, LDK, W, LDK, 1024, acc, smem);
  EPI_IDS;
  u16* Y = (u16*)(p.ws + O_YP) + (size_t)row0 * 3072 + col0;
  const float* bm = p.in[26] + (size_t)l * 3072 + col0 + wc * 64 + fr;
  img_load_bf16(Y, 3072, smem, 256, 0);
  img_barrier();
  u16* img = (u16*)smem + (wr * 128 + fq * 4) * IMG_LD + wc * 64 + fr;
#pragma unroll
  for (int n = 0; n < 4; ++n) {
    const float bv = bm[n * 16];
#pragma unroll
    for (int m = 0; m < 8; ++m)
#pragma unroll
      for (int j = 0; j < 4; ++j) {
        u16* q = img + (m * 16 + j) * IMG_LD + n * 16;
        *q = f2bf(sigmoidf_(acc[m][n][j] + bv) * bf2f(*q));
      }
  }
  img_barrier();
  img_store_bf16(Y, 3072, smem, 0);
}
DI void resid_tile(const Params& p, const u16* A, int ldk, const u16* W, int mt, int nt, int k0, int klen, bool atomic, char* smem) {
  const int row0 = mt * 256, col0 = nt * 256;
  f32x4 acc[8][4];
  zero_acc8(acc);
  gemm512(A + (size_t)row0 * ldk + k0, ldk, W + (size_t)col0 * ldk + k0, ldk, klen, acc, smem);
  if (!atomic) { tile_out_f32<true, false>(acc, p.out + (size_t)row0 * 1024 + col0, 1024, smem, 0, nullptr); return; }
  EPI_IDS;
#pragma unroll
  for (int m = 0; m < 8; ++m) {
    asm volatile("" ::: "memory");
#pragma unroll
    for (int n = 0; n < 4; ++n)
#pragma unroll
      for (int j = 0; j < 4; ++j) {
        const int row = row0 + wr * 128 + m * 16 + fq * 4 + j, col = col0 + wc * 64 + n * 16 + fr;
        float* q = p.out + (size_t)row * 1024 + col;
        if (atomic) unsafeAtomicAdd(q, acc[m][n][j]); else *q += acc[m][n][j];
      }
  }
}
DI void resid_phase(const Params& p, const u16* A, int ldk, const u16* W, int B, int G, char* smem) {
  const int ns = ldk / 256;
  int k = 0, u = B;
  while (true) {
    int mt, nt, k0 = 0, kl = ldk;
    bool at = false;
    if (xcd_tile(B, G, k, 128, 4, mt, nt)) { ++k; }
    else if (u < 8 * ns) { const int t = u / ns, sl = u - t * ns; mt = 128 + (t >> 2); nt = t & 3; k0 = sl * 256; kl = 256; at = true; u += G; }
    else break;
    asm volatile("" : "+s"(kl));
    resid_tile(p, A, ldk, W, mt, nt, k0, kl, at, smem);
  }
}

DI void ffgate_tile(const Params& p, int l, int mt, int nt, char* smem) {
  const int row0 = mt * 256, col0 = nt * 256;
  const u16* W = (const u16*)(p.ws + O_WT) + (size_t)l * W_LAYER + W_FG;
  f32x4 acc[8][4];
  zero_acc8(acc);
  gemm512((const u16*)(p.ws + O_XN) + (size_t)row0 * LDK, LDK, W + (size_t)col0 * LDK, LDK, 1024, acc, smem);
  if (mt < 128) {
    EPI_IDS;
    tile_out_bf16<false>(acc, (u16*)(p.ws + O_GU) + (size_t)row0 * DFF + col0, DFF, smem, 1.f, 0, nullptr);
    if (((row0 + 256) & 8191) == 0 && wr == 1 && fq == 3) {
      const int b = row0 >> 13;
#pragma unroll
      for (int n = 0; n < 4; ++n) {
        const int col = col0 + wc * 64 + n * 16 + fr;
        p.out[FC_P + (((size_t)l * PB + b) * 2 + 0) * DFF + col] = acc[7][n][2];
        p.out[FC_P + (((size_t)l * PB + b) * 2 + 1) * DFF + col] = acc[7][n][3];
      }
    }
    return;
  }
  EPI_IDS;
  u16* GU = (u16*)(p.ws + O_GU);
  const bool isS = row0 >= MP;
#pragma unroll
  for (int m = 0; m < 8; ++m) {
    asm volatile("" ::: "memory");
#pragma unroll
    for (int n = 0; n < 4; ++n)
#pragma unroll
      for (int j = 0; j < 4; ++j) {
        const int row = row0 + wr * 128 + m * 16 + fq * 4 + j, col = col0 + wc * 64 + n * 16 + fr;
        const float v = acc[m][n][j];
        GU[(size_t)row * DFF + col] = f2bf(v);
        if (isS) {
          const int rs = row - MP, b = rs >> 5, t = rs & 31;
          if (t >= STT - 2) p.out[FC_S + (((size_t)l * SBT + b) * 2 + (t - (STT - 2))) * DFF + col] = v;
        } else {
          const int b = row >> 13, t = row & 8191;
          if (t >= PT - 2) p.out[FC_P + (((size_t)l * PB + b) * 2 + (t - (PT - 2))) * DFF + col] = v;
        }
      }
  }
}
DI void ffup_tile(const Params& p, int l, int mt, int nt, char* smem) {
  const int row0 = mt * 256, col0 = nt * 256;
  const u16* W = (const u16*)(p.ws + O_WT) + (size_t)l * W_LAYER + W_FU;
  f32x4 acc[8][4];
  zero_acc8(acc);
  gemm512((const u16*)(p.ws + O_XN) + (size_t)row0 * LDK, LDK, W + (size_t)col0 * LDK, LDK, 1024, acc, smem);
  if (mt < 128) {
    EPI_IDS;
    const u16* GUt = (const u16*)(p.ws + O_GU) + (size_t)row0 * DFF + col0;
    if (row0 >= 2) img_load_bf16(GUt - 2 * DFF, DFF, smem, 258, 0); else img_load_bf16(GUt, DFF, smem, 256, 2);
    img_barrier();
    const u16* img = (const u16*)smem + (wr * 128 + fq * 4) * IMG_LD + wc * 64 + fr;
#pragma unroll
    for (int n = 0; n < 4; ++n) {
      const int col = col0 + wc * 64 + n * 16 + fr;
      const float* cw = p.in[30] + (size_t)l * 3 * DFF + col;
      const float w0 = cw[0], w1 = cw[DFF], w2 = cw[2 * DFF], cb = p.in[31][(size_t)l * DFF + col];
#pragma unroll
      for (int m = 0; m < 8; ++m) {
        if ((m & 1) == 0) asm volatile("" ::: "memory");
        const int t = (row0 + wr * 128 + m * 16 + fq * 4) & 8191;
        float g[6];
#pragma unroll
        for (int d = 0; d < 6; ++d) { const float gv = bf2f(img[(m * 16 + d) * IMG_LD + n * 16]); g[d] = (d >= 2 || t - 2 + d >= 0) ? gv : 0.f; }
#pragma unroll
        for (int j = 0; j < 4; ++j) acc[m][n][j] *= gelu_tanh(cb + w0 * g[j] + w1 * g[j + 1] + w2 * g[j + 2]);
      }
    }
    img_barrier();
    img_put_bf16<false>(acc, smem, 2, 1.f, 0, nullptr);
    img_barrier();
    img_store_bf16((u16*)(p.ws + O_FF) + (size_t)row0 * DFF + col0, DFF, smem, 2);
    return;
  }
  EPI_IDS;
  const u16* GU = (const u16*)(p.ws + O_GU);
  u16* FF = (u16*)(p.ws + O_FF);
  const bool isS = row0 >= MP;
  const int rowq = row0 + wr * 128 + fq * 4;
  const unsigned gbase = (unsigned)rowq * (unsigned)DFF + (unsigned)(col0 + wc * 64 + fr);
#pragma unroll
  for (int n = 0; n < 4; ++n) {
    const int col = col0 + wc * 64 + n * 16 + fr;
    const float* cw = p.in[30] + (size_t)l * 3 * DFF + col;
    const float w0 = cw[0], w1 = cw[DFF], w2 = cw[2 * DFF], cb = p.in[31][(size_t)l * DFF + col];
#pragma unroll
    for (int mh = 0; mh < 2; ++mh) {
      asm volatile("" ::: "memory");
      float g[4][6];
#pragma unroll
      for (int m = 0; m < 4; ++m) {
        const int rowb = rowq + (mh * 4 + m) * 16;
        int b, t;
        if (isS) { int rs = rowb - MP; b = rs >> 5; t = rs & 31; } else { b = rowb >> 13; t = rowb & 8191; }
#pragma unroll
        for (int d = 0; d < 6; ++d) {
          const int tt = t - 2 + d;
          if (tt >= 0) g[m][d] = bf2f(GU[gbase + (unsigned)((((mh * 4 + m) * 16 + d) * DFF) + n * 16) - 2u * (unsigned)DFF]);
          else g[m][d] = isS ? p.in[7][(((size_t)l * SBT + b) * 2 + (2 + tt)) * DFF + col] : 0.f;
        }
      }
#pragma unroll
      for (int m = 0; m < 4; ++m)
#pragma unroll
        for (int j = 0; j < 4; ++j) {
          const float gc = cb + w0 * g[m][j] + w1 * g[m][j + 1] + w2 * g[m][j + 2];
          FF[gbase + (unsigned)((((mh * 4 + m) * 16 + j) * DFF) + n * 16)] = f2bf(gelu_tanh(gc) * acc[mh * 4 + m][n][j]);
        }
    }
  }
}

DI void norm_phase(const Params& p, int l, int mode, int B, int G, char* smem) {
  const int tid = TID512(), lane = tid & 63, wid = tid >> 6;
  const float* gamma = mode == 0 ? p.in[8] + (size_t)l * 1024 : (mode == 1 ? p.in[28] + (size_t)l * 1024 : p.in[34]);
  float* wga = (float*)smem;
  if (mode == 0) {
    __syncthreads();
    const float* src = p.in[9] + (size_t)l * 1024 * PW + 3072;
#pragma unroll
    for (int i = 0; i < 8; ++i) {
      const int id = tid + i * 512, k = id >> 2, part = id & 3;
      ((float4*)wga)[(((k >> 8) * 4 + (k & 3)) * 4 + part) * 64 + ((k >> 2) & 63)] = *(const float4*)(src + (size_t)k * PW + part * 4);
    }
    __syncthreads();
  }
  float4 g[4];
#pragma unroll
  for (int i = 0; i < 4; ++i) g[i] = *(const float4*)(gamma + i * 256 + lane * 4);
  for (int row = B * 8 + wid; row < MT; row += G * 8) {
    float* X = p.out + (size_t)row * 1024;
    float4 v[4];
    float ss = 0.f;
#pragma unroll
    for (int i = 0; i < 4; ++i) { v[i] = *(const float4*)(X + i * 256 + lane * 4); ss += v[i].x * v[i].x + v[i].y * v[i].y + v[i].z * v[i].z + v[i].w * v[i].w; }
    ss = wave_sum(ss);
    const float rs = rsqrtf(ss * (1.f / 1024.f) + EPS);
    u16* XN = (u16*)(p.ws + O_XN) + (size_t)row * LDK;
#pragma unroll
    for (int i = 0; i < 4; ++i) {
      v[i] = float4{v[i].x * rs * g[i].x, v[i].y * rs * g[i].y, v[i].z * rs * g[i].z, v[i].w * rs * g[i].w};
      if (mode == 2) *(float4*)(X + i * 256 + lane * 4) = v[i];
      else *(uint2*)(XN + i * 256 + lane * 4) = uint2{pack2(v[i].x, v[i].y), pack2(v[i].z, v[i].w)};
    }
    if (mode == 0) {
      float ga[16];
#pragma unroll
      for (int r = 0; r < 16; ++r) ga[r] = 0.f;
#pragma unroll
      for (int i = 0; i < 4; ++i) {
        const float xv[4] = {v[i].x, v[i].y, v[i].z, v[i].w};
#pragma unroll
        for (int e = 0; e < 4; ++e) {
          asm volatile("" ::: "memory");
#pragma unroll
          for (int q = 0; q < 4; ++q) {
            const float4 w = ((const float4*)wga)[((i * 4 + e) * 4 + q) * 64 + lane];
            ga[q * 4 + 0] += xv[e] * w.x; ga[q * 4 + 1] += xv[e] * w.y; ga[q * 4 + 2] += xv[e] * w.z; ga[q * 4 + 3] += xv[e] * w.w;
          }
        }
      }
      float mine = 0.f;
#pragma unroll
      for (int r = 0; r < 16; ++r) { const float s = wave_sum(ga[r]); if (lane == r) mine = s; }
      if (lane < 16) ((float*)(p.ws + O_GA))[(size_t)row * 16 + lane] = mine;
    }
  }
}

#ifndef ONLY
#define ONLY -1
#endif
constexpr int HALF_LDS = 73728;
constexpr int SMEM_BYTES = 2 * HALF_LDS;
#define VB() (2 * B + (TID512() >> 8))
#define HS() (smem + (TID512() >> 8) * HALF_LDS)
__global__ void __launch_bounds__(512, 2) mega(Params p) {
  cg::grid_group grid = cg::this_grid();
  extern __shared__ __attribute__((aligned(16))) char smem[];
  const int G = gridDim.x, B = blockIdx.x;
  const int vG = 2 * G;
  if (ONLY < 0 || ONLY == 0) for (int it = VB(); it < PREP_ITEMS; it += vG) prep_item(p, it, HS());
  grid.sync();
  for (int l = 0; l < NL; ++l) {
    const u16* W = (const u16*)(p.ws + O_WT) + (size_t)l * W_LAYER;
    if (ONLY < 0 || ONLY == 1) norm_phase(p, l, 0, B, G, smem);
    grid.sync();
    if (ONLY < 0 || ONLY == 2) { int mt, nt; for (int k = 0; xcd_tile(B, G, k, 130, 16, mt, nt); ++k) projin_tile(p, l, mt, nt, smem); for (int it = VB(); it < PB_KC + PB_VC; it += vG) cache_conv_item(p, l, it, HS()); }
    grid.sync();
    if (ONLY < 0 || ONLY == 3) for (int it = B; it < 1024 + 64; it += G) attn_item(p, l, it, smem);
    if (ONLY < 0 || ONLY == 13) for (int it = VB(); it < NGI; it += vG) gla1_item(p, l, it, HS());
    if (ONLY < 0 || ONLY == 14) for (int it = VB(); it < L1_ITEMS; it += vG) lru1_item(p, l, it, HS());
    grid.sync();
    if (ONLY < 0 || ONLY == 4) for (int it = VB(); it < G2_ITEMS + L2_ITEMS; it += vG) { if (it < G2_ITEMS) gla2_item(p, l, it); else lru2_item(p, l, it - G2_ITEMS); }
    grid.sync();
    if (ONLY < 0 || ONLY == 5) { for (int it = VB(); it < NGI; it += vG) gla3_item(p, l, it, HS()); for (int it = VB(); it < L3_ITEMS; it += vG) lru3_item(p, it); }
    grid.sync();
    if (ONLY < 0 || ONLY == 6) { int mt, nt; for (int k = 0; xcd_tile(B, G, k, 130, 12, mt, nt); ++k) ybr_tile(p, l, mt, nt, smem); }
    grid.sync();
    if (ONLY < 0 || ONLY == 7) { int mt, nt; for (int k = 0; xcd_tile(B, G, k, 130, 12, mt, nt); ++k) gate_tile(p, l, mt, nt, smem); }
    grid.sync();
    if (ONLY < 0 || ONLY == 8) resid_phase(p, (const u16*)(p.ws + O_YP), 3072, W + W_OUT, B, G, smem);
    grid.sync();
    if (ONLY < 0 || ONLY == 9) norm_phase(p, l, 1, B, G, smem);
    grid.sync();
    if (ONLY < 0 || ONLY == 10) { int mt, nt; for (int k = 0; xcd_tile(B, G, k, 130, 11, mt, nt); ++k) ffgate_tile(p, l, mt, nt, smem); }
    grid.sync();
    if (ONLY < 0 || ONLY == 11) { int mt, nt; for (int k = 0; xcd_tile(B, G, k, 130, 11, mt, nt); ++k) ffup_tile(p, l, mt, nt, smem); }
    grid.sync();
    if (ONLY < 0 || ONLY == 12) resid_phase(p, (const u16*)(p.ws + O_FF), DFF, W + W_FD, B, G, smem);
    grid.sync();
  }
  if (ONLY < 0 || ONLY == 15) norm_phase(p, 0, 2, B, G, smem);
}

extern "C" void kernel_launch(void* const* d_in, const int* in_sizes, int n_in, void* d_out, int out_size, void* d_ws, size_t ws_size,
                              hipStream_t stream) {
  static int grid_blocks = 0;
  if (!grid_blocks) {
    int dev = 0, cus = 0, per = 0;
    (void)hipGetDevice(&dev);
    (void)hipDeviceGetAttribute(&cus, hipDeviceAttributeMultiprocessorCount, dev);
    (void)hipFuncSetAttribute((const void*)mega, hipFuncAttributeMaxDynamicSharedMemorySize, SMEM_BYTES);
    (void)hipOccupancyMaxActiveBlocksPerMultiprocessor(&per, mega, 512, SMEM_BYTES);
    if (per < 1) per = 1;
    grid_blocks = cus;
  }
  if (ws_size < WS_NEED) fprintf(stderr, "workspace too small: %zu < %zu\n", ws_size, (size_t)WS_NEED);
  Params p{};
  for (int i = 0; i < 35; ++i) p.in[i] = (const float*)d_in[i];
  p.out = (float*)d_out;
  p.ws = (char*)d_ws;
  void* args[] = {&p};
  hipError_t e = hipLaunchCooperativeKernel((void*)mega, dim3(grid_blocks), dim3(512), args, SMEM_BYTES, stream);
  if (e != hipSuccess) fprintf(stderr, "cooperative launch failed: %s (grid %d)\n", hipGetErrorString(e), grid_blocks);
}
```

```cpp
#include <hip/hip_runtime.h>
#include <hip/hip_cooperative_groups.h>
#include <cstdio>
namespace cg = cooperative_groups;

#define DI __device__ __forceinline__
typedef unsigned short u16;
using bf16x8 = __attribute__((ext_vector_type(8))) short;
using f32x4 = __attribute__((ext_vector_type(4))) float;
using u32x4 = __attribute__((ext_vector_type(4))) unsigned;
#define MFMA16(a, b, c) __builtin_amdgcn_mfma_f32_16x16x32_bf16((a), (b), (c), 0, 0, 0)

constexpr int DM = 1024, PB = 4, PT = 8192, SBT = 16, STT = 32, PAST = 2048, NL = 4;
constexpr int MP = PB * PT, MS = SBT * STT, MT = MP + MS;
constexpr int SKP = 2112;
constexpr int SKV = PAST + STT;
constexpr int DFF = 2816, PW = 4112, PWP = 4224;
constexpr int NGI = PB * 4 * 128 + SBT * 4;
constexpr int NLC = MP / 64 + SBT;
constexpr float EPS = 1e-6f;
constexpr float QSCALE = 0.125f * 1.4426950408889634f;
constexpr int LDK = 1088;

constexpr size_t W_IN = 0, W_MG = W_IN + (size_t)4096 * LDK, W_BR = W_MG + (size_t)3072 * LDK, W_OUT = W_BR + (size_t)3 * 1024 * 512,
                 W_FG = W_OUT + (size_t)1024 * 3072, W_FU = W_FG + (size_t)DFF * LDK, W_FD = W_FU + (size_t)DFF * LDK,
                 W_WA = W_FD + (size_t)1024 * DFF, W_WX = W_WA + 32768, W_LAYER = W_WX + 32768;

struct Params {
  const float* in[35];
  float* out;
  char* ws;
};

constexpr size_t al(size_t x) { return (x + 255) & ~(size_t)255; }
constexpr size_t O_WT = 0;
constexpr size_t O_ROPE = al(O_WT + W_LAYER * NL * 2);
constexpr size_t O_LAM = al(O_ROPE + 2 * 8192 * 8 * 4);
constexpr size_t O_BAR = al(O_LAM + 256);
constexpr size_t O_XN = al(O_BAR + 4096 * 4);
constexpr size_t O_REG = al(O_XN + (size_t)MT * LDK * 2);
constexpr size_t O_QB = O_REG;
constexpr size_t O_KB = al(O_QB + (size_t)MT * 512 * 2);
constexpr size_t O_KS = al(O_KB + (size_t)MP * 512 * 2);
constexpr size_t O_VT = al(O_KS + (size_t)SBT * SKP * 512 * 2);
constexpr size_t O_VTS = al(O_VT + (size_t)MP * 512 * 2);
constexpr size_t O_GQ = al(O_VTS + (size_t)SBT * SKP * 512 * 2);
constexpr size_t O_GK = al(O_GQ + (size_t)MT * 256 * 2);
constexpr size_t O_GV = al(O_GK + (size_t)MT * 256 * 2);
constexpr size_t O_GR = al(O_GV + (size_t)MT * 512 * 2);
constexpr size_t O_GA = al(O_GR + (size_t)MT * 512 * 2);
constexpr size_t O_LX = al(O_GA + (size_t)MT * 16 * 4);
constexpr size_t O_LG = al(O_LX + (size_t)MT * 512 * 4);
constexpr size_t O_KVT = al(O_LG + (size_t)MT * 512 * 2);
constexpr size_t O_DEC = al(O_KVT + (size_t)NGI * 8192 * 2);
constexpr size_t O_HL = al(O_DEC + (size_t)NGI * 64 * 4);
constexpr size_t O_PP = al(O_HL + (size_t)MT * 512 * 2);
constexpr size_t O_CA = al(O_PP + (size_t)MT * 512 * 2);
constexpr size_t O_CH = al(O_CA + (size_t)NLC * 512 * 4);
constexpr size_t O_HS = al(O_CH + (size_t)NLC * 512 * 4);
constexpr size_t O_OA = al(O_HS + (size_t)NLC * 512 * 4);
constexpr size_t O_OG = al(O_OA + (size_t)MT * 512 * 2);
constexpr size_t O_OL = al(O_OG + (size_t)MT * 512 * 2);
constexpr size_t O_END1 = al(O_OL + (size_t)MT * 512 * 2);
constexpr size_t O_YP = O_QB;
static_assert(O_YP + (size_t)MT * 3072 * 2 <= O_OA, "Y buffer overlaps live mixer outputs");
constexpr size_t O_GU = O_REG;
constexpr size_t O_FF = al(O_GU + (size_t)MT * DFF * 2);
constexpr size_t O_END2 = al(O_FF + (size_t)MT * DFF * 2);
constexpr size_t WS_NEED = O_END1 > O_END2 ? O_END1 : O_END2;

constexpr size_t Y_P = 0, Y_S = Y_P + (size_t)MP * 1024, K_P = Y_S + (size_t)MS * 1024, V_P = K_P + (size_t)NL * MP * 512,
                 GLA_P = V_P + (size_t)NL * MP * 512, LC_P = GLA_P + (size_t)NL * PB * 32768, LH_P = LC_P + (size_t)NL * PB * 3 * 512,
                 FC_P = LH_P + (size_t)NL * PB * 512, K_S = FC_P + (size_t)NL * PB * 2 * DFF, V_S = K_S + (size_t)NL * MS * 512,
                 GLA_S = V_S + (size_t)NL * MS * 512, LC_S = GLA_S + (size_t)NL * SBT * 32768, LH_S = LC_S + (size_t)NL * SBT * 3 * 512,
                 FC_S = LH_S + (size_t)NL * SBT * 512, OUT_TOTAL = FC_S + (size_t)NL * SBT * 2 * DFF;

DI int TID() { int t = threadIdx.x & 255; asm volatile("" : "+v"(t)); return t; }
DI int TID512() { int t = threadIdx.x; asm volatile("" : "+v"(t)); return t; }
DI u16 f2bf(float x) { __bf16 h = (__bf16)x; return __builtin_bit_cast(u16, h); }
DI float bf2f(u16 h) { return __uint_as_float(((unsigned)h) << 16); }
typedef __bf16 bf16v2_t __attribute__((ext_vector_type(2)));
typedef float f32v2_t __attribute__((ext_vector_type(2)));
DI unsigned pack2(float a, float b) { f32v2_t v = {a, b}; bf16v2_t r = __builtin_convertvector(v, bf16v2_t); return __builtin_bit_cast(unsigned, r); }
DI float sigmoidf_(float x) { return __builtin_amdgcn_rcpf(1.f + __expf(-x)); }
DI float gelu_tanh(float x) { float u = 0.7978845608028654f * (x + 0.044715f * x * x * x); return x * sigmoidf_(2.f * u); }
DI float softplusf_(float x) { return fmaxf(x, 0.f) + __logf(1.f + __expf(-fabsf(x))); }
DI float quad_max(float v) {
  auto a = __builtin_amdgcn_permlane16_swap(__float_as_uint(v), __float_as_uint(v), false, false);
  v = fmaxf(__uint_as_float(a[0]), __uint_as_float(a[1]));
  auto b = __builtin_amdgcn_permlane32_swap(__float_as_uint(v), __float_as_uint(v), false, false);
  return fmaxf(__uint_as_float(b[0]), __uint_as_float(b[1]));
}
DI float wave_sum(float v) {
  for (int o = 32; o > 0; o >>= 1) v += __shfl_xor(v, o);
  return v;
}

DI void gemm512(const u16* __restrict__ A, int lda, const u16* __restrict__ B, int ldb, int K, f32x4 (&acc)[8][4], char* smem) {
  const int tid = TID512(), lane = tid & 63, wid = tid >> 6, wr = wid >> 2, wc = wid & 3, fr = lane & 15, fq = lane >> 4;
  const int lrow = tid >> 3;
  const int gch = (tid & 7) ^ ((lrow >> 1) & 7);
  const unsigned aov = (unsigned)(lrow * lda + gch * 8);
  const unsigned bov = (unsigned)(lrow * ldb + gch * 8);
  const int soff = tid * 16;
  const int sw = (fr >> 1) & 7;
  const int aoff = (wr * 128 + fr) * 128, boff = 32768 + (wc * 64 + fr) * 128;
  const int nk = K >> 6;
  asm volatile("s_waitcnt vmcnt(0) lgkmcnt(0)" ::: "memory");
  __builtin_amdgcn_s_barrier();
#pragma unroll
  for (int i = 0; i < 4; ++i) {
    __builtin_amdgcn_global_load_lds((const unsigned*)((A + (size_t)i * 64 * lda) + aov), (unsigned*)(smem + soff + i * 8192), 16, 0, 0);
    __builtin_amdgcn_global_load_lds((const unsigned*)((B + (size_t)i * 64 * ldb) + bov), (unsigned*)(smem + 32768 + soff + i * 8192), 16, 0, 0);
  }
  asm volatile("s_waitcnt vmcnt(0)" ::: "memory");
  __builtin_amdgcn_s_barrier();
  for (int kt = 0; kt < nk; ++kt) {
    const int buf = kt & 1;
    if (kt + 1 < nk) {
      char* st = smem + (buf ^ 1) * 65536 + soff;
      const u16* An = A + (kt + 1) * 64;
      const u16* Bn = B + (kt + 1) * 64;
#pragma unroll
      for (int i = 0; i < 4; ++i) {
        __builtin_amdgcn_global_load_lds((const unsigned*)((An + (size_t)i * 64 * lda) + aov), (unsigned*)(st + i * 8192), 16, 0, 0);
        __builtin_amdgcn_global_load_lds((const unsigned*)((Bn + (size_t)i * 64 * ldb) + bov), (unsigned*)(st + 32768 + i * 8192), 16, 0, 0);
      }
    }
    const char* Sb = smem + buf * 65536;
#pragma unroll
    for (int ks = 0; ks < 2; ++ks) {
      const int co = ((ks * 4 + fq) ^ sw) << 4;
      bf16x8 bfr[4], af[8];
#pragma unroll
      for (int n = 0; n < 4; ++n) bfr[n] = *(const bf16x8*)(Sb + boff + n * 2048 + co);
#pragma unroll
      for (int m = 0; m < 8; ++m) af[m] = *(const bf16x8*)(Sb + aoff + m * 2048 + co);
      __builtin_amdgcn_sched_barrier(0);
#pragma unroll
      for (int m = 0; m < 8; ++m)
#pragma unroll
        for (int n = 0; n < 4; ++n) acc[m][n] = MFMA16(af[m], bfr[n], acc[m][n]);
      __builtin_amdgcn_sched_barrier(0);
    }
    asm volatile("s_waitcnt vmcnt(0) lgkmcnt(0)" ::: "memory");
    __builtin_amdgcn_s_barrier();
  }
}
DI void zero_acc8(f32x4 (&acc)[8][4]) {
#pragma unroll
  for (int m = 0; m < 8; ++m)
#pragma unroll
    for (int n = 0; n < 4; ++n) acc[m][n] = f32x4{0.f, 0.f, 0.f, 0.f};
}
#define EPI_IDS const int tid = TID512(), lane = tid & 63, wid = tid >> 6, wr = wid >> 2, wc = wid & 3, fr = lane & 15, fq = lane >> 4


constexpr int IMG_LD = 264;
constexpr int IMGF_LD = 260;
DI void img_barrier() { asm volatile("s_waitcnt vmcnt(0) lgkmcnt(0)" ::: "memory"); __builtin_amdgcn_s_barrier(); }
template <bool ROPE>
DI float epi_val(const f32x4 (&acc)[8][4], int m, int n, int j, const float* cs4, const float* sn4, int fr) {
  float v = acc[m][n][j];
  if (ROPE && n == 0) {
    const float pr = __shfl_xor(v, 8);
    v = (fr < 8) ? v * cs4[j] - pr * sn4[j] : v * cs4[j] + pr * sn4[j];
  }
  return v;
}
template <bool ROPE>
DI void img_put_bf16(const f32x4 (&acc)[8][4], char* smem, int rowoff, float scale, int prow0, const float* cosT) {
  EPI_IDS;
  u16* img = (u16*)smem + (wr * 128 + fq * 4 + rowoff) * IMG_LD + wc * 64 + fr;
#pragma unroll
  for (int m = 0; m < 8; ++m) {
    float cs4[4] = {0.f, 0.f, 0.f, 0.f}, sn4[4] = {0.f, 0.f, 0.f, 0.f};
    if (ROPE) {
#pragma unroll
      for (int j = 0; j < 4; ++j) { const int pos = prow0 + wr * 128 + m * 16 + fq * 4 + j; cs4[j] = cosT[pos * 8 + (fr & 7)]; sn4[j] = cosT[8192 * 8 + pos * 8 + (fr & 7)]; }
    }
#pragma unroll
    for (int n = 0; n < 4; ++n)
#pragma unroll
      for (int j = 0; j < 4; ++j) img[(m * 16 + j) * IMG_LD + n * 16] = f2bf(epi_val<ROPE>(acc, m, n, j, cs4, sn4, fr) * scale);
  }
}
DI void img_store_bf16(u16* dst, int ld, const char* smem, int rowoff) {
  const int tid = TID512();
#pragma unroll
  for (int q = 0; q < 16; ++q) {
    const int slot = tid + q * 512, row = slot >> 5, c16 = slot & 31;
    *(u32x4*)(dst + (size_t)row * ld + c16 * 8) = *(const u32x4*)(smem + (row + rowoff) * (IMG_LD * 2) + c16 * 16);
  }
}
DI void img_load_bf16(const u16* src, int ld, char* smem, int nrows, int rowoff) {
  for (int slot = TID512(); slot < nrows * 32; slot += 512) {
    const int row = slot >> 5, c16 = slot & 31;
    *(u32x4*)(smem + (row + rowoff) * (IMG_LD * 2) + c16 * 16) = *(const u32x4*)(src + (size_t)row * ld + c16 * 8);
  }
}
template <bool ROPE>
DI void imgf_put(const f32x4 (&acc)[8][4], int h, char* smem, int prow0, const float* cosT) {
  EPI_IDS;
  if (wr == h) {
    float* f = (float*)smem + (fq * 4) * IMGF_LD + wc * 64 + fr;
#pragma unroll
    for (int m = 0; m < 8; ++m) {
      float cs4[4] = {0.f, 0.f, 0.f, 0.f}, sn4[4] = {0.f, 0.f, 0.f, 0.f};
      if (ROPE) {
#pragma unroll
        for (int j = 0; j < 4; ++j) { const int pos = prow0 + wr * 128 + m * 16 + fq * 4 + j; cs4[j] = cosT[pos * 8 + (fr & 7)]; sn4[j] = cosT[8192 * 8 + pos * 8 + (fr & 7)]; }
      }
#pragma unroll
      for (int n = 0; n < 4; ++n)
#pragma unroll
        for (int j = 0; j < 4; ++j) f[(m * 16 + j) * IMGF_LD + n * 16] = epi_val<ROPE>(acc, m, n, j, cs4, sn4, fr);
    }
  }
}
template <bool ADD>
DI void imgf_store(float* dst, int ld, const char* smem) {
  const int tid = TID512();
  const unsigned o0 = (unsigned)((tid >> 6) * ld + (tid & 63) * 4);
  const char* src = smem + (tid >> 6) * (IMGF_LD * 4) + (tid & 63) * 16;
#pragma unroll
  for (int q = 0; q < 16; ++q) {
    if ((q & 3) == 0) asm volatile("" ::: "memory");
    float4 v = *(const float4*)(src + q * 8 * (IMGF_LD * 4));
    float4* d = (float4*)(dst + (o0 + (unsigned)(q * 8 * ld)));
    if (ADD) { const float4 x = *d; v.x += x.x; v.y += x.y; v.z += x.z; v.w += x.w; }
    *d = v;
  }
}
template <bool ADD, bool ROPE>
DI void tile_out_f32(const f32x4 (&acc)[8][4], float* dst, int ld, char* smem, int prow0, const float* cosT) {
#pragma unroll 1
  for (int h = 0; h < 2; ++h) {
    img_barrier();
    imgf_put<ROPE>(acc, h, smem, prow0, cosT);
    img_barrier();
    imgf_store<ADD>(dst + (size_t)h * 128 * ld, ld, smem);
  }
}
template <bool ROPE>
DI void tile_out_bf16(const f32x4 (&acc)[8][4], u16* dst, int ld, char* smem, float scale, int prow0, const float* cosT) {
  img_barrier();
  img_put_bf16<ROPE>(acc, smem, 0, scale, prow0, cosT);
  img_barrier();
  img_store_bf16(dst, ld, smem, 0);
}

template <int KS>
DI f32x4 lds_mm(const u16* As, int lsa, int arow, const u16* Bs, int lsb, int brow, f32x4 acc) {
  const int lane = TID() & 63, fr = lane & 15, fq = lane >> 4;
#pragma unroll
  for (int ks = 0; ks < KS; ++ks) {
    bf16x8 a = *(const bf16x8*)(As + (arow + fr) * lsa + ks * 32 + fq * 8);
    bf16x8 b = *(const bf16x8*)(Bs + (brow + fr) * lsb + ks * 32 + fq * 8);
    acc = MFMA16(a, b, acc);
  }
  return acc;
}

constexpr int PREP_T_PER_LAYER = 64 * 16 + 48 * 16 + 3 * 128 + 3 * 256 + 3 * 704 + 16;
constexpr int PREP_T = PREP_T_PER_LAYER * NL;
constexpr int PREP_COPY = MT * 1024 / 4096;
constexpr int PREP_ROPE = 8192 * 8 / 256;
constexpr int PREP_ITEMS = PREP_T + PREP_COPY + PREP_ROPE + 2;

DI void transpose_tile(const float* src, int lds_, int k0, int c0, int ncols_valid, u16* dst, int ldd, int n0, float* tile) {
  const int tid = TID();
  __syncthreads();
#pragma unroll
  for (int i = 0; i < 16; ++i) {
    int e = tid + i * 256, r = e >> 6, c = e & 63;
    tile[r * 65 + c] = (c < ncols_valid) ? src[(size_t)(k0 + r) * lds_ + c0 + c] : 0.f;
  }
  __syncthreads();
#pragma unroll
  for (int i = 0; i < 16; ++i) {
    int e = tid + i * 256, c = e >> 6, r = e & 63;
    dst[(size_t)(n0 + c) * ldd + k0 + r] = f2bf(tile[r * 65 + c]);
  }
}

DI void prep_item(const Params& p, int it, char* smem) {
  const int tid = TID();
  if (it < PREP_T) {
    const int l = it / PREP_T_PER_LAYER;
    int t = it % PREP_T_PER_LAYER;
    u16* W = (u16*)(p.ws + O_WT) + (size_t)l * W_LAYER;
    float* tile = (float*)smem;
    if (t < 64 * 16) {
      int nt = t / 16, kt = t % 16, n0 = nt * 64;
      const int c0 = n0 < 3072 ? n0 : n0 + 16;
      transpose_tile(p.in[9] + (size_t)l * 1024 * PW, PW, kt * 64, c0, 64, W + W_IN, LDK, n0, tile);
      return;
    }
    t -= 64 * 16;
    if (t < 48 * 16) { transpose_tile(p.in[25] + (size_t)l * 1024 * 3072, 3072, (t % 16) * 64, (t / 16) * 64, 64, W + W_MG, LDK, (t / 16) * 64, tile); return; }
    t -= 48 * 16;
    if (t < 3 * 128) {
      int br = t / 128, tt = t % 128;
      transpose_tile(p.in[22 + br] + (size_t)l * 512 * 1024, 1024, (tt % 8) * 64, (tt / 8) * 64, 64, W + W_BR + (size_t)br * 1024 * 512, 512, (tt / 8) * 64, tile);
      return;
    }
    t -= 3 * 128;
    if (t < 768) { const int cp = t / 256, tt = t % 256; transpose_tile(p.in[27] + (size_t)l * 1024 * 1024, 1024, (tt % 16) * 64, (tt / 16) * 64, 64, W + W_OUT + cp * 1024, 3072, (tt / 16) * 64, tile); return; }
    t -= 768;
    if (t < 704) { transpose_tile(p.in[29] + (size_t)l * 1024 * DFF, DFF, (t % 16) * 64, (t / 16) * 64, 64, W + W_FG, LDK, (t / 16) * 64, tile); return; }
    t -= 704;
    if (t < 704) { transpose_tile(p.in[32] + (size_t)l * 1024 * DFF, DFF, (t % 16) * 64, (t / 16) * 64, 64, W + W_FU, LDK, (t / 16) * 64, tile); return; }
    t -= 704;
    if (t < 704) { transpose_tile(p.in[33] + (size_t)l * DFF * 1024, 1024, (t % 44) * 64, (t / 44) * 64, 64, W + W_FD, DFF, (t / 44) * 64, tile); return; }
    t -= 704;
    if (t < 8) { transpose_tile(p.in[17] + (size_t)l * 32768 + t * 4096, 64, 0, 0, 64, W + W_WA + t * 4096, 64, 0, tile); return; }
    t -= 8;
    transpose_tile(p.in[19] + (size_t)l * 32768 + t * 4096, 64, 0, 0, 64, W + W_WX + t * 4096, 64, 0, tile);
    return;
  }
  it -= PREP_T;
  if (it < PREP_COPY) {
    size_t base = (size_t)it * 4096;
    float* X = p.out;
#pragma unroll
    for (int i = 0; i < 4; ++i) {
      size_t e = base + (size_t)(tid + i * 256) * 4;
      float4 v = (e < (size_t)MP * 1024) ? *(const float4*)(p.in[0] + e) : *(const float4*)(p.in[1] + (e - (size_t)MP * 1024));
      *(float4*)(X + e) = v;
    }
    return;
  }
  it -= PREP_COPY;
  if (it < PREP_ROPE) {
    int e = it * 256 + tid, pos = e >> 3, i = e & 7;
    double inv = pow(500000.0, -(double)i / 8.0);
    double ang = (double)pos * inv;
    double kq = rint(ang * 0.15915494309189535);
    double r = ang - kq * 6.283185307179586;
    float rf = (float)r;
    float* cs = (float*)(p.ws + O_ROPE);
    cs[e] = cosf(rf);
    cs[8192 * 8 + e] = sinf(rf);
    return;
  }
  if (it == PREP_ROPE && tid < 64 * NL) {
    int l = tid >> 6, i = tid & 63;
    const float* lq = p.in[10] + (size_t)l * 256;
    float a = lq[i] * lq[64 + i], b = lq[128 + i] * lq[192 + i];
    a = wave_sum(a); b = wave_sum(b);
    if (i == 0) {
      float lam_init = 0.8f - 0.6f * __expf(-0.3f * (float)l);
      ((float*)(p.ws + O_LAM))[l] = __expf(a) - __expf(b) + lam_init;
    }
  }
}

DI bool xcd_tile(int B, int G, int iter, int MTILES, int NT, int& mt, int& nt) {
  const int nxb = G >> 3;
  const int x = B & 7, lb = B >> 3;
  const int q = MTILES >> 3, r = MTILES & 7;
  const int mx = q + (x < r ? 1 : 0);
  const int mbase = x * q + (x < r ? x : r);
  const int j = lb + iter * nxb;
  if (j >= mx * NT) return false;
  const int band = j / (8 * NT);
  const int rem = j - band * 8 * NT;
  const int nb = (mx - band * 8) < 8 ? (mx - band * 8) : 8;
  mt = mbase + band * 8 + rem % nb;
  nt = rem / nb;
  return true;
}

constexpr int PB_KC = SBT * PAST * 512 / 4096;
constexpr int PB_VC = SBT * 32 * 8;

DI void projin_tile(const Params& p, int l, int mt, int nt, char* smem) {
  const int row0 = mt * 256, col0 = nt * 256;
  const u16* W = (const u16*)(p.ws + O_WT) + (size_t)l * W_LAYER + W_IN;
  const u16* XN = (const u16*)(p.ws + O_XN);
  f32x4 acc[8][4];
  zero_acc8(acc);
  gemm512(XN + (size_t)row0 * LDK, LDK, W + (size_t)col0 * LDK, LDK, 1024, acc, smem);
  const float* cosT = (const float*)(p.ws + O_ROPE);
  const float* sinT = cosT + 8192 * 8;
  if (mt < 128) {
    const int prow0 = row0 & 8191;
    if (nt < 2) {
      tile_out_bf16<true>(acc, (u16*)(p.ws + O_QB) + (size_t)row0 * 512 + col0, 512, smem, QSCALE, prow0, cosT);
    } else if (nt < 4) {
      tile_out_f32<false, true>(acc, p.out + K_P + ((size_t)l * MP + row0) * 512 + (col0 - 512), 512, smem, prow0, cosT);
      tile_out_bf16<true>(acc, (u16*)(p.ws + O_KB) + (size_t)row0 * 512 + (col0 - 512), 512, smem, 1.f, prow0, cosT);
    } else if (nt < 6) {
      tile_out_f32<false, false>(acc, p.out + V_P + ((size_t)l * MP + row0) * 512 + (col0 - 1024), 512, smem, 0, nullptr);
      EPI_IDS;
      u16* VT = (u16*)(p.ws + O_VT);
      const unsigned vb = (unsigned)((row0 >> 13) * 512 + (col0 - 1024) + wc * 64 + fr) * (unsigned)PT + (unsigned)((row0 & 8191) + wr * 128 + fq * 4);
#pragma unroll
      for (int m = 0; m < 8; ++m) {
        asm volatile("" ::: "memory");
#pragma unroll
        for (int n = 0; n < 4; ++n) {
          const uint2 pk = {pack2(acc[m][n][0], acc[m][n][1]), pack2(acc[m][n][2], acc[m][n][3])};
          *(uint2*)(VT + (vb + (unsigned)(n * 16 * PT + m * 16))) = pk;
        }
      }
    } else if (nt >= 12 && nt < 14) {
      tile_out_f32<false, false>(acc, (float*)(p.ws + O_LX) + (size_t)row0 * 512 + (col0 - 3072), 512, smem, 0, nullptr);
    } else {
      u16* dst; int ld = 512, cbase;
      if (nt == 6) { dst = (u16*)(p.ws + O_GQ); ld = 256; cbase = 1536; }
      else if (nt == 7) { dst = (u16*)(p.ws + O_GK); ld = 256; cbase = 1792; }
      else if (nt < 10) { dst = (u16*)(p.ws + O_GV); cbase = 2048; }
      else if (nt < 12) { dst = (u16*)(p.ws + O_GR); cbase = 2560; }
      else { dst = (u16*)(p.ws + O_LG); cbase = 3584; }
      tile_out_bf16<false>(acc, dst + (size_t)row0 * ld + (col0 - cbase), ld, smem, nt == 6 ? 0.125f : 1.f, 0, nullptr);
    }
    return;
  }
  EPI_IDS;
  const bool isS = row0 >= MP;
  if (nt < 4) {
    const bool isq = nt < 2;
    u16* QB = (u16*)(p.ws + O_QB);
    u16* KB = (u16*)(p.ws + O_KB);
    u16* KS = (u16*)(p.ws + O_KS);
#pragma unroll
    for (int m = 0; m < 8; ++m) {
      asm volatile("" ::: "memory");
#pragma unroll
      for (int n = 0; n < 4; ++n)
#pragma unroll
        for (int j = 0; j < 4; ++j) {
          const int row = row0 + wr * 128 + m * 16 + fq * 4 + j;
          const int col = col0 + wc * 64 + n * 16 + fr;
          float v = acc[m][n][j];
          int b, t;
          if (isS) { int rs = row - MP; b = rs >> 5; t = rs & 31; } else { b = row >> 13; t = row & 8191; }
          const int pos = isS ? PAST + t : t;
          if (n == 0) {
            float pr = __shfl_xor(v, 8);
            float cs = cosT[pos * 8 + (fr & 7)], sn = sinT[pos * 8 + (fr & 7)];
            v = (fr < 8) ? v * cs - pr * sn : v * cs + pr * sn;
          }
          if (isq) {
            QB[(size_t)row * 512 + col] = f2bf(v * QSCALE);
          } else {
            const int ck = col - 512;
            if (isS) {
              p.out[K_S + ((size_t)l * MS + (row - MP)) * 512 + ck] = v;
              KS[((size_t)b * SKP + PAST + t) * 512 + ck] = f2bf(v);
            } else {
              p.out[K_P + ((size_t)l * MP + row) * 512 + ck] = v;
              KB[(size_t)row * 512 + ck] = f2bf(v);
            }
          }
        }
    }
  } else if (nt < 6) {
    u16* VT = (u16*)(p.ws + O_VT);
    u16* VTS = (u16*)(p.ws + O_VTS);
#pragma unroll
    for (int m = 0; m < 8; ++m) {
      asm volatile("" ::: "memory");
#pragma unroll
      for (int n = 0; n < 4; ++n) {
        const int rowb = row0 + wr * 128 + m * 16 + fq * 4;
        const int cv = col0 - 1024 + wc * 64 + n * 16 + fr;
        const int h = cv >> 7, vd = cv & 127;
        int b, t;
        if (isS) { int rs = rowb - MP; b = rs >> 5; t = rs & 31; } else { b = rowb >> 13; t = rowb & 8191; }
#pragma unroll
        for (int j = 0; j < 4; ++j) {
          if (isS) p.out[V_S + ((size_t)l * MS + (rowb + j - MP)) * 512 + cv] = acc[m][n][j];
          else p.out[V_P + ((size_t)l * MP + rowb + j) * 512 + cv] = acc[m][n][j];
        }
        uint2 pk = {pack2(acc[m][n][0], acc[m][n][1]), pack2(acc[m][n][2], acc[m][n][3])};
        if (isS) *(uint2*)(VTS + ((size_t)(b * 4 + h) * 128 + vd) * SKP + PAST + t) = pk;
        else *(uint2*)(VT + ((size_t)(b * 4 + h) * 128 + vd) * PT + t) = pk;
      }
    }
  } else {
    u16* dst16 = nullptr; float* dst32 = nullptr; int ld = 512, cbase = 0; float scale = 1.f;
    if (nt == 6) { dst16 = (u16*)(p.ws + O_GQ); ld = 256; cbase = 1536; scale = 0.125f; }
    else if (nt == 7) { dst16 = (u16*)(p.ws + O_GK); ld = 256; cbase = 1792; }
    else if (nt < 10) { dst16 = (u16*)(p.ws + O_GV); cbase = 2048; }
    else if (nt < 12) { dst16 = (u16*)(p.ws + O_GR); cbase = 2560; }
    else if (nt < 14) { dst32 = (float*)(p.ws + O_LX); cbase = 3072; }
    else { dst16 = (u16*)(p.ws + O_LG); cbase = 3584; }
#pragma unroll
    for (int m = 0; m < 8; ++m) {
      asm volatile("" ::: "memory");
#pragma unroll
      for (int n = 0; n < 4; ++n)
#pragma unroll
        for (int j = 0; j < 4; ++j) {
          const int row = row0 + wr * 128 + m * 16 + fq * 4 + j;
          const int c = col0 + wc * 64 + n * 16 + fr - cbase;
          const float v = acc[m][n][j] * scale;
          if (dst16) dst16[(size_t)row * ld + c] = f2bf(v);
          else dst32[(size_t)row * ld + c] = v;
        }
    }
  }
}

DI void cache_conv_item(const Params& p, int l, int it, char* smem) {
  const int tid = TID();
  if (it < PB_KC) {
    const float* src = p.in[2] + (size_t)l * SBT * PAST * 512;
    u16* KS = (u16*)(p.ws + O_KS);
#pragma unroll
    for (int i = 0; i < 4; ++i) {
      size_t e = (size_t)it * 4096 + (size_t)(tid + i * 256) * 4;
      float4 v = *(const float4*)(src + e);
      size_t b = e / ((size_t)PAST * 512), r = e % ((size_t)PAST * 512);
      *(uint2*)(KS + b * SKP * 512 + r) = uint2{pack2(v.x, v.y), pack2(v.z, v.w)};
    }
    return;
  }
  it -= PB_KC;
  const int b = it / 256, r = it % 256, ptile = r / 8, ctile = r % 8;
  const float* src = p.in[3] + ((size_t)l * SBT + b) * PAST * 512;
  u16* VTS = (u16*)(p.ws + O_VTS);
  transpose_tile(src, 512, ptile * 64, ctile * 64, 64, VTS + (size_t)b * 512 * SKP, SKP, ctile * 64, (float*)smem);
}

DI int kswz(int key) { return (((key >> 3) & 3) << 2) | (key & 3); }

DI void attn_item(const Params& p, int l, int idx, char* smem) {
  const int tid = TID512(), lane = tid & 63, wid = tid >> 6, fr = lane & 15, fq = lane >> 4;
  bool isS; int b, h, cp;
  if (idx < 1024) {
    isS = false;
    const int r = idx >> 8, pos = idx & 255, q = pos >> 4, base = 63 - 16 * r;
    cp = (r & 1) ? base - 15 + q : base - q;
    b = (pos & 15) >> 2; h = pos & 3;
  } else { isS = true; const int s = idx - 1024; b = s >> 2; h = s & 3; cp = 0; }
  const int nkt = isS ? 33 : 2 * cp + 2;
  const int klen = isS ? SKV : nkt * 64;
  const int mykt = isS ? 33 : (wid < 4 ? 2 * cp + 1 : 2 * cp + 2);
  const u16* QB = (const u16*)(p.ws + O_QB);
  const u16* Kg = isS ? (const u16*)(p.ws + O_KS) + (size_t)b * SKP * 512 + h * 128 : (const u16*)(p.ws + O_KB) + (size_t)b * PT * 512 + h * 128;
  const int vstride = isS ? SKP : PT;
  const u16* Vg = (isS ? (const u16*)(p.ws + O_VTS) : (const u16*)(p.ws + O_VT)) + (size_t)(b * 4 + h) * 128 * vstride;
  const int qrow0 = isS ? MP + b * 32 : b * PT + cp * 128;
  const bool wactive = isS ? (wid < 2) : true;
  const int qrow = qrow0 + wid * 16 + fr;
  bf16x8 qf[2][2];
#pragma unroll
  for (int mp = 0; mp < 2; ++mp)
#pragma unroll
    for (int ks = 0; ks < 2; ++ks)
      qf[mp][ks] = wactive ? *(const bf16x8*)(QB + (size_t)qrow * 512 + h * 128 + mp * 64 + ks * 32 + fq * 8) : bf16x8{0, 0, 0, 0, 0, 0, 0, 0};
  f32x4 ot[2][8];
#pragma unroll
  for (int mp = 0; mp < 2; ++mp)
#pragma unroll
    for (int n = 0; n < 8; ++n) ot[mp][n] = f32x4{0.f, 0.f, 0.f, 0.f};
  float mrun[2] = {-INFINITY, -INFINITY}, lrun[2] = {0.f, 0.f};
  char* Ks = smem;
  char* Vs = smem + 32768;
  const int kkey = tid >> 4, vvd = tid >> 3;
  const int kgch = (tid & 15) ^ kswz(kkey);
  const int vgch = (tid & 7) ^ ((vvd >> 1) & 7);
  const int soff = tid * 16;
  asm volatile("s_waitcnt vmcnt(0) lgkmcnt(0)" ::: "memory");
  __builtin_amdgcn_s_barrier();
#pragma unroll
  for (int i = 0; i < 2; ++i) {
    __builtin_amdgcn_global_load_lds((const unsigned*)(Kg + (size_t)(kkey + i * 32) * 512 + kgch * 8), (unsigned*)(Ks + soff + i * 8192), 16, 0, 0);
    __builtin_amdgcn_global_load_lds((const unsigned*)(Vg + (size_t)(vvd + i * 64) * vstride + vgch * 8), (unsigned*)(Vs + soff + i * 8192), 16, 0, 0);
  }
  asm volatile("s_waitcnt vmcnt(0)" ::: "memory");
  asm volatile("" ::"v"(qf[0][0]), "v"(qf[0][1]), "v"(qf[1][0]), "v"(qf[1][1]));
  __builtin_amdgcn_s_barrier();
  for (int kt = 0; kt < nkt; ++kt) {
    const int buf = kt & 1;
    const bool more = kt + 1 < nkt;
    if (more) {
      const int nb = buf ^ 1;
#pragma unroll
      for (int i = 0; i < 2; ++i) {
        __builtin_amdgcn_global_load_lds((const unsigned*)(Kg + (size_t)((kt + 1) * 64 + kkey + i * 32) * 512 + kgch * 8), (unsigned*)(Ks + nb * 16384 + soff + i * 8192), 16, 0, 0);
        __builtin_amdgcn_global_load_lds((const unsigned*)(Vg + (size_t)(vvd + i * 64) * vstride + (kt + 1) * 64 + vgch * 8), (unsigned*)(Vs + nb * 16384 + soff + i * 8192), 16, 0, 0);
      }
    }
    const bool active = wactive && kt < mykt;
    if (active) {
      const char* Kb = Ks + buf * 16384;
      const char* Vb = Vs + buf * 16384;
      f32x4 st[2][4];
      {
        bf16x8 kf[2][4][2];
#pragma unroll
        for (int mp = 0; mp < 2; ++mp)
#pragma unroll
          for (int mt = 0; mt < 4; ++mt) {
            const int key = 32 * (mt >> 1) + 8 * (fr >> 2) + 4 * (mt & 1) + (fr & 3);
#pragma unroll
            for (int ks = 0; ks < 2; ++ks) kf[mp][mt][ks] = *(const bf16x8*)(Kb + key * 256 + (((mp * 8 + ks * 4 + fq) ^ kswz(key)) << 4));
          }
#pragma unroll
        for (int mp = 0; mp < 2; ++mp)
#pragma unroll
          for (int mt = 0; mt < 4; ++mt) {
            f32x4 a = MFMA16(kf[mp][mt][0], qf[mp][0], (f32x4{0.f, 0.f, 0.f, 0.f}));
            st[mp][mt] = MFMA16(kf[mp][mt][1], qf[mp][1], a);
          }
      }
      const bool needmask = (kt + 1) * 64 > klen;
#pragma unroll
      for (int mp = 0; mp < 2; ++mp) {
        if (needmask) {
#pragma unroll
          for (int mt = 0; mt < 4; ++mt)
#pragma unroll
            for (int j = 0; j < 4; ++j) {
              const int key = kt * 64 + 32 * (mt >> 1) + 8 * fq + 4 * (mt & 1) + j;
              if (key >= klen) st[mp][mt][j] = -INFINITY;
            }
        }
        float mx = -INFINITY;
#pragma unroll
        for (int mt = 0; mt < 4; ++mt)
#pragma unroll
          for (int j = 0; j < 4; ++j) mx = fmaxf(mx, st[mp][mt][j]);
        mx = quad_max(mx);
        const float mold = mrun[mp];
        const float mnew = fmaxf(mold, mx);
        mrun[mp] = mnew;
        float ps = 0.f;
#pragma unroll
        for (int mt = 0; mt < 4; ++mt)
#pragma unroll
          for (int j = 0; j < 4; ++j) { float e = __builtin_amdgcn_exp2f(st[mp][mt][j] - mnew); st[mp][mt][j] = e; ps += e; }
        if (__any(mnew > mold)) {
          const float alpha = __builtin_amdgcn_exp2f(mold - mnew);
          lrun[mp] *= alpha;
#pragma unroll
          for (int n = 0; n < 8; ++n) { ot[mp][n][0] *= alpha; ot[mp][n][1] *= alpha; ot[mp][n][2] *= alpha; ot[mp][n][3] *= alpha; }
        }
        lrun[mp] += ps;
      }
      bf16x8 pf[2][2];
#pragma unroll
      for (int mp = 0; mp < 2; ++mp)
#pragma unroll
        for (int s = 0; s < 2; ++s) {
          uint4 u = {pack2(st[mp][2 * s][0], st[mp][2 * s][1]), pack2(st[mp][2 * s][2], st[mp][2 * s][3]),
                     pack2(st[mp][2 * s + 1][0], st[mp][2 * s + 1][1]), pack2(st[mp][2 * s + 1][2], st[mp][2 * s + 1][3])};
          pf[mp][s] = __builtin_bit_cast(bf16x8, u);
        }
#pragma unroll
      for (int nh = 0; nh < 2; ++nh) {
        bf16x8 vf[4][2];
#pragma unroll
        for (int n = 0; n < 4; ++n) {
          const int vd = (nh * 4 + n) * 16 + fr;
#pragma unroll
          for (int s = 0; s < 2; ++s) vf[n][s] = *(const bf16x8*)(Vb + vd * 128 + (((s * 4 + fq) ^ ((vd >> 1) & 7)) << 4));
        }
#pragma unroll
        for (int n = 0; n < 4; ++n)
#pragma unroll
          for (int s = 0; s < 2; ++s) {
            ot[0][nh * 4 + n] = MFMA16(vf[n][s], pf[0][s], ot[0][nh * 4 + n]);
            ot[1][nh * 4 + n] = MFMA16(vf[n][s], pf[1][s], ot[1][nh * 4 + n]);
          }
      }
    }
    asm volatile("s_waitcnt vmcnt(0) lgkmcnt(0)" ::: "memory");
    __builtin_amdgcn_s_barrier();
  }
  if (wactive) {
    float l0 = lrun[0], l1 = lrun[1];
    l0 += __shfl_xor(l0, 16); l0 += __shfl_xor(l0, 32);
    l1 += __shfl_xor(l1, 16); l1 += __shfl_xor(l1, 32);
    const float lam = ((const float*)(p.ws + O_LAM))[l];
    const float lam_init = 0.8f - 0.6f * __expf(-0.3f * (float)l);
    const float i0 = 1.f / l0, i1 = lam / l1;
    float ss = 0.f;
#pragma unroll
    for (int n = 0; n < 8; ++n)
#pragma unroll
      for (int j = 0; j < 4; ++j) { float o = ot[0][n][j] * i0 - ot[1][n][j] * i1; ot[0][n][j] = o; ss += o * o; }
    ss += __shfl_xor(ss, 16); ss += __shfl_xor(ss, 32);
    const float rs = rsqrtf(ss * (1.f / 128.f) + EPS) * (1.f - lam_init);
    const float* g = p.in[11] + (size_t)l * 128;
    u16* OA = (u16*)(p.ws + O_OA) + (size_t)qrow * 512 + h * 128;
#pragma unroll
    for (int n = 0; n < 8; ++n) {
      const int vd = n * 16 + fq * 4;
      float4 gg = *(const float4*)(g + vd);
      *(uint2*)(OA + vd) = uint2{pack2(ot[0][n][0] * rs * gg.x, ot[0][n][1] * rs * gg.y), pack2(ot[0][n][2] * rs * gg.z, ot[0][n][3] * rs * gg.w)};
    }
  }
}

constexpr int LP = 72;
constexpr int BCS = 68;
DI void gla_decode(int gi, bool& isS, int& b, int& h, int& c, int& row0, int& Lc) {
  if (gi < PB * 4 * 128) { isS = false; c = gi & 127; h = (gi >> 7) & 3; b = gi >> 9; row0 = b * PT + c * 64; Lc = 64; }
  else { isS = true; int s = gi - PB * 4 * 128; b = s >> 2; h = s & 3; c = 0; row0 = MP + b * 32; Lc = 32; }
}
DI void gla_bcum(const Params& p, int l, int row0, int Lc, int h, float* bc, float* tot, float* gas) {
  const int tid = TID(), kd = tid & 63, tq = tid >> 6;
  const float* W2 = p.in[12] + (size_t)l * 16 * 256 + h * 64 + kd;
  const float b2 = p.in[13][(size_t)l * 256 + h * 64 + kd];
  const float* GA = (const float*)(p.ws + O_GA);
  {
    const int r = tid >> 2, part = tid & 3;
    float4 v = {0.f, 0.f, 0.f, 0.f};
    if (r < Lc) v = *(const float4*)(GA + (size_t)(row0 + r) * 16 + part * 4);
    *(float4*)(gas + r * 16 + part * 4) = v;
  }
  float w[16];
#pragma unroll
  for (int r = 0; r < 16; ++r) w[r] = W2[r * 256];
  __syncthreads();
  float run = 0.f;
#pragma unroll
  for (int i = 0; i < 16; ++i) {
    const int t = tq * 16 + i;
    const float4* ga = (const float4*)(gas + t * 16);
    const float4 g0 = ga[0], g1 = ga[1], g2 = ga[2], g3 = ga[3];
    const float x = b2 + g0.x * w[0] + g0.y * w[1] + g0.z * w[2] + g0.w * w[3] + g1.x * w[4] + g1.y * w[5] + g1.z * w[6] + g1.w * w[7] +
                    g2.x * w[8] + g2.y * w[9] + g2.z * w[10] + g2.w * w[11] + g3.x * w[12] + g3.y * w[13] + g3.z * w[14] + g3.w * w[15];
    const float la = (t < Lc) ? -softplusf_(-x) * (1.f / 16.f) : 0.f;
    run += la;
    bc[t * BCS + kd] = run;
  }
  tot[tq * 64 + kd] = run;
  __syncthreads();
  float off = 0.f;
  for (int g = 0; g < tq; ++g) off += tot[g * 64 + kd];
#pragma unroll
  for (int i = 0; i < 16; ++i) bc[(tq * 16 + i) * BCS + kd] += off;
  __syncthreads();
}
DI void gla_load_vt(const Params& p, int row0, int Lc, int h, u16* vt) {
  const int tid = TID(), s = tid & 63, cg4 = tid >> 6;
  const u16* GV = (const u16*)(p.ws + O_GV) + (size_t)(row0 + s) * 512 + h * 128;
  u32x4 v[4];
#pragma unroll
  for (int i = 0; i < 4; ++i) v[i] = (s < Lc) ? *(const u32x4*)(GV + (cg4 + 4 * i) * 8) : u32x4{0u, 0u, 0u, 0u};
#pragma unroll
  for (int i = 0; i < 4; ++i) {
    const int vd0 = (cg4 + 4 * i) * 8;
#pragma unroll
    for (int e = 0; e < 4; ++e) {
      vt[(vd0 + 2 * e) * LP + s] = (u16)(v[i][e] & 0xffffu);
      vt[(vd0 + 2 * e + 1) * LP + s] = (u16)(v[i][e] >> 16);
    }
  }
}

DI void gla1_item(const Params& p, int l, int gi, char* smem) {
  bool isS; int b, h, c, row0, Lc;
  gla_decode(gi, isS, b, h, c, row0, Lc);
  const int tid = TID(), lane = tid & 63, wid = tid >> 6, fr = lane & 15, fq = lane >> 4;
  float* bc = (float*)smem;
  float* tot = (float*)(smem + 17408);
  u16* kh = (u16*)(smem + 18432);
  u16* vt = (u16*)(smem + 18432 + 9216);
  __syncthreads();
  gla_bcum(p, l, row0, Lc, h, bc, tot, (float*)kh);
  {
    const int s = tid & 63, c2 = tid >> 6;
    const u16* GK = (const u16*)(p.ws + O_GK) + (size_t)(row0 + s) * 256 + h * 64;
    u32x4 kv[2];
#pragma unroll
    for (int i = 0; i < 2; ++i) kv[i] = (s < Lc) ? *(const u32x4*)(GK + (c2 + 4 * i) * 8) : u32x4{0u, 0u, 0u, 0u};
#pragma unroll
    for (int i = 0; i < 2; ++i) {
      const int kd0 = (c2 + 4 * i) * 8;
#pragma unroll
      for (int e = 0; e < 8; ++e) {
        const unsigned w = kv[i][e >> 1];
        const float kf = bf2f((u16)((e & 1) ? (w >> 16) : (w & 0xffffu)));
        const float bl = bc[63 * BCS + kd0 + e];
        kh[(kd0 + e) * LP + s] = f2bf(kf * __expf(bl - bc[s * BCS + kd0 + e]));
      }
    }
    if (tid < 64) ((float*)(p.ws + O_DEC))[(size_t)gi * 64 + tid] = __expf(bc[63 * BCS + tid]);
  }
  gla_load_vt(p, row0, Lc, h, vt);
  __syncthreads();
  u16* KVT = (u16*)(p.ws + O_KVT) + (size_t)gi * 8192;
#pragma unroll
  for (int mi = 0; mi < 2; ++mi)
#pragma unroll
    for (int n = 0; n < 4; ++n) {
      const int m = wid * 2 + mi;
      f32x4 a = lds_mm<2>(vt, LP, m * 16, kh, LP, n * 16, f32x4{0.f, 0.f, 0.f, 0.f});
#pragma unroll
      for (int j = 0; j < 4; ++j) KVT[(m * 16 + fq * 4 + j) * 64 + n * 16 + fr] = f2bf(a[j]);
    }
}

constexpr int G2_ITEMS = (PB * 4 + SBT * 4) * 32;
DI void gla2_item(const Params& p, int l, int it) {
  const int seq = it >> 5, e = (it & 31) * 256 + TID();
  const int vd = e >> 6, kd = e & 63;
  u16* KVT = (u16*)(p.ws + O_KVT);
  const float* DEC = (const float*)(p.ws + O_DEC);
  if (seq < PB * 4) {
    float S = 0.f;
    const int gi0 = seq * 128;
    for (int c0 = 0; c0 < 128; c0 += 32) {
      u16 kvv[32]; float dd[32];
#pragma unroll
      for (int c = 0; c < 32; ++c) { kvv[c] = KVT[(size_t)(gi0 + c0 + c) * 8192 + e]; dd[c] = DEC[(size_t)(gi0 + c0 + c) * 64 + kd]; }
#pragma unroll
      for (int c = 0; c < 32; ++c) { KVT[(size_t)(gi0 + c0 + c) * 8192 + e] = f2bf(S); S = dd[c] * S + bf2f(kvv[c]); }
    }
    p.out[GLA_P + ((size_t)l * PB * 4 + seq) * 8192 + kd * 128 + vd] = S;
  } else {
    const int s = seq - PB * 4, gi = PB * 4 * 128 + s;
    const float S0 = p.in[4][((size_t)l * SBT * 4 + s) * 8192 + kd * 128 + vd];
    u16* q = KVT + (size_t)gi * 8192 + e;
    const float kv = bf2f(*q);
    const float d = DEC[(size_t)gi * 64 + kd];
    *q = f2bf(S0);
    p.out[GLA_S + ((size_t)l * SBT * 4 + s) * 8192 + kd * 128 + vd] = d * S0 + kv;
  }
}

DI void gla3_item(const Params& p, int l, int gi, char* smem) {
  bool isS; int b, h, c, row0, Lc;
  gla_decode(gi, isS, b, h, c, row0, Lc);
  const int tid = TID(), lane = tid & 63, wid = tid >> 6, fr = lane & 15, fq = lane >> 4;
  float* bc = (float*)smem;
  u16* att = (u16*)smem;
  float* tot = (float*)(smem + 17408);
  u16* qt = (u16*)(smem + 18432);
  u16* kt_ = (u16*)(smem + 18432 + 9216);
  u16* vt = (u16*)(smem + 18432 + 2 * 9216);
  u16* st = (u16*)(smem + 18432 + 2 * 9216 + 18432);
  __syncthreads();
  gla_bcum(p, l, row0, Lc, h, bc, tot, (float*)qt);
  const u16* KVT = (const u16*)(p.ws + O_KVT) + (size_t)gi * 8192;
  {
    const int s = tid & 63, c2 = tid >> 6;
    const u16* GQ = (const u16*)(p.ws + O_GQ) + (size_t)(row0 + s) * 256 + h * 64;
    const u16* GK = (const u16*)(p.ws + O_GK) + (size_t)(row0 + s) * 256 + h * 64;
    u32x4 qv[2], kv[2], sv[4];
#pragma unroll
    for (int i = 0; i < 2; ++i) {
      qv[i] = (s < Lc) ? *(const u32x4*)(GQ + (c2 + 4 * i) * 8) : u32x4{0u, 0u, 0u, 0u};
      kv[i] = (s < Lc) ? *(const u32x4*)(GK + (c2 + 4 * i) * 8) : u32x4{0u, 0u, 0u, 0u};
    }
#pragma unroll
    for (int i = 0; i < 4; ++i) { const int id = tid + i * 256; sv[i] = *(const u32x4*)(KVT + (id >> 3) * 64 + (id & 7) * 8); }
#pragma unroll
    for (int i = 0; i < 2; ++i) {
      const int kd0 = (c2 + 4 * i) * 8;
      u32x4 qo, ko;
#pragma unroll
      for (int e2 = 0; e2 < 4; ++e2) {
        const float b0 = bc[s * BCS + kd0 + 2 * e2], b1 = bc[s * BCS + kd0 + 2 * e2 + 1];
        const float e0 = __expf(b0), e1 = __expf(b1);
        const float q0 = bf2f((u16)(qv[i][e2] & 0xffffu)) * e0, q1 = bf2f((u16)(qv[i][e2] >> 16)) * e1;
        const float k0 = bf2f((u16)(kv[i][e2] & 0xffffu)) / e0, k1 = bf2f((u16)(kv[i][e2] >> 16)) / e1;
        qo[e2] = pack2(q0, q1);
        ko[e2] = pack2(k0, k1);
      }
      *(u32x4*)(qt + s * LP + kd0) = qo;
      *(u32x4*)(kt_ + s * LP + kd0) = ko;
    }
#pragma unroll
    for (int i = 0; i < 4; ++i) { const int id = tid + i * 256; *(u32x4*)(st + (id >> 3) * LP + (id & 7) * 8) = sv[i]; }
  }
  gla_load_vt(p, row0, Lc, h, vt);
  __syncthreads();
  {
    f32x4 a[4];
#pragma unroll
    for (int n = 0; n < 4; ++n) a[n] = lds_mm<2>(qt, LP, wid * 16, kt_, LP, n * 16, f32x4{0.f, 0.f, 0.f, 0.f});
#pragma unroll
    for (int n = 0; n < 4; ++n)
#pragma unroll
      for (int j = 0; j < 4; ++j) {
        const int t = wid * 16 + fq * 4 + j, s = n * 16 + fr;
        att[t * LP + s] = f2bf(t >= s ? a[n][j] : 0.f);
      }
  }
  __syncthreads();
  f32x4 o[8];
#pragma unroll
  for (int n = 0; n < 8; ++n) {
    f32x4 a = lds_mm<2>(att, LP, wid * 16, vt, LP, n * 16, f32x4{0.f, 0.f, 0.f, 0.f});
    o[n] = lds_mm<2>(qt, LP, wid * 16, st, LP, n * 16, a);
  }
  const float* gn = p.in[14] + (size_t)l * 128;
  const u16* GR = (const u16*)(p.ws + O_GR);
  u16* OG = (u16*)(p.ws + O_OG);
  float gnv[8];
#pragma unroll
  for (int n = 0; n < 8; ++n) gnv[n] = gn[n * 16 + fr];
#pragma unroll
  for (int j = 0; j < 4; ++j) {
    float ss = 0.f;
#pragma unroll
    for (int n = 0; n < 8; ++n) ss += o[n][j] * o[n][j];
    ss += __shfl_xor(ss, 1); ss += __shfl_xor(ss, 2); ss += __shfl_xor(ss, 4); ss += __shfl_xor(ss, 8);
    const float rs = rsqrtf(ss * (1.f / 128.f) + EPS);
    const int t = wid * 16 + fq * 4 + j;
    if (t < Lc) {
      const size_t ro = (size_t)(row0 + t) * 512 + h * 128;
      u16 grv[8];
#pragma unroll
      for (int n = 0; n < 8; ++n) grv[n] = GR[ro + n * 16 + fr];
#pragma unroll
      for (int n = 0; n < 8; ++n) {
        const float gr = bf2f(grv[n]);
        OG[ro + n * 16 + fr] = f2bf(o[n][j] * rs * gnv[n] * gr * sigmoidf_(gr));
      }
    }
  }
}

constexpr int L1_ITEMS = NLC * 8;
DI void lru_decode(int ci, bool& isS, int& b, int& row0, int& Lc, int& t0) {
  if (ci < MP / 64) { isS = false; b = ci >> 7; t0 = (ci & 127) * 64; row0 = ci * 64; Lc = 64; }
  else { isS = true; b = ci - MP / 64; t0 = 0; row0 = MP + b * 32; Lc = 32; }
}
DI void lru1_item(const Params& p, int l, int it, char* smem) {
  const int ci = it >> 3, nb = it & 7;
  bool isS; int b, row0, Lc, t0;
  lru_decode(ci, isS, b, row0, Lc, t0);
  const int tid = TID(), lane = tid & 63, wid = tid >> 6, fr = lane & 15, fq = lane >> 4;
  u16* xcs = (u16*)smem;
  u16* was = (u16*)(smem + 9216);
  u16* wxs = (u16*)(smem + 2 * 9216);
  float* as_ = (float*)(smem + 3 * 9216);
  float* us_ = (float*)(smem + 3 * 9216 + 16384);
  float* segP = (float*)(smem + 3 * 9216 + 32768);
  float* segH = (float*)(smem + 3 * 9216 + 32768 + 1024);
  const float* LX = (const float*)(p.ws + O_LX);
  const u16* Wl = (const u16*)(p.ws + O_WT) + (size_t)l * W_LAYER;
  const int i = tid & 63, tq = tid >> 6, ch = nb * 64 + i;
  __syncthreads();
  {
    const float* cw = p.in[15] + (size_t)l * 4 * 512 + ch;
    const float w0 = cw[0], w1 = cw[512], w2 = cw[1024], w3 = cw[1536], cb = p.in[16][(size_t)l * 512 + ch];
    const float* buf = isS ? p.in[5] + ((size_t)l * SBT + b) * 3 * 512 + ch : nullptr;
    float x[19];
#pragma unroll
    for (int j = 0; j < 19; ++j) {
      const int tl = tq * 16 - 3 + j;
      const int tt = t0 + tl;
      float v = 0.f;
      if (tl < Lc) {
        if (tt >= 0) v = LX[(size_t)(row0 + tl) * 512 + ch];
        else if (isS) v = buf[(3 + tt) * 512];
      }
      x[j] = v;
    }
#pragma unroll
    for (int k = 0; k < 16; ++k) {
      const int t = tq * 16 + k;
      const float xv = (t < Lc) ? cb + w0 * x[k] + w1 * x[k + 1] + w2 * x[k + 2] + w3 * x[k + 3] : 0.f;
      xcs[t * LP + i] = f2bf(xv);
    }
#pragma unroll
    for (int k = 0; k < 2; ++k) {
      const int id = tid + k * 256, r = id >> 3, c8 = id & 7;
      *(uint4*)(was + r * LP + c8 * 8) = *(const uint4*)(Wl + W_WA + nb * 4096 + r * 64 + c8 * 8);
      *(uint4*)(wxs + r * LP + c8 * 8) = *(const uint4*)(Wl + W_WX + nb * 4096 + r * 64 + c8 * 8);
    }
    const int T = isS ? STT : PT;
    if (t0 + Lc == T && tid < 192) {
      const int k = tid >> 6;
      const float v = LX[(size_t)(row0 + Lc - 3 + k) * 512 + ch];
      if (isS) p.out[LC_S + (((size_t)l * SBT + b) * 3 + k) * 512 + ch] = v;
      else p.out[LC_P + (((size_t)l * PB + b) * 3 + k) * 512 + ch] = v;
    }
  }
  __syncthreads();
  {
    const float* ba = p.in[18] + (size_t)l * 512 + nb * 64;
    const float* bx = p.in[20] + (size_t)l * 512 + nb * 64;
    const float* lm = p.in[21] + (size_t)l * 512 + nb * 64;
#pragma unroll
    for (int n = 0; n < 4; ++n) {
      f32x4 r = lds_mm<2>(xcs, LP, wid * 16, was, LP, n * 16, f32x4{0.f, 0.f, 0.f, 0.f});
      f32x4 g = lds_mm<2>(xcs, LP, wid * 16, wxs, LP, n * 16, f32x4{0.f, 0.f, 0.f, 0.f});
      const int j = n * 16 + fr;
      const float sp = softplusf_(-lm[j]), bav = ba[j], bxv = bx[j];
#pragma unroll
      for (int q = 0; q < 4; ++q) {
        const int t = wid * 16 + fq * 4 + q;
        const float rr = sigmoidf_(r[q] + bav), ii = sigmoidf_(g[q] + bxv);
        const float la = -8.f * rr * sp;
        const float a = __expf(la);
        const float x2 = 2.f * la;
        const float om = (x2 > -0.01f) ? -x2 * (1.f + x2 * (0.5f + x2 * (1.f / 6.f))) : 1.f - __expf(x2);
        const float u = sqrtf(om) * ii * bf2f(xcs[t * LP + j]);
        as_[t * 64 + j] = a;
        us_[t * 64 + j] = u;
      }
    }
  }
  __syncthreads();
  {
    float av[16], uv[16];
#pragma unroll
    for (int k = 0; k < 16; ++k) { av[k] = as_[(tq * 16 + k) * 64 + i]; uv[k] = us_[(tq * 16 + k) * 64 + i]; }
    float P = 1.f, hh = 0.f;
#pragma unroll
    for (int k = 0; k < 16; ++k) { P *= av[k]; hh = av[k] * hh + uv[k]; }
    segP[tq * 64 + i] = P; segH[tq * 64 + i] = hh;
    __syncthreads();
    float Pin = 1.f, hin = 0.f;
    for (int g = 0; g < tq; ++g) { const float pg = segP[g * 64 + i], hg = segH[g * 64 + i]; hin = pg * hin + hg; Pin *= pg; }
    u16* HL = (u16*)(p.ws + O_HL);
    u16* PPp = (u16*)(p.ws + O_PP);
    P = Pin; hh = hin;
#pragma unroll
    for (int k = 0; k < 16; ++k) {
      const int t = tq * 16 + k;
      P *= av[k]; hh = av[k] * hh + uv[k];
      if (t < Lc) {
        HL[(size_t)(row0 + t) * 512 + ch] = f2bf(hh);
        PPp[(size_t)(row0 + t) * 512 + ch] = f2bf(P);
      }
    }
    if (tq * 16 + 16 == Lc) {
      ((float*)(p.ws + O_CA))[(size_t)ci * 512 + ch] = P;
      ((float*)(p.ws + O_CH))[(size_t)ci * 512 + ch] = hh;
    }
  }
}
constexpr int L2_ITEMS = 8 + 32;
DI void lru2_item(const Params& p, int l, int it) {
  const float* CA = (const float*)(p.ws + O_CA);
  const float* CH = (const float*)(p.ws + O_CH);
  float* HS = (float*)(p.ws + O_HS);
  if (it < 8) {
    const int e = it * 256 + TID(), b = e >> 9, ch = e & 511;
    float hh = 0.f;
    for (int c0 = 0; c0 < 128; c0 += 16) {
      float ca[16], chv[16];
#pragma unroll
      for (int c = 0; c < 16; ++c) { const size_t o = (size_t)(b * 128 + c0 + c) * 512 + ch; ca[c] = CA[o]; chv[c] = CH[o]; }
#pragma unroll
      for (int c = 0; c < 16; ++c) { const size_t o = (size_t)(b * 128 + c0 + c) * 512 + ch; HS[o] = hh; hh = ca[c] * hh + chv[c]; }
    }
    p.out[LH_P + ((size_t)l * PB + b) * 512 + ch] = hh;
  } else {
    const int e = (it - 8) * 256 + TID(), b = e >> 9, ch = e & 511;
    const float h0 = p.in[6][((size_t)l * SBT + b) * 512 + ch];
    const size_t o = (size_t)(MP / 64 + b) * 512 + ch;
    HS[o] = h0;
    p.out[LH_S + ((size_t)l * SBT + b) * 512 + ch] = CA[o] * h0 + CH[o];
  }
}
constexpr int L3_ITEMS = MT / 8;
DI void lru3_item(const Params& p, int it) {
  const u16* HL = (const u16*)(p.ws + O_HL);
  const u16* PPp = (const u16*)(p.ws + O_PP);
  const u16* LG = (const u16*)(p.ws + O_LG);
  const float* HS = (const float*)(p.ws + O_HS);
  u16* OL = (u16*)(p.ws + O_OL);
#pragma unroll
  for (int i = 0; i < 4; ++i) {
    const int id = TID() + i * 256;
    const int row = it * 8 + (id >> 7), c4 = (id & 127) * 4;
    const int ci = row < MP ? (row >> 6) : MP / 64 + ((row - MP) >> 5);
    const size_t o = (size_t)row * 512 + c4;
    const uint2 hl = *(const uint2*)(HL + o), pp = *(const uint2*)(PPp + o), lg = *(const uint2*)(LG + o);
    const float4 hs = *(const float4*)(HS + (size_t)ci * 512 + c4);
    float y0 = (bf2f(hl.x & 0xffff) + bf2f(pp.x & 0xffff) * hs.x) * gelu_tanh(bf2f(lg.x & 0xffff));
    float y1 = (bf2f(hl.x >> 16) + bf2f(pp.x >> 16) * hs.y) * gelu_tanh(bf2f(lg.x >> 16));
    float y2 = (bf2f(hl.y & 0xffff) + bf2f(pp.y & 0xffff) * hs.z) * gelu_tanh(bf2f(lg.y & 0xffff));
    float y3 = (bf2f(hl.y >> 16) + bf2f(pp.y >> 16) * hs.w) * gelu_tanh(bf2f(lg.y >> 16));
    *(uint2*)(OL + o) = uint2{pack2(y0, y1), pack2(y2, y3)};
  }
}

DI void ybr_tile(const Params& p, int l, int mt, int nt, char* smem) {
  const int row0 = mt * 256, col0 = nt * 256, br = nt >> 2;
  const u16* W = (const u16*)(p.ws + O_WT) + (size_t)l * W_LAYER + W_BR + (size_t)br * 1024 * 512 + (size_t)((nt & 3) * 256) * 512;
  const u16* O = (const u16*)(p.ws + (br == 0 ? O_OA : (br == 1 ? O_OG : O_OL))) + (size_t)row0 * 512;
  f32x4 acc[8][4];
  zero_acc8(acc);
  gemm512(O, 512, W, 512, 512, acc, smem);
  tile_out_bf16<false>(acc, (u16*)(p.ws + O_YP) + (size_t)row0 * 3072 + col0, 3072, smem, 1.f, 0, nullptr);
}
DI void gate_tile(const Params& p, int l, int mt, int nt, char* smem) {
  const int row0 = mt * 256, col0 = nt * 256;
  const u16* W = (const u16*)(p.ws + O_WT) + (size_t)l * W_LAYER + W_MG + (size_t)col0 * LDK;
  f32x4 acc[8][4];
  zero_acc8(acc);
  gemm512((const u16*)(p.ws + O_XN) + (size_t)row0 * LDK, LDK, W, LDK, 1024, acc, smem);
  EPI_IDS;
  u16* Y = (u16*)(p.ws + O_YP) + (size_t)row0 * 3072 + col0;
  const float* bm = p.in[26] + (size_t)l * 3072 + col0 + wc * 64 + fr;
  img_load_bf16(Y, 3072, smem, 256, 0);
  img_barrier();
  u16* img = (u16*)smem + (wr * 128 + fq * 4) * IMG_LD + wc * 64 + fr;
#pragma unroll
  for (int n = 0; n < 4; ++n) {
    const float bv = bm[n * 16];
#pragma unroll
    for (int m = 0; m < 8; ++m)
#pragma unroll
      for (int j = 0; j < 4; ++j) {
        u16* q = img + (m * 16 + j) * IMG_LD + n * 16;
        *q = f2bf(sigmoidf_(acc[m][n][j] + bv) * bf2f(*q));
      }
  }
  img_barrier();
  img_store_bf16(Y, 3072, smem, 0);
}
DI void resid_tile(const Params& p, const u16* A, int ldk, const u16* W, int mt, int nt, int k0, int klen, bool atomic, char* smem) {
  const int row0 = mt * 256, col0 = nt * 256;
  f32x4 acc[8][4];
  zero_acc8(acc);
  gemm512(A + (size_t)row0 * ldk + k0, ldk, W + (size_t)col0 * ldk + k0, ldk, klen, acc, smem);
  if (!atomic) { tile_out_f32<true, false>(acc, p.out + (size_t)row0 * 1024 + col0, 1024, smem, 0, nullptr); return; }
  EPI_IDS;
#pragma unroll
  for (int m = 0; m < 8; ++m) {
    asm volatile("" ::: "memory");
#pragma unroll
    for (int n = 0; n < 4; ++n)
#pragma unroll
      for (int j = 0; j < 4; ++j) {
        const int row = row0 + wr * 128 + m * 16 + fq * 4 + j, col = col0 + wc * 64 + n * 16 + fr;
        float* q = p.out + (size_t)row * 1024 + col;
        if (atomic) unsafeAtomicAdd(q, acc[m][n][j]); else *q += acc[m][n][j];
      }
  }
}
DI void resid_phase(const Params& p, const u16* A, int ldk, const u16* W, int B, int G, char* smem) {
  const int ns = ldk / 256;
  int k = 0, u = B;
  while (true) {
    int mt, nt, k0 = 0, kl = ldk;
    bool at = false;
    if (xcd_tile(B, G, k, 128, 4, mt, nt)) { ++k; }
    else if (u < 8 * ns) { const int t = u / ns, sl = u - t * ns; mt = 128 + (t >> 2); nt = t & 3; k0 = sl * 256; kl = 256; at = true; u += G; }
    else break;
    asm volatile("" : "+s"(kl));
    resid_tile(p, A, ldk, W, mt, nt, k0, kl, at, smem);
  }
}

DI void ffgate_tile(const Params& p, int l, int mt, int nt, char* smem) {
  const int row0 = mt * 256, col0 = nt * 256;
  const u16* W = (const u16*)(p.ws + O_WT) + (size_t)l * W_LAYER + W_FG;
  f32x4 acc[8][4];
  zero_acc8(acc);
  gemm512((const u16*)(p.ws + O_XN) + (size_t)row0 * LDK, LDK, W + (size_t)col0 * LDK, LDK, 1024, acc, smem);
  if (mt < 128) {
    EPI_IDS;
    tile_out_bf16<false>(acc, (u16*)(p.ws + O_GU) + (size_t)row0 * DFF + col0, DFF, smem, 1.f, 0, nullptr);
    if (((row0 + 256) & 8191) == 0 && wr == 1 && fq == 3) {
      const int b = row0 >> 13;
#pragma unroll
      for (int n = 0; n < 4; ++n) {
        const int col = col0 + wc * 64 + n * 16 + fr;
        p.out[FC_P + (((size_t)l * PB + b) * 2 + 0) * DFF + col] = acc[7][n][2];
        p.out[FC_P + (((size_t)l * PB + b) * 2 + 1) * DFF + col] = acc[7][n][3];
      }
    }
    return;
  }
  EPI_IDS;
  u16* GU = (u16*)(p.ws + O_GU);
  const bool isS = row0 >= MP;
#pragma unroll
  for (int m = 0; m < 8; ++m) {
    asm volatile("" ::: "memory");
#pragma unroll
    for (int n = 0; n < 4; ++n)
#pragma unroll
      for (int j = 0; j < 4; ++j) {
        const int row = row0 + wr * 128 + m * 16 + fq * 4 + j, col = col0 + wc * 64 + n * 16 + fr;
        const float v = acc[m][n][j];
        GU[(size_t)row * DFF + col] = f2bf(v);
        if (isS) {
          const int rs = row - MP, b = rs >> 5, t = rs & 31;
          if (t >= STT - 2) p.out[FC_S + (((size_t)l * SBT + b) * 2 + (t - (STT - 2))) * DFF + col] = v;
        } else {
          const int b = row >> 13, t = row & 8191;
          if (t >= PT - 2) p.out[FC_P + (((size_t)l * PB + b) * 2 + (t - (PT - 2))) * DFF + col] = v;
        }
      }
  }
}
DI void ffup_tile(const Params& p, int l, int mt, int nt, char* smem) {
  const int row0 = mt * 256, col0 = nt * 256;
  const u16* W = (const u16*)(p.ws + O_WT) + (size_t)l * W_LAYER + W_FU;
  f32x4 acc[8][4];
  zero_acc8(acc);
  gemm512((const u16*)(p.ws + O_XN) + (size_t)row0 * LDK, LDK, W + (size_t)col0 * LDK, LDK, 1024, acc, smem);
  if (mt < 128) {
    EPI_IDS;
    const u16* GUt = (const u16*)(p.ws + O_GU) + (size_t)row0 * DFF + col0;
    if (row0 >= 2) img_load_bf16(GUt - 2 * DFF, DFF, smem, 258, 0); else img_load_bf16(GUt, DFF, smem, 256, 2);
    img_barrier();
    const u16* img = (const u16*)smem + (wr * 128 + fq * 4) * IMG_LD + wc * 64 + fr;
#pragma unroll
    for (int n = 0; n < 4; ++n) {
      const int col = col0 + wc * 64 + n * 16 + fr;
      const float* cw = p.in[30] + (size_t)l * 3 * DFF + col;
      const float w0 = cw[0], w1 = cw[DFF], w2 = cw[2 * DFF], cb = p.in[31][(size_t)l * DFF + col];
#pragma unroll
      for (int m = 0; m < 8; ++m) {
        if ((m & 1) == 0) asm volatile("" ::: "memory");
        const int t = (row0 + wr * 128 + m * 16 + fq * 4) & 8191;
        float g[6];
#pragma unroll
        for (int d = 0; d < 6; ++d) { const float gv = bf2f(img[(m * 16 + d) * IMG_LD + n * 16]); g[d] = (d >= 2 || t - 2 + d >= 0) ? gv : 0.f; }
#pragma unroll
        for (int j = 0; j < 4; ++j) acc[m][n][j] *= gelu_tanh(cb + w0 * g[j] + w1 * g[j + 1] + w2 * g[j + 2]);
      }
    }
    img_barrier();
    img_put_bf16<false>(acc, smem, 2, 1.f, 0, nullptr);
    img_barrier();
    img_store_bf16((u16*)(p.ws + O_FF) + (size_t)row0 * DFF + col0, DFF, smem, 2);
    return;
  }
  EPI_IDS;
  const u16* GU = (const u16*)(p.ws + O_GU);
  u16* FF = (u16*)(p.ws + O_FF);
  const bool isS = row0 >= MP;
  const int rowq = row0 + wr * 128 + fq * 4;
  const unsigned gbase = (unsigned)rowq * (unsigned)DFF + (unsigned)(col0 + wc * 64 + fr);
#pragma unroll
  for (int n = 0; n < 4; ++n) {
    const int col = col0 + wc * 64 + n * 16 + fr;
    const float* cw = p.in[30] + (size_t)l * 3 * DFF + col;
    const float w0 = cw[0], w1 = cw[DFF], w2 = cw[2 * DFF], cb = p.in[31][(size_t)l * DFF + col];
#pragma unroll
    for (int mh = 0; mh < 2; ++mh) {
      asm volatile("" ::: "memory");
      float g[4][6];
#pragma unroll
      for (int m = 0; m < 4; ++m) {
        const int rowb = rowq + (mh * 4 + m) * 16;
        int b, t;
        if (isS) { int rs = rowb - MP; b = rs >> 5; t = rs & 31; } else { b = rowb >> 13; t = rowb & 8191; }
#pragma unroll
        for (int d = 0; d < 6; ++d) {
          const int tt = t - 2 + d;
          if (tt >= 0) g[m][d] = bf2f(GU[gbase + (unsigned)((((mh * 4 + m) * 16 + d) * DFF) + n * 16) - 2u * (unsigned)DFF]);
          else g[m][d] = isS ? p.in[7][(((size_t)l * SBT + b) * 2 + (2 + tt)) * DFF + col] : 0.f;
        }
      }
#pragma unroll
      for (int m = 0; m < 4; ++m)
#pragma unroll
        for (int j = 0; j < 4; ++j) {
          const float gc = cb + w0 * g[m][j] + w1 * g[m][j + 1] + w2 * g[m][j + 2];
          FF[gbase + (unsigned)((((mh * 4 + m) * 16 + j) * DFF) + n * 16)] = f2bf(gelu_tanh(gc) * acc[mh * 4 + m][n][j]);
        }
    }
  }
}

DI void norm_phase(const Params& p, int l, int mode, int B, int G, char* smem) {
  const int tid = TID512(), lane = tid & 63, wid = tid >> 6;
  const float* gamma = mode == 0 ? p.in[8] + (size_t)l * 1024 : (mode == 1 ? p.in[28] + (size_t)l * 1024 : p.in[34]);
  float* wga = (float*)smem;
  if (mode == 0) {
    __syncthreads();
    const float* src = p.in[9] + (size_t)l * 1024 * PW + 3072;
#pragma unroll
    for (int i = 0; i < 8; ++i) {
      const int id = tid + i * 512, k = id >> 2, part = id & 3;
      ((float4*)wga)[(((k >> 8) * 4 + (k & 3)) * 4 + part) * 64 + ((k >> 2) & 63)] = *(const float4*)(src + (size_t)k * PW + part * 4);
    }
    __syncthreads();
  }
  float4 g[4];
#pragma unroll
  for (int i = 0; i < 4; ++i) g[i] = *(const float4*)(gamma + i * 256 + lane * 4);
  for (int row = B * 8 + wid; row < MT; row += G * 8) {
    float* X = p.out + (size_t)row * 1024;
    float4 v[4];
    float ss = 0.f;
#pragma unroll
    for (int i = 0; i < 4; ++i) { v[i] = *(const float4*)(X + i * 256 + lane * 4); ss += v[i].x * v[i].x + v[i].y * v[i].y + v[i].z * v[i].z + v[i].w * v[i].w; }
    ss = wave_sum(ss);
    const float rs = rsqrtf(ss * (1.f / 1024.f) + EPS);
    u16* XN = (u16*)(p.ws + O_XN) + (size_t)row * LDK;
#pragma unroll
    for (int i = 0; i < 4; ++i) {
      v[i] = float4{v[i].x * rs * g[i].x, v[i].y * rs * g[i].y, v[i].z * rs * g[i].z, v[i].w * rs * g[i].w};
      if (mode == 2) *(float4*)(X + i * 256 + lane * 4) = v[i];
      else *(uint2*)(XN + i * 256 + lane * 4) = uint2{pack2(v[i].x, v[i].y), pack2(v[i].z, v[i].w)};
    }
    if (mode == 0) {
      float ga[16];
#pragma unroll
      for (int r = 0; r < 16; ++r) ga[r] = 0.f;
#pragma unroll
      for (int i = 0; i < 4; ++i) {
        const float xv[4] = {v[i].x, v[i].y, v[i].z, v[i].w};
#pragma unroll
        for (int e = 0; e < 4; ++e) {
          asm volatile("" ::: "memory");
#pragma unroll
          for (int q = 0; q < 4; ++q) {
            const float4 w = ((const float4*)wga)[((i * 4 + e) * 4 + q) * 64 + lane];
            ga[q * 4 + 0] += xv[e] * w.x; ga[q * 4 + 1] += xv[e] * w.y; ga[q * 4 + 2] += xv[e] * w.z; ga[q * 4 + 3] += xv[e] * w.w;
          }
        }
      }
      float mine = 0.f;
#pragma unroll
      for (int r = 0; r < 16; ++r) { const float s = wave_sum(ga[r]); if (lane == r) mine = s; }
      if (lane < 16) ((float*)(p.ws + O_GA))[(size_t)row * 16 + lane] = mine;
    }
  }
}

#define XB_TMO      128
#define XB_XCNT(j)  (256  + 64 * (j))
#define XB_XSUB(j)  (1280 + 64 * (j))
#define XB_XGEN(j)  (2304 + 64 * (j))
#define XB_TOP      3328
#define XB_TOPGEN   3392
#define XCD_BAR_WORDS 3456
#define XB_SPIN_CAP (1u << 18)
#define LAS __attribute__((address_space(3)))

__device__ __forceinline__ unsigned xb_ld(unsigned* p)              { return __hip_atomic_load(p, __ATOMIC_RELAXED, __HIP_MEMORY_SCOPE_AGENT); }
__device__ __forceinline__ unsigned xb_add(unsigned* p, unsigned v) { return __hip_atomic_fetch_add(p, v, __ATOMIC_RELAXED, __HIP_MEMORY_SCOPE_AGENT); }
__device__ __forceinline__ unsigned xb_xcc_id() { return (unsigned)__builtin_amdgcn_s_getreg((3 << 11) | 20) & 0xFu; }
#define XB_SPIN(cond, bar) do { unsigned _sp = 0; while (cond) { __builtin_amdgcn_s_sleep(1); \
    if ((++_sp & 255u) == 0u) { if (xb_ld(&(bar)[XB_TMO])) break; if (_sp > XB_SPIN_CAP) { atomicAdd(&(bar)[XB_TMO], 1u); break; } } } } while (0)

struct XcdBarrier {
    unsigned* bar; unsigned x;
    volatile LAS unsigned* st;
};

__device__ __forceinline__ XcdBarrier xcd_barrier_post(unsigned* bar, volatile LAS unsigned* st) {
    XcdBarrier b; b.bar = bar; b.x = xb_xcc_id(); b.st = st;
    if (threadIdx.x == 0) (void)xb_add(&bar[XB_XCNT(b.x)], 1u);
    return b;
}
__device__ __forceinline__ void xcd_barrier_complete(unsigned* bar, unsigned x, unsigned& nloc, unsigned& nx) {
    const unsigned G = gridDim.x * gridDim.y * gridDim.z;
    unsigned sum, cnt, mine, sp = 0u;
    for (;;) {
        sum = 0u; cnt = 0u; mine = 0u;
#pragma unroll
        for (unsigned j = 0; j < 16; ++j) { const unsigned c = xb_ld(&bar[XB_XCNT(j)]); sum += c; cnt += (c > 0u) ? 1u : 0u; mine = (j == x) ? c : mine; }
        if (sum == G) break;
        __builtin_amdgcn_s_sleep(1);
        if ((++sp & 255u) == 0u) { if (xb_ld(&bar[XB_TMO])) break; if (sp > XB_SPIN_CAP) { atomicAdd(&bar[XB_TMO], 1u); break; } }
    }
    nloc = mine > 0u ? mine : 1u; nx = cnt > 0u ? cnt : 1u;
}

__device__ __forceinline__ void xcd_barrier(const XcdBarrier& b) {
    asm volatile("s_waitcnt vmcnt(0)" ::: "memory");
    __syncthreads();
    if (threadIdx.x == 0) {
        unsigned* bar = b.bar;
        __builtin_amdgcn_s_waitcnt(0);
        unsigned nloc = b.st[0], nx = b.st[1];
        if (nloc == 0u) { xcd_barrier_complete(bar, b.x, nloc, nx); b.st[0] = nloc; b.st[1] = nx; }
        const unsigned old = xb_add(&bar[XB_XSUB(b.x)], 1u);
        const unsigned gen = old / nloc;
        if (old + 1u == (gen + 1u) * nloc) {
            __builtin_amdgcn_fence(__ATOMIC_RELEASE, "agent");
            asm volatile("s_waitcnt vmcnt(0)" ::: "memory");
            const unsigned og = xb_add(&bar[XB_TOP], 1u);
            const unsigned tg = og / nx;
            if (og + 1u == (tg + 1u) * nx) xb_add(&bar[XB_TOPGEN], 1u);
            else XB_SPIN(xb_ld(&bar[XB_TOPGEN]) == tg, bar);
            __builtin_amdgcn_fence(__ATOMIC_ACQUIRE, "agent");
            xb_add(&bar[XB_XGEN(b.x)], 1u);
            asm volatile("s_waitcnt vmcnt(0)" ::: "memory");
        } else {
            XB_SPIN(xb_ld(&bar[XB_XGEN(b.x)]) == gen, bar);
            __builtin_amdgcn_fence(__ATOMIC_ACQUIRE, "agent");
            asm volatile("s_waitcnt vmcnt(0)" ::: "memory");
        }
    }
    __syncthreads();
}


#ifndef ONLY
#define ONLY -1
#endif
constexpr int HALF_LDS = 73728;
constexpr int SMEM_BYTES = 2 * HALF_LDS;
#define VB() (2 * B + (TID512() >> 8))
#define HS() (smem + (TID512() >> 8) * HALF_LDS)
__global__ void __launch_bounds__(512, 2) mega(Params p) {
  cg::grid_group grid = cg::this_grid();
  extern __shared__ __attribute__((aligned(16))) char smem[];
  const int G = gridDim.x, B = blockIdx.x;
  __shared__ __attribute__((aligned(16))) unsigned xb_words[4];
  if (threadIdx.x < 4) xb_words[threadIdx.x] = 0u;
  __syncthreads();
  const XcdBarrier xb = xcd_barrier_post((unsigned*)(p.ws + O_BAR), (volatile LAS unsigned*)xb_words);
  const int vG = 2 * G;
  if (ONLY < 0 || ONLY == 0) for (int it = VB(); it < PREP_ITEMS; it += vG) prep_item(p, it, HS());
  grid.sync();
  for (int l = 0; l < NL; ++l) {
    const u16* W = (const u16*)(p.ws + O_WT) + (size_t)l * W_LAYER;
    if (ONLY < 0 || ONLY == 1) norm_phase(p, l, 0, B, G, smem);
    xcd_barrier(xb);
    if (ONLY < 0 || ONLY == 2) { int mt, nt; for (int k = 0; xcd_tile(B, G, k, 130, 16, mt, nt); ++k) projin_tile(p, l, mt, nt, smem); for (int it = VB(); it < PB_KC + PB_VC; it += vG) cache_conv_item(p, l, it, HS()); }
    xcd_barrier(xb);
    if (ONLY < 0 || ONLY == 3) for (int it = B; it < 1024 + 64; it += G) attn_item(p, l, it, smem);
    if (ONLY < 0 || ONLY == 13) for (int it = VB(); it < NGI; it += vG) gla1_item(p, l, it, HS());
    if (ONLY < 0 || ONLY == 14) for (int it = VB(); it < L1_ITEMS; it += vG) lru1_item(p, l, it, HS());
    xcd_barrier(xb);
    if (ONLY < 0 || ONLY == 4) for (int it = VB(); it < G2_ITEMS + L2_ITEMS; it += vG) { if (it < G2_ITEMS) gla2_item(p, l, it); else lru2_item(p, l, it - G2_ITEMS); }
    xcd_barrier(xb);
    if (ONLY < 0 || ONLY == 5) { for (int it = VB(); it < NGI; it += vG) gla3_item(p, l, it, HS()); for (int it = VB(); it < L3_ITEMS; it += vG) lru3_item(p, it); }
    xcd_barrier(xb);
    if (ONLY < 0 || ONLY == 6) { int mt, nt; for (int k = 0; xcd_tile(B, G, k, 130, 12, mt, nt); ++k) ybr_tile(p, l, mt, nt, smem); }
    xcd_barrier(xb);
    if (ONLY < 0 || ONLY == 7) { int mt, nt; for (int k = 0; xcd_tile(B, G, k, 130, 12, mt, nt); ++k) gate_tile(p, l, mt, nt, smem); }
    xcd_barrier(xb);
    if (ONLY < 0 || ONLY == 8) resid_phase(p, (const u16*)(p.ws + O_YP), 3072, W + W_OUT, B, G, smem);
    xcd_barrier(xb);
    if (ONLY < 0 || ONLY == 9) norm_phase(p, l, 1, B, G, smem);
    xcd_barrier(xb);
    if (ONLY < 0 || ONLY == 10) { int mt, nt; for (int k = 0; xcd_tile(B, G, k, 130, 11, mt, nt); ++k) ffgate_tile(p, l, mt, nt, smem); }
    xcd_barrier(xb);
    if (ONLY < 0 || ONLY == 11) { int mt, nt; for (int k = 0; xcd_tile(B, G, k, 130, 11, mt, nt); ++k) ffup_tile(p, l, mt, nt, smem); }
    xcd_barrier(xb);
    if (ONLY < 0 || ONLY == 12) resid_phase(p, (const u16*)(p.ws + O_FF), DFF, W + W_FD, B, G, smem);
    xcd_barrier(xb);
  }
  if (ONLY < 0 || ONLY == 15) norm_phase(p, 0, 2, B, G, smem);
}

extern "C" void kernel_launch(void* const* d_in, const int* in_sizes, int n_in, void* d_out, int out_size, void* d_ws, size_t ws_size,
                              hipStream_t stream) {
  static int grid_blocks = 0;
  if (!grid_blocks) {
    int dev = 0, cus = 0, per = 0;
    (void)hipGetDevice(&dev);
    (void)hipDeviceGetAttribute(&cus, hipDeviceAttributeMultiprocessorCount, dev);
    (void)hipFuncSetAttribute((const void*)mega, hipFuncAttributeMaxDynamicSharedMemorySize, SMEM_BYTES);
    (void)hipOccupancyMaxActiveBlocksPerMultiprocessor(&per, mega, 512, SMEM_BYTES);
    if (per < 1) per = 1;
    grid_blocks = cus;
  }
  if (ws_size < WS_NEED) fprintf(stderr, "workspace too small: %zu < %zu\n", ws_size, (size_t)WS_NEED);
  Params p{};
  for (int i = 0; i < 35; ++i) p.in[i] = (const float*)d_in[i];
  p.out = (float*)d_out;
  p.ws = (char*)d_ws;
  (void)hipMemsetAsync((char*)d_ws + O_BAR, 0, XCD_BAR_WORDS * sizeof(unsigned), stream);
  void* args[] = {&p};
  hipError_t e = hipLaunchCooperativeKernel((void*)mega, dim3(grid_blocks), dim3(512), args, SMEM_BYTES, stream);
  if (e != hipSuccess) fprintf(stderr, "cooperative launch failed: %s (grid %d)\n", hipGetErrorString(e), grid_blocks);
}
```

```cpp
#include <hip/hip_runtime.h>
#include <hip/hip_cooperative_groups.h>
#include <cstdio>
namespace cg = cooperative_groups;

#define DI __device__ __forceinline__
typedef unsigned short u16;
using bf16x8 = __attribute__((ext_vector_type(8))) short;
using f32x4 = __attribute__((ext_vector_type(4))) float;
using u32x4 = __attribute__((ext_vector_type(4))) unsigned;
#define MFMA16(a, b, c) __builtin_amdgcn_mfma_f32_16x16x32_bf16((a), (b), (c), 0, 0, 0)

constexpr int DM = 1024, PB = 4, PT = 8192, SBT = 16, STT = 32, PAST = 2048, NL = 4;
constexpr int MP = PB * PT, MS = SBT * STT, MT = MP + MS;
constexpr int SKP = 2112;
constexpr int SKV = PAST + STT;
constexpr int DFF = 2816, PW = 4112, PWP = 4224;
constexpr int NGI = PB * 4 * 128 + SBT * 4;
constexpr int NLC = MP / 64 + SBT;
constexpr float EPS = 1e-6f;
constexpr float QSCALE = 0.125f * 1.4426950408889634f;
constexpr int LDK = 1088;

constexpr size_t W_IN = 0, W_MG = W_IN + (size_t)4096 * LDK, W_BR = W_MG + (size_t)3072 * LDK, W_OUT = W_BR + (size_t)3 * 1024 * 512,
                 W_FG = W_OUT + (size_t)1024 * 3072, W_FU = W_FG + (size_t)DFF * LDK, W_FD = W_FU + (size_t)DFF * LDK,
                 W_WA = W_FD + (size_t)1024 * DFF, W_WX = W_WA + 32768, W_LAYER = W_WX + 32768;

struct Params {
  const float* in[35];
  float* out;
  char* ws;
};

constexpr size_t al(size_t x) { return (x + 255) & ~(size_t)255; }
constexpr size_t O_WT = 0;
constexpr size_t O_ROPE = al(O_WT + W_LAYER * NL * 2);
constexpr size_t O_LAM = al(O_ROPE + 2 * 8192 * 8 * 4);
constexpr size_t O_BAR = al(O_LAM + 256);
constexpr size_t O_XN = al(O_BAR + 4096 * 4);
constexpr size_t O_REG = al(O_XN + (size_t)MT * LDK * 2);
constexpr size_t O_QB = O_REG;
constexpr size_t O_KB = al(O_QB + (size_t)MT * 512 * 2);
constexpr size_t O_KS = al(O_KB + (size_t)MP * 512 * 2);
constexpr size_t O_VT = al(O_KS + (size_t)SBT * SKP * 512 * 2);
constexpr size_t O_VTS = al(O_VT + (size_t)MP * 512 * 2);
constexpr size_t O_GQ = al(O_VTS + (size_t)SBT * SKP * 512 * 2);
constexpr size_t O_GK = al(O_GQ + (size_t)MT * 256 * 2);
constexpr size_t O_GV = al(O_GK + (size_t)MT * 256 * 2);
constexpr size_t O_GR = al(O_GV + (size_t)MT * 512 * 2);
constexpr size_t O_GA = al(O_GR + (size_t)MT * 512 * 2);
constexpr size_t O_LX = al(O_GA + (size_t)MT * 16 * 4);
constexpr size_t O_LG = al(O_LX + (size_t)MT * 512 * 4);
constexpr size_t O_KVT = al(O_LG + (size_t)MT * 512 * 2);
constexpr size_t O_DEC = al(O_KVT + (size_t)NGI * 8192 * 2);
constexpr size_t O_HL = al(O_DEC + (size_t)NGI * 64 * 4);
constexpr size_t O_PP = al(O_HL + (size_t)MT * 512 * 2);
constexpr size_t O_CA = al(O_PP + (size_t)MT * 512 * 2);
constexpr size_t O_CH = al(O_CA + (size_t)NLC * 512 * 4);
constexpr size_t O_HS = al(O_CH + (size_t)NLC * 512 * 4);
constexpr size_t O_OA = al(O_HS + (size_t)NLC * 512 * 4);
constexpr size_t O_OG = al(O_OA + (size_t)MT * 512 * 2);
constexpr size_t O_OL = al(O_OG + (size_t)MT * 512 * 2);
constexpr size_t O_END1 = al(O_OL + (size_t)MT * 512 * 2);
constexpr size_t O_YP = O_QB;
static_assert(O_YP + (size_t)MT * 3072 * 2 <= O_OA, "Y buffer overlaps live mixer outputs");
constexpr size_t O_GU = O_REG;
constexpr size_t O_FF = al(O_GU + (size_t)MT * DFF * 2);
constexpr size_t O_END2 = al(O_FF + (size_t)MT * DFF * 2);
constexpr size_t WS_NEED = O_END1 > O_END2 ? O_END1 : O_END2;

constexpr size_t Y_P = 0, Y_S = Y_P + (size_t)MP * 1024, K_P = Y_S + (size_t)MS * 1024, V_P = K_P + (size_t)NL * MP * 512,
                 GLA_P = V_P + (size_t)NL * MP * 512, LC_P = GLA_P + (size_t)NL * PB * 32768, LH_P = LC_P + (size_t)NL * PB * 3 * 512,
                 FC_P = LH_P + (size_t)NL * PB * 512, K_S = FC_P + (size_t)NL * PB * 2 * DFF, V_S = K_S + (size_t)NL * MS * 512,
                 GLA_S = V_S + (size_t)NL * MS * 512, LC_S = GLA_S + (size_t)NL * SBT * 32768, LH_S = LC_S + (size_t)NL * SBT * 3 * 512,
                 FC_S = LH_S + (size_t)NL * SBT * 512, OUT_TOTAL = FC_S + (size_t)NL * SBT * 2 * DFF;

DI int TID() { int t = threadIdx.x & 255; asm volatile("" : "+v"(t)); return t; }
DI int TID512() { int t = threadIdx.x; asm volatile("" : "+v"(t)); return t; }
DI u16 f2bf(float x) { __bf16 h = (__bf16)x; return __builtin_bit_cast(u16, h); }
DI float bf2f(u16 h) { return __uint_as_float(((unsigned)h) << 16); }
typedef __bf16 bf16v2_t __attribute__((ext_vector_type(2)));
typedef float f32v2_t __attribute__((ext_vector_type(2)));
DI unsigned pack2(float a, float b) { f32v2_t v = {a, b}; bf16v2_t r = __builtin_convertvector(v, bf16v2_t); return __builtin_bit_cast(unsigned, r); }
DI float sigmoidf_(float x) { return __builtin_amdgcn_rcpf(1.f + __expf(-x)); }
DI float gelu_tanh(float x) { float u = 0.7978845608028654f * (x + 0.044715f * x * x * x); return x * sigmoidf_(2.f * u); }
DI float softplusf_(float x) { return fmaxf(x, 0.f) + __logf(1.f + __expf(-fabsf(x))); }
DI float quad_max(float v) {
  auto a = __builtin_amdgcn_permlane16_swap(__float_as_uint(v), __float_as_uint(v), false, false);
  v = fmaxf(__uint_as_float(a[0]), __uint_as_float(a[1]));
  auto b = __builtin_amdgcn_permlane32_swap(__float_as_uint(v), __float_as_uint(v), false, false);
  return fmaxf(__uint_as_float(b[0]), __uint_as_float(b[1]));
}
DI float wave_sum(float v) {
  for (int o = 32; o > 0; o >>= 1) v += __shfl_xor(v, o);
  return v;
}

DI void gemm512(const u16* __restrict__ A, int lda, const u16* __restrict__ B, int ldb, int K, f32x4 (&acc)[8][4], char* smem) {
  const int tid = TID512(), lane = tid & 63, wid = tid >> 6, wr = wid >> 2, wc = wid & 3, fr = lane & 15, fq = lane >> 4;
  const int lrow = tid >> 3;
  const int gch = (tid & 7) ^ ((lrow >> 1) & 7);
  const unsigned aov = (unsigned)(lrow * lda + gch * 8);
  const unsigned bov = (unsigned)(lrow * ldb + gch * 8);
  const int soff = tid * 16;
  const int sw = (fr >> 1) & 7;
  const int aoff = (wr * 128 + fr) * 128, boff = 32768 + (wc * 64 + fr) * 128;
  const int nk = K >> 6;
  asm volatile("s_waitcnt lgkmcnt(0)" ::: "memory");
  __builtin_amdgcn_s_barrier();
#pragma unroll
  for (int i = 0; i < 4; ++i) {
    __builtin_amdgcn_global_load_lds((const unsigned*)((A + (size_t)i * 64 * lda) + aov), (unsigned*)(smem + soff + i * 8192), 16, 0, 0);
    __builtin_amdgcn_global_load_lds((const unsigned*)((B + (size_t)i * 64 * ldb) + bov), (unsigned*)(smem + 32768 + soff + i * 8192), 16, 0, 0);
  }
  asm volatile("s_waitcnt vmcnt(0)" ::: "memory");
  __builtin_amdgcn_s_barrier();
  for (int kt = 0; kt < nk; ++kt) {
    const int buf = kt & 1;
    if (kt + 1 < nk) {
      char* st = smem + (buf ^ 1) * 65536 + soff;
      const u16* An = A + (kt + 1) * 64;
      const u16* Bn = B + (kt + 1) * 64;
#pragma unroll
      for (int i = 0; i < 4; ++i) {
        __builtin_amdgcn_global_load_lds((const unsigned*)((An + (size_t)i * 64 * lda) + aov), (unsigned*)(st + i * 8192), 16, 0, 0);
        __builtin_amdgcn_global_load_lds((const unsigned*)((Bn + (size_t)i * 64 * ldb) + bov), (unsigned*)(st + 32768 + i * 8192), 16, 0, 0);
      }
    }
    const char* Sb = smem + buf * 65536;
#pragma unroll
    for (int ks = 0; ks < 2; ++ks) {
      const int co = ((ks * 4 + fq) ^ sw) << 4;
      bf16x8 bfr[4], af[8];
#pragma unroll
      for (int n = 0; n < 4; ++n) bfr[n] = *(const bf16x8*)(Sb + boff + n * 2048 + co);
#pragma unroll
      for (int m = 0; m < 8; ++m) af[m] = *(const bf16x8*)(Sb + aoff + m * 2048 + co);
      __builtin_amdgcn_sched_barrier(0);
#pragma unroll
      for (int m = 0; m < 8; ++m)
#pragma unroll
        for (int n = 0; n < 4; ++n) acc[m][n] = MFMA16(af[m], bfr[n], acc[m][n]);
      __builtin_amdgcn_sched_barrier(0);
    }
    asm volatile("s_waitcnt vmcnt(0) lgkmcnt(0)" ::: "memory");
    __builtin_amdgcn_s_barrier();
  }
}
DI void zero_acc8(f32x4 (&acc)[8][4]) {
#pragma unroll
  for (int m = 0; m < 8; ++m)
#pragma unroll
    for (int n = 0; n < 4; ++n) acc[m][n] = f32x4{0.f, 0.f, 0.f, 0.f};
}
#define EPI_IDS const int tid = TID512(), lane = tid & 63, wid = tid >> 6, wr = wid >> 2, wc = wid & 3, fr = lane & 15, fq = lane >> 4


constexpr int IMG_LD = 264;
constexpr int IMGF_LD = 260;
DI void img_barrier() { asm volatile("s_waitcnt lgkmcnt(0)" ::: "memory"); __builtin_amdgcn_s_barrier(); }
template <bool ROPE>
DI float epi_val(const f32x4 (&acc)[8][4], int m, int n, int j, const float* cs4, const float* sn4, int fr) {
  float v = acc[m][n][j];
  if (ROPE && n == 0) {
    const float pr = __shfl_xor(v, 8);
    v = (fr < 8) ? v * cs4[j] - pr * sn4[j] : v * cs4[j] + pr * sn4[j];
  }
  return v;
}
template <bool ROPE>
DI void img_put_bf16(const f32x4 (&acc)[8][4], char* smem, int rowoff, float scale, int prow0, const float* cosT) {
  EPI_IDS;
  u16* img = (u16*)smem + (wr * 128 + fq * 4 + rowoff) * IMG_LD + wc * 64 + fr;
#pragma unroll
  for (int m = 0; m < 8; ++m) {
    float cs4[4] = {0.f, 0.f, 0.f, 0.f}, sn4[4] = {0.f, 0.f, 0.f, 0.f};
    if (ROPE) {
#pragma unroll
      for (int j = 0; j < 4; ++j) { const int pos = prow0 + wr * 128 + m * 16 + fq * 4 + j; cs4[j] = cosT[pos * 8 + (fr & 7)]; sn4[j] = cosT[8192 * 8 + pos * 8 + (fr & 7)]; }
    }
#pragma unroll
    for (int n = 0; n < 4; ++n)
#pragma unroll
      for (int j = 0; j < 4; ++j) img[(m * 16 + j) * IMG_LD + n * 16] = f2bf(epi_val<ROPE>(acc, m, n, j, cs4, sn4, fr) * scale);
  }
}
DI void img_store_bf16(u16* dst, int ld, const char* smem, int rowoff) {
  const int tid = TID512();
#pragma unroll
  for (int q = 0; q < 16; ++q) {
    const int slot = tid + q * 512, row = slot >> 5, c16 = slot & 31;
    *(u32x4*)(dst + (size_t)row * ld + c16 * 8) = *(const u32x4*)(smem + (row + rowoff) * (IMG_LD * 2) + c16 * 16);
  }
}
DI void img_load_bf16(const u16* src, int ld, char* smem, int nrows, int rowoff) {
  for (int slot = TID512(); slot < nrows * 32; slot += 512) {
    const int row = slot >> 5, c16 = slot & 31;
    *(u32x4*)(smem + (row + rowoff) * (IMG_LD * 2) + c16 * 16) = *(const u32x4*)(src + (size_t)row * ld + c16 * 8);
  }
}
template <bool ROPE>
DI void imgf_put(const f32x4 (&acc)[8][4], int h, char* smem, int prow0, const float* cosT) {
  EPI_IDS;
  if (wr == h) {
    float* f = (float*)smem + (fq * 4) * IMGF_LD + wc * 64 + fr;
#pragma unroll
    for (int m = 0; m < 8; ++m) {
      float cs4[4] = {0.f, 0.f, 0.f, 0.f}, sn4[4] = {0.f, 0.f, 0.f, 0.f};
      if (ROPE) {
#pragma unroll
        for (int j = 0; j < 4; ++j) { const int pos = prow0 + wr * 128 + m * 16 + fq * 4 + j; cs4[j] = cosT[pos * 8 + (fr & 7)]; sn4[j] = cosT[8192 * 8 + pos * 8 + (fr & 7)]; }
      }
#pragma unroll
      for (int n = 0; n < 4; ++n)
#pragma unroll
        for (int j = 0; j < 4; ++j) f[(m * 16 + j) * IMGF_LD + n * 16] = epi_val<ROPE>(acc, m, n, j, cs4, sn4, fr);
    }
  }
}
template <bool ADD>
DI void imgf_store(float* dst, int ld, const char* smem) {
  const int tid = TID512();
  const unsigned o0 = (unsigned)((tid >> 6) * ld + (tid & 63) * 4);
  const char* src = smem + (tid >> 6) * (IMGF_LD * 4) + (tid & 63) * 16;
#pragma unroll
  for (int q = 0; q < 16; ++q) {
    if ((q & 3) == 0) asm volatile("" ::: "memory");
    float4 v = *(const float4*)(src + q * 8 * (IMGF_LD * 4));
    float4* d = (float4*)(dst + (o0 + (unsigned)(q * 8 * ld)));
    if (ADD) { const float4 x = *d; v.x += x.x; v.y += x.y; v.z += x.z; v.w += x.w; }
    *d = v;
  }
}
template <bool ADD, bool ROPE>
DI void tile_out_f32(const f32x4 (&acc)[8][4], float* dst, int ld, char* smem, int prow0, const float* cosT) {
#pragma unroll 1
  for (int h = 0; h < 2; ++h) {
    img_barrier();
    imgf_put<ROPE>(acc, h, smem, prow0, cosT);
    img_barrier();
    imgf_store<ADD>(dst + (size_t)h * 128 * ld, ld, smem);
  }
}
template <bool ROPE>
DI void tile_out_bf16(const f32x4 (&acc)[8][4], u16* dst, int ld, char* smem, float scale, int prow0, const float* cosT) {
  img_barrier();
  img_put_bf16<ROPE>(acc, smem, 0, scale, prow0, cosT);
  img_barrier();
  img_store_bf16(dst, ld, smem, 0);
}

template <int KS>
DI f32x4 lds_mm(const u16* As, int lsa, int arow, const u16* Bs, int lsb, int brow, f32x4 acc) {
  const int lane = TID() & 63, fr = lane & 15, fq = lane >> 4;
#pragma unroll
  for (int ks = 0; ks < KS; ++ks) {
    bf16x8 a = *(const bf16x8*)(As + (arow + fr) * lsa + ks * 32 + fq * 8);
    bf16x8 b = *(const bf16x8*)(Bs + (brow + fr) * lsb + ks * 32 + fq * 8);
    acc = MFMA16(a, b, acc);
  }
  return acc;
}

constexpr int PREP_T_PER_LAYER = 64 * 16 + 48 * 16 + 3 * 128 + 3 * 256 + 3 * 704 + 16;
constexpr int PREP_T = PREP_T_PER_LAYER * NL;
constexpr int PREP_COPY = MT * 1024 / 4096;
constexpr int PREP_ROPE = 8192 * 8 / 256;
constexpr int PREP_ITEMS = PREP_T + PREP_COPY + PREP_ROPE + 2;

DI void transpose_tile(const float* src, int lds_, int k0, int c0, int ncols_valid, u16* dst, int ldd, int n0, float* tile) {
  const int tid = TID();
  __syncthreads();
#pragma unroll
  for (int i = 0; i < 16; ++i) {
    int e = tid + i * 256, r = e >> 6, c = e & 63;
    tile[r * 65 + c] = (c < ncols_valid) ? src[(size_t)(k0 + r) * lds_ + c0 + c] : 0.f;
  }
  __syncthreads();
#pragma unroll
  for (int i = 0; i < 16; ++i) {
    int e = tid + i * 256, c = e >> 6, r = e & 63;
    dst[(size_t)(n0 + c) * ldd + k0 + r] = f2bf(tile[r * 65 + c]);
  }
}

DI void prep_item(const Params& p, int it, char* smem) {
  const int tid = TID();
  if (it < PREP_T) {
    const int l = it / PREP_T_PER_LAYER;
    int t = it % PREP_T_PER_LAYER;
    u16* W = (u16*)(p.ws + O_WT) + (size_t)l * W_LAYER;
    float* tile = (float*)smem;
    if (t < 64 * 16) {
      int nt = t / 16, kt = t % 16, n0 = nt * 64;
      const int c0 = n0 < 3072 ? n0 : n0 + 16;
      transpose_tile(p.in[9] + (size_t)l * 1024 * PW, PW, kt * 64, c0, 64, W + W_IN, LDK, n0, tile);
      return;
    }
    t -= 64 * 16;
    if (t < 48 * 16) { transpose_tile(p.in[25] + (size_t)l * 1024 * 3072, 3072, (t % 16) * 64, (t / 16) * 64, 64, W + W_MG, LDK, (t / 16) * 64, tile); return; }
    t -= 48 * 16;
    if (t < 3 * 128) {
      int br = t / 128, tt = t % 128;
      transpose_tile(p.in[22 + br] + (size_t)l * 512 * 1024, 1024, (tt % 8) * 64, (tt / 8) * 64, 64, W + W_BR + (size_t)br * 1024 * 512, 512, (tt / 8) * 64, tile);
      return;
    }
    t -= 3 * 128;
    if (t < 768) { const int cp = t / 256, tt = t % 256; transpose_tile(p.in[27] + (size_t)l * 1024 * 1024, 1024, (tt % 16) * 64, (tt / 16) * 64, 64, W + W_OUT + cp * 1024, 3072, (tt / 16) * 64, tile); return; }
    t -= 768;
    if (t < 704) { transpose_tile(p.in[29] + (size_t)l * 1024 * DFF, DFF, (t % 16) * 64, (t / 16) * 64, 64, W + W_FG, LDK, (t / 16) * 64, tile); return; }
    t -= 704;
    if (t < 704) { transpose_tile(p.in[32] + (size_t)l * 1024 * DFF, DFF, (t % 16) * 64, (t / 16) * 64, 64, W + W_FU, LDK, (t / 16) * 64, tile); return; }
    t -= 704;
    if (t < 704) { transpose_tile(p.in[33] + (size_t)l * DFF * 1024, 1024, (t % 44) * 64, (t / 44) * 64, 64, W + W_FD, DFF, (t / 44) * 64, tile); return; }
    t -= 704;
    if (t < 8) { transpose_tile(p.in[17] + (size_t)l * 32768 + t * 4096, 64, 0, 0, 64, W + W_WA + t * 4096, 64, 0, tile); return; }
    t -= 8;
    transpose_tile(p.in[19] + (size_t)l * 32768 + t * 4096, 64, 0, 0, 64, W + W_WX + t * 4096, 64, 0, tile);
    return;
  }
  it -= PREP_T;
  if (it < PREP_COPY) {
    size_t base = (size_t)it * 4096;
    float* X = p.out;
#pragma unroll
    for (int i = 0; i < 4; ++i) {
      size_t e = base + (size_t)(tid + i * 256) * 4;
      float4 v = (e < (size_t)MP * 1024) ? *(const float4*)(p.in[0] + e) : *(const float4*)(p.in[1] + (e - (size_t)MP * 1024));
      *(float4*)(X + e) = v;
    }
    return;
  }
  it -= PREP_COPY;
  if (it < PREP_ROPE) {
    int e = it * 256 + tid, pos = e >> 3, i = e & 7;
    double inv = pow(500000.0, -(double)i / 8.0);
    double ang = (double)pos * inv;
    double kq = rint(ang * 0.15915494309189535);
    double r = ang - kq * 6.283185307179586;
    float rf = (float)r;
    float* cs = (float*)(p.ws + O_ROPE);
    cs[e] = cosf(rf);
    cs[8192 * 8 + e] = sinf(rf);
    return;
  }
  if (it == PREP_ROPE && tid < 64 * NL) {
    int l = tid >> 6, i = tid & 63;
    const float* lq = p.in[10] + (size_t)l * 256;
    float a = lq[i] * lq[64 + i], b = lq[128 + i] * lq[192 + i];
    a = wave_sum(a); b = wave_sum(b);
    if (i == 0) {
      float lam_init = 0.8f - 0.6f * __expf(-0.3f * (float)l);
      ((float*)(p.ws + O_LAM))[l] = __expf(a) - __expf(b) + lam_init;
    }
  }
}

DI bool xcd_tile(int B, int G, int iter, int MTILES, int NT, int& mt, int& nt) {
  const int nxb = G >> 3;
  const int x = B & 7, lb = B >> 3;
  const int q = MTILES >> 3, r = MTILES & 7;
  const int mx = q + (x < r ? 1 : 0);
  const int mbase = x * q + (x < r ? x : r);
  const int j = lb + iter * nxb;
  if (j >= mx * NT) return false;
  const int band = j / (8 * NT);
  const int rem = j - band * 8 * NT;
  const int nb = (mx - band * 8) < 8 ? (mx - band * 8) : 8;
  mt = mbase + band * 8 + rem % nb;
  nt = rem / nb;
  return true;
}

constexpr int PB_KC = SBT * PAST * 512 / 4096;
constexpr int PB_VC = SBT * 32 * 8;

DI void projin_tile(const Params& p, int l, int mt, int nt, char* smem) {
  const int row0 = mt * 256, col0 = nt * 256;
  const u16* W = (const u16*)(p.ws + O_WT) + (size_t)l * W_LAYER + W_IN;
  const u16* XN = (const u16*)(p.ws + O_XN);
  f32x4 acc[8][4];
  zero_acc8(acc);
  gemm512(XN + (size_t)row0 * LDK, LDK, W + (size_t)col0 * LDK, LDK, 1024, acc, smem);
  const float* cosT = (const float*)(p.ws + O_ROPE);
  const float* sinT = cosT + 8192 * 8;
  if (mt < 128) {
    const int prow0 = row0 & 8191;
    if (nt < 2) {
      tile_out_bf16<true>(acc, (u16*)(p.ws + O_QB) + (size_t)row0 * 512 + col0, 512, smem, QSCALE, prow0, cosT);
    } else if (nt < 4) {
      tile_out_f32<false, true>(acc, p.out + K_P + ((size_t)l * MP + row0) * 512 + (col0 - 512), 512, smem, prow0, cosT);
      tile_out_bf16<true>(acc, (u16*)(p.ws + O_KB) + (size_t)row0 * 512 + (col0 - 512), 512, smem, 1.f, prow0, cosT);
    } else if (nt < 6) {
      tile_out_f32<false, false>(acc, p.out + V_P + ((size_t)l * MP + row0) * 512 + (col0 - 1024), 512, smem, 0, nullptr);
      EPI_IDS;
      u16* VT = (u16*)(p.ws + O_VT);
      const unsigned vb = (unsigned)((row0 >> 13) * 512 + (col0 - 1024) + wc * 64 + fr) * (unsigned)PT + (unsigned)((row0 & 8191) + wr * 128 + fq * 4);
#pragma unroll
      for (int m = 0; m < 8; ++m) {
        asm volatile("" ::: "memory");
#pragma unroll
        for (int n = 0; n < 4; ++n) {
          const uint2 pk = {pack2(acc[m][n][0], acc[m][n][1]), pack2(acc[m][n][2], acc[m][n][3])};
          *(uint2*)(VT + (vb + (unsigned)(n * 16 * PT + m * 16))) = pk;
        }
      }
    } else if (nt >= 12 && nt < 14) {
      tile_out_f32<false, false>(acc, (float*)(p.ws + O_LX) + (size_t)row0 * 512 + (col0 - 3072), 512, smem, 0, nullptr);
    } else {
      u16* dst; int ld = 512, cbase;
      if (nt == 6) { dst = (u16*)(p.ws + O_GQ); ld = 256; cbase = 1536; }
      else if (nt == 7) { dst = (u16*)(p.ws + O_GK); ld = 256; cbase = 1792; }
      else if (nt < 10) { dst = (u16*)(p.ws + O_GV); cbase = 2048; }
      else if (nt < 12) { dst = (u16*)(p.ws + O_GR); cbase = 2560; }
      else { dst = (u16*)(p.ws + O_LG); cbase = 3584; }
      tile_out_bf16<false>(acc, dst + (size_t)row0 * ld + (col0 - cbase), ld, smem, nt == 6 ? 0.125f : 1.f, 0, nullptr);
    }
    return;
  }
  EPI_IDS;
  const bool isS = row0 >= MP;
  if (nt < 4) {
    const bool isq = nt < 2;
    u16* QB = (u16*)(p.ws + O_QB);
    u16* KB = (u16*)(p.ws + O_KB);
    u16* KS = (u16*)(p.ws + O_KS);
#pragma unroll
    for (int m = 0; m < 8; ++m) {
      asm volatile("" ::: "memory");
#pragma unroll
      for (int n = 0; n < 4; ++n)
#pragma unroll
        for (int j = 0; j < 4; ++j) {
          const int row = row0 + wr * 128 + m * 16 + fq * 4 + j;
          const int col = col0 + wc * 64 + n * 16 + fr;
          float v = acc[m][n][j];
          int b, t;
          if (isS) { int rs = row - MP; b = rs >> 5; t = rs & 31; } else { b = row >> 13; t = row & 8191; }
          const int pos = isS ? PAST + t : t;
          if (n == 0) {
            float pr = __shfl_xor(v, 8);
            float cs = cosT[pos * 8 + (fr & 7)], sn = sinT[pos * 8 + (fr & 7)];
            v = (fr < 8) ? v * cs - pr * sn : v * cs + pr * sn;
          }
          if (isq) {
            QB[(size_t)row * 512 + col] = f2bf(v * QSCALE);
          } else {
            const int ck = col - 512;
            if (isS) {
              p.out[K_S + ((size_t)l * MS + (row - MP)) * 512 + ck] = v;
              KS[((size_t)b * SKP + PAST + t) * 512 + ck] = f2bf(v);
            } else {
              p.out[K_P + ((size_t)l * MP + row) * 512 + ck] = v;
              KB[(size_t)row * 512 + ck] = f2bf(v);
            }
          }
        }
    }
  } else if (nt < 6) {
    u16* VT = (u16*)(p.ws + O_VT);
    u16* VTS = (u16*)(p.ws + O_VTS);
#pragma unroll
    for (int m = 0; m < 8; ++m) {
      asm volatile("" ::: "memory");
#pragma unroll
      for (int n = 0; n < 4; ++n) {
        const int rowb = row0 + wr * 128 + m * 16 + fq * 4;
        const int cv = col0 - 1024 + wc * 64 + n * 16 + fr;
        const int h = cv >> 7, vd = cv & 127;
        int b, t;
        if (isS) { int rs = rowb - MP; b = rs >> 5; t = rs & 31; } else { b = rowb >> 13; t = rowb & 8191; }
#pragma unroll
        for (int j = 0; j < 4; ++j) {
          if (isS) p.out[V_S + ((size_t)l * MS + (rowb + j - MP)) * 512 + cv] = acc[m][n][j];
          else p.out[V_P + ((size_t)l * MP + rowb + j) * 512 + cv] = acc[m][n][j];
        }
        uint2 pk = {pack2(acc[m][n][0], acc[m][n][1]), pack2(acc[m][n][2], acc[m][n][3])};
        if (isS) *(uint2*)(VTS + ((size_t)(b * 4 + h) * 128 + vd) * SKP + PAST + t) = pk;
        else *(uint2*)(VT + ((size_t)(b * 4 + h) * 128 + vd) * PT + t) = pk;
      }
    }
  } else {
    u16* dst16 = nullptr; float* dst32 = nullptr; int ld = 512, cbase = 0; float scale = 1.f;
    if (nt == 6) { dst16 = (u16*)(p.ws + O_GQ); ld = 256; cbase = 1536; scale = 0.125f; }
    else if (nt == 7) { dst16 = (u16*)(p.ws + O_GK); ld = 256; cbase = 1792; }
    else if (nt < 10) { dst16 = (u16*)(p.ws + O_GV); cbase = 2048; }
    else if (nt < 12) { dst16 = (u16*)(p.ws + O_GR); cbase = 2560; }
    else if (nt < 14) { dst32 = (float*)(p.ws + O_LX); cbase = 3072; }
    else { dst16 = (u16*)(p.ws + O_LG); cbase = 3584; }
#pragma unroll
    for (int m = 0; m < 8; ++m) {
      asm volatile("" ::: "memory");
#pragma unroll
      for (int n = 0; n < 4; ++n)
#pragma unroll
        for (int j = 0; j < 4; ++j) {
          const int row = row0 + wr * 128 + m * 16 + fq * 4 + j;
          const int c = col0 + wc * 64 + n * 16 + fr - cbase;
          const float v = acc[m][n][j] * scale;
          if (dst16) dst16[(size_t)row * ld + c] = f2bf(v);
          else dst32[(size_t)row * ld + c] = v;
        }
    }
  }
}

DI void cache_conv_item(const Params& p, int l, int it, char* smem) {
  const int tid = TID();
  if (it < PB_KC) {
    const float* src = p.in[2] + (size_t)l * SBT * PAST * 512;
    u16* KS = (u16*)(p.ws + O_KS);
#pragma unroll
    for (int i = 0; i < 4; ++i) {
      size_t e = (size_t)it * 4096 + (size_t)(tid + i * 256) * 4;
      float4 v = *(const float4*)(src + e);
      size_t b = e / ((size_t)PAST * 512), r = e % ((size_t)PAST * 512);
      *(uint2*)(KS + b * SKP * 512 + r) = uint2{pack2(v.x, v.y), pack2(v.z, v.w)};
    }
    return;
  }
  it -= PB_KC;
  const int b = it / 256, r = it % 256, ptile = r / 8, ctile = r % 8;
  const float* src = p.in[3] + ((size_t)l * SBT + b) * PAST * 512;
  u16* VTS = (u16*)(p.ws + O_VTS);
  transpose_tile(src, 512, ptile * 64, ctile * 64, 64, VTS + (size_t)b * 512 * SKP, SKP, ctile * 64, (float*)smem);
}

DI int kswz(int key) { return (((key >> 3) & 3) << 2) | (key & 3); }

DI void attn_item(const Params& p, int l, bool isS, int b, int h, int cp, char* smem) {
  const int tid = TID512(), lane = tid & 63, wid = tid >> 6, fr = lane & 15, fq = lane >> 4;
  const int nkt = isS ? 33 : 2 * cp + 2;
  const int klen = isS ? SKV : nkt * 64;
  const int mykt = isS ? 33 : (wid < 4 ? 2 * cp + 1 : 2 * cp + 2);
  const u16* QB = (const u16*)(p.ws + O_QB);
  const u16* Kg = isS ? (const u16*)(p.ws + O_KS) + (size_t)b * SKP * 512 + h * 128 : (const u16*)(p.ws + O_KB) + (size_t)b * PT * 512 + h * 128;
  const int vstride = isS ? SKP : PT;
  const u16* Vg = (isS ? (const u16*)(p.ws + O_VTS) : (const u16*)(p.ws + O_VT)) + (size_t)(b * 4 + h) * 128 * vstride;
  const int qrow0 = isS ? MP + b * 32 : b * PT + cp * 128;
  const bool wactive = isS ? (wid < 2) : true;
  const int qrow = qrow0 + wid * 16 + fr;
  bf16x8 qf[2][2];
#pragma unroll
  for (int mp = 0; mp < 2; ++mp)
#pragma unroll
    for (int ks = 0; ks < 2; ++ks)
      qf[mp][ks] = wactive ? *(const bf16x8*)(QB + (size_t)qrow * 512 + h * 128 + mp * 64 + ks * 32 + fq * 8) : bf16x8{0, 0, 0, 0, 0, 0, 0, 0};
  f32x4 ot[2][8];
#pragma unroll
  for (int mp = 0; mp < 2; ++mp)
#pragma unroll
    for (int n = 0; n < 8; ++n) ot[mp][n] = f32x4{0.f, 0.f, 0.f, 0.f};
  float mrun[2] = {-INFINITY, -INFINITY}, lrun[2] = {0.f, 0.f};
  char* Ks = smem;
  char* Vs = smem + 32768;
  const int kkey = tid >> 4, vvd = tid >> 3;
  const int kgch = (tid & 15) ^ kswz(kkey);
  const int vgch = (tid & 7) ^ ((vvd >> 1) & 7);
  const int soff = tid * 16;
  auto issue_k = [&](int kt) {
#pragma unroll
    for (int i = 0; i < 2; ++i)
      __builtin_amdgcn_global_load_lds((const unsigned*)(Kg + (size_t)(kt * 64 + kkey + i * 32) * 512 + kgch * 8), (unsigned*)(Ks + (kt & 1) * 16384 + soff + i * 8192), 16, 0, 0);
  };
  auto issue_v = [&](int kt) {
#pragma unroll
    for (int i = 0; i < 2; ++i)
      __builtin_amdgcn_global_load_lds((const unsigned*)(Vg + (size_t)(vvd + i * 64) * vstride + kt * 64 + vgch * 8), (unsigned*)(Vs + (kt & 1) * 16384 + soff + i * 8192), 16, 0, 0);
  };
  auto qk_tile = [&](int kt, f32x4 (&st)[2][4]) {
    const char* Kb = Ks + (kt & 1) * 16384;
    bf16x8 kf[2][4][2];
#pragma unroll
    for (int mp = 0; mp < 2; ++mp)
#pragma unroll
      for (int mt = 0; mt < 4; ++mt) {
        const int key = 32 * (mt >> 1) + 8 * (fr >> 2) + 4 * (mt & 1) + (fr & 3);
#pragma unroll
        for (int ks = 0; ks < 2; ++ks) kf[mp][mt][ks] = *(const bf16x8*)(Kb + key * 256 + (((mp * 8 + ks * 4 + fq) ^ kswz(key)) << 4));
      }
#pragma unroll
    for (int mp = 0; mp < 2; ++mp)
#pragma unroll
      for (int mt = 0; mt < 4; ++mt) {
        f32x4 a = MFMA16(kf[mp][mt][0], qf[mp][0], (f32x4{0.f, 0.f, 0.f, 0.f}));
        st[mp][mt] = MFMA16(kf[mp][mt][1], qf[mp][1], a);
      }
    if ((kt + 1) * 64 > klen) {
      asm volatile("" ::: "memory");
#pragma unroll
      for (int mp = 0; mp < 2; ++mp)
#pragma unroll
        for (int mt = 0; mt < 4; ++mt)
#pragma unroll
          for (int j = 0; j < 4; ++j) {
            const int key = kt * 64 + 32 * (mt >> 1) + 8 * fq + 4 * (mt & 1) + j;
            if (key >= klen) st[mp][mt][j] = -INFINITY;
          }
    }
  };
  auto softmax_tile = [&](f32x4 (&st)[2][4], bf16x8 (&pfn)[2][2], float (&alpha)[2], float (&psum)[2], bool (&moved)[2]) {
#pragma unroll
    for (int mp = 0; mp < 2; ++mp) {
      float mx = -INFINITY;
#pragma unroll
      for (int mt = 0; mt < 4; ++mt)
#pragma unroll
        for (int j = 0; j < 4; ++j) mx = fmaxf(mx, st[mp][mt][j]);
      mx = quad_max(mx);
      const float mold = mrun[mp];
      const float mnew = fmaxf(mold, mx);
      mrun[mp] = mnew;
      float ps = 0.f;
#pragma unroll
      for (int mt = 0; mt < 4; ++mt)
#pragma unroll
        for (int j = 0; j < 4; ++j) { float e = __builtin_amdgcn_exp2f(st[mp][mt][j] - mnew); st[mp][mt][j] = e; ps += e; }
      psum[mp] = ps;
      moved[mp] = __any(mnew > mold);
      alpha[mp] = __builtin_amdgcn_exp2f(mold - mnew);
#pragma unroll
      for (int s = 0; s < 2; ++s) {
        uint4 u = {pack2(st[mp][2 * s][0], st[mp][2 * s][1]), pack2(st[mp][2 * s][2], st[mp][2 * s][3]),
                   pack2(st[mp][2 * s + 1][0], st[mp][2 * s + 1][1]), pack2(st[mp][2 * s + 1][2], st[mp][2 * s + 1][3])};
        pfn[mp][s] = __builtin_bit_cast(bf16x8, u);
      }
    }
  };
  auto apply_scale = [&](const float (&alpha)[2], const float (&psum)[2], const bool (&moved)[2]) {
#pragma unroll
    for (int mp = 0; mp < 2; ++mp) {
      if (moved[mp]) {
        lrun[mp] *= alpha[mp];
#pragma unroll
        for (int n = 0; n < 8; ++n) { ot[mp][n][0] *= alpha[mp]; ot[mp][n][1] *= alpha[mp]; ot[mp][n][2] *= alpha[mp]; ot[mp][n][3] *= alpha[mp]; }
      }
      lrun[mp] += psum[mp];
    }
  };
  asm volatile("s_waitcnt vmcnt(0) lgkmcnt(0)" ::: "memory");
  __builtin_amdgcn_s_barrier();
  issue_k(0); issue_v(0);
  if (nkt > 1) issue_k(1);
  asm volatile("s_waitcnt vmcnt(0)" ::: "memory");
  asm volatile("" ::"v"(qf[0][0]), "v"(qf[0][1]), "v"(qf[1][0]), "v"(qf[1][1]));
  __builtin_amdgcn_s_barrier();
  bf16x8 pf[2][2];
#pragma unroll
  for (int mp = 0; mp < 2; ++mp)
#pragma unroll
    for (int s = 0; s < 2; ++s) pf[mp][s] = bf16x8{0, 0, 0, 0, 0, 0, 0, 0};
  if (wactive) {
    f32x4 st[2][4];
    float alpha[2], psum[2]; bool moved[2];
    qk_tile(0, st);
    softmax_tile(st, pf, alpha, psum, moved);
    apply_scale(alpha, psum, moved);
  }
  asm volatile("s_waitcnt lgkmcnt(0)" ::: "memory");
  __builtin_amdgcn_s_barrier();
  for (int j = 0; j < nkt; ++j) {
    if (j + 2 < nkt) issue_k(j + 2);
    if (j + 1 < nkt) issue_v(j + 1);
    const bool doPV = wactive && j < mykt;
    const bool doQK = wactive && j + 1 < mykt;
    f32x4 st[2][4];
    bf16x8 pfn[2][2];
    float alpha[2] = {1.f, 1.f}, psum[2] = {0.f, 0.f}; bool moved[2] = {false, false};
    auto pv_tile = [&]() {
      const char* Vb = Vs + (j & 1) * 16384;
#pragma unroll
      for (int nh = 0; nh < 2; ++nh) {
        bf16x8 vf[4][2];
#pragma unroll
        for (int n = 0; n < 4; ++n) {
          const int vd = (nh * 4 + n) * 16 + fr;
#pragma unroll
          for (int s = 0; s < 2; ++s) vf[n][s] = *(const bf16x8*)(Vb + vd * 128 + (((s * 4 + fq) ^ ((vd >> 1) & 7)) << 4));
        }
#pragma unroll
        for (int n = 0; n < 4; ++n)
#pragma unroll
          for (int s = 0; s < 2; ++s) {
            ot[0][nh * 4 + n] = MFMA16(vf[n][s], pf[0][s], ot[0][nh * 4 + n]);
            ot[1][nh * 4 + n] = MFMA16(vf[n][s], pf[1][s], ot[1][nh * 4 + n]);
          }
      }
    };
    if (doQK) {
      qk_tile(j + 1, st);
      pv_tile();
      softmax_tile(st, pfn, alpha, psum, moved);
      apply_scale(alpha, psum, moved);
#pragma unroll
      for (int mp = 0; mp < 2; ++mp)
#pragma unroll
        for (int s = 0; s < 2; ++s) pf[mp][s] = pfn[mp][s];
    } else if (doPV) {
      pv_tile();
    }
    asm volatile("s_waitcnt vmcnt(0) lgkmcnt(0)" ::: "memory");
    __builtin_amdgcn_s_barrier();
  }
  if (wactive) {
    float l0 = lrun[0], l1 = lrun[1];
    l0 += __shfl_xor(l0, 16); l0 += __shfl_xor(l0, 32);
    l1 += __shfl_xor(l1, 16); l1 += __shfl_xor(l1, 32);
    const float lam = ((const float*)(p.ws + O_LAM))[l];
    const float lam_init = 0.8f - 0.6f * __expf(-0.3f * (float)l);
    const float i0 = 1.f / l0, i1 = lam / l1;
    float ss = 0.f;
#pragma unroll
    for (int n = 0; n < 8; ++n)
#pragma unroll
      for (int j = 0; j < 4; ++j) { float o = ot[0][n][j] * i0 - ot[1][n][j] * i1; ot[0][n][j] = o; ss += o * o; }
    ss += __shfl_xor(ss, 16); ss += __shfl_xor(ss, 32);
    const float rs = rsqrtf(ss * (1.f / 128.f) + EPS) * (1.f - lam_init);
    const float* g = p.in[11] + (size_t)l * 128;
    u16* OA = (u16*)(p.ws + O_OA) + (size_t)qrow * 512 + h * 128;
#pragma unroll
    for (int n = 0; n < 8; ++n) {
      const int vd = n * 16 + fq * 4;
      float4 gg = *(const float4*)(g + vd);
      *(uint2*)(OA + vd) = uint2{pack2(ot[0][n][0] * rs * gg.x, ot[0][n][1] * rs * gg.y), pack2(ot[0][n][2] * rs * gg.z, ot[0][n][3] * rs * gg.w)};
    }
  }
}

constexpr int LP = 72;
constexpr int BCS = 68;
DI void gla_decode(int gi, bool& isS, int& b, int& h, int& c, int& row0, int& Lc) {
  if (gi < PB * 4 * 128) { isS = false; c = gi & 127; h = (gi >> 7) & 3; b = gi >> 9; row0 = b * PT + c * 64; Lc = 64; }
  else { isS = true; int s = gi - PB * 4 * 128; b = s >> 2; h = s & 3; c = 0; row0 = MP + b * 32; Lc = 32; }
}
DI void gla_bcum(const Params& p, int l, int row0, int Lc, int h, float* bc, float* tot, float* gas) {
  const int tid = TID(), kd = tid & 63, tq = tid >> 6;
  const float* W2 = p.in[12] + (size_t)l * 16 * 256 + h * 64 + kd;
  const float b2 = p.in[13][(size_t)l * 256 + h * 64 + kd];
  const float* GA = (const float*)(p.ws + O_GA);
  {
    const int r = tid >> 2, part = tid & 3;
    float4 v = {0.f, 0.f, 0.f, 0.f};
    if (r < Lc) v = *(const float4*)(GA + (size_t)(row0 + r) * 16 + part * 4);
    *(float4*)(gas + r * 16 + part * 4) = v;
  }
  float w[16];
#pragma unroll
  for (int r = 0; r < 16; ++r) w[r] = W2[r * 256];
  __syncthreads();
  float run = 0.f;
#pragma unroll
  for (int i = 0; i < 16; ++i) {
    const int t = tq * 16 + i;
    const float4* ga = (const float4*)(gas + t * 16);
    const float4 g0 = ga[0], g1 = ga[1], g2 = ga[2], g3 = ga[3];
    const float x = b2 + g0.x * w[0] + g0.y * w[1] + g0.z * w[2] + g0.w * w[3] + g1.x * w[4] + g1.y * w[5] + g1.z * w[6] + g1.w * w[7] +
                    g2.x * w[8] + g2.y * w[9] + g2.z * w[10] + g2.w * w[11] + g3.x * w[12] + g3.y * w[13] + g3.z * w[14] + g3.w * w[15];
    const float la = (t < Lc) ? -softplusf_(-x) * (1.f / 16.f) : 0.f;
    run += la;
    bc[t * BCS + kd] = run;
  }
  tot[tq * 64 + kd] = run;
  __syncthreads();
  float off = 0.f;
  for (int g = 0; g < tq; ++g) off += tot[g * 64 + kd];
#pragma unroll
  for (int i = 0; i < 16; ++i) bc[(tq * 16 + i) * BCS + kd] += off;
  __syncthreads();
}
DI void gla_load_vt(const Params& p, int row0, int Lc, int h, u16* vt) {
  const int tid = TID(), s = tid & 63, cg4 = tid >> 6;
  const u16* GV = (const u16*)(p.ws + O_GV) + (size_t)(row0 + s) * 512 + h * 128;
  u32x4 v[4];
#pragma unroll
  for (int i = 0; i < 4; ++i) v[i] = (s < Lc) ? *(const u32x4*)(GV + (cg4 + 4 * i) * 8) : u32x4{0u, 0u, 0u, 0u};
#pragma unroll
  for (int i = 0; i < 4; ++i) {
    const int vd0 = (cg4 + 4 * i) * 8;
#pragma unroll
    for (int e = 0; e < 4; ++e) {
      vt[(vd0 + 2 * e) * LP + s] = (u16)(v[i][e] & 0xffffu);
      vt[(vd0 + 2 * e + 1) * LP + s] = (u16)(v[i][e] >> 16);
    }
  }
}

DI void gla1_item(const Params& p, int l, int gi, char* smem) {
  bool isS; int b, h, c, row0, Lc;
  gla_decode(gi, isS, b, h, c, row0, Lc);
  const int tid = TID(), lane = tid & 63, wid = tid >> 6, fr = lane & 15, fq = lane >> 4;
  float* bc = (float*)smem;
  float* tot = (float*)(smem + 17408);
  u16* kh = (u16*)(smem + 18432);
  u16* vt = (u16*)(smem + 18432 + 9216);
  __syncthreads();
  gla_bcum(p, l, row0, Lc, h, bc, tot, (float*)kh);
  {
    const int s = tid & 63, c2 = tid >> 6;
    const u16* GK = (const u16*)(p.ws + O_GK) + (size_t)(row0 + s) * 256 + h * 64;
    u32x4 kv[2];
#pragma unroll
    for (int i = 0; i < 2; ++i) kv[i] = (s < Lc) ? *(const u32x4*)(GK + (c2 + 4 * i) * 8) : u32x4{0u, 0u, 0u, 0u};
#pragma unroll
    for (int i = 0; i < 2; ++i) {
      const int kd0 = (c2 + 4 * i) * 8;
#pragma unroll
      for (int e = 0; e < 8; ++e) {
        const unsigned w = kv[i][e >> 1];
        const float kf = bf2f((u16)((e & 1) ? (w >> 16) : (w & 0xffffu)));
        const float bl = bc[63 * BCS + kd0 + e];
        kh[(kd0 + e) * LP + s] = f2bf(kf * __expf(bl - bc[s * BCS + kd0 + e]));
      }
    }
    if (tid < 64) ((float*)(p.ws + O_DEC))[(size_t)gi * 64 + tid] = __expf(bc[63 * BCS + tid]);
  }
  gla_load_vt(p, row0, Lc, h, vt);
  __syncthreads();
  u16* KVT = (u16*)(p.ws + O_KVT) + (size_t)gi * 8192;
#pragma unroll
  for (int mi = 0; mi < 2; ++mi)
#pragma unroll
    for (int n = 0; n < 4; ++n) {
      const int m = wid * 2 + mi;
      f32x4 a = lds_mm<2>(vt, LP, m * 16, kh, LP, n * 16, f32x4{0.f, 0.f, 0.f, 0.f});
#pragma unroll
      for (int j = 0; j < 4; ++j) KVT[(m * 16 + fq * 4 + j) * 64 + n * 16 + fr] = f2bf(a[j]);
    }
}

constexpr int G2_ITEMS = (PB * 4 + SBT * 4) * 32;
DI void gla2_item(const Params& p, int l, int it) {
  const int seq = it >> 5, e = (it & 31) * 256 + TID();
  const int vd = e >> 6, kd = e & 63;
  u16* KVT = (u16*)(p.ws + O_KVT);
  const float* DEC = (const float*)(p.ws + O_DEC);
  if (seq < PB * 4) {
    float S = 0.f;
    const int gi0 = seq * 128;
    for (int c0 = 0; c0 < 128; c0 += 32) {
      u16 kvv[32]; float dd[32];
#pragma unroll
      for (int c = 0; c < 32; ++c) { kvv[c] = KVT[(size_t)(gi0 + c0 + c) * 8192 + e]; dd[c] = DEC[(size_t)(gi0 + c0 + c) * 64 + kd]; }
#pragma unroll
      for (int c = 0; c < 32; ++c) { KVT[(size_t)(gi0 + c0 + c) * 8192 + e] = f2bf(S); S = dd[c] * S + bf2f(kvv[c]); }
    }
    p.out[GLA_P + ((size_t)l * PB * 4 + seq) * 8192 + kd * 128 + vd] = S;
  } else {
    const int s = seq - PB * 4, gi = PB * 4 * 128 + s;
    const float S0 = p.in[4][((size_t)l * SBT * 4 + s) * 8192 + kd * 128 + vd];
    u16* q = KVT + (size_t)gi * 8192 + e;
    const float kv = bf2f(*q);
    const float d = DEC[(size_t)gi * 64 + kd];
    *q = f2bf(S0);
    p.out[GLA_S + ((size_t)l * SBT * 4 + s) * 8192 + kd * 128 + vd] = d * S0 + kv;
  }
}

DI void gla3_item(const Params& p, int l, int gi, char* smem) {
  bool isS; int b, h, c, row0, Lc;
  gla_decode(gi, isS, b, h, c, row0, Lc);
  const int tid = TID(), lane = tid & 63, wid = tid >> 6, fr = lane & 15, fq = lane >> 4;
  float* bc = (float*)smem;
  u16* att = (u16*)smem;
  float* tot = (float*)(smem + 17408);
  u16* qt = (u16*)(smem + 18432);
  u16* kt_ = (u16*)(smem + 18432 + 9216);
  u16* vt = (u16*)(smem + 18432 + 2 * 9216);
  u16* st = (u16*)(smem + 18432 + 2 * 9216 + 18432);
  __syncthreads();
  gla_bcum(p, l, row0, Lc, h, bc, tot, (float*)qt);
  const u16* KVT = (const u16*)(p.ws + O_KVT) + (size_t)gi * 8192;
  {
    const int s = tid & 63, c2 = tid >> 6;
    const u16* GQ = (const u16*)(p.ws + O_GQ) + (size_t)(row0 + s) * 256 + h * 64;
    const u16* GK = (const u16*)(p.ws + O_GK) + (size_t)(row0 + s) * 256 + h * 64;
    u32x4 qv[2], kv[2], sv[4];
#pragma unroll
    for (int i = 0; i < 2; ++i) {
      qv[i] = (s < Lc) ? *(const u32x4*)(GQ + (c2 + 4 * i) * 8) : u32x4{0u, 0u, 0u, 0u};
      kv[i] = (s < Lc) ? *(const u32x4*)(GK + (c2 + 4 * i) * 8) : u32x4{0u, 0u, 0u, 0u};
    }
#pragma unroll
    for (int i = 0; i < 4; ++i) { const int id = tid + i * 256; sv[i] = *(const u32x4*)(KVT + (id >> 3) * 64 + (id & 7) * 8); }
#pragma unroll
    for (int i = 0; i < 2; ++i) {
      const int kd0 = (c2 + 4 * i) * 8;
      u32x4 qo, ko;
#pragma unroll
      for (int e2 = 0; e2 < 4; ++e2) {
        const float b0 = bc[s * BCS + kd0 + 2 * e2], b1 = bc[s * BCS + kd0 + 2 * e2 + 1];
        const float e0 = __expf(b0), e1 = __expf(b1);
        const float q0 = bf2f((u16)(qv[i][e2] & 0xffffu)) * e0, q1 = bf2f((u16)(qv[i][e2] >> 16)) * e1;
        const float k0 = bf2f((u16)(kv[i][e2] & 0xffffu)) / e0, k1 = bf2f((u16)(kv[i][e2] >> 16)) / e1;
        qo[e2] = pack2(q0, q1);
        ko[e2] = pack2(k0, k1);
      }
      *(u32x4*)(qt + s * LP + kd0) = qo;
      *(u32x4*)(kt_ + s * LP + kd0) = ko;
    }
#pragma unroll
    for (int i = 0; i < 4; ++i) { const int id = tid + i * 256; *(u32x4*)(st + (id >> 3) * LP + (id & 7) * 8) = sv[i]; }
  }
  gla_load_vt(p, row0, Lc, h, vt);
  __syncthreads();
  {
    f32x4 a[4];
#pragma unroll
    for (int n = 0; n < 4; ++n) a[n] = lds_mm<2>(qt, LP, wid * 16, kt_, LP, n * 16, f32x4{0.f, 0.f, 0.f, 0.f});
#pragma unroll
    for (int n = 0; n < 4; ++n)
#pragma unroll
      for (int j = 0; j < 4; ++j) {
        const int t = wid * 16 + fq * 4 + j, s = n * 16 + fr;
        att[t * LP + s] = f2bf(t >= s ? a[n][j] : 0.f);
      }
  }
  __syncthreads();
  f32x4 o[8];
#pragma unroll
  for (int n = 0; n < 8; ++n) {
    f32x4 a = lds_mm<2>(att, LP, wid * 16, vt, LP, n * 16, f32x4{0.f, 0.f, 0.f, 0.f});
    o[n] = lds_mm<2>(qt, LP, wid * 16, st, LP, n * 16, a);
  }
  const float* gn = p.in[14] + (size_t)l * 128;
  const u16* GR = (const u16*)(p.ws + O_GR);
  u16* OG = (u16*)(p.ws + O_OG);
  float gnv[8];
#pragma unroll
  for (int n = 0; n < 8; ++n) gnv[n] = gn[n * 16 + fr];
#pragma unroll
  for (int j = 0; j < 4; ++j) {
    float ss = 0.f;
#pragma unroll
    for (int n = 0; n < 8; ++n) ss += o[n][j] * o[n][j];
    ss += __shfl_xor(ss, 1); ss += __shfl_xor(ss, 2); ss += __shfl_xor(ss, 4); ss += __shfl_xor(ss, 8);
    const float rs = rsqrtf(ss * (1.f / 128.f) + EPS);
    const int t = wid * 16 + fq * 4 + j;
    if (t < Lc) {
      const size_t ro = (size_t)(row0 + t) * 512 + h * 128;
      u16 grv[8];
#pragma unroll
      for (int n = 0; n < 8; ++n) grv[n] = GR[ro + n * 16 + fr];
#pragma unroll
      for (int n = 0; n < 8; ++n) {
        const float gr = bf2f(grv[n]);
        OG[ro + n * 16 + fr] = f2bf(o[n][j] * rs * gnv[n] * gr * sigmoidf_(gr));
      }
    }
  }
}

constexpr int L1_ITEMS = NLC * 8;
DI void lru_decode(int ci, bool& isS, int& b, int& row0, int& Lc, int& t0) {
  if (ci < MP / 64) { isS = false; b = ci >> 7; t0 = (ci & 127) * 64; row0 = ci * 64; Lc = 64; }
  else { isS = true; b = ci - MP / 64; t0 = 0; row0 = MP + b * 32; Lc = 32; }
}
DI void lru1_item(const Params& p, int l, int it, char* smem) {
  const int ci = it >> 3, nb = it & 7;
  bool isS; int b, row0, Lc, t0;
  lru_decode(ci, isS, b, row0, Lc, t0);
  const int tid = TID(), lane = tid & 63, wid = tid >> 6, fr = lane & 15, fq = lane >> 4;
  u16* xcs = (u16*)smem;
  u16* was = (u16*)(smem + 9216);
  u16* wxs = (u16*)(smem + 2 * 9216);
  float* as_ = (float*)(smem + 3 * 9216);
  float* us_ = (float*)(smem + 3 * 9216 + 16384);
  float* segP = (float*)(smem + 3 * 9216 + 32768);
  float* segH = (float*)(smem + 3 * 9216 + 32768 + 1024);
  const float* LX = (const float*)(p.ws + O_LX);
  const u16* Wl = (const u16*)(p.ws + O_WT) + (size_t)l * W_LAYER;
  const int i = tid & 63, tq = tid >> 6, ch = nb * 64 + i;
  __syncthreads();
  {
    const float* cw = p.in[15] + (size_t)l * 4 * 512 + ch;
    const float w0 = cw[0], w1 = cw[512], w2 = cw[1024], w3 = cw[1536], cb = p.in[16][(size_t)l * 512 + ch];
    const float* buf = isS ? p.in[5] + ((size_t)l * SBT + b) * 3 * 512 + ch : nullptr;
    float x[19];
#pragma unroll
    for (int j = 0; j < 19; ++j) {
      const int tl = tq * 16 - 3 + j;
      const int tt = t0 + tl;
      float v = 0.f;
      if (tl < Lc) {
        if (tt >= 0) v = LX[(size_t)(row0 + tl) * 512 + ch];
        else if (isS) v = buf[(3 + tt) * 512];
      }
      x[j] = v;
    }
#pragma unroll
    for (int k = 0; k < 16; ++k) {
      const int t = tq * 16 + k;
      const float xv = (t < Lc) ? cb + w0 * x[k] + w1 * x[k + 1] + w2 * x[k + 2] + w3 * x[k + 3] : 0.f;
      xcs[t * LP + i] = f2bf(xv);
    }
#pragma unroll
    for (int k = 0; k < 2; ++k) {
      const int id = tid + k * 256, r = id >> 3, c8 = id & 7;
      *(uint4*)(was + r * LP + c8 * 8) = *(const uint4*)(Wl + W_WA + nb * 4096 + r * 64 + c8 * 8);
      *(uint4*)(wxs + r * LP + c8 * 8) = *(const uint4*)(Wl + W_WX + nb * 4096 + r * 64 + c8 * 8);
    }
    const int T = isS ? STT : PT;
    if (t0 + Lc == T && tid < 192) {
      const int k = tid >> 6;
      const float v = LX[(size_t)(row0 + Lc - 3 + k) * 512 + ch];
      if (isS) p.out[LC_S + (((size_t)l * SBT + b) * 3 + k) * 512 + ch] = v;
      else p.out[LC_P + (((size_t)l * PB + b) * 3 + k) * 512 + ch] = v;
    }
  }
  __syncthreads();
  {
    const float* ba = p.in[18] + (size_t)l * 512 + nb * 64;
    const float* bx = p.in[20] + (size_t)l * 512 + nb * 64;
    const float* lm = p.in[21] + (size_t)l * 512 + nb * 64;
#pragma unroll
    for (int n = 0; n < 4; ++n) {
      f32x4 r = lds_mm<2>(xcs, LP, wid * 16, was, LP, n * 16, f32x4{0.f, 0.f, 0.f, 0.f});
      f32x4 g = lds_mm<2>(xcs, LP, wid * 16, wxs, LP, n * 16, f32x4{0.f, 0.f, 0.f, 0.f});
      const int j = n * 16 + fr;
      const float sp = softplusf_(-lm[j]), bav = ba[j], bxv = bx[j];
#pragma unroll
      for (int q = 0; q < 4; ++q) {
        const int t = wid * 16 + fq * 4 + q;
        const float rr = sigmoidf_(r[q] + bav), ii = sigmoidf_(g[q] + bxv);
        const float la = -8.f * rr * sp;
        const float a = __expf(la);
        const float x2 = 2.f * la;
        const float om = (x2 > -0.01f) ? -x2 * (1.f + x2 * (0.5f + x2 * (1.f / 6.f))) : 1.f - __expf(x2);
        const float u = sqrtf(om) * ii * bf2f(xcs[t * LP + j]);
        as_[t * 64 + j] = a;
        us_[t * 64 + j] = u;
      }
    }
  }
  __syncthreads();
  {
    float av[16], uv[16];
#pragma unroll
    for (int k = 0; k < 16; ++k) { av[k] = as_[(tq * 16 + k) * 64 + i]; uv[k] = us_[(tq * 16 + k) * 64 + i]; }
    float P = 1.f, hh = 0.f;
#pragma unroll
    for (int k = 0; k < 16; ++k) { P *= av[k]; hh = av[k] * hh + uv[k]; }
    segP[tq * 64 + i] = P; segH[tq * 64 + i] = hh;
    __syncthreads();
    float Pin = 1.f, hin = 0.f;
    for (int g = 0; g < tq; ++g) { const float pg = segP[g * 64 + i], hg = segH[g * 64 + i]; hin = pg * hin + hg; Pin *= pg; }
    u16* HL = (u16*)(p.ws + O_HL);
    u16* PPp = (u16*)(p.ws + O_PP);
    P = Pin; hh = hin;
#pragma unroll
    for (int k = 0; k < 16; ++k) {
      const int t = tq * 16 + k;
      P *= av[k]; hh = av[k] * hh + uv[k];
      if (t < Lc) {
        HL[(size_t)(row0 + t) * 512 + ch] = f2bf(hh);
        PPp[(size_t)(row0 + t) * 512 + ch] = f2bf(P);
      }
    }
    if (tq * 16 + 16 == Lc) {
      ((float*)(p.ws + O_CA))[(size_t)ci * 512 + ch] = P;
      ((float*)(p.ws + O_CH))[(size_t)ci * 512 + ch] = hh;
    }
  }
}
constexpr int L2_ITEMS = 8 + 32;
DI void lru2_item(const Params& p, int l, int it) {
  const float* CA = (const float*)(p.ws + O_CA);
  const float* CH = (const float*)(p.ws + O_CH);
  float* HS = (float*)(p.ws + O_HS);
  if (it < 8) {
    const int e = it * 256 + TID(), b = e >> 9, ch = e & 511;
    float hh = 0.f;
    for (int c0 = 0; c0 < 128; c0 += 16) {
      float ca[16], chv[16];
#pragma unroll
      for (int c = 0; c < 16; ++c) { const size_t o = (size_t)(b * 128 + c0 + c) * 512 + ch; ca[c] = CA[o]; chv[c] = CH[o]; }
#pragma unroll
      for (int c = 0; c < 16; ++c) { const size_t o = (size_t)(b * 128 + c0 + c) * 512 + ch; HS[o] = hh; hh = ca[c] * hh + chv[c]; }
    }
    p.out[LH_P + ((size_t)l * PB + b) * 512 + ch] = hh;
  } else {
    const int e = (it - 8) * 256 + TID(), b = e >> 9, ch = e & 511;
    const float h0 = p.in[6][((size_t)l * SBT + b) * 512 + ch];
    const size_t o = (size_t)(MP / 64 + b) * 512 + ch;
    HS[o] = h0;
    p.out[LH_S + ((size_t)l * SBT + b) * 512 + ch] = CA[o] * h0 + CH[o];
  }
}
constexpr int L3_ITEMS = MT / 8;
DI void lru3_item(const Params& p, int it) {
  const u16* HL = (const u16*)(p.ws + O_HL);
  const u16* PPp = (const u16*)(p.ws + O_PP);
  const u16* LG = (const u16*)(p.ws + O_LG);
  const float* HS = (const float*)(p.ws + O_HS);
  u16* OL = (u16*)(p.ws + O_OL);
#pragma unroll
  for (int i = 0; i < 4; ++i) {
    const int id = TID() + i * 256;
    const int row = it * 8 + (id >> 7), c4 = (id & 127) * 4;
    const int ci = row < MP ? (row >> 6) : MP / 64 + ((row - MP) >> 5);
    const size_t o = (size_t)row * 512 + c4;
    const uint2 hl = *(const uint2*)(HL + o), pp = *(const uint2*)(PPp + o), lg = *(const uint2*)(LG + o);
    const float4 hs = *(const float4*)(HS + (size_t)ci * 512 + c4);
    float y0 = (bf2f(hl.x & 0xffff) + bf2f(pp.x & 0xffff) * hs.x) * gelu_tanh(bf2f(lg.x & 0xffff));
    float y1 = (bf2f(hl.x >> 16) + bf2f(pp.x >> 16) * hs.y) * gelu_tanh(bf2f(lg.x >> 16));
    float y2 = (bf2f(hl.y & 0xffff) + bf2f(pp.y & 0xffff) * hs.z) * gelu_tanh(bf2f(lg.y & 0xffff));
    float y3 = (bf2f(hl.y >> 16) + bf2f(pp.y >> 16) * hs.w) * gelu_tanh(bf2f(lg.y >> 16));
    *(uint2*)(OL + o) = uint2{pack2(y0, y1), pack2(y2, y3)};
  }
}

DI void ybr_tile(const Params& p, int l, int mt, int nt, char* smem) {
  const int row0 = mt * 256, col0 = nt * 256, br = nt >> 2;
  const u16* W = (const u16*)(p.ws + O_WT) + (size_t)l * W_LAYER + W_BR + (size_t)br * 1024 * 512 + (size_t)((nt & 3) * 256) * 512;
  const u16* O = (const u16*)(p.ws + (br == 0 ? O_OA : (br == 1 ? O_OG : O_OL))) + (size_t)row0 * 512;
  f32x4 acc[8][4];
  zero_acc8(acc);
  gemm512(O, 512, W, 512, 512, acc, smem);
  tile_out_bf16<false>(acc, (u16*)(p.ws + O_YP) + (size_t)row0 * 3072 + col0, 3072, smem, 1.f, 0, nullptr);
}
DI void gate_tile(const Params& p, int l, int mt, int nt, char* smem) {
  const int row0 = mt * 256, col0 = nt * 256;
  const u16* W = (const u16*)(p.ws + O_WT) + (size_t)l * W_LAYER + W_MG + (size_t)col0 * LDK;
  f32x4 acc[8][4];
  zero_acc8(acc);
  gemm512((const u16*)(p.ws + O_XN) + (size_t)row0 * LDK, LDK, W, LDK, 1024, acc, smem);
  EPI_IDS;
  u16* Y = (u16*)(p.ws + O_YP) + (size_t)row0 * 3072 + col0;
  const float* bm = p.in[26] + (size_t)l * 3072 + col0 + wc * 64 + fr;
  img_load_bf16(Y, 3072, smem, 256, 0);
  img_barrier();
  u16* img = (u16*)smem + (wr * 128 + fq * 4) * IMG_LD + wc * 64 + fr;
#pragma unroll
  for (int n = 0; n < 4; ++n) {
    const float bv = bm[n * 16];
#pragma unroll
    for (int m = 0; m < 8; ++m)
#pragma unroll
      for (int j = 0; j < 4; ++j) {
        u16* q = img + (m * 16 + j) * IMG_LD + n * 16;
        *q = f2bf(sigmoidf_(acc[m][n][j] + bv) * bf2f(*q));
      }
  }
  img_barrier();
  img_store_bf16(Y, 3072, smem, 0);
}
DI void resid_tile(const Params& p, const u16* A, int ldk, const u16* W, int mt, int nt, int k0, int klen, bool atomic, char* smem) {
  const int row0 = mt * 256, col0 = nt * 256;
  f32x4 acc[8][4];
  zero_acc8(acc);
  gemm512(A + (size_t)row0 * ldk + k0, ldk, W + (size_t)col0 * ldk + k0, ldk, klen, acc, smem);
  if (!atomic) { tile_out_f32<true, false>(acc, p.out + (size_t)row0 * 1024 + col0, 1024, smem, 0, nullptr); return; }
  EPI_IDS;
#pragma unroll
  for (int m = 0; m < 8; ++m) {
    asm volatile("" ::: "memory");
#pragma unroll
    for (int n = 0; n < 4; ++n)
#pragma unroll
      for (int j = 0; j < 4; ++j) {
        const int row = row0 + wr * 128 + m * 16 + fq * 4 + j, col = col0 + wc * 64 + n * 16 + fr;
        float* q = p.out + (size_t)row * 1024 + col;
        if (atomic) unsafeAtomicAdd(q, acc[m][n][j]); else *q += acc[m][n][j];
      }
  }
}
DI void resid_phase(const Params& p, const u16* A, int ldk, const u16* W, int B, int G, char* smem) {
  const int ns = ldk / 256;
  int k = 0, u = B;
  while (true) {
    int mt, nt, k0 = 0, kl = ldk;
    bool at = false;
    if (xcd_tile(B, G, k, 128, 4, mt, nt)) { ++k; }
    else if (u < 8 * ns) { const int t = u / ns, sl = u - t * ns; mt = 128 + (t >> 2); nt = t & 3; k0 = sl * 256; kl = 256; at = true; u += G; }
    else break;
    asm volatile("" : "+s"(kl));
    resid_tile(p, A, ldk, W, mt, nt, k0, kl, at, smem);
  }
}

DI void ffgate_tile(const Params& p, int l, int mt, int nt, char* smem) {
  const int row0 = mt * 256, col0 = nt * 256;
  const u16* W = (const u16*)(p.ws + O_WT) + (size_t)l * W_LAYER + W_FG;
  f32x4 acc[8][4];
  zero_acc8(acc);
  gemm512((const u16*)(p.ws + O_XN) + (size_t)row0 * LDK, LDK, W + (size_t)col0 * LDK, LDK, 1024, acc, smem);
  if (mt < 128) {
    EPI_IDS;
    tile_out_bf16<false>(acc, (u16*)(p.ws + O_GU) + (size_t)row0 * DFF + col0, DFF, smem, 1.f, 0, nullptr);
    if (((row0 + 256) & 8191) == 0 && wr == 1 && fq == 3) {
      const int b = row0 >> 13;
#pragma unroll
      for (int n = 0; n < 4; ++n) {
        const int col = col0 + wc * 64 + n * 16 + fr;
        p.out[FC_P + (((size_t)l * PB + b) * 2 + 0) * DFF + col] = acc[7][n][2];
        p.out[FC_P + (((size_t)l * PB + b) * 2 + 1) * DFF + col] = acc[7][n][3];
      }
    }
    return;
  }
  EPI_IDS;
  u16* GU = (u16*)(p.ws + O_GU);
  const bool isS = row0 >= MP;
#pragma unroll
  for (int m = 0; m < 8; ++m) {
    asm volatile("" ::: "memory");
#pragma unroll
    for (int n = 0; n < 4; ++n)
#pragma unroll
      for (int j = 0; j < 4; ++j) {
        const int row = row0 + wr * 128 + m * 16 + fq * 4 + j, col = col0 + wc * 64 + n * 16 + fr;
        const float v = acc[m][n][j];
        GU[(size_t)row * DFF + col] = f2bf(v);
        if (isS) {
          const int rs = row - MP, b = rs >> 5, t = rs & 31;
          if (t >= STT - 2) p.out[FC_S + (((size_t)l * SBT + b) * 2 + (t - (STT - 2))) * DFF + col] = v;
        } else {
          const int b = row >> 13, t = row & 8191;
          if (t >= PT - 2) p.out[FC_P + (((size_t)l * PB + b) * 2 + (t - (PT - 2))) * DFF + col] = v;
        }
      }
  }
}
DI void ffup_tile(const Params& p, int l, int mt, int nt, char* smem) {
  const int row0 = mt * 256, col0 = nt * 256;
  const u16* W = (const u16*)(p.ws + O_WT) + (size_t)l * W_LAYER + W_FU;
  f32x4 acc[8][4];
  zero_acc8(acc);
  gemm512((const u16*)(p.ws + O_XN) + (size_t)row0 * LDK, LDK, W + (size_t)col0 * LDK, LDK, 1024, acc, smem);
  if (mt < 128) {
    EPI_IDS;
    const u16* GUt = (const u16*)(p.ws + O_GU) + (size_t)row0 * DFF + col0;
    if (row0 >= 2) img_load_bf16(GUt - 2 * DFF, DFF, smem, 258, 0); else img_load_bf16(GUt, DFF, smem, 256, 2);
    img_barrier();
    const u16* img = (const u16*)smem + (wr * 128 + fq * 4) * IMG_LD + wc * 64 + fr;
#pragma unroll
    for (int n = 0; n < 4; ++n) {
      const int col = col0 + wc * 64 + n * 16 + fr;
      const float* cw = p.in[30] + (size_t)l * 3 * DFF + col;
      const float w0 = cw[0], w1 = cw[DFF], w2 = cw[2 * DFF], cb = p.in[31][(size_t)l * DFF + col];
#pragma unroll
      for (int m = 0; m < 8; ++m) {
        if ((m & 1) == 0) asm volatile("" ::: "memory");
        const int t = (row0 + wr * 128 + m * 16 + fq * 4) & 8191;
        float g[6];
#pragma unroll
        for (int d = 0; d < 6; ++d) { const float gv = bf2f(img[(m * 16 + d) * IMG_LD + n * 16]); g[d] = (d >= 2 || t - 2 + d >= 0) ? gv : 0.f; }
#pragma unroll
        for (int j = 0; j < 4; ++j) acc[m][n][j] *= gelu_tanh(cb + w0 * g[j] + w1 * g[j + 1] + w2 * g[j + 2]);
      }
    }
    img_barrier();
    img_put_bf16<false>(acc, smem, 2, 1.f, 0, nullptr);
    img_barrier();
    img_store_bf16((u16*)(p.ws + O_FF) + (size_t)row0 * DFF + col0, DFF, smem, 2);
    return;
  }
  EPI_IDS;
  const u16* GU = (const u16*)(p.ws + O_GU);
  u16* FF = (u16*)(p.ws + O_FF);
  const bool isS = row0 >= MP;
  const int rowq = row0 + wr * 128 + fq * 4;
  const unsigned gbase = (unsigned)rowq * (unsigned)DFF + (unsigned)(col0 + wc * 64 + fr);
#pragma unroll
  for (int n = 0; n < 4; ++n) {
    const int col = col0 + wc * 64 + n * 16 + fr;
    const float* cw = p.in[30] + (size_t)l * 3 * DFF + col;
    const float w0 = cw[0], w1 = cw[DFF], w2 = cw[2 * DFF], cb = p.in[31][(size_t)l * DFF + col];
#pragma unroll
    for (int mh = 0; mh < 2; ++mh) {
      asm volatile("" ::: "memory");
      float g[4][6];
#pragma unroll
      for (int m = 0; m < 4; ++m) {
        const int rowb = rowq + (mh * 4 + m) * 16;
        int b, t;
        if (isS) { int rs = rowb - MP; b = rs >> 5; t = rs & 31; } else { b = rowb >> 13; t = rowb & 8191; }
#pragma unroll
        for (int d = 0; d < 6; ++d) {
          const int tt = t - 2 + d;
          if (tt >= 0) g[m][d] = bf2f(GU[gbase + (unsigned)((((mh * 4 + m) * 16 + d) * DFF) + n * 16) - 2u * (unsigned)DFF]);
          else g[m][d] = isS ? p.in[7][(((size_t)l * SBT + b) * 2 + (2 + tt)) * DFF + col] : 0.f;
        }
      }
#pragma unroll
      for (int m = 0; m < 4; ++m)
#pragma unroll
        for (int j = 0; j < 4; ++j) {
          const float gc = cb + w0 * g[m][j] + w1 * g[m][j + 1] + w2 * g[m][j + 2];
          FF[gbase + (unsigned)((((mh * 4 + m) * 16 + j) * DFF) + n * 16)] = f2bf(gelu_tanh(gc) * acc[mh * 4 + m][n][j]);
        }
    }
  }
}

DI void norm_phase(const Params& p, int l, int mode, int B, int G, char* smem) {
  const int tid = TID512(), lane = tid & 63, wid = tid >> 6;
  const float* gamma = mode == 0 ? p.in[8] + (size_t)l * 1024 : (mode == 1 ? p.in[28] + (size_t)l * 1024 : p.in[34]);
  float* wga = (float*)smem;
  if (mode == 0) {
    __syncthreads();
    const float* src = p.in[9] + (size_t)l * 1024 * PW + 3072;
#pragma unroll
    for (int i = 0; i < 8; ++i) {
      const int id = tid + i * 512, k = id >> 2, part = id & 3;
      ((float4*)wga)[(((k >> 8) * 4 + (k & 3)) * 4 + part) * 64 + ((k >> 2) & 63)] = *(const float4*)(src + (size_t)k * PW + part * 4);
    }
    __syncthreads();
  }
  float4 g[4];
#pragma unroll
  for (int i = 0; i < 4; ++i) g[i] = *(const float4*)(gamma + i * 256 + lane * 4);
  for (int row = B * 8 + wid; row < MT; row += G * 8) {
    float* X = p.out + (size_t)row * 1024;
    float4 v[4];
    float ss = 0.f;
#pragma unroll
    for (int i = 0; i < 4; ++i) { v[i] = *(const float4*)(X + i * 256 + lane * 4); ss += v[i].x * v[i].x + v[i].y * v[i].y + v[i].z * v[i].z + v[i].w * v[i].w; }
    ss = wave_sum(ss);
    const float rs = rsqrtf(ss * (1.f / 1024.f) + EPS);
    u16* XN = (u16*)(p.ws + O_XN) + (size_t)row * LDK;
#pragma unroll
    for (int i = 0; i < 4; ++i) {
      v[i] = float4{v[i].x * rs * g[i].x, v[i].y * rs * g[i].y, v[i].z * rs * g[i].z, v[i].w * rs * g[i].w};
      if (mode == 2) *(float4*)(X + i * 256 + lane * 4) = v[i];
      else *(uint2*)(XN + i * 256 + lane * 4) = uint2{pack2(v[i].x, v[i].y), pack2(v[i].z, v[i].w)};
    }
    if (mode == 0) {
      float ga[16];
#pragma unroll
      for (int r = 0; r < 16; ++r) ga[r] = 0.f;
#pragma unroll
      for (int i = 0; i < 4; ++i) {
        const float xv[4] = {v[i].x, v[i].y, v[i].z, v[i].w};
#pragma unroll
        for (int e = 0; e < 4; ++e) {
          asm volatile("" ::: "memory");
#pragma unroll
          for (int q = 0; q < 4; ++q) {
            const float4 w = ((const float4*)wga)[((i * 4 + e) * 4 + q) * 64 + lane];
            ga[q * 4 + 0] += xv[e] * w.x; ga[q * 4 + 1] += xv[e] * w.y; ga[q * 4 + 2] += xv[e] * w.z; ga[q * 4 + 3] += xv[e] * w.w;
          }
        }
      }
      float mine = 0.f;
#pragma unroll
      for (int r = 0; r < 16; ++r) { const float s = wave_sum(ga[r]); if (lane == r) mine = s; }
      if (lane < 16) ((float*)(p.ws + O_GA))[(size_t)row * 16 + lane] = mine;
    }
  }
}

#define XB_TMO      128
#define XB_XCNT(j)  (256  + 64 * (j))
#define XB_XSUB(j)  (1280 + 64 * (j))
#define XB_XGEN(j)  (2304 + 64 * (j))
#define XB_TOP      3328
#define XB_TOPGEN   3392
#define XCD_BAR_WORDS 3456
#define XB_SPIN_CAP (1u << 18)
#define LAS __attribute__((address_space(3)))

__device__ __forceinline__ unsigned xb_ld(unsigned* p)              { return __hip_atomic_load(p, __ATOMIC_RELAXED, __HIP_MEMORY_SCOPE_AGENT); }
__device__ __forceinline__ unsigned xb_add(unsigned* p, unsigned v) { return __hip_atomic_fetch_add(p, v, __ATOMIC_RELAXED, __HIP_MEMORY_SCOPE_AGENT); }
__device__ __forceinline__ unsigned xb_xcc_id() { return (unsigned)__builtin_amdgcn_s_getreg((3 << 11) | 20) & 0xFu; }
#define XB_SPIN(cond, bar) do { unsigned _sp = 0; while (cond) { __builtin_amdgcn_s_sleep(1); \
    if ((++_sp & 255u) == 0u) { if (xb_ld(&(bar)[XB_TMO])) break; if (_sp > XB_SPIN_CAP) { atomicAdd(&(bar)[XB_TMO], 1u); break; } } } } while (0)

struct XcdBarrier {
    unsigned* bar; unsigned x;
    volatile LAS unsigned* st;
};

__device__ __forceinline__ XcdBarrier xcd_barrier_post(unsigned* bar, volatile LAS unsigned* st) {
    XcdBarrier b; b.bar = bar; b.x = xb_xcc_id(); b.st = st;
    if (threadIdx.x == 0) (void)xb_add(&bar[XB_XCNT(b.x)], 1u);
    return b;
}
__device__ __forceinline__ void xcd_barrier_complete(unsigned* bar, unsigned x, unsigned& nloc, unsigned& nx) {
    const unsigned G = gridDim.x * gridDim.y * gridDim.z;
    unsigned sum, cnt, mine, sp = 0u;
    for (;;) {
        sum = 0u; cnt = 0u; mine = 0u;
#pragma unroll
        for (unsigned j = 0; j < 16; ++j) { const unsigned c = xb_ld(&bar[XB_XCNT(j)]); sum += c; cnt += (c > 0u) ? 1u : 0u; mine = (j == x) ? c : mine; }
        if (sum == G) break;
        __builtin_amdgcn_s_sleep(1);
        if ((++sp & 255u) == 0u) { if (xb_ld(&bar[XB_TMO])) break; if (sp > XB_SPIN_CAP) { atomicAdd(&bar[XB_TMO], 1u); break; } }
    }
    nloc = mine > 0u ? mine : 1u; nx = cnt > 0u ? cnt : 1u;
}

__device__ __forceinline__ void xcd_barrier(const XcdBarrier& b) {
    asm volatile("s_waitcnt vmcnt(0)" ::: "memory");
    __syncthreads();
    if (threadIdx.x == 0) {
        unsigned* bar = b.bar;
        __builtin_amdgcn_s_waitcnt(0);
        unsigned nloc = b.st[0], nx = b.st[1];
        if (nloc == 0u) { xcd_barrier_complete(bar, b.x, nloc, nx); b.st[0] = nloc; b.st[1] = nx; }
        const unsigned old = xb_add(&bar[XB_XSUB(b.x)], 1u);
        const unsigned gen = old / nloc;
        if (old + 1u == (gen + 1u) * nloc) {
            __builtin_amdgcn_fence(__ATOMIC_RELEASE, "agent");
            asm volatile("s_waitcnt vmcnt(0)" ::: "memory");
            const unsigned og = xb_add(&bar[XB_TOP], 1u);
            const unsigned tg = og / nx;
            if (og + 1u == (tg + 1u) * nx) xb_add(&bar[XB_TOPGEN], 1u);
            else XB_SPIN(xb_ld(&bar[XB_TOPGEN]) == tg, bar);
            __builtin_amdgcn_fence(__ATOMIC_ACQUIRE, "agent");
            xb_add(&bar[XB_XGEN(b.x)], 1u);
            asm volatile("s_waitcnt vmcnt(0)" ::: "memory");
        } else {
            XB_SPIN(xb_ld(&bar[XB_XGEN(b.x)]) == gen, bar);
            __builtin_amdgcn_fence(__ATOMIC_ACQUIRE, "agent");
            asm volatile("s_waitcnt vmcnt(0)" ::: "memory");
        }
    }
    __syncthreads();
}


#ifndef ONLY
#define ONLY -1
#endif
constexpr int HALF_LDS = 73728;
constexpr int SMEM_BYTES = 2 * HALF_LDS;
#define VB() (2 * B + (TID512() >> 8))
#define HS() (smem + (TID512() >> 8) * HALF_LDS)
__global__ void __launch_bounds__(512, 2) mega(Params p) {
  cg::grid_group grid = cg::this_grid();
  extern __shared__ __attribute__((aligned(16))) char smem[];
  const int G = gridDim.x, B = blockIdx.x;
  __shared__ __attribute__((aligned(16))) unsigned xb_words[4];
  if (threadIdx.x < 4) xb_words[threadIdx.x] = 0u;
  __syncthreads();
  const XcdBarrier xb = xcd_barrier_post((unsigned*)(p.ws + O_BAR), (volatile LAS unsigned*)xb_words);
  const int vG = 2 * G;
  if (ONLY < 0 || ONLY == 0) for (int it = VB(); it < PREP_ITEMS; it += vG) prep_item(p, it, HS());
  grid.sync();
  for (int l = 0; l < NL; ++l) {
    const u16* W = (const u16*)(p.ws + O_WT) + (size_t)l * W_LAYER;
    if (ONLY < 0 || ONLY == 1) norm_phase(p, l, 0, B, G, smem);
    xcd_barrier(xb);
    if (ONLY < 0 || ONLY == 2) { int mt, nt; for (int k = 0; xcd_tile(B, G, k, 130, 16, mt, nt); ++k) projin_tile(p, l, mt, nt, smem); for (int it = VB(); it < PB_KC + PB_VC; it += vG) cache_conv_item(p, l, it, HS()); }
    xcd_barrier(xb);
    if (ONLY < 0 || ONLY == 3) {
      for (int k = 0; k < (G == 256 ? 5 : (1088 + G - 1) / G); ++k) {
        bool isS = false; int bh = 0, cp = 0; bool have = true;
        if (G == 256) {
          const int q = B >> 4; bh = B & 15;
          if (k == 0) cp = 63 - q; else if (k == 1) cp = 32 + q; else if (k == 2) cp = 31 - q;
          else if (k == 3) { if (q <= 11) cp = q + 4; else { isS = true; bh = (q - 12) * 16 + (B & 15); } }
          else { if (q >= 12) cp = q - 12; else have = false; }
        } else {
          const int it = B + k * G;
          if (it >= 1088) have = false; else if (it < 1024) { cp = it >> 4; bh = it & 15; } else { isS = true; bh = it - 1024; }
        }
        if (have) attn_item(p, l, isS, isS ? (bh >> 2) : (bh >> 2), bh & 3, cp, smem);
      }
    }
    if (ONLY < 0 || ONLY == 13) for (int it = VB(); it < NGI; it += vG) gla1_item(p, l, it, HS());
    if (ONLY < 0 || ONLY == 14) for (int it = VB(); it < L1_ITEMS; it += vG) lru1_item(p, l, it, HS());
    xcd_barrier(xb);
    if (ONLY < 0 || ONLY == 4) for (int it = VB(); it < G2_ITEMS + L2_ITEMS; it += vG) { if (it < G2_ITEMS) gla2_item(p, l, it); else lru2_item(p, l, it - G2_ITEMS); }
    xcd_barrier(xb);
    if (ONLY < 0 || ONLY == 5) { for (int it = VB(); it < NGI; it += vG) gla3_item(p, l, it, HS()); for (int it = VB(); it < L3_ITEMS; it += vG) lru3_item(p, it); }
    xcd_barrier(xb);
    if (ONLY < 0 || ONLY == 6) { int mt, nt; for (int k = 0; xcd_tile(B, G, k, 130, 12, mt, nt); ++k) ybr_tile(p, l, mt, nt, smem); }
    xcd_barrier(xb);
    if (ONLY < 0 || ONLY == 7) { int mt, nt; for (int k = 0; xcd_tile(B, G, k, 130, 12, mt, nt); ++k) gate_tile(p, l, mt, nt, smem); }
    xcd_barrier(xb);
    if (ONLY < 0 || ONLY == 8) resid_phase(p, (const u16*)(p.ws + O_YP), 3072, W + W_OUT, B, G, smem);
    xcd_barrier(xb);
    if (ONLY < 0 || ONLY == 9) norm_phase(p, l, 1, B, G, smem);
    xcd_barrier(xb);
    if (ONLY < 0 || ONLY == 10) { int mt, nt; for (int k = 0; xcd_tile(B, G, k, 130, 11, mt, nt); ++k) ffgate_tile(p, l, mt, nt, smem); }
    xcd_barrier(xb);
    if (ONLY < 0 || ONLY == 11) { int mt, nt; for (int k = 0; xcd_tile(B, G, k, 130, 11, mt, nt); ++k) ffup_tile(p, l, mt, nt, smem); }
    xcd_barrier(xb);
    if (ONLY < 0 || ONLY == 12) resid_phase(p, (const u16*)(p.ws + O_FF), DFF, W + W_FD, B, G, smem);
    xcd_barrier(xb);
  }
  if (ONLY < 0 || ONLY == 15) norm_phase(p, 0, 2, B, G, smem);
}

extern "C" void kernel_launch(void* const* d_in, const int* in_sizes, int n_in, void* d_out, int out_size, void* d_ws, size_t ws_size,
                              hipStream_t stream) {
  static int grid_blocks = 0;
  if (!grid_blocks) {
    int dev = 0, cus = 0, per = 0;
    (void)hipGetDevice(&dev);
    (void)hipDeviceGetAttribute(&cus, hipDeviceAttributeMultiprocessorCount, dev);
    (void)hipFuncSetAttribute((const void*)mega, hipFuncAttributeMaxDynamicSharedMemorySize, SMEM_BYTES);
    (void)hipOccupancyMaxActiveBlocksPerMultiprocessor(&per, mega, 512, SMEM_BYTES);
    if (per < 1) per = 1;
    grid_blocks = cus;
  }
  if (ws_size < WS_NEED) fprintf(stderr, "workspace too small: %zu < %zu\n", ws_size, (size_t)WS_NEED);
  Params p{};
  for (int i = 0; i < 35; ++i) p.in[i] = (const float*)d_in[i];
  p.out = (float*)d_out;
  p.ws = (char*)d_ws;
  (void)hipMemsetAsync((char*)d_ws + O_BAR, 0, XCD_BAR_WORDS * sizeof(unsigned), stream);
  void* args[] = {&p};
  hipError_t e = hipLaunchCooperativeKernel((void*)mega, dim3(grid_blocks), dim3(512), args, SMEM_BYTES, stream);
  if (e != hipSuccess) fprintf(stderr, "cooperative launch failed: %s (grid %d)\n", hipGetErrorString(e), grid_blocks);
}
```

```cpp
#include <hip/hip_runtime.h>
#include <hip/hip_cooperative_groups.h>
#include <cstdio>
namespace cg = cooperative_groups;

#define DI __device__ __forceinline__
typedef unsigned short u16;
using bf16x8 = __attribute__((ext_vector_type(8))) short;
using f32x4 = __attribute__((ext_vector_type(4))) float;
using u32x4 = __attribute__((ext_vector_type(4))) unsigned;
#define MFMA16(a, b, c) __builtin_amdgcn_mfma_f32_16x16x32_bf16((a), (b), (c), 0, 0, 0)

constexpr int DM = 1024, PB = 4, PT = 8192, SBT = 16, STT = 32, PAST = 2048, NL = 4;
constexpr int MP = PB * PT, MS = SBT * STT, MT = MP + MS;
constexpr int SKP = 2112;
constexpr int SKV = PAST + STT;
constexpr int DFF = 2816, PW = 4112, PWP = 4224;
constexpr int NGI = PB * 4 * 128 + SBT * 4;
constexpr int NLC = MP / 64 + SBT;
constexpr float EPS = 1e-6f;
constexpr float QSCALE = 0.125f * 1.4426950408889634f;
constexpr int LDK = 1088;

constexpr size_t W_IN = 0, W_MG = W_IN + (size_t)4096 * LDK, W_BR = W_MG + (size_t)3072 * LDK, W_OUT = W_BR + (size_t)3 * 1024 * 512,
                 W_FG = W_OUT + (size_t)1024 * 3072, W_FU = W_FG + (size_t)DFF * LDK, W_FD = W_FU + (size_t)DFF * LDK,
                 W_WA = W_FD + (size_t)1024 * DFF, W_WX = W_WA + 32768, W_LAYER = W_WX + 32768;

struct Params {
  const float* in[35];
  float* out;
  char* ws;
};

constexpr size_t al(size_t x) { return (x + 255) & ~(size_t)255; }
constexpr size_t O_WT = 0;
constexpr size_t O_ROPE = al(O_WT + W_LAYER * NL * 2);
constexpr size_t O_LAM = al(O_ROPE + 2 * 8192 * 8 * 4);
constexpr size_t O_BAR = al(O_LAM + 256);
constexpr size_t O_XN = al(O_BAR + 4096 * 4);
constexpr size_t O_REG = al(O_XN + (size_t)MT * LDK * 2);
constexpr size_t O_QB = O_REG;
constexpr size_t O_KB = al(O_QB + (size_t)MT * 512 * 2);
constexpr size_t O_KS = al(O_KB + (size_t)MP * 512 * 2);
constexpr size_t O_VT = al(O_KS + (size_t)SBT * SKP * 512 * 2);
constexpr size_t O_VTS = al(O_VT + (size_t)MP * 512 * 2);
constexpr size_t O_GQ = al(O_VTS + (size_t)SBT * SKP * 512 * 2);
constexpr size_t O_GK = al(O_GQ + (size_t)MT * 256 * 2);
constexpr size_t O_GV = al(O_GK + (size_t)MT * 256 * 2);
constexpr size_t O_GR = al(O_GV + (size_t)MT * 512 * 2);
constexpr size_t O_GA = al(O_GR + (size_t)MT * 512 * 2);
constexpr size_t O_LX = al(O_GA + (size_t)MT * 16 * 4);
constexpr size_t O_LG = al(O_LX + (size_t)MT * 512 * 4);
constexpr size_t O_KVT = al(O_LG + (size_t)MT * 512 * 2);
constexpr size_t O_DEC = al(O_KVT + (size_t)NGI * 8192 * 2);
constexpr size_t O_HL = al(O_DEC + (size_t)NGI * 64 * 4);
constexpr size_t O_PP = al(O_HL + (size_t)MT * 512 * 2);
constexpr size_t O_CA = al(O_PP + (size_t)MT * 512 * 2);
constexpr size_t O_CH = al(O_CA + (size_t)NLC * 512 * 4);
constexpr size_t O_HS = al(O_CH + (size_t)NLC * 512 * 4);
constexpr size_t O_OA = al(O_HS + (size_t)NLC * 512 * 4);
constexpr size_t O_OG = al(O_OA + (size_t)MT * 512 * 2);
constexpr size_t O_OL = al(O_OG + (size_t)MT * 512 * 2);
constexpr size_t O_END1 = al(O_OL + (size_t)MT * 512 * 2);
constexpr size_t O_YP = O_QB;
static_assert(O_YP + (size_t)MT * 3072 * 2 <= O_OA, "Y buffer overlaps live mixer outputs");
constexpr size_t O_GU = O_REG;
constexpr size_t O_FF = al(O_GU + (size_t)MT * DFF * 2);
constexpr size_t O_END2 = al(O_FF + (size_t)MT * DFF * 2);
constexpr size_t WS_NEED = O_END1 > O_END2 ? O_END1 : O_END2;

constexpr size_t Y_P = 0, Y_S = Y_P + (size_t)MP * 1024, K_P = Y_S + (size_t)MS * 1024, V_P = K_P + (size_t)NL * MP * 512,
                 GLA_P = V_P + (size_t)NL * MP * 512, LC_P = GLA_P + (size_t)NL * PB * 32768, LH_P = LC_P + (size_t)NL * PB * 3 * 512,
                 FC_P = LH_P + (size_t)NL * PB * 512, K_S = FC_P + (size_t)NL * PB * 2 * DFF, V_S = K_S + (size_t)NL * MS * 512,
                 GLA_S = V_S + (size_t)NL * MS * 512, LC_S = GLA_S + (size_t)NL * SBT * 32768, LH_S = LC_S + (size_t)NL * SBT * 3 * 512,
                 FC_S = LH_S + (size_t)NL * SBT * 512, OUT_TOTAL = FC_S + (size_t)NL * SBT * 2 * DFF;

DI int TID() { int t = threadIdx.x & 255; asm volatile("" : "+v"(t)); return t; }
DI int TID512() { int t = threadIdx.x; asm volatile("" : "+v"(t)); return t; }
DI u16 f2bf(float x) { __bf16 h = (__bf16)x; return __builtin_bit_cast(u16, h); }
DI float bf2f(u16 h) { return __uint_as_float(((unsigned)h) << 16); }
typedef __bf16 bf16v2_t __attribute__((ext_vector_type(2)));
typedef float f32v2_t __attribute__((ext_vector_type(2)));
DI unsigned pack2(float a, float b) { f32v2_t v = {a, b}; bf16v2_t r = __builtin_convertvector(v, bf16v2_t); return __builtin_bit_cast(unsigned, r); }
DI float sigmoidf_(float x) { return __builtin_amdgcn_rcpf(1.f + __expf(-x)); }
DI float gelu_tanh(float x) { float u = 0.7978845608028654f * (x + 0.044715f * x * x * x); return x * sigmoidf_(2.f * u); }
DI float softplusf_(float x) { return fmaxf(x, 0.f) + __logf(1.f + __expf(-fabsf(x))); }
DI float quad_max(float v) {
  auto a = __builtin_amdgcn_permlane16_swap(__float_as_uint(v), __float_as_uint(v), false, false);
  v = fmaxf(__uint_as_float(a[0]), __uint_as_float(a[1]));
  auto b = __builtin_amdgcn_permlane32_swap(__float_as_uint(v), __float_as_uint(v), false, false);
  return fmaxf(__uint_as_float(b[0]), __uint_as_float(b[1]));
}
DI float wave_sum(float v) {
  for (int o = 32; o > 0; o >>= 1) v += __shfl_xor(v, o);
  return v;
}

DI void gemm512(const u16* __restrict__ A, int lda, const u16* __restrict__ B, int ldb, int K, f32x4 (&acc)[8][4], char* smem) {
  const int tid = TID512(), lane = tid & 63, wid = tid >> 6, wr = wid >> 2, wc = wid & 3, fr = lane & 15, fq = lane >> 4;
  const int lrow = tid >> 3;
  const int gch = (tid & 7) ^ ((lrow >> 1) & 7);
  const unsigned aov = (unsigned)(lrow * lda + gch * 8);
  const unsigned bov = (unsigned)(lrow * ldb + gch * 8);
  const int soff = tid * 16;
  const int sw = (fr >> 1) & 7;
  const int aoff = (wr * 128 + fr) * 128, boff = 32768 + (wc * 64 + fr) * 128;
  const int nk = K >> 6;
  asm volatile("s_waitcnt lgkmcnt(0)" ::: "memory");
  __builtin_amdgcn_s_barrier();
#pragma unroll
  for (int i = 0; i < 4; ++i) {
    __builtin_amdgcn_global_load_lds((const unsigned*)((A + (size_t)i * 64 * lda) + aov), (unsigned*)(smem + soff + i * 8192), 16, 0, 0);
    __builtin_amdgcn_global_load_lds((const unsigned*)((B + (size_t)i * 64 * ldb) + bov), (unsigned*)(smem + 32768 + soff + i * 8192), 16, 0, 0);
  }
  asm volatile("s_waitcnt vmcnt(0)" ::: "memory");
  __builtin_amdgcn_s_barrier();
  for (int kt = 0; kt < nk; ++kt) {
    const int buf = kt & 1;
    const bool more = kt + 1 < nk;
    char* st = smem + (buf ^ 1) * 65536 + soff;
    const u16* An = A + (kt + 1) * 64;
    const u16* Bn = B + (kt + 1) * 64;
    const char* Sb = smem + buf * 65536;
#pragma unroll
    for (int ks = 0; ks < 2; ++ks) {
      const int co = ((ks * 4 + fq) ^ sw) << 4;
      bf16x8 bfr[4], af[8];
#pragma unroll
      for (int n = 0; n < 4; ++n) bfr[n] = *(const bf16x8*)(Sb + boff + n * 2048 + co);
#pragma unroll
      for (int m = 0; m < 8; ++m) af[m] = *(const bf16x8*)(Sb + aoff + m * 2048 + co);
      __builtin_amdgcn_sched_barrier(0);
#pragma unroll
      for (int g = 0; g < 4; ++g) {
#pragma unroll
        for (int mm = 0; mm < 2; ++mm)
#pragma unroll
          for (int n = 0; n < 4; ++n) acc[g * 2 + mm][n] = MFMA16(af[g * 2 + mm], bfr[n], acc[g * 2 + mm][n]);
        __builtin_amdgcn_sched_barrier(0);
        if (more && ks == 0) {
          __builtin_amdgcn_global_load_lds((const unsigned*)((An + (size_t)g * 64 * lda) + aov), (unsigned*)(st + g * 8192), 16, 0, 0);
          __builtin_amdgcn_global_load_lds((const unsigned*)((Bn + (size_t)g * 64 * ldb) + bov), (unsigned*)(st + 32768 + g * 8192), 16, 0, 0);
        }
        __builtin_amdgcn_sched_barrier(0);
      }
    }
    asm volatile("s_waitcnt vmcnt(0) lgkmcnt(0)" ::: "memory");
    __builtin_amdgcn_s_barrier();
  }
}
DI void zero_acc8(f32x4 (&acc)[8][4]) {
#pragma unroll
  for (int m = 0; m < 8; ++m)
#pragma unroll
    for (int n = 0; n < 4; ++n) acc[m][n] = f32x4{0.f, 0.f, 0.f, 0.f};
}
#define EPI_IDS const int tid = TID512(), lane = tid & 63, wid = tid >> 6, wr = wid >> 2, wc = wid & 3, fr = lane & 15, fq = lane >> 4


constexpr int IMG_LD = 264;
constexpr int IMGF_LD = 260;
DI void img_barrier() { asm volatile("s_waitcnt lgkmcnt(0)" ::: "memory"); __builtin_amdgcn_s_barrier(); }
template <bool ROPE>
DI float epi_val(const f32x4 (&acc)[8][4], int m, int n, int j, const float* cs4, const float* sn4, int fr) {
  float v = acc[m][n][j];
  if (ROPE && n == 0) {
    const float pr = __shfl_xor(v, 8);
    v = (fr < 8) ? v * cs4[j] - pr * sn4[j] : v * cs4[j] + pr * sn4[j];
  }
  return v;
}
template <bool ROPE>
DI void img_put_bf16(const f32x4 (&acc)[8][4], char* smem, int rowoff, float scale, int prow0, const float* cosT) {
  EPI_IDS;
  u16* img = (u16*)smem + (wr * 128 + fq * 4 + rowoff) * IMG_LD + wc * 64 + fr;
#pragma unroll
  for (int m = 0; m < 8; ++m) {
    float cs4[4] = {0.f, 0.f, 0.f, 0.f}, sn4[4] = {0.f, 0.f, 0.f, 0.f};
    if (ROPE) {
#pragma unroll
      for (int j = 0; j < 4; ++j) { const int pos = prow0 + wr * 128 + m * 16 + fq * 4 + j; cs4[j] = cosT[pos * 8 + (fr & 7)]; sn4[j] = cosT[8192 * 8 + pos * 8 + (fr & 7)]; }
    }
#pragma unroll
    for (int n = 0; n < 4; ++n)
#pragma unroll
      for (int j = 0; j < 4; ++j) img[(m * 16 + j) * IMG_LD + n * 16] = f2bf(epi_val<ROPE>(acc, m, n, j, cs4, sn4, fr) * scale);
  }
}
DI void img_store_bf16(u16* dst, int ld, const char* smem, int rowoff) {
  const int tid = TID512();
#pragma unroll
  for (int q = 0; q < 16; ++q) {
    const int slot = tid + q * 512, row = slot >> 5, c16 = slot & 31;
    *(u32x4*)(dst + (size_t)row * ld + c16 * 8) = *(const u32x4*)(smem + (row + rowoff) * (IMG_LD * 2) + c16 * 16);
  }
}
DI void img_load_bf16(const u16* src, int ld, char* smem, int nrows, int rowoff) {
  for (int slot = TID512(); slot < nrows * 32; slot += 512) {
    const int row = slot >> 5, c16 = slot & 31;
    *(u32x4*)(smem + (row + rowoff) * (IMG_LD * 2) + c16 * 16) = *(const u32x4*)(src + (size_t)row * ld + c16 * 8);
  }
}
template <bool ROPE>
DI void imgf_put(const f32x4 (&acc)[8][4], int h, char* smem, int prow0, const float* cosT) {
  EPI_IDS;
  if (wr == h) {
    float* f = (float*)smem + (fq * 4) * IMGF_LD + wc * 64 + fr;
#pragma unroll
    for (int m = 0; m < 8; ++m) {
      float cs4[4] = {0.f, 0.f, 0.f, 0.f}, sn4[4] = {0.f, 0.f, 0.f, 0.f};
      if (ROPE) {
#pragma unroll
        for (int j = 0; j < 4; ++j) { const int pos = prow0 + wr * 128 + m * 16 + fq * 4 + j; cs4[j] = cosT[pos * 8 + (fr & 7)]; sn4[j] = cosT[8192 * 8 + pos * 8 + (fr & 7)]; }
      }
#pragma unroll
      for (int n = 0; n < 4; ++n)
#pragma unroll
        for (int j = 0; j < 4; ++j) f[(m * 16 + j) * IMGF_LD + n * 16] = epi_val<ROPE>(acc, m, n, j, cs4, sn4, fr);
    }
  }
}
template <bool ADD>
DI void imgf_store(float* dst, int ld, const char* smem) {
  const int tid = TID512();
  const unsigned o0 = (unsigned)((tid >> 6) * ld + (tid & 63) * 4);
  const char* src = smem + (tid >> 6) * (IMGF_LD * 4) + (tid & 63) * 16;
#pragma unroll
  for (int q = 0; q < 16; ++q) {
    if ((q & 3) == 0) asm volatile("" ::: "memory");
    float4 v = *(const float4*)(src + q * 8 * (IMGF_LD * 4));
    float4* d = (float4*)(dst + (o0 + (unsigned)(q * 8 * ld)));
    if (ADD) { const float4 x = *d; v.x += x.x; v.y += x.y; v.z += x.z; v.w += x.w; }
    *d = v;
  }
}
template <bool ADD, bool ROPE>
DI void tile_out_f32(const f32x4 (&acc)[8][4], float* dst, int ld, char* smem, int prow0, const float* cosT) {
#pragma unroll 1
  for (int h = 0; h < 2; ++h) {
    img_barrier();
    imgf_put<ROPE>(acc, h, smem, prow0, cosT);
    img_barrier();
    imgf_store<ADD>(dst + (size_t)h * 128 * ld, ld, smem);
  }
}
template <bool ROPE>
DI void tile_out_bf16(const f32x4 (&acc)[8][4], u16* dst, int ld, char* smem, float scale, int prow0, const float* cosT) {
  img_barrier();
  img_put_bf16<ROPE>(acc, smem, 0, scale, prow0, cosT);
  img_barrier();
  img_store_bf16(dst, ld, smem, 0);
}

template <int KS>
DI f32x4 lds_mm(const u16* As, int lsa, int arow, const u16* Bs, int lsb, int brow, f32x4 acc) {
  const int lane = TID() & 63, fr = lane & 15, fq = lane >> 4;
#pragma unroll
  for (int ks = 0; ks < KS; ++ks) {
    bf16x8 a = *(const bf16x8*)(As + (arow + fr) * lsa + ks * 32 + fq * 8);
    bf16x8 b = *(const bf16x8*)(Bs + (brow + fr) * lsb + ks * 32 + fq * 8);
    acc = MFMA16(a, b, acc);
  }
  return acc;
}

constexpr int PREP_T_PER_LAYER = 64 * 16 + 48 * 16 + 3 * 128 + 3 * 256 + 3 * 704 + 16;
constexpr int PREP_T = PREP_T_PER_LAYER * NL;
constexpr int PREP_COPY = MT * 1024 / 4096;
constexpr int PREP_ROPE = 8192 * 8 / 256;
constexpr int PREP_ITEMS = PREP_T + PREP_COPY + PREP_ROPE + 2;

DI void transpose_tile(const float* src, int lds_, int k0, int c0, int ncols_valid, u16* dst, int ldd, int n0, float* tile) {
  const int tid = TID();
  __syncthreads();
#pragma unroll
  for (int i = 0; i < 16; ++i) {
    int e = tid + i * 256, r = e >> 6, c = e & 63;
    tile[r * 65 + c] = (c < ncols_valid) ? src[(size_t)(k0 + r) * lds_ + c0 + c] : 0.f;
  }
  __syncthreads();
#pragma unroll
  for (int i = 0; i < 16; ++i) {
    int e = tid + i * 256, c = e >> 6, r = e & 63;
    dst[(size_t)(n0 + c) * ldd + k0 + r] = f2bf(tile[r * 65 + c]);
  }
}

DI void prep_item(const Params& p, int it, char* smem) {
  const int tid = TID();
  if (it < PREP_T) {
    const int l = it / PREP_T_PER_LAYER;
    int t = it % PREP_T_PER_LAYER;
    u16* W = (u16*)(p.ws + O_WT) + (size_t)l * W_LAYER;
    float* tile = (float*)smem;
    if (t < 64 * 16) {
      int nt = t / 16, kt = t % 16, n0 = nt * 64;
      const int c0 = n0 < 3072 ? n0 : n0 + 16;
      transpose_tile(p.in[9] + (size_t)l * 1024 * PW, PW, kt * 64, c0, 64, W + W_IN, LDK, n0, tile);
      return;
    }
    t -= 64 * 16;
    if (t < 48 * 16) { transpose_tile(p.in[25] + (size_t)l * 1024 * 3072, 3072, (t % 16) * 64, (t / 16) * 64, 64, W + W_MG, LDK, (t / 16) * 64, tile); return; }
    t -= 48 * 16;
    if (t < 3 * 128) {
      int br = t / 128, tt = t % 128;
      transpose_tile(p.in[22 + br] + (size_t)l * 512 * 1024, 1024, (tt % 8) * 64, (tt / 8) * 64, 64, W + W_BR + (size_t)br * 1024 * 512, 512, (tt / 8) * 64, tile);
      return;
    }
    t -= 3 * 128;
    if (t < 768) { const int cp = t / 256, tt = t % 256; transpose_tile(p.in[27] + (size_t)l * 1024 * 1024, 1024, (tt % 16) * 64, (tt / 16) * 64, 64, W + W_OUT + cp * 1024, 3072, (tt / 16) * 64, tile); return; }
    t -= 768;
    if (t < 704) { transpose_tile(p.in[29] + (size_t)l * 1024 * DFF, DFF, (t % 16) * 64, (t / 16) * 64, 64, W + W_FG, LDK, (t / 16) * 64, tile); return; }
    t -= 704;
    if (t < 704) { transpose_tile(p.in[32] + (size_t)l * 1024 * DFF, DFF, (t % 16) * 64, (t / 16) * 64, 64, W + W_FU, LDK, (t / 16) * 64, tile); return; }
    t -= 704;
    if (t < 704) { transpose_tile(p.in[33] + (size_t)l * DFF * 1024, 1024, (t % 44) * 64, (t / 44) * 64, 64, W + W_FD, DFF, (t / 44) * 64, tile); return; }
    t -= 704;
    if (t < 8) { transpose_tile(p.in[17] + (size_t)l * 32768 + t * 4096, 64, 0, 0, 64, W + W_WA + t * 4096, 64, 0, tile); return; }
    t -= 8;
    transpose_tile(p.in[19] + (size_t)l * 32768 + t * 4096, 64, 0, 0, 64, W + W_WX + t * 4096, 64, 0, tile);
    return;
  }
  it -= PREP_T;
  if (it < PREP_COPY) {
    size_t base = (size_t)it * 4096;
    float* X = p.out;
#pragma unroll
    for (int i = 0; i < 4; ++i) {
      size_t e = base + (size_t)(tid + i * 256) * 4;
      float4 v = (e < (size_t)MP * 1024) ? *(const float4*)(p.in[0] + e) : *(const float4*)(p.in[1] + (e - (size_t)MP * 1024));
      *(float4*)(X + e) = v;
    }
    return;
  }
  it -= PREP_COPY;
  if (it < PREP_ROPE) {
    int e = it * 256 + tid, pos = e >> 3, i = e & 7;
    double inv = pow(500000.0, -(double)i / 8.0);
    double ang = (double)pos * inv;
    double kq = rint(ang * 0.15915494309189535);
    double r = ang - kq * 6.283185307179586;
    float rf = (float)r;
    float* cs = (float*)(p.ws + O_ROPE);
    cs[e] = cosf(rf);
    cs[8192 * 8 + e] = sinf(rf);
    return;
  }
  if (it == PREP_ROPE && tid < 64 * NL) {
    int l = tid >> 6, i = tid & 63;
    const float* lq = p.in[10] + (size_t)l * 256;
    float a = lq[i] * lq[64 + i], b = lq[128 + i] * lq[192 + i];
    a = wave_sum(a); b = wave_sum(b);
    if (i == 0) {
      float lam_init = 0.8f - 0.6f * __expf(-0.3f * (float)l);
      ((float*)(p.ws + O_LAM))[l] = __expf(a) - __expf(b) + lam_init;
    }
  }
}

DI bool xcd_tile(int B, int G, int iter, int MTILES, int NT, int& mt, int& nt) {
  const int nxb = G >> 3;
  const int x = B & 7, lb = B >> 3;
  const int q = MTILES >> 3, r = MTILES & 7;
  const int mx = q + (x < r ? 1 : 0);
  const int mbase = x * q + (x < r ? x : r);
  const int j = lb + iter * nxb;
  if (j >= mx * NT) return false;
  const int band = j / (8 * NT);
  const int rem = j - band * 8 * NT;
  const int nb = (mx - band * 8) < 8 ? (mx - band * 8) : 8;
  mt = mbase + band * 8 + rem % nb;
  nt = rem / nb;
  return true;
}

constexpr int PB_KC = SBT * PAST * 512 / 4096;
constexpr int PB_VC = SBT * 32 * 8;

DI void projin_tile(const Params& p, int l, int mt, int nt, char* smem) {
  const int row0 = mt * 256, col0 = nt * 256;
  const u16* W = (const u16*)(p.ws + O_WT) + (size_t)l * W_LAYER + W_IN;
  const u16* XN = (const u16*)(p.ws + O_XN);
  f32x4 acc[8][4];
  zero_acc8(acc);
  gemm512(XN + (size_t)row0 * LDK, LDK, W + (size_t)col0 * LDK, LDK, 1024, acc, smem);
  const float* cosT = (const float*)(p.ws + O_ROPE);
  const float* sinT = cosT + 8192 * 8;
  if (mt < 128) {
    const int prow0 = row0 & 8191;
    if (nt < 2) {
      tile_out_bf16<true>(acc, (u16*)(p.ws + O_QB) + (size_t)row0 * 512 + col0, 512, smem, QSCALE, prow0, cosT);
    } else if (nt < 4) {
      tile_out_f32<false, true>(acc, p.out + K_P + ((size_t)l * MP + row0) * 512 + (col0 - 512), 512, smem, prow0, cosT);
      tile_out_bf16<true>(acc, (u16*)(p.ws + O_KB) + (size_t)row0 * 512 + (col0 - 512), 512, smem, 1.f, prow0, cosT);
    } else if (nt < 6) {
      tile_out_f32<false, false>(acc, p.out + V_P + ((size_t)l * MP + row0) * 512 + (col0 - 1024), 512, smem, 0, nullptr);
      EPI_IDS;
      u16* VT = (u16*)(p.ws + O_VT);
      const unsigned vb = (unsigned)((row0 >> 13) * 512 + (col0 - 1024) + wc * 64 + fr) * (unsigned)PT + (unsigned)((row0 & 8191) + wr * 128 + fq * 4);
#pragma unroll
      for (int m = 0; m < 8; ++m) {
        asm volatile("" ::: "memory");
#pragma unroll
        for (int n = 0; n < 4; ++n) {
          const uint2 pk = {pack2(acc[m][n][0], acc[m][n][1]), pack2(acc[m][n][2], acc[m][n][3])};
          *(uint2*)(VT + (vb + (unsigned)(n * 16 * PT + m * 16))) = pk;
        }
      }
    } else if (nt >= 12 && nt < 14) {
      tile_out_f32<false, false>(acc, (float*)(p.ws + O_LX) + (size_t)row0 * 512 + (col0 - 3072), 512, smem, 0, nullptr);
    } else {
      u16* dst; int ld = 512, cbase;
      if (nt == 6) { dst = (u16*)(p.ws + O_GQ); ld = 256; cbase = 1536; }
      else if (nt == 7) { dst = (u16*)(p.ws + O_GK); ld = 256; cbase = 1792; }
      else if (nt < 10) { dst = (u16*)(p.ws + O_GV); cbase = 2048; }
      else if (nt < 12) { dst = (u16*)(p.ws + O_GR); cbase = 2560; }
      else { dst = (u16*)(p.ws + O_LG); cbase = 3584; }
      tile_out_bf16<false>(acc, dst + (size_t)row0 * ld + (col0 - cbase), ld, smem, nt == 6 ? 0.125f : 1.f, 0, nullptr);
    }
    return;
  }
  EPI_IDS;
  const bool isS = row0 >= MP;
  if (nt < 4) {
    const bool isq = nt < 2;
    u16* QB = (u16*)(p.ws + O_QB);
    u16* KB = (u16*)(p.ws + O_KB);
    u16* KS = (u16*)(p.ws + O_KS);
#pragma unroll
    for (int m = 0; m < 8; ++m) {
      asm volatile("" ::: "memory");
#pragma unroll
      for (int n = 0; n < 4; ++n)
#pragma unroll
        for (int j = 0; j < 4; ++j) {
          const int row = row0 + wr * 128 + m * 16 + fq * 4 + j;
          const int col = col0 + wc * 64 + n * 16 + fr;
          float v = acc[m][n][j];
          int b, t;
          if (isS) { int rs = row - MP; b = rs >> 5; t = rs & 31; } else { b = row >> 13; t = row & 8191; }
          const int pos = isS ? PAST + t : t;
          if (n == 0) {
            float pr = __shfl_xor(v, 8);
            float cs = cosT[pos * 8 + (fr & 7)], sn = sinT[pos * 8 + (fr & 7)];
            v = (fr < 8) ? v * cs - pr * sn : v * cs + pr * sn;
          }
          if (isq) {
            QB[(size_t)row * 512 + col] = f2bf(v * QSCALE);
          } else {
            const int ck = col - 512;
            if (isS) {
              p.out[K_S + ((size_t)l * MS + (row - MP)) * 512 + ck] = v;
              KS[((size_t)b * SKP + PAST + t) * 512 + ck] = f2bf(v);
            } else {
              p.out[K_P + ((size_t)l * MP + row) * 512 + ck] = v;
              KB[(size_t)row * 512 + ck] = f2bf(v);
            }
          }
        }
    }
  } else if (nt < 6) {
    u16* VT = (u16*)(p.ws + O_VT);
    u16* VTS = (u16*)(p.ws + O_VTS);
#pragma unroll
    for (int m = 0; m < 8; ++m) {
      asm volatile("" ::: "memory");
#pragma unroll
      for (int n = 0; n < 4; ++n) {
        const int rowb = row0 + wr * 128 + m * 16 + fq * 4;
        const int cv = col0 - 1024 + wc * 64 + n * 16 + fr;
        const int h = cv >> 7, vd = cv & 127;
        int b, t;
        if (isS) { int rs = rowb - MP; b = rs >> 5; t = rs & 31; } else { b = rowb >> 13; t = rowb & 8191; }
#pragma unroll
        for (int j = 0; j < 4; ++j) {
          if (isS) p.out[V_S + ((size_t)l * MS + (rowb + j - MP)) * 512 + cv] = acc[m][n][j];
          else p.out[V_P + ((size_t)l * MP + rowb + j) * 512 + cv] = acc[m][n][j];
        }
        uint2 pk = {pack2(acc[m][n][0], acc[m][n][1]), pack2(acc[m][n][2], acc[m][n][3])};
        if (isS) *(uint2*)(VTS + ((size_t)(b * 4 + h) * 128 + vd) * SKP + PAST + t) = pk;
        else *(uint2*)(VT + ((size_t)(b * 4 + h) * 128 + vd) * PT + t) = pk;
      }
    }
  } else {
    u16* dst16 = nullptr; float* dst32 = nullptr; int ld = 512, cbase = 0; float scale = 1.f;
    if (nt == 6) { dst16 = (u16*)(p.ws + O_GQ); ld = 256; cbase = 1536; scale = 0.125f; }
    else if (nt == 7) { dst16 = (u16*)(p.ws + O_GK); ld = 256; cbase = 1792; }
    else if (nt < 10) { dst16 = (u16*)(p.ws + O_GV); cbase = 2048; }
    else if (nt < 12) { dst16 = (u16*)(p.ws + O_GR); cbase = 2560; }
    else if (nt < 14) { dst32 = (float*)(p.ws + O_LX); cbase = 3072; }
    else { dst16 = (u16*)(p.ws + O_LG); cbase = 3584; }
#pragma unroll
    for (int m = 0; m < 8; ++m) {
      asm volatile("" ::: "memory");
#pragma unroll
      for (int n = 0; n < 4; ++n)
#pragma unroll
        for (int j = 0; j < 4; ++j) {
          const int row = row0 + wr * 128 + m * 16 + fq * 4 + j;
          const int c = col0 + wc * 64 + n * 16 + fr - cbase;
          const float v = acc[m][n][j] * scale;
          if (dst16) dst16[(size_t)row * ld + c] = f2bf(v);
          else dst32[(size_t)row * ld + c] = v;
        }
    }
  }
}

DI void cache_conv_item(const Params& p, int l, int it, char* smem) {
  const int tid = TID();
  if (it < PB_KC) {
    const float* src = p.in[2] + (size_t)l * SBT * PAST * 512;
    u16* KS = (u16*)(p.ws + O_KS);
#pragma unroll
    for (int i = 0; i < 4; ++i) {
      size_t e = (size_t)it * 4096 + (size_t)(tid + i * 256) * 4;
      float4 v = *(const float4*)(src + e);
      size_t b = e / ((size_t)PAST * 512), r = e % ((size_t)PAST * 512);
      *(uint2*)(KS + b * SKP * 512 + r) = uint2{pack2(v.x, v.y), pack2(v.z, v.w)};
    }
    return;
  }
  it -= PB_KC;
  const int b = it / 256, r = it % 256, ptile = r / 8, ctile = r % 8;
  const float* src = p.in[3] + ((size_t)l * SBT + b) * PAST * 512;
  u16* VTS = (u16*)(p.ws + O_VTS);
  transpose_tile(src, 512, ptile * 64, ctile * 64, 64, VTS + (size_t)b * 512 * SKP, SKP, ctile * 64, (float*)smem);
}

DI int kswz(int key) { return (((key >> 3) & 3) << 2) | (key & 3); }

DI void attn_item(const Params& p, int l, bool isS, int b, int h, int cp, char* smem) {
  const int tid = TID512(), lane = tid & 63, wid = tid >> 6, fr = lane & 15, fq = lane >> 4;
  const int nkt = isS ? 33 : 2 * cp + 2;
  const int klen = isS ? SKV : nkt * 64;
  const int mykt = isS ? 33 : (wid < 4 ? 2 * cp + 1 : 2 * cp + 2);
  const u16* QB = (const u16*)(p.ws + O_QB);
  const u16* Kg = isS ? (const u16*)(p.ws + O_KS) + (size_t)b * SKP * 512 + h * 128 : (const u16*)(p.ws + O_KB) + (size_t)b * PT * 512 + h * 128;
  const int vstride = isS ? SKP : PT;
  const u16* Vg = (isS ? (const u16*)(p.ws + O_VTS) : (const u16*)(p.ws + O_VT)) + (size_t)(b * 4 + h) * 128 * vstride;
  const int qrow0 = isS ? MP + b * 32 : b * PT + cp * 128;
  const bool wactive = isS ? (wid < 2) : true;
  const int qrow = qrow0 + wid * 16 + fr;
  bf16x8 qf[2][2];
#pragma unroll
  for (int mp = 0; mp < 2; ++mp)
#pragma unroll
    for (int ks = 0; ks < 2; ++ks)
      qf[mp][ks] = wactive ? *(const bf16x8*)(QB + (size_t)qrow * 512 + h * 128 + mp * 64 + ks * 32 + fq * 8) : bf16x8{0, 0, 0, 0, 0, 0, 0, 0};
  f32x4 ot[2][8];
#pragma unroll
  for (int mp = 0; mp < 2; ++mp)
#pragma unroll
    for (int n = 0; n < 8; ++n) ot[mp][n] = f32x4{0.f, 0.f, 0.f, 0.f};
  float mrun[2] = {-INFINITY, -INFINITY}, lrun[2] = {0.f, 0.f};
  char* Ks = smem;
  char* Vs = smem + 32768;
  const int kkey = tid >> 4, vvd = tid >> 3;
  const int kgch = (tid & 15) ^ kswz(kkey);
  const int vgch = (tid & 7) ^ ((vvd >> 1) & 7);
  const int soff = tid * 16;
  auto issue_k = [&](int kt) {
#pragma unroll
    for (int i = 0; i < 2; ++i)
      __builtin_amdgcn_global_load_lds((const unsigned*)(Kg + (size_t)(kt * 64 + kkey + i * 32) * 512 + kgch * 8), (unsigned*)(Ks + (kt & 1) * 16384 + soff + i * 8192), 16, 0, 0);
  };
  auto issue_v = [&](int kt) {
#pragma unroll
    for (int i = 0; i < 2; ++i)
      __builtin_amdgcn_global_load_lds((const unsigned*)(Vg + (size_t)(vvd + i * 64) * vstride + kt * 64 + vgch * 8), (unsigned*)(Vs + (kt & 1) * 16384 + soff + i * 8192), 16, 0, 0);
  };
  auto qk_tile = [&](int kt, f32x4 (&st)[2][4]) {
    const char* Kb = Ks + (kt & 1) * 16384;
    bf16x8 kf[2][4][2];
#pragma unroll
    for (int mp = 0; mp < 2; ++mp)
#pragma unroll
      for (int mt = 0; mt < 4; ++mt) {
        const int key = 32 * (mt >> 1) + 8 * (fr >> 2) + 4 * (mt & 1) + (fr & 3);
#pragma unroll
        for (int ks = 0; ks < 2; ++ks) kf[mp][mt][ks] = *(const bf16x8*)(Kb + key * 256 + (((mp * 8 + ks * 4 + fq) ^ kswz(key)) << 4));
      }
#pragma unroll
    for (int mp = 0; mp < 2; ++mp)
#pragma unroll
      for (int mt = 0; mt < 4; ++mt) {
        f32x4 a = MFMA16(kf[mp][mt][0], qf[mp][0], (f32x4{0.f, 0.f, 0.f, 0.f}));
        st[mp][mt] = MFMA16(kf[mp][mt][1], qf[mp][1], a);
      }
    if ((kt + 1) * 64 > klen) {
      asm volatile("" ::: "memory");
#pragma unroll
      for (int mp = 0; mp < 2; ++mp)
#pragma unroll
        for (int mt = 0; mt < 4; ++mt)
#pragma unroll
          for (int j = 0; j < 4; ++j) {
            const int key = kt * 64 + 32 * (mt >> 1) + 8 * fq + 4 * (mt & 1) + j;
            if (key >= klen) st[mp][mt][j] = -INFINITY;
          }
    }
  };
  auto softmax_tile = [&](f32x4 (&st)[2][4], bf16x8 (&pfn)[2][2], float (&alpha)[2], float (&psum)[2], bool (&moved)[2]) {
#pragma unroll
    for (int mp = 0; mp < 2; ++mp) {
      float mx = -INFINITY;
#pragma unroll
      for (int mt = 0; mt < 4; ++mt)
#pragma unroll
        for (int j = 0; j < 4; ++j) mx = fmaxf(mx, st[mp][mt][j]);
      mx = quad_max(mx);
      const float mold = mrun[mp];
      const float mnew = fmaxf(mold, mx);
      mrun[mp] = mnew;
      float ps = 0.f;
#pragma unroll
      for (int mt = 0; mt < 4; ++mt)
#pragma unroll
        for (int j = 0; j < 4; ++j) { float e = __builtin_amdgcn_exp2f(st[mp][mt][j] - mnew); st[mp][mt][j] = e; ps += e; }
      psum[mp] = ps;
      moved[mp] = __any(mnew > mold);
      alpha[mp] = __builtin_amdgcn_exp2f(mold - mnew);
#pragma unroll
      for (int s = 0; s < 2; ++s) {
        uint4 u = {pack2(st[mp][2 * s][0], st[mp][2 * s][1]), pack2(st[mp][2 * s][2], st[mp][2 * s][3]),
                   pack2(st[mp][2 * s + 1][0], st[mp][2 * s + 1][1]), pack2(st[mp][2 * s + 1][2], st[mp][2 * s + 1][3])};
        pfn[mp][s] = __builtin_bit_cast(bf16x8, u);
      }
    }
  };
  auto apply_scale = [&](const float (&alpha)[2], const float (&psum)[2], const bool (&moved)[2]) {
#pragma unroll
    for (int mp = 0; mp < 2; ++mp) {
      if (moved[mp]) {
        lrun[mp] *= alpha[mp];
#pragma unroll
        for (int n = 0; n < 8; ++n) { ot[mp][n][0] *= alpha[mp]; ot[mp][n][1] *= alpha[mp]; ot[mp][n][2] *= alpha[mp]; ot[mp][n][3] *= alpha[mp]; }
      }
      lrun[mp] += psum[mp];
    }
  };
  asm volatile("s_waitcnt vmcnt(0) lgkmcnt(0)" ::: "memory");
  __builtin_amdgcn_s_barrier();
  issue_k(0); issue_v(0);
  if (nkt > 1) issue_k(1);
  asm volatile("s_waitcnt vmcnt(0)" ::: "memory");
  asm volatile("" ::"v"(qf[0][0]), "v"(qf[0][1]), "v"(qf[1][0]), "v"(qf[1][1]));
  __builtin_amdgcn_s_barrier();
  bf16x8 pf[2][2];
#pragma unroll
  for (int mp = 0; mp < 2; ++mp)
#pragma unroll
    for (int s = 0; s < 2; ++s) pf[mp][s] = bf16x8{0, 0, 0, 0, 0, 0, 0, 0};
  if (wactive) {
    f32x4 st[2][4];
    float alpha[2], psum[2]; bool moved[2];
    qk_tile(0, st);
    softmax_tile(st, pf, alpha, psum, moved);
    apply_scale(alpha, psum, moved);
  }
  asm volatile("s_waitcnt lgkmcnt(0)" ::: "memory");
  __builtin_amdgcn_s_barrier();
  for (int j = 0; j < nkt; ++j) {
    if (j + 2 < nkt) issue_k(j + 2);
    if (j + 1 < nkt) issue_v(j + 1);
    const bool doPV = wactive && j < mykt;
    const bool doQK = wactive && j + 1 < mykt;
    f32x4 st[2][4];
    bf16x8 pfn[2][2];
    float alpha[2] = {1.f, 1.f}, psum[2] = {0.f, 0.f}; bool moved[2] = {false, false};
    auto pv_tile = [&]() {
      const char* Vb = Vs + (j & 1) * 16384;
#pragma unroll
      for (int nh = 0; nh < 2; ++nh) {
        bf16x8 vf[4][2];
#pragma unroll
        for (int n = 0; n < 4; ++n) {
          const int vd = (nh * 4 + n) * 16 + fr;
#pragma unroll
          for (int s = 0; s < 2; ++s) vf[n][s] = *(const bf16x8*)(Vb + vd * 128 + (((s * 4 + fq) ^ ((vd >> 1) & 7)) << 4));
        }
#pragma unroll
        for (int n = 0; n < 4; ++n)
#pragma unroll
          for (int s = 0; s < 2; ++s) {
            ot[0][nh * 4 + n] = MFMA16(vf[n][s], pf[0][s], ot[0][nh * 4 + n]);
            ot[1][nh * 4 + n] = MFMA16(vf[n][s], pf[1][s], ot[1][nh * 4 + n]);
          }
      }
    };
    if (doQK) {
      qk_tile(j + 1, st);
      pv_tile();
      softmax_tile(st, pfn, alpha, psum, moved);
      apply_scale(alpha, psum, moved);
#pragma unroll
      for (int mp = 0; mp < 2; ++mp)
#pragma unroll
        for (int s = 0; s < 2; ++s) pf[mp][s] = pfn[mp][s];
    } else if (doPV) {
      pv_tile();
    }
    asm volatile("s_waitcnt vmcnt(0) lgkmcnt(0)" ::: "memory");
    __builtin_amdgcn_s_barrier();
  }
  if (wactive) {
    float l0 = lrun[0], l1 = lrun[1];
    l0 += __shfl_xor(l0, 16); l0 += __shfl_xor(l0, 32);
    l1 += __shfl_xor(l1, 16); l1 += __shfl_xor(l1, 32);
    const float lam = ((const float*)(p.ws + O_LAM))[l];
    const float lam_init = 0.8f - 0.6f * __expf(-0.3f * (float)l);
    const float i0 = 1.f / l0, i1 = lam / l1;
    float ss = 0.f;
#pragma unroll
    for (int n = 0; n < 8; ++n)
#pragma unroll
      for (int j = 0; j < 4; ++j) { float o = ot[0][n][j] * i0 - ot[1][n][j] * i1; ot[0][n][j] = o; ss += o * o; }
    ss += __shfl_xor(ss, 16); ss += __shfl_xor(ss, 32);
    const float rs = rsqrtf(ss * (1.f / 128.f) + EPS) * (1.f - lam_init);
    const float* g = p.in[11] + (size_t)l * 128;
    u16* OA = (u16*)(p.ws + O_OA) + (size_t)qrow * 512 + h * 128;
#pragma unroll
    for (int n = 0; n < 8; ++n) {
      const int vd = n * 16 + fq * 4;
      float4 gg = *(const float4*)(g + vd);
      *(uint2*)(OA + vd) = uint2{pack2(ot[0][n][0] * rs * gg.x, ot[0][n][1] * rs * gg.y), pack2(ot[0][n][2] * rs * gg.z, ot[0][n][3] * rs * gg.w)};
    }
  }
}

constexpr int LP = 72;
constexpr int BCS = 68;
DI void gla_decode(int gi, bool& isS, int& b, int& h, int& c, int& row0, int& Lc) {
  if (gi < PB * 4 * 128) { isS = false; c = gi & 127; h = (gi >> 7) & 3; b = gi >> 9; row0 = b * PT + c * 64; Lc = 64; }
  else { isS = true; int s = gi - PB * 4 * 128; b = s >> 2; h = s & 3; c = 0; row0 = MP + b * 32; Lc = 32; }
}
DI void gla_bcum(const Params& p, int l, int row0, int Lc, int h, float* bc, float* tot, float* gas) {
  const int tid = TID(), kd = tid & 63, tq = tid >> 6;
  const float* W2 = p.in[12] + (size_t)l * 16 * 256 + h * 64 + kd;
  const float b2 = p.in[13][(size_t)l * 256 + h * 64 + kd];
  const float* GA = (const float*)(p.ws + O_GA);
  {
    const int r = tid >> 2, part = tid & 3;
    float4 v = {0.f, 0.f, 0.f, 0.f};
    if (r < Lc) v = *(const float4*)(GA + (size_t)(row0 + r) * 16 + part * 4);
    *(float4*)(gas + r * 16 + part * 4) = v;
  }
  float w[16];
#pragma unroll
  for (int r = 0; r < 16; ++r) w[r] = W2[r * 256];
  __syncthreads();
  float run = 0.f;
#pragma unroll
  for (int i = 0; i < 16; ++i) {
    const int t = tq * 16 + i;
    const float4* ga = (const float4*)(gas + t * 16);
    const float4 g0 = ga[0], g1 = ga[1], g2 = ga[2], g3 = ga[3];
    const float x = b2 + g0.x * w[0] + g0.y * w[1] + g0.z * w[2] + g0.w * w[3] + g1.x * w[4] + g1.y * w[5] + g1.z * w[6] + g1.w * w[7] +
                    g2.x * w[8] + g2.y * w[9] + g2.z * w[10] + g2.w * w[11] + g3.x * w[12] + g3.y * w[13] + g3.z * w[14] + g3.w * w[15];
    const float la = (t < Lc) ? -softplusf_(-x) * (1.f / 16.f) : 0.f;
    run += la;
    bc[t * BCS + kd] = run;
  }
  tot[tq * 64 + kd] = run;
  __syncthreads();
  float off = 0.f;
  for (int g = 0; g < tq; ++g) off += tot[g * 64 + kd];
#pragma unroll
  for (int i = 0; i < 16; ++i) bc[(tq * 16 + i) * BCS + kd] += off;
  __syncthreads();
}
DI void gla_load_vt(const Params& p, int row0, int Lc, int h, u16* vt) {
  const int tid = TID(), s = tid & 63, cg4 = tid >> 6;
  const u16* GV = (const u16*)(p.ws + O_GV) + (size_t)(row0 + s) * 512 + h * 128;
  u32x4 v[4];
#pragma unroll
  for (int i = 0; i < 4; ++i) v[i] = (s < Lc) ? *(const u32x4*)(GV + (cg4 + 4 * i) * 8) : u32x4{0u, 0u, 0u, 0u};
#pragma unroll
  for (int i = 0; i < 4; ++i) {
    const int vd0 = (cg4 + 4 * i) * 8;
#pragma unroll
    for (int e = 0; e < 4; ++e) {
      vt[(vd0 + 2 * e) * LP + s] = (u16)(v[i][e] & 0xffffu);
      vt[(vd0 + 2 * e + 1) * LP + s] = (u16)(v[i][e] >> 16);
    }
  }
}

DI void gla1_item(const Params& p, int l, int gi, char* smem) {
  bool isS; int b, h, c, row0, Lc;
  gla_decode(gi, isS, b, h, c, row0, Lc);
  const int tid = TID(), lane = tid & 63, wid = tid >> 6, fr = lane & 15, fq = lane >> 4;
  float* bc = (float*)smem;
  float* tot = (float*)(smem + 17408);
  u16* kh = (u16*)(smem + 18432);
  u16* vt = (u16*)(smem + 18432 + 9216);
  __syncthreads();
  gla_bcum(p, l, row0, Lc, h, bc, tot, (float*)kh);
  {
    const int s = tid & 63, c2 = tid >> 6;
    const u16* GK = (const u16*)(p.ws + O_GK) + (size_t)(row0 + s) * 256 + h * 64;
    u32x4 kv[2];
#pragma unroll
    for (int i = 0; i < 2; ++i) kv[i] = (s < Lc) ? *(const u32x4*)(GK + (c2 + 4 * i) * 8) : u32x4{0u, 0u, 0u, 0u};
#pragma unroll
    for (int i = 0; i < 2; ++i) {
      const int kd0 = (c2 + 4 * i) * 8;
#pragma unroll
      for (int e = 0; e < 8; ++e) {
        const unsigned w = kv[i][e >> 1];
        const float kf = bf2f((u16)((e & 1) ? (w >> 16) : (w & 0xffffu)));
        const float bl = bc[63 * BCS + kd0 + e];
        kh[(kd0 + e) * LP + s] = f2bf(kf * __expf(bl - bc[s * BCS + kd0 + e]));
      }
    }
    if (tid < 64) ((float*)(p.ws + O_DEC))[(size_t)gi * 64 + tid] = __expf(bc[63 * BCS + tid]);
  }
  gla_load_vt(p, row0, Lc, h, vt);
  __syncthreads();
  u16* KVT = (u16*)(p.ws + O_KVT) + (size_t)gi * 8192;
#pragma unroll
  for (int mi = 0; mi < 2; ++mi)
#pragma unroll
    for (int n = 0; n < 4; ++n) {
      const int m = wid * 2 + mi;
      f32x4 a = lds_mm<2>(vt, LP, m * 16, kh, LP, n * 16, f32x4{0.f, 0.f, 0.f, 0.f});
#pragma unroll
      for (int j = 0; j < 4; ++j) KVT[(m * 16 + fq * 4 + j) * 64 + n * 16 + fr] = f2bf(a[j]);
    }
}

constexpr int G2_ITEMS = (PB * 4 + SBT * 4) * 32;
DI void gla2_item(const Params& p, int l, int it) {
  const int seq = it >> 5, e = (it & 31) * 256 + TID();
  const int vd = e >> 6, kd = e & 63;
  u16* KVT = (u16*)(p.ws + O_KVT);
  const float* DEC = (const float*)(p.ws + O_DEC);
  if (seq < PB * 4) {
    float S = 0.f;
    const int gi0 = seq * 128;
    for (int c0 = 0; c0 < 128; c0 += 32) {
      u16 kvv[32]; float dd[32];
#pragma unroll
      for (int c = 0; c < 32; ++c) { kvv[c] = KVT[(size_t)(gi0 + c0 + c) * 8192 + e]; dd[c] = DEC[(size_t)(gi0 + c0 + c) * 64 + kd]; }
#pragma unroll
      for (int c = 0; c < 32; ++c) { KVT[(size_t)(gi0 + c0 + c) * 8192 + e] = f2bf(S); S = dd[c] * S + bf2f(kvv[c]); }
    }
    p.out[GLA_P + ((size_t)l * PB * 4 + seq) * 8192 + kd * 128 + vd] = S;
  } else {
    const int s = seq - PB * 4, gi = PB * 4 * 128 + s;
    const float S0 = p.in[4][((size_t)l * SBT * 4 + s) * 8192 + kd * 128 + vd];
    u16* q = KVT + (size_t)gi * 8192 + e;
    const float kv = bf2f(*q);
    const float d = DEC[(size_t)gi * 64 + kd];
    *q = f2bf(S0);
    p.out[GLA_S + ((size_t)l * SBT * 4 + s) * 8192 + kd * 128 + vd] = d * S0 + kv;
  }
}

DI void gla3_item(const Params& p, int l, int gi, char* smem) {
  bool isS; int b, h, c, row0, Lc;
  gla_decode(gi, isS, b, h, c, row0, Lc);
  const int tid = TID(), lane = tid & 63, wid = tid >> 6, fr = lane & 15, fq = lane >> 4;
  float* bc = (float*)smem;
  u16* att = (u16*)smem;
  float* tot = (float*)(smem + 17408);
  u16* qt = (u16*)(smem + 18432);
  u16* kt_ = (u16*)(smem + 18432 + 9216);
  u16* vt = (u16*)(smem + 18432 + 2 * 9216);
  u16* st = (u16*)(smem + 18432 + 2 * 9216 + 18432);
  __syncthreads();
  gla_bcum(p, l, row0, Lc, h, bc, tot, (float*)qt);
  const u16* KVT = (const u16*)(p.ws + O_KVT) + (size_t)gi * 8192;
  {
    const int s = tid & 63, c2 = tid >> 6;
    const u16* GQ = (const u16*)(p.ws + O_GQ) + (size_t)(row0 + s) * 256 + h * 64;
    const u16* GK = (const u16*)(p.ws + O_GK) + (size_t)(row0 + s) * 256 + h * 64;
    u32x4 qv[2], kv[2], sv[4];
#pragma unroll
    for (int i = 0; i < 2; ++i) {
      qv[i] = (s < Lc) ? *(const u32x4*)(GQ + (c2 + 4 * i) * 8) : u32x4{0u, 0u, 0u, 0u};
      kv[i] = (s < Lc) ? *(const u32x4*)(GK + (c2 + 4 * i) * 8) : u32x4{0u, 0u, 0u, 0u};
    }
#pragma unroll
    for (int i = 0; i < 4; ++i) { const int id = tid + i * 256; sv[i] = *(const u32x4*)(KVT + (id >> 3) * 64 + (id & 7) * 8); }
#pragma unroll
    for (int i = 0; i < 2; ++i) {
      const int kd0 = (c2 + 4 * i) * 8;
      u32x4 qo, ko;
#pragma unroll
      for (int e2 = 0; e2 < 4; ++e2) {
        const float b0 = bc[s * BCS + kd0 + 2 * e2], b1 = bc[s * BCS + kd0 + 2 * e2 + 1];
        const float e0 = __expf(b0), e1 = __expf(b1);
        const float q0 = bf2f((u16)(qv[i][e2] & 0xffffu)) * e0, q1 = bf2f((u16)(qv[i][e2] >> 16)) * e1;
        const float k0 = bf2f((u16)(kv[i][e2] & 0xffffu)) / e0, k1 = bf2f((u16)(kv[i][e2] >> 16)) / e1;
        qo[e2] = pack2(q0, q1);
        ko[e2] = pack2(k0, k1);
      }
      *(u32x4*)(qt + s * LP + kd0) = qo;
      *(u32x4*)(kt_ + s * LP + kd0) = ko;
    }
#pragma unroll
    for (int i = 0; i < 4; ++i) { const int id = tid + i * 256; *(u32x4*)(st + (id >> 3) * LP + (id & 7) * 8) = sv[i]; }
  }
  gla_load_vt(p, row0, Lc, h, vt);
  __syncthreads();
  {
    f32x4 a[4];
#pragma unroll
    for (int n = 0; n < 4; ++n) a[n] = lds_mm<2>(qt, LP, wid * 16, kt_, LP, n * 16, f32x4{0.f, 0.f, 0.f, 0.f});
#pragma unroll
    for (int n = 0; n < 4; ++n)
#pragma unroll
      for (int j = 0; j < 4; ++j) {
        const int t = wid * 16 + fq * 4 + j, s = n * 16 + fr;
        att[t * LP + s] = f2bf(t >= s ? a[n][j] : 0.f);
      }
  }
  __syncthreads();
  f32x4 o[8];
#pragma unroll
  for (int n = 0; n < 8; ++n) {
    f32x4 a = lds_mm<2>(att, LP, wid * 16, vt, LP, n * 16, f32x4{0.f, 0.f, 0.f, 0.f});
    o[n] = lds_mm<2>(qt, LP, wid * 16, st, LP, n * 16, a);
  }
  const float* gn = p.in[14] + (size_t)l * 128;
  const u16* GR = (const u16*)(p.ws + O_GR);
  u16* OG = (u16*)(p.ws + O_OG);
  float gnv[8];
#pragma unroll
  for (int n = 0; n < 8; ++n) gnv[n] = gn[n * 16 + fr];
#pragma unroll
  for (int j = 0; j < 4; ++j) {
    float ss = 0.f;
#pragma unroll
    for (int n = 0; n < 8; ++n) ss += o[n][j] * o[n][j];
    ss += __shfl_xor(ss, 1); ss += __shfl_xor(ss, 2); ss += __shfl_xor(ss, 4); ss += __shfl_xor(ss, 8);
    const float rs = rsqrtf(ss * (1.f / 128.f) + EPS);
    const int t = wid * 16 + fq * 4 + j;
    if (t < Lc) {
      const size_t ro = (size_t)(row0 + t) * 512 + h * 128;
      u16 grv[8];
#pragma unroll
      for (int n = 0; n < 8; ++n) grv[n] = GR[ro + n * 16 + fr];
#pragma unroll
      for (int n = 0; n < 8; ++n) {
        const float gr = bf2f(grv[n]);
        OG[ro + n * 16 + fr] = f2bf(o[n][j] * rs * gnv[n] * gr * sigmoidf_(gr));
      }
    }
  }
}

constexpr int L1_ITEMS = NLC * 8;
DI void lru_decode(int ci, bool& isS, int& b, int& row0, int& Lc, int& t0) {
  if (ci < MP / 64) { isS = false; b = ci >> 7; t0 = (ci & 127) * 64; row0 = ci * 64; Lc = 64; }
  else { isS = true; b = ci - MP / 64; t0 = 0; row0 = MP + b * 32; Lc = 32; }
}
DI void lru1_item(const Params& p, int l, int it, char* smem) {
  const int ci = it >> 3, nb = it & 7;
  bool isS; int b, row0, Lc, t0;
  lru_decode(ci, isS, b, row0, Lc, t0);
  const int tid = TID(), lane = tid & 63, wid = tid >> 6, fr = lane & 15, fq = lane >> 4;
  u16* xcs = (u16*)smem;
  u16* was = (u16*)(smem + 9216);
  u16* wxs = (u16*)(smem + 2 * 9216);
  float* as_ = (float*)(smem + 3 * 9216);
  float* us_ = (float*)(smem + 3 * 9216 + 16384);
  float* segP = (float*)(smem + 3 * 9216 + 32768);
  float* segH = (float*)(smem + 3 * 9216 + 32768 + 1024);
  const float* LX = (const float*)(p.ws + O_LX);
  const u16* Wl = (const u16*)(p.ws + O_WT) + (size_t)l * W_LAYER;
  const int i = tid & 63, tq = tid >> 6, ch = nb * 64 + i;
  __syncthreads();
  {
    const float* cw = p.in[15] + (size_t)l * 4 * 512 + ch;
    const float w0 = cw[0], w1 = cw[512], w2 = cw[1024], w3 = cw[1536], cb = p.in[16][(size_t)l * 512 + ch];
    const float* buf = isS ? p.in[5] + ((size_t)l * SBT + b) * 3 * 512 + ch : nullptr;
    float x[19];
#pragma unroll
    for (int j = 0; j < 19; ++j) {
      const int tl = tq * 16 - 3 + j;
      const int tt = t0 + tl;
      float v = 0.f;
      if (tl < Lc) {
        if (tt >= 0) v = LX[(size_t)(row0 + tl) * 512 + ch];
        else if (isS) v = buf[(3 + tt) * 512];
      }
      x[j] = v;
    }
#pragma unroll
    for (int k = 0; k < 16; ++k) {
      const int t = tq * 16 + k;
      const float xv = (t < Lc) ? cb + w0 * x[k] + w1 * x[k + 1] + w2 * x[k + 2] + w3 * x[k + 3] : 0.f;
      xcs[t * LP + i] = f2bf(xv);
    }
#pragma unroll
    for (int k = 0; k < 2; ++k) {
      const int id = tid + k * 256, r = id >> 3, c8 = id & 7;
      *(uint4*)(was + r * LP + c8 * 8) = *(const uint4*)(Wl + W_WA + nb * 4096 + r * 64 + c8 * 8);
      *(uint4*)(wxs + r * LP + c8 * 8) = *(const uint4*)(Wl + W_WX + nb * 4096 + r * 64 + c8 * 8);
    }
    const int T = isS ? STT : PT;
    if (t0 + Lc == T && tid < 192) {
      const int k = tid >> 6;
      const float v = LX[(size_t)(row0 + Lc - 3 + k) * 512 + ch];
      if (isS) p.out[LC_S + (((size_t)l * SBT + b) * 3 + k) * 512 + ch] = v;
      else p.out[LC_P + (((size_t)l * PB + b) * 3 + k) * 512 + ch] = v;
    }
  }
  __syncthreads();
  {
    const float* ba = p.in[18] + (size_t)l * 512 + nb * 64;
    const float* bx = p.in[20] + (size_t)l * 512 + nb * 64;
    const float* lm = p.in[21] + (size_t)l * 512 + nb * 64;
#pragma unroll
    for (int n = 0; n < 4; ++n) {
      f32x4 r = lds_mm<2>(xcs, LP, wid * 16, was, LP, n * 16, f32x4{0.f, 0.f, 0.f, 0.f});
      f32x4 g = lds_mm<2>(xcs, LP, wid * 16, wxs, LP, n * 16, f32x4{0.f, 0.f, 0.f, 0.f});
      const int j = n * 16 + fr;
      const float sp = softplusf_(-lm[j]), bav = ba[j], bxv = bx[j];
#pragma unroll
      for (int q = 0; q < 4; ++q) {
        const int t = wid * 16 + fq * 4 + q;
        const float rr = sigmoidf_(r[q] + bav), ii = sigmoidf_(g[q] + bxv);
        const float la = -8.f * rr * sp;
        const float a = __expf(la);
        const float x2 = 2.f * la;
        const float om = (x2 > -0.01f) ? -x2 * (1.f + x2 * (0.5f + x2 * (1.f / 6.f))) : 1.f - __expf(x2);
        const float u = sqrtf(om) * ii * bf2f(xcs[t * LP + j]);
        as_[t * 64 + j] = a;
        us_[t * 64 + j] = u;
      }
    }
  }
  __syncthreads();
  {
    float av[16], uv[16];
#pragma unroll
    for (int k = 0; k < 16; ++k) { av[k] = as_[(tq * 16 + k) * 64 + i]; uv[k] = us_[(tq * 16 + k) * 64 + i]; }
    float P = 1.f, hh = 0.f;
#pragma unroll
    for (int k = 0; k < 16; ++k) { P *= av[k]; hh = av[k] * hh + uv[k]; }
    segP[tq * 64 + i] = P; segH[tq * 64 + i] = hh;
    __syncthreads();
    float Pin = 1.f, hin = 0.f;
    for (int g = 0; g < tq; ++g) { const float pg = segP[g * 64 + i], hg = segH[g * 64 + i]; hin = pg * hin + hg; Pin *= pg; }
    u16* HL = (u16*)(p.ws + O_HL);
    u16* PPp = (u16*)(p.ws + O_PP);
    P = Pin; hh = hin;
#pragma unroll
    for (int k = 0; k < 16; ++k) {
      const int t = tq * 16 + k;
      P *= av[k]; hh = av[k] * hh + uv[k];
      if (t < Lc) {
        HL[(size_t)(row0 + t) * 512 + ch] = f2bf(hh);
        PPp[(size_t)(row0 + t) * 512 + ch] = f2bf(P);
      }
    }
    if (tq * 16 + 16 == Lc) {
      ((float*)(p.ws + O_CA))[(size_t)ci * 512 + ch] = P;
      ((float*)(p.ws + O_CH))[(size_t)ci * 512 + ch] = hh;
    }
  }
}
constexpr int L2_ITEMS = 8 + 32;
DI void lru2_item(const Params& p, int l, int it) {
  const float* CA = (const float*)(p.ws + O_CA);
  const float* CH = (const float*)(p.ws + O_CH);
  float* HS = (float*)(p.ws + O_HS);
  if (it < 8) {
    const int e = it * 256 + TID(), b = e >> 9, ch = e & 511;
    float hh = 0.f;
    for (int c0 = 0; c0 < 128; c0 += 16) {
      float ca[16], chv[16];
#pragma unroll
      for (int c = 0; c < 16; ++c) { const size_t o = (size_t)(b * 128 + c0 + c) * 512 + ch; ca[c] = CA[o]; chv[c] = CH[o]; }
#pragma unroll
      for (int c = 0; c < 16; ++c) { const size_t o = (size_t)(b * 128 + c0 + c) * 512 + ch; HS[o] = hh; hh = ca[c] * hh + chv[c]; }
    }
    p.out[LH_P + ((size_t)l * PB + b) * 512 + ch] = hh;
  } else {
    const int e = (it - 8) * 256 + TID(), b = e >> 9, ch = e & 511;
    const float h0 = p.in[6][((size_t)l * SBT + b) * 512 + ch];
    const size_t o = (size_t)(MP / 64 + b) * 512 + ch;
    HS[o] = h0;
    p.out[LH_S + ((size_t)l * SBT + b) * 512 + ch] = CA[o] * h0 + CH[o];
  }
}
constexpr int L3_ITEMS = MT / 8;
DI void lru3_item(const Params& p, int it) {
  const u16* HL = (const u16*)(p.ws + O_HL);
  const u16* PPp = (const u16*)(p.ws + O_PP);
  const u16* LG = (const u16*)(p.ws + O_LG);
  const float* HS = (const float*)(p.ws + O_HS);
  u16* OL = (u16*)(p.ws + O_OL);
#pragma unroll
  for (int i = 0; i < 4; ++i) {
    const int id = TID() + i * 256;
    const int row = it * 8 + (id >> 7), c4 = (id & 127) * 4;
    const int ci = row < MP ? (row >> 6) : MP / 64 + ((row - MP) >> 5);
    const size_t o = (size_t)row * 512 + c4;
    const uint2 hl = *(const uint2*)(HL + o), pp = *(const uint2*)(PPp + o), lg = *(const uint2*)(LG + o);
    const float4 hs = *(const float4*)(HS + (size_t)ci * 512 + c4);
    float y0 = (bf2f(hl.x & 0xffff) + bf2f(pp.x & 0xffff) * hs.x) * gelu_tanh(bf2f(lg.x & 0xffff));
    float y1 = (bf2f(hl.x >> 16) + bf2f(pp.x >> 16) * hs.y) * gelu_tanh(bf2f(lg.x >> 16));
    float y2 = (bf2f(hl.y & 0xffff) + bf2f(pp.y & 0xffff) * hs.z) * gelu_tanh(bf2f(lg.y & 0xffff));
    float y3 = (bf2f(hl.y >> 16) + bf2f(pp.y >> 16) * hs.w) * gelu_tanh(bf2f(lg.y >> 16));
    *(uint2*)(OL + o) = uint2{pack2(y0, y1), pack2(y2, y3)};
  }
}

DI void ybr_tile(const Params& p, int l, int mt, int nt, char* smem) {
  const int row0 = mt * 256, col0 = nt * 256, br = nt >> 2;
  const u16* W = (const u16*)(p.ws + O_WT) + (size_t)l * W_LAYER + W_BR + (size_t)br * 1024 * 512 + (size_t)((nt & 3) * 256) * 512;
  const u16* O = (const u16*)(p.ws + (br == 0 ? O_OA : (br == 1 ? O_OG : O_OL))) + (size_t)row0 * 512;
  f32x4 acc[8][4];
  zero_acc8(acc);
  gemm512(O, 512, W, 512, 512, acc, smem);
  tile_out_bf16<false>(acc, (u16*)(p.ws + O_YP) + (size_t)row0 * 3072 + col0, 3072, smem, 1.f, 0, nullptr);
}
DI void gate_tile(const Params& p, int l, int mt, int nt, char* smem) {
  const int row0 = mt * 256, col0 = nt * 256;
  const u16* W = (const u16*)(p.ws + O_WT) + (size_t)l * W_LAYER + W_MG + (size_t)col0 * LDK;
  f32x4 acc[8][4];
  zero_acc8(acc);
  gemm512((const u16*)(p.ws + O_XN) + (size_t)row0 * LDK, LDK, W, LDK, 1024, acc, smem);
  EPI_IDS;
  u16* Y = (u16*)(p.ws + O_YP) + (size_t)row0 * 3072 + col0;
  const float* bm = p.in[26] + (size_t)l * 3072 + col0 + wc * 64 + fr;
  img_load_bf16(Y, 3072, smem, 256, 0);
  img_barrier();
  u16* img = (u16*)smem + (wr * 128 + fq * 4) * IMG_LD + wc * 64 + fr;
#pragma unroll
  for (int n = 0; n < 4; ++n) {
    const float bv = bm[n * 16];
#pragma unroll
    for (int m = 0; m < 8; ++m)
#pragma unroll
      for (int j = 0; j < 4; ++j) {
        u16* q = img + (m * 16 + j) * IMG_LD + n * 16;
        *q = f2bf(sigmoidf_(acc[m][n][j] + bv) * bf2f(*q));
      }
  }
  img_barrier();
  img_store_bf16(Y, 3072, smem, 0);
}
DI void resid_tile(const Params& p, const u16* A, int ldk, const u16* W, int mt, int nt, int k0, int klen, bool atomic, char* smem) {
  const int row0 = mt * 256, col0 = nt * 256;
  f32x4 acc[8][4];
  zero_acc8(acc);
  gemm512(A + (size_t)row0 * ldk + k0, ldk, W + (size_t)col0 * ldk + k0, ldk, klen, acc, smem);
  if (!atomic) { tile_out_f32<true, false>(acc, p.out + (size_t)row0 * 1024 + col0, 1024, smem, 0, nullptr); return; }
  EPI_IDS;
#pragma unroll
  for (int m = 0; m < 8; ++m) {
    asm volatile("" ::: "memory");
#pragma unroll
    for (int n = 0; n < 4; ++n)
#pragma unroll
      for (int j = 0; j < 4; ++j) {
        const int row = row0 + wr * 128 + m * 16 + fq * 4 + j, col = col0 + wc * 64 + n * 16 + fr;
        float* q = p.out + (size_t)row * 1024 + col;
        if (atomic) unsafeAtomicAdd(q, acc[m][n][j]); else *q += acc[m][n][j];
      }
  }
}
DI void resid_phase(const Params& p, const u16* A, int ldk, const u16* W, int B, int G, char* smem) {
  const int ns = ldk / 256;
  int k = 0, u = B;
  while (true) {
    int mt, nt, k0 = 0, kl = ldk;
    bool at = false;
    if (xcd_tile(B, G, k, 128, 4, mt, nt)) { ++k; }
    else if (u < 8 * ns) { const int t = u / ns, sl = u - t * ns; mt = 128 + (t >> 2); nt = t & 3; k0 = sl * 256; kl = 256; at = true; u += G; }
    else break;
    asm volatile("" : "+s"(kl));
    resid_tile(p, A, ldk, W, mt, nt, k0, kl, at, smem);
  }
}

DI void ffgate_tile(const Params& p, int l, int mt, int nt, char* smem) {
  const int row0 = mt * 256, col0 = nt * 256;
  const u16* W = (const u16*)(p.ws + O_WT) + (size_t)l * W_LAYER + W_FG;
  f32x4 acc[8][4];
  zero_acc8(acc);
  gemm512((const u16*)(p.ws + O_XN) + (size_t)row0 * LDK, LDK, W + (size_t)col0 * LDK, LDK, 1024, acc, smem);
  if (mt < 128) {
    EPI_IDS;
    tile_out_bf16<false>(acc, (u16*)(p.ws + O_GU) + (size_t)row0 * DFF + col0, DFF, smem, 1.f, 0, nullptr);
    if (((row0 + 256) & 8191) == 0 && wr == 1 && fq == 3) {
      const int b = row0 >> 13;
#pragma unroll
      for (int n = 0; n < 4; ++n) {
        const int col = col0 + wc * 64 + n * 16 + fr;
        p.out[FC_P + (((size_t)l * PB + b) * 2 + 0) * DFF + col] = acc[7][n][2];
        p.out[FC_P + (((size_t)l * PB + b) * 2 + 1) * DFF + col] = acc[7][n][3];
      }
    }
    return;
  }
  EPI_IDS;
  u16* GU = (u16*)(p.ws + O_GU);
  const bool isS = row0 >= MP;
#pragma unroll
  for (int m = 0; m < 8; ++m) {
    asm volatile("" ::: "memory");
#pragma unroll
    for (int n = 0; n < 4; ++n)
#pragma unroll
      for (int j = 0; j < 4; ++j) {
        const int row = row0 + wr * 128 + m * 16 + fq * 4 + j, col = col0 + wc * 64 + n * 16 + fr;
        const float v = acc[m][n][j];
        GU[(size_t)row * DFF + col] = f2bf(v);
        if (isS) {
          const int rs = row - MP, b = rs >> 5, t = rs & 31;
          if (t >= STT - 2) p.out[FC_S + (((size_t)l * SBT + b) * 2 + (t - (STT - 2))) * DFF + col] = v;
        } else {
          const int b = row >> 13, t = row & 8191;
          if (t >= PT - 2) p.out[FC_P + (((size_t)l * PB + b) * 2 + (t - (PT - 2))) * DFF + col] = v;
        }
      }
  }
}
DI void ffup_tile(const Params& p, int l, int mt, int nt, char* smem) {
  const int row0 = mt * 256, col0 = nt * 256;
  const u16* W = (const u16*)(p.ws + O_WT) + (size_t)l * W_LAYER + W_FU;
  f32x4 acc[8][4];
  zero_acc8(acc);
  gemm512((const u16*)(p.ws + O_XN) + (size_t)row0 * LDK, LDK, W + (size_t)col0 * LDK, LDK, 1024, acc, smem);
  if (mt < 128) {
    EPI_IDS;
    const u16* GUt = (const u16*)(p.ws + O_GU) + (size_t)row0 * DFF + col0;
    if (row0 >= 2) img_load_bf16(GUt - 2 * DFF, DFF, smem, 258, 0); else img_load_bf16(GUt, DFF, smem, 256, 2);
    img_barrier();
    const u16* img = (const u16*)smem + (wr * 128 + fq * 4) * IMG_LD + wc * 64 + fr;
#pragma unroll
    for (int n = 0; n < 4; ++n) {
      const int col = col0 + wc * 64 + n * 16 + fr;
      const float* cw = p.in[30] + (size_t)l * 3 * DFF + col;
      const float w0 = cw[0], w1 = cw[DFF], w2 = cw[2 * DFF], cb = p.in[31][(size_t)l * DFF + col];
#pragma unroll
      for (int m = 0; m < 8; ++m) {
        if ((m & 1) == 0) asm volatile("" ::: "memory");
        const int t = (row0 + wr * 128 + m * 16 + fq * 4) & 8191;
        float g[6];
#pragma unroll
        for (int d = 0; d < 6; ++d) { const float gv = bf2f(img[(m * 16 + d) * IMG_LD + n * 16]); g[d] = (d >= 2 || t - 2 + d >= 0) ? gv : 0.f; }
#pragma unroll
        for (int j = 0; j < 4; ++j) acc[m][n][j] *= gelu_tanh(cb + w0 * g[j] + w1 * g[j + 1] + w2 * g[j + 2]);
      }
    }
    img_barrier();
    img_put_bf16<false>(acc, smem, 2, 1.f, 0, nullptr);
    img_barrier();
    img_store_bf16((u16*)(p.ws + O_FF) + (size_t)row0 * DFF + col0, DFF, smem, 2);
    return;
  }
  EPI_IDS;
  const u16* GU = (const u16*)(p.ws + O_GU);
  u16* FF = (u16*)(p.ws + O_FF);
  const bool isS = row0 >= MP;
  const int rowq = row0 + wr * 128 + fq * 4;
  const unsigned gbase = (unsigned)rowq * (unsigned)DFF + (unsigned)(col0 + wc * 64 + fr);
#pragma unroll
  for (int n = 0; n < 4; ++n) {
    const int col = col0 + wc * 64 + n * 16 + fr;
    const float* cw = p.in[30] + (size_t)l * 3 * DFF + col;
    const float w0 = cw[0], w1 = cw[DFF], w2 = cw[2 * DFF], cb = p.in[31][(size_t)l * DFF + col];
#pragma unroll
    for (int mh = 0; mh < 2; ++mh) {
      asm volatile("" ::: "memory");
      float g[4][6];
#pragma unroll
      for (int m = 0; m < 4; ++m) {
        const int rowb = rowq + (mh * 4 + m) * 16;
        int b, t;
        if (isS) { int rs = rowb - MP; b = rs >> 5; t = rs & 31; } else { b = rowb >> 13; t = rowb & 8191; }
#pragma unroll
        for (int d = 0; d < 6; ++d) {
          const int tt = t - 2 + d;
          if (tt >= 0) g[m][d] = bf2f(GU[gbase + (unsigned)((((mh * 4 + m) * 16 + d) * DFF) + n * 16) - 2u * (unsigned)DFF]);
          else g[m][d] = isS ? p.in[7][(((size_t)l * SBT + b) * 2 + (2 + tt)) * DFF + col] : 0.f;
        }
      }
#pragma unroll
      for (int m = 0; m < 4; ++m)
#pragma unroll
        for (int j = 0; j < 4; ++j) {
          const float gc = cb + w0 * g[m][j] + w1 * g[m][j + 1] + w2 * g[m][j + 2];
          FF[gbase + (unsigned)((((mh * 4 + m) * 16 + j) * DFF) + n * 16)] = f2bf(gelu_tanh(gc) * acc[mh * 4 + m][n][j]);
        }
    }
  }
}

DI void norm_phase(const Params& p, int l, int mode, int B, int G, char* smem) {
  const int tid = TID512(), lane = tid & 63, wid = tid >> 6;
  const float* gamma = mode == 0 ? p.in[8] + (size_t)l * 1024 : (mode == 1 ? p.in[28] + (size_t)l * 1024 : p.in[34]);
  float* wga = (float*)smem;
  if (mode == 0) {
    __syncthreads();
    const float* src = p.in[9] + (size_t)l * 1024 * PW + 3072;
#pragma unroll
    for (int i = 0; i < 8; ++i) {
      const int id = tid + i * 512, k = id >> 2, part = id & 3;
      ((float4*)wga)[(((k >> 8) * 4 + (k & 3)) * 4 + part) * 64 + ((k >> 2) & 63)] = *(const float4*)(src + (size_t)k * PW + part * 4);
    }
    __syncthreads();
  }
  float4 g[4];
#pragma unroll
  for (int i = 0; i < 4; ++i) g[i] = *(const float4*)(gamma + i * 256 + lane * 4);
  for (int row = B * 8 + wid; row < MT; row += G * 8) {
    float* X = p.out + (size_t)row * 1024;
    float4 v[4];
    float ss = 0.f;
#pragma unroll
    for (int i = 0; i < 4; ++i) { v[i] = *(const float4*)(X + i * 256 + lane * 4); ss += v[i].x * v[i].x + v[i].y * v[i].y + v[i].z * v[i].z + v[i].w * v[i].w; }
    ss = wave_sum(ss);
    const float rs = rsqrtf(ss * (1.f / 1024.f) + EPS);
    u16* XN = (u16*)(p.ws + O_XN) + (size_t)row * LDK;
#pragma unroll
    for (int i = 0; i < 4; ++i) {
      v[i] = float4{v[i].x * rs * g[i].x, v[i].y * rs * g[i].y, v[i].z * rs * g[i].z, v[i].w * rs * g[i].w};
      if (mode == 2) *(float4*)(X + i * 256 + lane * 4) = v[i];
      else *(uint2*)(XN + i * 256 + lane * 4) = uint2{pack2(v[i].x, v[i].y), pack2(v[i].z, v[i].w)};
    }
    if (mode == 0) {
      float ga[16];
#pragma unroll
      for (int r = 0; r < 16; ++r) ga[r] = 0.f;
#pragma unroll
      for (int i = 0; i < 4; ++i) {
        const float xv[4] = {v[i].x, v[i].y, v[i].z, v[i].w};
#pragma unroll
        for (int e = 0; e < 4; ++e) {
          asm volatile("" ::: "memory");
#pragma unroll
          for (int q = 0; q < 4; ++q) {
            const float4 w = ((const float4*)wga)[((i * 4 + e) * 4 + q) * 64 + lane];
            ga[q * 4 + 0] += xv[e] * w.x; ga[q * 4 + 1] += xv[e] * w.y; ga[q * 4 + 2] += xv[e] * w.z; ga[q * 4 + 3] += xv[e] * w.w;
          }
        }
      }
      float mine = 0.f;
#pragma unroll
      for (int r = 0; r < 16; ++r) { const float s = wave_sum(ga[r]); if (lane == r) mine = s; }
      if (lane < 16) ((float*)(p.ws + O_GA))[(size_t)row * 16 + lane] = mine;
    }
  }
}

#define XB_TMO      128
#define XB_XCNT(j)  (256  + 64 * (j))
#define XB_XSUB(j)  (1280 + 64 * (j))
#define XB_XGEN(j)  (2304 + 64 * (j))
#define XB_TOP      3328
#define XB_TOPGEN   3392
#define XCD_BAR_WORDS 3456
#define XB_SPIN_CAP (1u << 18)
#define LAS __attribute__((address_space(3)))

__device__ __forceinline__ unsigned xb_ld(unsigned* p)              { return __hip_atomic_load(p, __ATOMIC_RELAXED, __HIP_MEMORY_SCOPE_AGENT); }
__device__ __forceinline__ unsigned xb_add(unsigned* p, unsigned v) { return __hip_atomic_fetch_add(p, v, __ATOMIC_RELAXED, __HIP_MEMORY_SCOPE_AGENT); }
__device__ __forceinline__ unsigned xb_xcc_id() { return (unsigned)__builtin_amdgcn_s_getreg((3 << 11) | 20) & 0xFu; }
#define XB_SPIN(cond, bar) do { unsigned _sp = 0; while (cond) { __builtin_amdgcn_s_sleep(1); \
    if ((++_sp & 255u) == 0u) { if (xb_ld(&(bar)[XB_TMO])) break; if (_sp > XB_SPIN_CAP) { atomicAdd(&(bar)[XB_TMO], 1u); break; } } } } while (0)

struct XcdBarrier {
    unsigned* bar; unsigned x;
    volatile LAS unsigned* st;
};

__device__ __forceinline__ XcdBarrier xcd_barrier_post(unsigned* bar, volatile LAS unsigned* st) {
    XcdBarrier b; b.bar = bar; b.x = xb_xcc_id(); b.st = st;
    if (threadIdx.x == 0) (void)xb_add(&bar[XB_XCNT(b.x)], 1u);
    return b;
}
__device__ __forceinline__ void xcd_barrier_complete(unsigned* bar, unsigned x, unsigned& nloc, unsigned& nx) {
    const unsigned G = gridDim.x * gridDim.y * gridDim.z;
    unsigned sum, cnt, mine, sp = 0u;
    for (;;) {
        sum = 0u; cnt = 0u; mine = 0u;
#pragma unroll
        for (unsigned j = 0; j < 16; ++j) { const unsigned c = xb_ld(&bar[XB_XCNT(j)]); sum += c; cnt += (c > 0u) ? 1u : 0u; mine = (j == x) ? c : mine; }
        if (sum == G) break;
        __builtin_amdgcn_s_sleep(1);
        if ((++sp & 255u) == 0u) { if (xb_ld(&bar[XB_TMO])) break; if (sp > XB_SPIN_CAP) { atomicAdd(&bar[XB_TMO], 1u); break; } }
    }
    nloc = mine > 0u ? mine : 1u; nx = cnt > 0u ? cnt : 1u;
}

__device__ __forceinline__ void xcd_barrier(const XcdBarrier& b) {
    asm volatile("s_waitcnt vmcnt(0)" ::: "memory");
    __syncthreads();
    if (threadIdx.x == 0) {
        unsigned* bar = b.bar;
        __builtin_amdgcn_s_waitcnt(0);
        unsigned nloc = b.st[0], nx = b.st[1];
        if (nloc == 0u) { xcd_barrier_complete(bar, b.x, nloc, nx); b.st[0] = nloc; b.st[1] = nx; }
        const unsigned old = xb_add(&bar[XB_XSUB(b.x)], 1u);
        const unsigned gen = old / nloc;
        if (old + 1u == (gen + 1u) * nloc) {
            __builtin_amdgcn_fence(__ATOMIC_RELEASE, "agent");
            asm volatile("s_waitcnt vmcnt(0)" ::: "memory");
            const unsigned og = xb_add(&bar[XB_TOP], 1u);
            const unsigned tg = og / nx;
            if (og + 1u == (tg + 1u) * nx) xb_add(&bar[XB_TOPGEN], 1u);
            else XB_SPIN(xb_ld(&bar[XB_TOPGEN]) == tg, bar);
            __builtin_amdgcn_fence(__ATOMIC_ACQUIRE, "agent");
            xb_add(&bar[XB_XGEN(b.x)], 1u);
            asm volatile("s_waitcnt vmcnt(0)" ::: "memory");
        } else {
            XB_SPIN(xb_ld(&bar[XB_XGEN(b.x)]) == gen, bar);
            __builtin_amdgcn_fence(__ATOMIC_ACQUIRE, "agent");
            asm volatile("s_waitcnt vmcnt(0)" ::: "memory");
        }
    }
    __syncthreads();
}


#ifndef ONLY
#define ONLY -1
#endif
constexpr int HALF_LDS = 73728;
constexpr int SMEM_BYTES = 2 * HALF_LDS;
#define VB() (2 * B + (TID512() >> 8))
#define HS() (smem + (TID512() >> 8) * HALF_LDS)
__global__ void __launch_bounds__(512, 2) mega(Params p) {
  cg::grid_group grid = cg::this_grid();
  extern __shared__ __attribute__((aligned(16))) char smem[];
  const int G = gridDim.x, B = blockIdx.x;
  __shared__ __attribute__((aligned(16))) unsigned xb_words[4];
  if (threadIdx.x < 4) xb_words[threadIdx.x] = 0u;
  __syncthreads();
  const XcdBarrier xb = xcd_barrier_post((unsigned*)(p.ws + O_BAR), (volatile LAS unsigned*)xb_words);
  const int vG = 2 * G;
  if (ONLY < 0 || ONLY == 0) for (int it = VB(); it < PREP_ITEMS; it += vG) prep_item(p, it, HS());
  grid.sync();
  for (int l = 0; l < NL; ++l) {
    const u16* W = (const u16*)(p.ws + O_WT) + (size_t)l * W_LAYER;
    if (ONLY < 0 || ONLY == 1) norm_phase(p, l, 0, B, G, smem);
    xcd_barrier(xb);
    if (ONLY < 0 || ONLY == 2) { int mt, nt; for (int k = 0; xcd_tile(B, G, k, 130, 16, mt, nt); ++k) projin_tile(p, l, mt, nt, smem); for (int it = VB(); it < PB_KC + PB_VC; it += vG) cache_conv_item(p, l, it, HS()); }
    xcd_barrier(xb);
    if (ONLY < 0 || ONLY == 3) {
      for (int k = 0; k < (G == 256 ? 5 : (1088 + G - 1) / G); ++k) {
        bool isS = false; int bh = 0, cp = 0; bool have = true;
        if (G == 256) {
          const int q = B >> 4; bh = B & 15;
          if (k == 0) cp = 63 - q; else if (k == 1) cp = 32 + q; else if (k == 2) cp = 31 - q;
          else if (k == 3) { if (q <= 11) cp = q + 4; else { isS = true; bh = (q - 12) * 16 + (B & 15); } }
          else { if (q >= 12) cp = q - 12; else have = false; }
        } else {
          const int it = B + k * G;
          if (it >= 1088) have = false; else if (it < 1024) { cp = it >> 4; bh = it & 15; } else { isS = true; bh = it - 1024; }
        }
        if (have) attn_item(p, l, isS, isS ? (bh >> 2) : (bh >> 2), bh & 3, cp, smem);
      }
    }
    if (ONLY < 0 || ONLY == 13) for (int it = VB(); it < NGI; it += vG) gla1_item(p, l, it, HS());
    if (ONLY < 0 || ONLY == 14) for (int it = VB(); it < L1_ITEMS; it += vG) lru1_item(p, l, it, HS());
    xcd_barrier(xb);
    if (ONLY < 0 || ONLY == 4) for (int it = VB(); it < G2_ITEMS + L2_ITEMS; it += vG) { if (it < G2_ITEMS) gla2_item(p, l, it); else lru2_item(p, l, it - G2_ITEMS); }
    xcd_barrier(xb);
    if (ONLY < 0 || ONLY == 5) { for (int it = VB(); it < NGI; it += vG) gla3_item(p, l, it, HS()); for (int it = VB(); it < L3_ITEMS; it += vG) lru3_item(p, it); }
    xcd_barrier(xb);
    if (ONLY < 0 || ONLY == 6) { int mt, nt; for (int k = 0; xcd_tile(B, G, k, 130, 12, mt, nt); ++k) ybr_tile(p, l, mt, nt, smem); }
    xcd_barrier(xb);
    if (ONLY < 0 || ONLY == 7) { int mt, nt; for (int k = 0; xcd_tile(B, G, k, 130, 12, mt, nt); ++k) gate_tile(p, l, mt, nt, smem); }
    xcd_barrier(xb);
    if (ONLY < 0 || ONLY == 8) resid_phase(p, (const u16*)(p.ws + O_YP), 3072, W + W_OUT, B, G, smem);
    xcd_barrier(xb);
    if (ONLY < 0 || ONLY == 9) norm_phase(p, l, 1, B, G, smem);
    xcd_barrier(xb);
    if (ONLY < 0 || ONLY == 10) { int mt, nt; for (int k = 0; xcd_tile(B, G, k, 130, 11, mt, nt); ++k) ffgate_tile(p, l, mt, nt, smem); }
    xcd_barrier(xb);
    if (ONLY < 0 || ONLY == 11) { int mt, nt; for (int k = 0; xcd_tile(B, G, k, 130, 11, mt, nt); ++k) ffup_tile(p, l, mt, nt, smem); }
    xcd_barrier(xb);
    if (ONLY < 0 || ONLY == 12) resid_phase(p, (const u16*)(p.ws + O_FF), DFF, W + W_FD, B, G, smem);
    xcd_barrier(xb);
  }
  if (ONLY < 0 || ONLY == 15) norm_phase(p, 0, 2, B, G, smem);
}

extern "C" void kernel_launch(void* const* d_in, const int* in_sizes, int n_in, void* d_out, int out_size, void* d_ws, size_t ws_size,
                              hipStream_t stream) {
  static int grid_blocks = 0;
  if (!grid_blocks) {
    int dev = 0, cus = 0, per = 0;
    (void)hipGetDevice(&dev);
    (void)hipDeviceGetAttribute(&cus, hipDeviceAttributeMultiprocessorCount, dev);
    (void)hipFuncSetAttribute((const void*)mega, hipFuncAttributeMaxDynamicSharedMemorySize, SMEM_BYTES);
    (void)hipOccupancyMaxActiveBlocksPerMultiprocessor(&per, mega, 512, SMEM_BYTES);
    if (per < 1) per = 1;
    grid_blocks = cus;
  }
  if (ws_size < WS_NEED) fprintf(stderr, "workspace too small: %zu < %zu\n", ws_size, (size_t)WS_NEED);
  Params p{};
  for (int i = 0; i < 35; ++i) p.in[i] = (const float*)d_in[i];
  p.out = (float*)d_out;
  p.ws = (char*)d_ws;
  (void)hipMemsetAsync((char*)d_ws + O_BAR, 0, XCD_BAR_WORDS * sizeof(unsigned), stream);
  void* args[] = {&p};
  hipError_t e = hipLaunchCooperativeKernel((void*)mega, dim3(grid_blocks), dim3(512), args, SMEM_BYTES, stream);
  if (e != hipSuccess) fprintf(stderr, "cooperative launch failed: %s (grid %d)\n", hipGetErrorString(e), grid_blocks);
}
```

```cpp
#include <hip/hip_runtime.h>
#include <hip/hip_cooperative_groups.h>
#include <cstdio>
namespace cg = cooperative_groups;

#define DI __device__ __forceinline__
typedef unsigned short u16;
using bf16x8 = __attribute__((ext_vector_type(8))) short;
using f32x4 = __attribute__((ext_vector_type(4))) float;
using u32x4 = __attribute__((ext_vector_type(4))) unsigned;
#define MFMA16(a, b, c) __builtin_amdgcn_mfma_f32_16x16x32_bf16((a), (b), (c), 0, 0, 0)

constexpr int DM = 1024, PB = 4, PT = 8192, SBT = 16, STT = 32, PAST = 2048, NL = 4;
constexpr int MP = PB * PT, MS = SBT * STT, MT = MP + MS;
constexpr int SKP = 2112;
constexpr int SKV = PAST + STT;
constexpr int DFF = 2816, PW = 4112, PWP = 4224;
constexpr int NGI = PB * 4 * 128 + SBT * 4;
constexpr int NLC = MP / 64 + SBT;
constexpr float EPS = 1e-6f;
constexpr float QSCALE = 0.125f * 1.4426950408889634f;
constexpr int LDK = 1088;

constexpr size_t W_IN = 0, W_MG = W_IN + (size_t)4096 * LDK, W_BR = W_MG + (size_t)3072 * LDK, W_OUT = W_BR + (size_t)3 * 1024 * 512,
                 W_FG = W_OUT + (size_t)1024 * 3072, W_FU = W_FG + (size_t)DFF * LDK, W_FD = W_FU + (size_t)DFF * LDK,
                 W_WA = W_FD + (size_t)1024 * DFF, W_WX = W_WA + 32768, W_LAYER = W_WX + 32768;

struct Params {
  const float* in[35];
  float* out;
  char* ws;
};

constexpr size_t al(size_t x) { return (x + 255) & ~(size_t)255; }
constexpr size_t O_WT = 0;
constexpr size_t O_ROPE = al(O_WT + W_LAYER * NL * 2);
constexpr size_t O_LAM = al(O_ROPE + 2 * 8192 * 8 * 4);
constexpr size_t O_BAR = al(O_LAM + 256);
constexpr size_t O_XN = al(O_BAR + 4096 * 4);
constexpr size_t O_REG = al(O_XN + (size_t)MT * LDK * 2);
constexpr size_t O_QB = O_REG;
constexpr size_t O_KB = al(O_QB + (size_t)MT * 512 * 2);
constexpr size_t O_KS = al(O_KB + (size_t)MP * 512 * 2);
constexpr size_t O_VT = al(O_KS + (size_t)SBT * SKP * 512 * 2);
constexpr size_t O_VTS = al(O_VT + (size_t)MP * 512 * 2);
constexpr size_t O_GQ = al(O_VTS + (size_t)SBT * SKP * 512 * 2);
constexpr size_t O_GK = al(O_GQ + (size_t)MT * 256 * 2);
constexpr size_t O_GV = al(O_GK + (size_t)MT * 256 * 2);
constexpr size_t O_GR = al(O_GV + (size_t)MT * 512 * 2);
constexpr size_t O_GA = al(O_GR + (size_t)MT * 512 * 2);
constexpr size_t O_LX = al(O_GA + (size_t)MT * 16 * 4);
constexpr size_t O_LG = al(O_LX + (size_t)MT * 512 * 4);
constexpr size_t O_KVT = al(O_LG + (size_t)MT * 512 * 2);
constexpr size_t O_DEC = al(O_KVT + (size_t)NGI * 8192 * 2);
constexpr size_t O_HL = al(O_DEC + (size_t)NGI * 64 * 4);
constexpr size_t O_PP = al(O_HL + (size_t)MT * 512 * 2);
constexpr size_t O_CA = al(O_PP + (size_t)MT * 512 * 2);
constexpr size_t O_CH = al(O_CA + (size_t)NLC * 512 * 4);
constexpr size_t O_HS = al(O_CH + (size_t)NLC * 512 * 4);
constexpr size_t O_OA = al(O_HS + (size_t)NLC * 512 * 4);
constexpr size_t O_OG = al(O_OA + (size_t)MT * 512 * 2);
constexpr size_t O_OL = al(O_OG + (size_t)MT * 512 * 2);
constexpr size_t O_END1 = al(O_OL + (size_t)MT * 512 * 2);
constexpr size_t O_YP = O_QB;
static_assert(O_YP + (size_t)MT * 3072 * 2 <= O_OA, "Y buffer overlaps live mixer outputs");
constexpr size_t O_GU = O_REG;
constexpr size_t O_FF = al(O_GU + (size_t)MT * DFF * 2);
constexpr size_t O_END2 = al(O_FF + (size_t)MT * DFF * 2);
constexpr size_t WS_NEED = O_END1 > O_END2 ? O_END1 : O_END2;

constexpr size_t Y_P = 0, Y_S = Y_P + (size_t)MP * 1024, K_P = Y_S + (size_t)MS * 1024, V_P = K_P + (size_t)NL * MP * 512,
                 GLA_P = V_P + (size_t)NL * MP * 512, LC_P = GLA_P + (size_t)NL * PB * 32768, LH_P = LC_P + (size_t)NL * PB * 3 * 512,
                 FC_P = LH_P + (size_t)NL * PB * 512, K_S = FC_P + (size_t)NL * PB * 2 * DFF, V_S = K_S + (size_t)NL * MS * 512,
                 GLA_S = V_S + (size_t)NL * MS * 512, LC_S = GLA_S + (size_t)NL * SBT * 32768, LH_S = LC_S + (size_t)NL * SBT * 3 * 512,
                 FC_S = LH_S + (size_t)NL * SBT * 512, OUT_TOTAL = FC_S + (size_t)NL * SBT * 2 * DFF;

DI int TID() { int t = threadIdx.x & 255; asm volatile("" : "+v"(t)); return t; }
DI int TID512() { int t = threadIdx.x; asm volatile("" : "+v"(t)); return t; }
DI u16 f2bf(float x) { __bf16 h = (__bf16)x; return __builtin_bit_cast(u16, h); }
DI float bf2f(u16 h) { return __uint_as_float(((unsigned)h) << 16); }
typedef __bf16 bf16v2_t __attribute__((ext_vector_type(2)));
typedef float f32v2_t __attribute__((ext_vector_type(2)));
DI unsigned pack2(float a, float b) { f32v2_t v = {a, b}; bf16v2_t r = __builtin_convertvector(v, bf16v2_t); return __builtin_bit_cast(unsigned, r); }
DI float sigmoidf_(float x) { return __builtin_amdgcn_rcpf(1.f + __expf(-x)); }
DI float gelu_tanh(float x) { float u = 0.7978845608028654f * (x + 0.044715f * x * x * x); return x * sigmoidf_(2.f * u); }
DI float softplusf_(float x) { return fmaxf(x, 0.f) + __logf(1.f + __expf(-fabsf(x))); }
DI float quad_max(float v) {
  auto a = __builtin_amdgcn_permlane16_swap(__float_as_uint(v), __float_as_uint(v), false, false);
  v = fmaxf(__uint_as_float(a[0]), __uint_as_float(a[1]));
  auto b = __builtin_amdgcn_permlane32_swap(__float_as_uint(v), __float_as_uint(v), false, false);
  return fmaxf(__uint_as_float(b[0]), __uint_as_float(b[1]));
}
DI float wave_sum(float v) {
  for (int o = 32; o > 0; o >>= 1) v += __shfl_xor(v, o);
  return v;
}

DI void gemm512(const u16* __restrict__ A, int lda, const u16* __restrict__ B, int ldb, int K, f32x4 (&acc)[8][4], char* smem) {
  const int tid = TID512(), lane = tid & 63, wid = tid >> 6, wr = wid >> 2, wc = wid & 3, fr = lane & 15, fq = lane >> 4;
  const int lrow = tid >> 3;
  const int gch = (tid & 7) ^ ((lrow >> 1) & 7);
  const unsigned aov = (unsigned)(lrow * lda + gch * 8);
  const unsigned bov = (unsigned)(lrow * ldb + gch * 8);
  const int soff = tid * 16;
  const int sw = (fr >> 1) & 7;
  const int aoff = (wr * 128 + fr) * 128, boff = 32768 + (wc * 64 + fr) * 128;
  const int nk = K >> 6;
  asm volatile("s_waitcnt lgkmcnt(0)" ::: "memory");
  __builtin_amdgcn_s_barrier();
#pragma unroll
  for (int i = 0; i < 4; ++i) {
    __builtin_amdgcn_global_load_lds((const unsigned*)((A + (size_t)i * 64 * lda) + aov), (unsigned*)(smem + soff + i * 8192), 16, 0, 0);
    __builtin_amdgcn_global_load_lds((const unsigned*)((B + (size_t)i * 64 * ldb) + bov), (unsigned*)(smem + 32768 + soff + i * 8192), 16, 0, 0);
  }
  asm volatile("s_waitcnt vmcnt(0)" ::: "memory");
  __builtin_amdgcn_s_barrier();
  for (int kt = 0; kt < nk; ++kt) {
    const int buf = kt & 1;
    const bool more = kt + 1 < nk;
    char* st = smem + (buf ^ 1) * 65536 + soff;
    const u16* An = A + (kt + 1) * 64;
    const u16* Bn = B + (kt + 1) * 64;
    const char* Sb = smem + buf * 65536;
#pragma unroll
    for (int ks = 0; ks < 2; ++ks) {
      const int co = ((ks * 4 + fq) ^ sw) << 4;
      bf16x8 bfr[4], af[8];
#pragma unroll
      for (int n = 0; n < 4; ++n) bfr[n] = *(const bf16x8*)(Sb + boff + n * 2048 + co);
#pragma unroll
      for (int m = 0; m < 8; ++m) af[m] = *(const bf16x8*)(Sb + aoff + m * 2048 + co);
      __builtin_amdgcn_sched_barrier(0);
#pragma unroll
      for (int g = 0; g < 4; ++g) {
#pragma unroll
        for (int mm = 0; mm < 2; ++mm)
#pragma unroll
          for (int n = 0; n < 4; ++n) acc[g * 2 + mm][n] = MFMA16(af[g * 2 + mm], bfr[n], acc[g * 2 + mm][n]);
        __builtin_amdgcn_sched_barrier(0);
        if (more && ks == 0) {
          __builtin_amdgcn_global_load_lds((const unsigned*)((An + (size_t)g * 64 * lda) + aov), (unsigned*)(st + g * 8192), 16, 0, 0);
          __builtin_amdgcn_global_load_lds((const unsigned*)((Bn + (size_t)g * 64 * ldb) + bov), (unsigned*)(st + 32768 + g * 8192), 16, 0, 0);
        }
        __builtin_amdgcn_sched_barrier(0);
      }
    }
    asm volatile("s_waitcnt vmcnt(0) lgkmcnt(0)" ::: "memory");
    __builtin_amdgcn_s_barrier();
  }
}
DI void zero_acc8(f32x4 (&acc)[8][4]) {
#pragma unroll
  for (int m = 0; m < 8; ++m)
#pragma unroll
    for (int n = 0; n < 4; ++n) acc[m][n] = f32x4{0.f, 0.f, 0.f, 0.f};
}
#define EPI_IDS const int tid = TID512(), lane = tid & 63, wid = tid >> 6, wr = wid >> 2, wc = wid & 3, fr = lane & 15, fq = lane >> 4


constexpr int IMG_LD = 264;
constexpr int IMGF_LD = 260;
DI void img_barrier() { asm volatile("s_waitcnt lgkmcnt(0)" ::: "memory"); __builtin_amdgcn_s_barrier(); }
template <bool ROPE>
DI float epi_val(const f32x4 (&acc)[8][4], int m, int n, int j, const float* cs4, const float* sn4, int fr) {
  float v = acc[m][n][j];
  if (ROPE && n == 0) {
    const float pr = __shfl_xor(v, 8);
    v = (fr < 8) ? v * cs4[j] - pr * sn4[j] : v * cs4[j] + pr * sn4[j];
  }
  return v;
}
template <bool ROPE>
DI void img_put_bf16(const f32x4 (&acc)[8][4], char* smem, int rowoff, float scale, int prow0, const float* cosT) {
  EPI_IDS;
  u16* img = (u16*)smem + (wr * 128 + fq * 4 + rowoff) * IMG_LD + wc * 64 + fr;
#pragma unroll
  for (int m = 0; m < 8; ++m) {
    float cs4[4] = {0.f, 0.f, 0.f, 0.f}, sn4[4] = {0.f, 0.f, 0.f, 0.f};
    if (ROPE) {
#pragma unroll
      for (int j = 0; j < 4; ++j) { const int pos = prow0 + wr * 128 + m * 16 + fq * 4 + j; cs4[j] = cosT[pos * 8 + (fr & 7)]; sn4[j] = cosT[8192 * 8 + pos * 8 + (fr & 7)]; }
    }
#pragma unroll
    for (int n = 0; n < 4; ++n)
#pragma unroll
      for (int j = 0; j < 4; ++j) img[(m * 16 + j) * IMG_LD + n * 16] = f2bf(epi_val<ROPE>(acc, m, n, j, cs4, sn4, fr) * scale);
  }
}
DI void img_store_bf16(u16* dst, int ld, const char* smem, int rowoff) {
  const int tid = TID512();
#pragma unroll
  for (int q = 0; q < 16; ++q) {
    const int slot = tid + q * 512, row = slot >> 5, c16 = slot & 31;
    *(u32x4*)(dst + (size_t)row * ld + c16 * 8) = *(const u32x4*)(smem + (row + rowoff) * (IMG_LD * 2) + c16 * 16);
  }
}
DI void img_load_bf16(const u16* src, int ld, char* smem, int nrows, int rowoff) {
  for (int slot = TID512(); slot < nrows * 32; slot += 512) {
    const int row = slot >> 5, c16 = slot & 31;
    *(u32x4*)(smem + (row + rowoff) * (IMG_LD * 2) + c16 * 16) = *(const u32x4*)(src + (size_t)row * ld + c16 * 8);
  }
}
template <bool ROPE>
DI void imgf_put(const f32x4 (&acc)[8][4], int h, char* smem, int prow0, const float* cosT) {
  EPI_IDS;
  if (wr == h) {
    float* f = (float*)smem + (fq * 4) * IMGF_LD + wc * 64 + fr;
#pragma unroll
    for (int m = 0; m < 8; ++m) {
      float cs4[4] = {0.f, 0.f, 0.f, 0.f}, sn4[4] = {0.f, 0.f, 0.f, 0.f};
      if (ROPE) {
#pragma unroll
        for (int j = 0; j < 4; ++j) { const int pos = prow0 + wr * 128 + m * 16 + fq * 4 + j; cs4[j] = cosT[pos * 8 + (fr & 7)]; sn4[j] = cosT[8192 * 8 + pos * 8 + (fr & 7)]; }
      }
#pragma unroll
      for (int n = 0; n < 4; ++n)
#pragma unroll
        for (int j = 0; j < 4; ++j) f[(m * 16 + j) * IMGF_LD + n * 16] = epi_val<ROPE>(acc, m, n, j, cs4, sn4, fr);
    }
  }
}
template <bool ADD>
DI void imgf_store(float* dst, const float* rsrc, int ld, const char* smem) {
  const int tid = TID512();
  const unsigned o0 = (unsigned)((tid >> 6) * ld + (tid & 63) * 4);
  const char* src = smem + (tid >> 6) * (IMGF_LD * 4) + (tid & 63) * 16;
#pragma unroll
  for (int q = 0; q < 16; ++q) {
    if ((q & 3) == 0) asm volatile("" ::: "memory");
    float4 v = *(const float4*)(src + q * 8 * (IMGF_LD * 4));
    float4* d = (float4*)(dst + (o0 + (unsigned)(q * 8 * ld)));
    if (ADD) { const float4 x = *(const float4*)(rsrc + (o0 + (unsigned)(q * 8 * ld))); v.x += x.x; v.y += x.y; v.z += x.z; v.w += x.w; }
    *d = v;
  }
}
template <bool ADD, bool ROPE>
DI void tile_out_f32(const f32x4 (&acc)[8][4], float* dst, int ld, char* smem, int prow0, const float* cosT, const float* rsrc = nullptr) {
#pragma unroll 1
  for (int h = 0; h < 2; ++h) {
    img_barrier();
    imgf_put<ROPE>(acc, h, smem, prow0, cosT);
    img_barrier();
    imgf_store<ADD>(dst + (size_t)h * 128 * ld, ADD ? rsrc + (size_t)h * 128 * ld : nullptr, ld, smem);
  }
}
template <bool ROPE>
DI void tile_out_bf16(const f32x4 (&acc)[8][4], u16* dst, int ld, char* smem, float scale, int prow0, const float* cosT) {
  img_barrier();
  img_put_bf16<ROPE>(acc, smem, 0, scale, prow0, cosT);
  img_barrier();
  img_store_bf16(dst, ld, smem, 0);
}

template <int KS>
DI f32x4 lds_mm(const u16* As, int lsa, int arow, const u16* Bs, int lsb, int brow, f32x4 acc) {
  const int lane = TID() & 63, fr = lane & 15, fq = lane >> 4;
#pragma unroll
  for (int ks = 0; ks < KS; ++ks) {
    bf16x8 a = *(const bf16x8*)(As + (arow + fr) * lsa + ks * 32 + fq * 8);
    bf16x8 b = *(const bf16x8*)(Bs + (brow + fr) * lsb + ks * 32 + fq * 8);
    acc = MFMA16(a, b, acc);
  }
  return acc;
}

constexpr int PREP_T_PER_LAYER = 64 * 16 + 48 * 16 + 3 * 128 + 3 * 256 + 3 * 704 + 16;
constexpr int PREP_T = PREP_T_PER_LAYER * NL;
constexpr int PREP_COPY = MS * 1024 / 4096;
constexpr int PREP_ROPE = 8192 * 8 / 256;
constexpr int PREP_ITEMS = PREP_T + PREP_COPY + PREP_ROPE + 2;

DI void transpose_tile(const float* src, int lds_, int k0, int c0, int ncols_valid, u16* dst, int ldd, int n0, float* tile) {
  const int tid = TID();
  __syncthreads();
#pragma unroll
  for (int i = 0; i < 16; ++i) {
    int e = tid + i * 256, r = e >> 6, c = e & 63;
    tile[r * 65 + c] = (c < ncols_valid) ? src[(size_t)(k0 + r) * lds_ + c0 + c] : 0.f;
  }
  __syncthreads();
#pragma unroll
  for (int i = 0; i < 16; ++i) {
    int e = tid + i * 256, c = e >> 6, r = e & 63;
    dst[(size_t)(n0 + c) * ldd + k0 + r] = f2bf(tile[r * 65 + c]);
  }
}

DI void prep_item(const Params& p, int it, char* smem) {
  const int tid = TID();
  if (it < PREP_T) {
    const int l = it / PREP_T_PER_LAYER;
    int t = it % PREP_T_PER_LAYER;
    u16* W = (u16*)(p.ws + O_WT) + (size_t)l * W_LAYER;
    float* tile = (float*)smem;
    if (t < 64 * 16) {
      int nt = t / 16, kt = t % 16, n0 = nt * 64;
      const int c0 = n0 < 3072 ? n0 : n0 + 16;
      transpose_tile(p.in[9] + (size_t)l * 1024 * PW, PW, kt * 64, c0, 64, W + W_IN, LDK, n0, tile);
      return;
    }
    t -= 64 * 16;
    if (t < 48 * 16) { transpose_tile(p.in[25] + (size_t)l * 1024 * 3072, 3072, (t % 16) * 64, (t / 16) * 64, 64, W + W_MG, LDK, (t / 16) * 64, tile); return; }
    t -= 48 * 16;
    if (t < 3 * 128) {
      int br = t / 128, tt = t % 128;
      transpose_tile(p.in[22 + br] + (size_t)l * 512 * 1024, 1024, (tt % 8) * 64, (tt / 8) * 64, 64, W + W_BR + (size_t)br * 1024 * 512, 512, (tt / 8) * 64, tile);
      return;
    }
    t -= 3 * 128;
    if (t < 768) { const int cp = t / 256, tt = t % 256; transpose_tile(p.in[27] + (size_t)l * 1024 * 1024, 1024, (tt % 16) * 64, (tt / 16) * 64, 64, W + W_OUT + cp * 1024, 3072, (tt / 16) * 64, tile); return; }
    t -= 768;
    if (t < 704) { transpose_tile(p.in[29] + (size_t)l * 1024 * DFF, DFF, (t % 16) * 64, (t / 16) * 64, 64, W + W_FG, LDK, (t / 16) * 64, tile); return; }
    t -= 704;
    if (t < 704) { transpose_tile(p.in[32] + (size_t)l * 1024 * DFF, DFF, (t % 16) * 64, (t / 16) * 64, 64, W + W_FU, LDK, (t / 16) * 64, tile); return; }
    t -= 704;
    if (t < 704) { transpose_tile(p.in[33] + (size_t)l * DFF * 1024, 1024, (t % 44) * 64, (t / 44) * 64, 64, W + W_FD, DFF, (t / 44) * 64, tile); return; }
    t -= 704;
    if (t < 8) { transpose_tile(p.in[17] + (size_t)l * 32768 + t * 4096, 64, 0, 0, 64, W + W_WA + t * 4096, 64, 0, tile); return; }
    t -= 8;
    transpose_tile(p.in[19] + (size_t)l * 32768 + t * 4096, 64, 0, 0, 64, W + W_WX + t * 4096, 64, 0, tile);
    return;
  }
  it -= PREP_T;
  if (it < PREP_COPY) {
    const size_t base = (size_t)it * 4096;
#pragma unroll
    for (int i = 0; i < 4; ++i) {
      const size_t e = base + (size_t)(tid + i * 256) * 4;
      *(float4*)(p.out + (size_t)MP * 1024 + e) = *(const float4*)(p.in[1] + e);
    }
    return;
  }
  it -= PREP_COPY;
  if (it < PREP_ROPE) {
    int e = it * 256 + tid, pos = e >> 3, i = e & 7;
    double inv = pow(500000.0, -(double)i / 8.0);
    double ang = (double)pos * inv;
    double kq = rint(ang * 0.15915494309189535);
    double r = ang - kq * 6.283185307179586;
    float rf = (float)r;
    float* cs = (float*)(p.ws + O_ROPE);
    cs[e] = cosf(rf);
    cs[8192 * 8 + e] = sinf(rf);
    return;
  }
  if (it == PREP_ROPE && tid < 64 * NL) {
    int l = tid >> 6, i = tid & 63;
    const float* lq = p.in[10] + (size_t)l * 256;
    float a = lq[i] * lq[64 + i], b = lq[128 + i] * lq[192 + i];
    a = wave_sum(a); b = wave_sum(b);
    if (i == 0) {
      float lam_init = 0.8f - 0.6f * __expf(-0.3f * (float)l);
      ((float*)(p.ws + O_LAM))[l] = __expf(a) - __expf(b) + lam_init;
    }
  }
}

DI bool xcd_tile(int B, int G, int iter, int MTILES, int NT, int& mt, int& nt) {
  const int nxb = G >> 3;
  const int x = B & 7, lb = B >> 3;
  const int q = MTILES >> 3, r = MTILES & 7;
  const int mx = q + (x < r ? 1 : 0);
  const int mbase = x * q + (x < r ? x : r);
  const int j = lb + iter * nxb;
  if (j >= mx * NT) return false;
  const int band = j / (8 * NT);
  const int rem = j - band * 8 * NT;
  const int nb = (mx - band * 8) < 8 ? (mx - band * 8) : 8;
  mt = mbase + band * 8 + rem % nb;
  nt = rem / nb;
  return true;
}

constexpr int PB_KC = SBT * PAST * 512 / 4096;
constexpr int PB_VC = SBT * 32 * 8;

DI void projin_tile(const Params& p, int l, int mt, int nt, char* smem) {
  const int row0 = mt * 256, col0 = nt * 256;
  const u16* W = (const u16*)(p.ws + O_WT) + (size_t)l * W_LAYER + W_IN;
  const u16* XN = (const u16*)(p.ws + O_XN);
  f32x4 acc[8][4];
  zero_acc8(acc);
  gemm512(XN + (size_t)row0 * LDK, LDK, W + (size_t)col0 * LDK, LDK, 1024, acc, smem);
  const float* cosT = (const float*)(p.ws + O_ROPE);
  const float* sinT = cosT + 8192 * 8;
  if (mt < 128) {
    const int prow0 = row0 & 8191;
    if (nt < 2) {
      tile_out_bf16<true>(acc, (u16*)(p.ws + O_QB) + (size_t)row0 * 512 + col0, 512, smem, QSCALE, prow0, cosT);
    } else if (nt < 4) {
      tile_out_f32<false, true>(acc, p.out + K_P + ((size_t)l * MP + row0) * 512 + (col0 - 512), 512, smem, prow0, cosT);
      tile_out_bf16<true>(acc, (u16*)(p.ws + O_KB) + (size_t)row0 * 512 + (col0 - 512), 512, smem, 1.f, prow0, cosT);
    } else if (nt < 6) {
      tile_out_f32<false, false>(acc, p.out + V_P + ((size_t)l * MP + row0) * 512 + (col0 - 1024), 512, smem, 0, nullptr);
      EPI_IDS;
      u16* VT = (u16*)(p.ws + O_VT);
      const unsigned vb = (unsigned)((row0 >> 13) * 512 + (col0 - 1024) + wc * 64 + fr) * (unsigned)PT + (unsigned)((row0 & 8191) + wr * 128 + fq * 4);
#pragma unroll
      for (int m = 0; m < 8; ++m) {
        asm volatile("" ::: "memory");
#pragma unroll
        for (int n = 0; n < 4; ++n) {
          const uint2 pk = {pack2(acc[m][n][0], acc[m][n][1]), pack2(acc[m][n][2], acc[m][n][3])};
          *(uint2*)(VT + (vb + (unsigned)(n * 16 * PT + m * 16))) = pk;
        }
      }
    } else if (nt >= 12 && nt < 14) {
      tile_out_f32<false, false>(acc, (float*)(p.ws + O_LX) + (size_t)row0 * 512 + (col0 - 3072), 512, smem, 0, nullptr);
    } else {
      u16* dst; int ld = 512, cbase;
      if (nt == 6) { dst = (u16*)(p.ws + O_GQ); ld = 256; cbase = 1536; }
      else if (nt == 7) { dst = (u16*)(p.ws + O_GK); ld = 256; cbase = 1792; }
      else if (nt < 10) { dst = (u16*)(p.ws + O_GV); cbase = 2048; }
      else if (nt < 12) { dst = (u16*)(p.ws + O_GR); cbase = 2560; }
      else { dst = (u16*)(p.ws + O_LG); cbase = 3584; }
      tile_out_bf16<false>(acc, dst + (size_t)row0 * ld + (col0 - cbase), ld, smem, nt == 6 ? 0.125f : 1.f, 0, nullptr);
    }
    return;
  }
  EPI_IDS;
  const bool isS = row0 >= MP;
  if (nt < 4) {
    const bool isq = nt < 2;
    u16* QB = (u16*)(p.ws + O_QB);
    u16* KB = (u16*)(p.ws + O_KB);
    u16* KS = (u16*)(p.ws + O_KS);
#pragma unroll
    for (int m = 0; m < 8; ++m) {
      asm volatile("" ::: "memory");
#pragma unroll
      for (int n = 0; n < 4; ++n)
#pragma unroll
        for (int j = 0; j < 4; ++j) {
          const int row = row0 + wr * 128 + m * 16 + fq * 4 + j;
          const int col = col0 + wc * 64 + n * 16 + fr;
          float v = acc[m][n][j];
          int b, t;
          if (isS) { int rs = row - MP; b = rs >> 5; t = rs & 31; } else { b = row >> 13; t = row & 8191; }
          const int pos = isS ? PAST + t : t;
          if (n == 0) {
            float pr = __shfl_xor(v, 8);
            float cs = cosT[pos * 8 + (fr & 7)], sn = sinT[pos * 8 + (fr & 7)];
            v = (fr < 8) ? v * cs - pr * sn : v * cs + pr * sn;
          }
          if (isq) {
            QB[(size_t)row * 512 + col] = f2bf(v * QSCALE);
          } else {
            const int ck = col - 512;
            if (isS) {
              p.out[K_S + ((size_t)l * MS + (row - MP)) * 512 + ck] = v;
              KS[((size_t)b * SKP + PAST + t) * 512 + ck] = f2bf(v);
            } else {
              p.out[K_P + ((size_t)l * MP + row) * 512 + ck] = v;
              KB[(size_t)row * 512 + ck] = f2bf(v);
            }
          }
        }
    }
  } else if (nt < 6) {
    u16* VT = (u16*)(p.ws + O_VT);
    u16* VTS = (u16*)(p.ws + O_VTS);
#pragma unroll
    for (int m = 0; m < 8; ++m) {
      asm volatile("" ::: "memory");
#pragma unroll
      for (int n = 0; n < 4; ++n) {
        const int rowb = row0 + wr * 128 + m * 16 + fq * 4;
        const int cv = col0 - 1024 + wc * 64 + n * 16 + fr;
        const int h = cv >> 7, vd = cv & 127;
        int b, t;
        if (isS) { int rs = rowb - MP; b = rs >> 5; t = rs & 31; } else { b = rowb >> 13; t = rowb & 8191; }
#pragma unroll
        for (int j = 0; j < 4; ++j) {
          if (isS) p.out[V_S + ((size_t)l * MS + (rowb + j - MP)) * 512 + cv] = acc[m][n][j];
          else p.out[V_P + ((size_t)l * MP + rowb + j) * 512 + cv] = acc[m][n][j];
        }
        uint2 pk = {pack2(acc[m][n][0], acc[m][n][1]), pack2(acc[m][n][2], acc[m][n][3])};
        if (isS) *(uint2*)(VTS + ((size_t)(b * 4 + h) * 128 + vd) * SKP + PAST + t) = pk;
        else *(uint2*)(VT + ((size_t)(b * 4 + h) * 128 + vd) * PT + t) = pk;
      }
    }
  } else {
    u16* dst16 = nullptr; float* dst32 = nullptr; int ld = 512, cbase = 0; float scale = 1.f;
    if (nt == 6) { dst16 = (u16*)(p.ws + O_GQ); ld = 256; cbase = 1536; scale = 0.125f; }
    else if (nt == 7) { dst16 = (u16*)(p.ws + O_GK); ld = 256; cbase = 1792; }
    else if (nt < 10) { dst16 = (u16*)(p.ws + O_GV); cbase = 2048; }
    else if (nt < 12) { dst16 = (u16*)(p.ws + O_GR); cbase = 2560; }
    else if (nt < 14) { dst32 = (float*)(p.ws + O_LX); cbase = 3072; }
    else { dst16 = (u16*)(p.ws + O_LG); cbase = 3584; }
#pragma unroll
    for (int m = 0; m < 8; ++m) {
      asm volatile("" ::: "memory");
#pragma unroll
      for (int n = 0; n < 4; ++n)
#pragma unroll
        for (int j = 0; j < 4; ++j) {
          const int row = row0 + wr * 128 + m * 16 + fq * 4 + j;
          const int c = col0 + wc * 64 + n * 16 + fr - cbase;
          const float v = acc[m][n][j] * scale;
          if (dst16) dst16[(size_t)row * ld + c] = f2bf(v);
          else dst32[(size_t)row * ld + c] = v;
        }
    }
  }
}

DI void cache_conv_item(const Params& p, int l, int it, char* smem) {
  const int tid = TID();
  if (it < PB_KC) {
    const float* src = p.in[2] + (size_t)l * SBT * PAST * 512;
    u16* KS = (u16*)(p.ws + O_KS);
#pragma unroll
    for (int i = 0; i < 4; ++i) {
      size_t e = (size_t)it * 4096 + (size_t)(tid + i * 256) * 4;
      float4 v = *(const float4*)(src + e);
      size_t b = e / ((size_t)PAST * 512), r = e % ((size_t)PAST * 512);
      *(uint2*)(KS + b * SKP * 512 + r) = uint2{pack2(v.x, v.y), pack2(v.z, v.w)};
    }
    return;
  }
  it -= PB_KC;
  const int b = it / 256, r = it % 256, ptile = r / 8, ctile = r % 8;
  const float* src = p.in[3] + ((size_t)l * SBT + b) * PAST * 512;
  u16* VTS = (u16*)(p.ws + O_VTS);
  transpose_tile(src, 512, ptile * 64, ctile * 64, 64, VTS + (size_t)b * 512 * SKP, SKP, ctile * 64, (float*)smem);
}

DI int kswz(int key) { return (((key >> 3) & 3) << 2) | (key & 3); }

DI void attn_item(const Params& p, int l, bool isS, int b, int h, int cp, char* smem) {
  const int tid = TID512(), lane = tid & 63, wid = tid >> 6, fr = lane & 15, fq = lane >> 4;
  const int nkt = isS ? 33 : 2 * cp + 2;
  const int klen = isS ? SKV : nkt * 64;
  const int mykt = isS ? 33 : (wid < 4 ? 2 * cp + 1 : 2 * cp + 2);
  const u16* QB = (const u16*)(p.ws + O_QB);
  const u16* Kg = isS ? (const u16*)(p.ws + O_KS) + (size_t)b * SKP * 512 + h * 128 : (const u16*)(p.ws + O_KB) + (size_t)b * PT * 512 + h * 128;
  const int vstride = isS ? SKP : PT;
  const u16* Vg = (isS ? (const u16*)(p.ws + O_VTS) : (const u16*)(p.ws + O_VT)) + (size_t)(b * 4 + h) * 128 * vstride;
  const int qrow0 = isS ? MP + b * 32 : b * PT + cp * 128;
  const bool wactive = isS ? (wid < 2) : true;
  const int qrow = qrow0 + wid * 16 + fr;
  bf16x8 qf[2][2];
#pragma unroll
  for (int mp = 0; mp < 2; ++mp)
#pragma unroll
    for (int ks = 0; ks < 2; ++ks)
      qf[mp][ks] = wactive ? *(const bf16x8*)(QB + (size_t)qrow * 512 + h * 128 + mp * 64 + ks * 32 + fq * 8) : bf16x8{0, 0, 0, 0, 0, 0, 0, 0};
  f32x4 ot[2][8];
#pragma unroll
  for (int mp = 0; mp < 2; ++mp)
#pragma unroll
    for (int n = 0; n < 8; ++n) ot[mp][n] = f32x4{0.f, 0.f, 0.f, 0.f};
  float mrun[2] = {-INFINITY, -INFINITY}, lrun[2] = {0.f, 0.f};
  char* Ks = smem;
  char* Vs = smem + 32768;
  const int kkey = tid >> 4, vvd = tid >> 3;
  const int kgch = (tid & 15) ^ kswz(kkey);
  const int vgch = (tid & 7) ^ ((vvd >> 1) & 7);
  const int soff = tid * 16;
  auto issue_k = [&](int kt) {
#pragma unroll
    for (int i = 0; i < 2; ++i)
      __builtin_amdgcn_global_load_lds((const unsigned*)(Kg + (size_t)(kt * 64 + kkey + i * 32) * 512 + kgch * 8), (unsigned*)(Ks + (kt & 1) * 16384 + soff + i * 8192), 16, 0, 0);
  };
  auto issue_v = [&](int kt) {
#pragma unroll
    for (int i = 0; i < 2; ++i)
      __builtin_amdgcn_global_load_lds((const unsigned*)(Vg + (size_t)(vvd + i * 64) * vstride + kt * 64 + vgch * 8), (unsigned*)(Vs + (kt & 1) * 16384 + soff + i * 8192), 16, 0, 0);
  };
  auto qk_tile = [&](int kt, f32x4 (&st)[2][4]) {
    const char* Kb = Ks + (kt & 1) * 16384;
    bf16x8 kf[2][4][2];
#pragma unroll
    for (int mp = 0; mp < 2; ++mp)
#pragma unroll
      for (int mt = 0; mt < 4; ++mt) {
        const int key = 32 * (mt >> 1) + 8 * (fr >> 2) + 4 * (mt & 1) + (fr & 3);
#pragma unroll
        for (int ks = 0; ks < 2; ++ks) kf[mp][mt][ks] = *(const bf16x8*)(Kb + key * 256 + (((mp * 8 + ks * 4 + fq) ^ kswz(key)) << 4));
      }
#pragma unroll
    for (int mp = 0; mp < 2; ++mp)
#pragma unroll
      for (int mt = 0; mt < 4; ++mt) {
        f32x4 a = MFMA16(kf[mp][mt][0], qf[mp][0], (f32x4{0.f, 0.f, 0.f, 0.f}));
        st[mp][mt] = MFMA16(kf[mp][mt][1], qf[mp][1], a);
      }
    if ((kt + 1) * 64 > klen) {
      asm volatile("" ::: "memory");
#pragma unroll
      for (int mp = 0; mp < 2; ++mp)
#pragma unroll
        for (int mt = 0; mt < 4; ++mt)
#pragma unroll
          for (int j = 0; j < 4; ++j) {
            const int key = kt * 64 + 32 * (mt >> 1) + 8 * fq + 4 * (mt & 1) + j;
            if (key >= klen) st[mp][mt][j] = -INFINITY;
          }
    }
  };
  auto softmax_tile = [&](f32x4 (&st)[2][4], bf16x8 (&pfn)[2][2], float (&alpha)[2], float (&psum)[2], bool (&moved)[2]) {
#pragma unroll
    for (int mp = 0; mp < 2; ++mp) {
      float mx = -INFINITY;
#pragma unroll
      for (int mt = 0; mt < 4; ++mt)
#pragma unroll
        for (int j = 0; j < 4; ++j) mx = fmaxf(mx, st[mp][mt][j]);
      mx = quad_max(mx);
      const float mold = mrun[mp];
      const float mnew = fmaxf(mold, mx);
      mrun[mp] = mnew;
      float ps = 0.f;
#pragma unroll
      for (int mt = 0; mt < 4; ++mt)
#pragma unroll
        for (int j = 0; j < 4; ++j) { float e = __builtin_amdgcn_exp2f(st[mp][mt][j] - mnew); st[mp][mt][j] = e; ps += e; }
      psum[mp] = ps;
      moved[mp] = __any(mnew > mold);
      alpha[mp] = __builtin_amdgcn_exp2f(mold - mnew);
#pragma unroll
      for (int s = 0; s < 2; ++s) {
        uint4 u = {pack2(st[mp][2 * s][0], st[mp][2 * s][1]), pack2(st[mp][2 * s][2], st[mp][2 * s][3]),
                   pack2(st[mp][2 * s + 1][0], st[mp][2 * s + 1][1]), pack2(st[mp][2 * s + 1][2], st[mp][2 * s + 1][3])};
        pfn[mp][s] = __builtin_bit_cast(bf16x8, u);
      }
    }
  };
  auto apply_scale = [&](const float (&alpha)[2], const float (&psum)[2], const bool (&moved)[2]) {
#pragma unroll
    for (int mp = 0; mp < 2; ++mp) {
      if (moved[mp]) {
        lrun[mp] *= alpha[mp];
#pragma unroll
        for (int n = 0; n < 8; ++n) { ot[mp][n][0] *= alpha[mp]; ot[mp][n][1] *= alpha[mp]; ot[mp][n][2] *= alpha[mp]; ot[mp][n][3] *= alpha[mp]; }
      }
      lrun[mp] += psum[mp];
    }
  };
  asm volatile("s_waitcnt vmcnt(0) lgkmcnt(0)" ::: "memory");
  __builtin_amdgcn_s_barrier();
  issue_k(0); issue_v(0);
  if (nkt > 1) issue_k(1);
  asm volatile("s_waitcnt vmcnt(0)" ::: "memory");
  asm volatile("" ::"v"(qf[0][0]), "v"(qf[0][1]), "v"(qf[1][0]), "v"(qf[1][1]));
  __builtin_amdgcn_s_barrier();
  bf16x8 pf[2][2];
#pragma unroll
  for (int mp = 0; mp < 2; ++mp)
#pragma unroll
    for (int s = 0; s < 2; ++s) pf[mp][s] = bf16x8{0, 0, 0, 0, 0, 0, 0, 0};
  if (wactive) {
    f32x4 st[2][4];
    float alpha[2], psum[2]; bool moved[2];
    qk_tile(0, st);
    softmax_tile(st, pf, alpha, psum, moved);
    apply_scale(alpha, psum, moved);
  }
  asm volatile("s_waitcnt lgkmcnt(0)" ::: "memory");
  __builtin_amdgcn_s_barrier();
  for (int j = 0; j < nkt; ++j) {
    if (j + 2 < nkt) issue_k(j + 2);
    if (j + 1 < nkt) issue_v(j + 1);
    const bool doPV = wactive && j < mykt;
    const bool doQK = wactive && j + 1 < mykt;
    f32x4 st[2][4];
    bf16x8 pfn[2][2];
    float alpha[2] = {1.f, 1.f}, psum[2] = {0.f, 0.f}; bool moved[2] = {false, false};
    auto pv_tile = [&]() {
      const char* Vb = Vs + (j & 1) * 16384;
#pragma unroll
      for (int nh = 0; nh < 2; ++nh) {
        bf16x8 vf[4][2];
#pragma unroll
        for (int n = 0; n < 4; ++n) {
          const int vd = (nh * 4 + n) * 16 + fr;
#pragma unroll
          for (int s = 0; s < 2; ++s) vf[n][s] = *(const bf16x8*)(Vb + vd * 128 + (((s * 4 + fq) ^ ((vd >> 1) & 7)) << 4));
        }
#pragma unroll
        for (int n = 0; n < 4; ++n)
#pragma unroll
          for (int s = 0; s < 2; ++s) {
            ot[0][nh * 4 + n] = MFMA16(vf[n][s], pf[0][s], ot[0][nh * 4 + n]);
            ot[1][nh * 4 + n] = MFMA16(vf[n][s], pf[1][s], ot[1][nh * 4 + n]);
          }
      }
    };
    if (doQK) {
      qk_tile(j + 1, st);
      pv_tile();
      softmax_tile(st, pfn, alpha, psum, moved);
      apply_scale(alpha, psum, moved);
#pragma unroll
      for (int mp = 0; mp < 2; ++mp)
#pragma unroll
        for (int s = 0; s < 2; ++s) pf[mp][s] = pfn[mp][s];
    } else if (doPV) {
      pv_tile();
    }
    asm volatile("s_waitcnt vmcnt(0) lgkmcnt(0)" ::: "memory");
    __builtin_amdgcn_s_barrier();
  }
  if (wactive) {
    float l0 = lrun[0], l1 = lrun[1];
    l0 += __shfl_xor(l0, 16); l0 += __shfl_xor(l0, 32);
    l1 += __shfl_xor(l1, 16); l1 += __shfl_xor(l1, 32);
    const float lam = ((const float*)(p.ws + O_LAM))[l];
    const float lam_init = 0.8f - 0.6f * __expf(-0.3f * (float)l);
    const float i0 = 1.f / l0, i1 = lam / l1;
    float ss = 0.f;
#pragma unroll
    for (int n = 0; n < 8; ++n)
#pragma unroll
      for (int j = 0; j < 4; ++j) { float o = ot[0][n][j] * i0 - ot[1][n][j] * i1; ot[0][n][j] = o; ss += o * o; }
    ss += __shfl_xor(ss, 16); ss += __shfl_xor(ss, 32);
    const float rs = rsqrtf(ss * (1.f / 128.f) + EPS) * (1.f - lam_init);
    const float* g = p.in[11] + (size_t)l * 128;
    u16* OA = (u16*)(p.ws + O_OA) + (size_t)qrow * 512 + h * 128;
#pragma unroll
    for (int n = 0; n < 8; ++n) {
      const int vd = n * 16 + fq * 4;
      float4 gg = *(const float4*)(g + vd);
      *(uint2*)(OA + vd) = uint2{pack2(ot[0][n][0] * rs * gg.x, ot[0][n][1] * rs * gg.y), pack2(ot[0][n][2] * rs * gg.z, ot[0][n][3] * rs * gg.w)};
    }
  }
}

constexpr int LP = 72;
constexpr int BCS = 68;
DI void gla_decode(int gi, bool& isS, int& b, int& h, int& c, int& row0, int& Lc) {
  if (gi < PB * 4 * 128) { isS = false; c = gi & 127; h = (gi >> 7) & 3; b = gi >> 9; row0 = b * PT + c * 64; Lc = 64; }
  else { isS = true; int s = gi - PB * 4 * 128; b = s >> 2; h = s & 3; c = 0; row0 = MP + b * 32; Lc = 32; }
}
DI void gla_bcum(const Params& p, int l, int row0, int Lc, int h, float* bc, float* tot, float* gas) {
  const int tid = TID(), kd = tid & 63, tq = tid >> 6;
  const float* W2 = p.in[12] + (size_t)l * 16 * 256 + h * 64 + kd;
  const float b2 = p.in[13][(size_t)l * 256 + h * 64 + kd];
  const float* GA = (const float*)(p.ws + O_GA);
  {
    const int r = tid >> 2, part = tid & 3;
    float4 v = {0.f, 0.f, 0.f, 0.f};
    if (r < Lc) v = *(const float4*)(GA + (size_t)(row0 + r) * 16 + part * 4);
    *(float4*)(gas + r * 16 + part * 4) = v;
  }
  float w[16];
#pragma unroll
  for (int r = 0; r < 16; ++r) w[r] = W2[r * 256];
  __syncthreads();
  float run = 0.f;
#pragma unroll
  for (int i = 0; i < 16; ++i) {
    const int t = tq * 16 + i;
    const float4* ga = (const float4*)(gas + t * 16);
    const float4 g0 = ga[0], g1 = ga[1], g2 = ga[2], g3 = ga[3];
    const float x = b2 + g0.x * w[0] + g0.y * w[1] + g0.z * w[2] + g0.w * w[3] + g1.x * w[4] + g1.y * w[5] + g1.z * w[6] + g1.w * w[7] +
                    g2.x * w[8] + g2.y * w[9] + g2.z * w[10] + g2.w * w[11] + g3.x * w[12] + g3.y * w[13] + g3.z * w[14] + g3.w * w[15];
    const float la = (t < Lc) ? -softplusf_(-x) * (1.f / 16.f) : 0.f;
    run += la;
    bc[t * BCS + kd] = run;
  }
  tot[tq * 64 + kd] = run;
  __syncthreads();
  float off = 0.f;
  for (int g = 0; g < tq; ++g) off += tot[g * 64 + kd];
#pragma unroll
  for (int i = 0; i < 16; ++i) bc[(tq * 16 + i) * BCS + kd] += off;
  __syncthreads();
}
DI void gla_load_vt(const Params& p, int row0, int Lc, int h, u16* vt) {
  const int tid = TID(), s = tid & 63, cg4 = tid >> 6;
  const u16* GV = (const u16*)(p.ws + O_GV) + (size_t)(row0 + s) * 512 + h * 128;
  u32x4 v[4];
#pragma unroll
  for (int i = 0; i < 4; ++i) v[i] = (s < Lc) ? *(const u32x4*)(GV + (cg4 + 4 * i) * 8) : u32x4{0u, 0u, 0u, 0u};
#pragma unroll
  for (int i = 0; i < 4; ++i) {
    const int vd0 = (cg4 + 4 * i) * 8;
#pragma unroll
    for (int e = 0; e < 4; ++e) {
      vt[(vd0 + 2 * e) * LP + s] = (u16)(v[i][e] & 0xffffu);
      vt[(vd0 + 2 * e + 1) * LP + s] = (u16)(v[i][e] >> 16);
    }
  }
}

DI void gla1_item(const Params& p, int l, int gi, char* smem) {
  bool isS; int b, h, c, row0, Lc;
  gla_decode(gi, isS, b, h, c, row0, Lc);
  const int tid = TID(), lane = tid & 63, wid = tid >> 6, fr = lane & 15, fq = lane >> 4;
  float* bc = (float*)smem;
  float* tot = (float*)(smem + 17408);
  u16* kh = (u16*)(smem + 18432);
  u16* vt = (u16*)(smem + 18432 + 9216);
  __syncthreads();
  gla_bcum(p, l, row0, Lc, h, bc, tot, (float*)kh);
  {
    const int s = tid & 63, c2 = tid >> 6;
    const u16* GK = (const u16*)(p.ws + O_GK) + (size_t)(row0 + s) * 256 + h * 64;
    u32x4 kv[2];
#pragma unroll
    for (int i = 0; i < 2; ++i) kv[i] = (s < Lc) ? *(const u32x4*)(GK + (c2 + 4 * i) * 8) : u32x4{0u, 0u, 0u, 0u};
#pragma unroll
    for (int i = 0; i < 2; ++i) {
      const int kd0 = (c2 + 4 * i) * 8;
#pragma unroll
      for (int e = 0; e < 8; ++e) {
        const unsigned w = kv[i][e >> 1];
        const float kf = bf2f((u16)((e & 1) ? (w >> 16) : (w & 0xffffu)));
        const float bl = bc[63 * BCS + kd0 + e];
        kh[(kd0 + e) * LP + s] = f2bf(kf * __expf(bl - bc[s * BCS + kd0 + e]));
      }
    }
    if (tid < 64) ((float*)(p.ws + O_DEC))[(size_t)gi * 64 + tid] = __expf(bc[63 * BCS + tid]);
  }
  gla_load_vt(p, row0, Lc, h, vt);
  __syncthreads();
  u16* KVT = (u16*)(p.ws + O_KVT) + (size_t)gi * 8192;
#pragma unroll
  for (int mi = 0; mi < 2; ++mi)
#pragma unroll
    for (int n = 0; n < 4; ++n) {
      const int m = wid * 2 + mi;
      f32x4 a = lds_mm<2>(vt, LP, m * 16, kh, LP, n * 16, f32x4{0.f, 0.f, 0.f, 0.f});
#pragma unroll
      for (int j = 0; j < 4; ++j) KVT[(m * 16 + fq * 4 + j) * 64 + n * 16 + fr] = f2bf(a[j]);
    }
}

constexpr int G2_ITEMS = (PB * 4 + SBT * 4) * 32;
DI void gla2_item(const Params& p, int l, int it) {
  const int seq = it >> 5, e = (it & 31) * 256 + TID();
  const int vd = e >> 6, kd = e & 63;
  u16* KVT = (u16*)(p.ws + O_KVT);
  const float* DEC = (const float*)(p.ws + O_DEC);
  if (seq < PB * 4) {
    float S = 0.f;
    const int gi0 = seq * 128;
    for (int c0 = 0; c0 < 128; c0 += 32) {
      u16 kvv[32]; float dd[32];
#pragma unroll
      for (int c = 0; c < 32; ++c) { kvv[c] = KVT[(size_t)(gi0 + c0 + c) * 8192 + e]; dd[c] = DEC[(size_t)(gi0 + c0 + c) * 64 + kd]; }
#pragma unroll
      for (int c = 0; c < 32; ++c) { KVT[(size_t)(gi0 + c0 + c) * 8192 + e] = f2bf(S); S = dd[c] * S + bf2f(kvv[c]); }
    }
    p.out[GLA_P + ((size_t)l * PB * 4 + seq) * 8192 + kd * 128 + vd] = S;
  } else {
    const int s = seq - PB * 4, gi = PB * 4 * 128 + s;
    const float S0 = p.in[4][((size_t)l * SBT * 4 + s) * 8192 + kd * 128 + vd];
    u16* q = KVT + (size_t)gi * 8192 + e;
    const float kv = bf2f(*q);
    const float d = DEC[(size_t)gi * 64 + kd];
    *q = f2bf(S0);
    p.out[GLA_S + ((size_t)l * SBT * 4 + s) * 8192 + kd * 128 + vd] = d * S0 + kv;
  }
}

DI void gla3_item(const Params& p, int l, int gi, char* smem) {
  bool isS; int b, h, c, row0, Lc;
  gla_decode(gi, isS, b, h, c, row0, Lc);
  const int tid = TID(), lane = tid & 63, wid = tid >> 6, fr = lane & 15, fq = lane >> 4;
  float* bc = (float*)smem;
  u16* att = (u16*)smem;
  float* tot = (float*)(smem + 17408);
  u16* qt = (u16*)(smem + 18432);
  u16* kt_ = (u16*)(smem + 18432 + 9216);
  u16* vt = (u16*)(smem + 18432 + 2 * 9216);
  u16* st = (u16*)(smem + 18432 + 2 * 9216 + 18432);
  __syncthreads();
  gla_bcum(p, l, row0, Lc, h, bc, tot, (float*)qt);
  const u16* KVT = (const u16*)(p.ws + O_KVT) + (size_t)gi * 8192;
  {
    const int s = tid & 63, c2 = tid >> 6;
    const u16* GQ = (const u16*)(p.ws + O_GQ) + (size_t)(row0 + s) * 256 + h * 64;
    const u16* GK = (const u16*)(p.ws + O_GK) + (size_t)(row0 + s) * 256 + h * 64;
    u32x4 qv[2], kv[2], sv[4];
#pragma unroll
    for (int i = 0; i < 2; ++i) {
      qv[i] = (s < Lc) ? *(const u32x4*)(GQ + (c2 + 4 * i) * 8) : u32x4{0u, 0u, 0u, 0u};
      kv[i] = (s < Lc) ? *(const u32x4*)(GK + (c2 + 4 * i) * 8) : u32x4{0u, 0u, 0u, 0u};
    }
#pragma unroll
    for (int i = 0; i < 4; ++i) { const int id = tid + i * 256; sv[i] = *(const u32x4*)(KVT + (id >> 3) * 64 + (id & 7) * 8); }
#pragma unroll
    for (int i = 0; i < 2; ++i) {
      const int kd0 = (c2 + 4 * i) * 8;
      u32x4 qo, ko;
#pragma unroll
      for (int e2 = 0; e2 < 4; ++e2) {
        const float b0 = bc[s * BCS + kd0 + 2 * e2], b1 = bc[s * BCS + kd0 + 2 * e2 + 1];
        const float e0 = __expf(b0), e1 = __expf(b1);
        const float q0 = bf2f((u16)(qv[i][e2] & 0xffffu)) * e0, q1 = bf2f((u16)(qv[i][e2] >> 16)) * e1;
        const float k0 = bf2f((u16)(kv[i][e2] & 0xffffu)) / e0, k1 = bf2f((u16)(kv[i][e2] >> 16)) / e1;
        qo[e2] = pack2(q0, q1);
        ko[e2] = pack2(k0, k1);
      }
      *(u32x4*)(qt + s * LP + kd0) = qo;
      *(u32x4*)(kt_ + s * LP + kd0) = ko;
    }
#pragma unroll
    for (int i = 0; i < 4; ++i) { const int id = tid + i * 256; *(u32x4*)(st + (id >> 3) * LP + (id & 7) * 8) = sv[i]; }
  }
  gla_load_vt(p, row0, Lc, h, vt);
  __syncthreads();
  {
    f32x4 a[4];
#pragma unroll
    for (int n = 0; n < 4; ++n) a[n] = lds_mm<2>(qt, LP, wid * 16, kt_, LP, n * 16, f32x4{0.f, 0.f, 0.f, 0.f});
#pragma unroll
    for (int n = 0; n < 4; ++n)
#pragma unroll
      for (int j = 0; j < 4; ++j) {
        const int t = wid * 16 + fq * 4 + j, s = n * 16 + fr;
        att[t * LP + s] = f2bf(t >= s ? a[n][j] : 0.f);
      }
  }
  __syncthreads();
  f32x4 o[8];
#pragma unroll
  for (int n = 0; n < 8; ++n) {
    f32x4 a = lds_mm<2>(att, LP, wid * 16, vt, LP, n * 16, f32x4{0.f, 0.f, 0.f, 0.f});
    o[n] = lds_mm<2>(qt, LP, wid * 16, st, LP, n * 16, a);
  }
  const float* gn = p.in[14] + (size_t)l * 128;
  const u16* GR = (const u16*)(p.ws + O_GR);
  u16* OG = (u16*)(p.ws + O_OG);
  float gnv[8];
#pragma unroll
  for (int n = 0; n < 8; ++n) gnv[n] = gn[n * 16 + fr];
#pragma unroll
  for (int j = 0; j < 4; ++j) {
    float ss = 0.f;
#pragma unroll
    for (int n = 0; n < 8; ++n) ss += o[n][j] * o[n][j];
    ss += __shfl_xor(ss, 1); ss += __shfl_xor(ss, 2); ss += __shfl_xor(ss, 4); ss += __shfl_xor(ss, 8);
    const float rs = rsqrtf(ss * (1.f / 128.f) + EPS);
    const int t = wid * 16 + fq * 4 + j;
    if (t < Lc) {
      const size_t ro = (size_t)(row0 + t) * 512 + h * 128;
      u16 grv[8];
#pragma unroll
      for (int n = 0; n < 8; ++n) grv[n] = GR[ro + n * 16 + fr];
#pragma unroll
      for (int n = 0; n < 8; ++n) {
        const float gr = bf2f(grv[n]);
        OG[ro + n * 16 + fr] = f2bf(o[n][j] * rs * gnv[n] * gr * sigmoidf_(gr));
      }
    }
  }
}

constexpr int L1_ITEMS = NLC * 8;
DI void lru_decode(int ci, bool& isS, int& b, int& row0, int& Lc, int& t0) {
  if (ci < MP / 64) { isS = false; b = ci >> 7; t0 = (ci & 127) * 64; row0 = ci * 64; Lc = 64; }
  else { isS = true; b = ci - MP / 64; t0 = 0; row0 = MP + b * 32; Lc = 32; }
}
DI void lru1_item(const Params& p, int l, int it, char* smem) {
  const int ci = it >> 3, nb = it & 7;
  bool isS; int b, row0, Lc, t0;
  lru_decode(ci, isS, b, row0, Lc, t0);
  const int tid = TID(), lane = tid & 63, wid = tid >> 6, fr = lane & 15, fq = lane >> 4;
  u16* xcs = (u16*)smem;
  u16* was = (u16*)(smem + 9216);
  u16* wxs = (u16*)(smem + 2 * 9216);
  float* as_ = (float*)(smem + 3 * 9216);
  float* us_ = (float*)(smem + 3 * 9216 + 16384);
  float* segP = (float*)(smem + 3 * 9216 + 32768);
  float* segH = (float*)(smem + 3 * 9216 + 32768 + 1024);
  const float* LX = (const float*)(p.ws + O_LX);
  const u16* Wl = (const u16*)(p.ws + O_WT) + (size_t)l * W_LAYER;
  const int i = tid & 63, tq = tid >> 6, ch = nb * 64 + i;
  __syncthreads();
  {
    const float* cw = p.in[15] + (size_t)l * 4 * 512 + ch;
    const float w0 = cw[0], w1 = cw[512], w2 = cw[1024], w3 = cw[1536], cb = p.in[16][(size_t)l * 512 + ch];
    const float* buf = isS ? p.in[5] + ((size_t)l * SBT + b) * 3 * 512 + ch : nullptr;
    float x[19];
#pragma unroll
    for (int j = 0; j < 19; ++j) {
      const int tl = tq * 16 - 3 + j;
      const int tt = t0 + tl;
      float v = 0.f;
      if (tl < Lc) {
        if (tt >= 0) v = LX[(size_t)(row0 + tl) * 512 + ch];
        else if (isS) v = buf[(3 + tt) * 512];
      }
      x[j] = v;
    }
#pragma unroll
    for (int k = 0; k < 16; ++k) {
      const int t = tq * 16 + k;
      const float xv = (t < Lc) ? cb + w0 * x[k] + w1 * x[k + 1] + w2 * x[k + 2] + w3 * x[k + 3] : 0.f;
      xcs[t * LP + i] = f2bf(xv);
    }
#pragma unroll
    for (int k = 0; k < 2; ++k) {
      const int id = tid + k * 256, r = id >> 3, c8 = id & 7;
      *(uint4*)(was + r * LP + c8 * 8) = *(const uint4*)(Wl + W_WA + nb * 4096 + r * 64 + c8 * 8);
      *(uint4*)(wxs + r * LP + c8 * 8) = *(const uint4*)(Wl + W_WX + nb * 4096 + r * 64 + c8 * 8);
    }
    const int T = isS ? STT : PT;
    if (t0 + Lc == T && tid < 192) {
      const int k = tid >> 6;
      const float v = LX[(size_t)(row0 + Lc - 3 + k) * 512 + ch];
      if (isS) p.out[LC_S + (((size_t)l * SBT + b) * 3 + k) * 512 + ch] = v;
      else p.out[LC_P + (((size_t)l * PB + b) * 3 + k) * 512 + ch] = v;
    }
  }
  __syncthreads();
  {
    const float* ba = p.in[18] + (size_t)l * 512 + nb * 64;
    const float* bx = p.in[20] + (size_t)l * 512 + nb * 64;
    const float* lm = p.in[21] + (size_t)l * 512 + nb * 64;
#pragma unroll
    for (int n = 0; n < 4; ++n) {
      f32x4 r = lds_mm<2>(xcs, LP, wid * 16, was, LP, n * 16, f32x4{0.f, 0.f, 0.f, 0.f});
      f32x4 g = lds_mm<2>(xcs, LP, wid * 16, wxs, LP, n * 16, f32x4{0.f, 0.f, 0.f, 0.f});
      const int j = n * 16 + fr;
      const float sp = softplusf_(-lm[j]), bav = ba[j], bxv = bx[j];
#pragma unroll
      for (int q = 0; q < 4; ++q) {
        const int t = wid * 16 + fq * 4 + q;
        const float rr = sigmoidf_(r[q] + bav), ii = sigmoidf_(g[q] + bxv);
        const float la = -8.f * rr * sp;
        const float a = __expf(la);
        const float x2 = 2.f * la;
        const float om = (x2 > -0.01f) ? -x2 * (1.f + x2 * (0.5f + x2 * (1.f / 6.f))) : 1.f - __expf(x2);
        const float u = sqrtf(om) * ii * bf2f(xcs[t * LP + j]);
        as_[t * 64 + j] = a;
        us_[t * 64 + j] = u;
      }
    }
  }
  __syncthreads();
  {
    float av[16], uv[16];
#pragma unroll
    for (int k = 0; k < 16; ++k) { av[k] = as_[(tq * 16 + k) * 64 + i]; uv[k] = us_[(tq * 16 + k) * 64 + i]; }
    float P = 1.f, hh = 0.f;
#pragma unroll
    for (int k = 0; k < 16; ++k) { P *= av[k]; hh = av[k] * hh + uv[k]; }
    segP[tq * 64 + i] = P; segH[tq * 64 + i] = hh;
    __syncthreads();
    float Pin = 1.f, hin = 0.f;
    for (int g = 0; g < tq; ++g) { const float pg = segP[g * 64 + i], hg = segH[g * 64 + i]; hin = pg * hin + hg; Pin *= pg; }
    u16* HL = (u16*)(p.ws + O_HL);
    u16* PPp = (u16*)(p.ws + O_PP);
    P = Pin; hh = hin;
#pragma unroll
    for (int k = 0; k < 16; ++k) {
      const int t = tq * 16 + k;
      P *= av[k]; hh = av[k] * hh + uv[k];
      if (t < Lc) {
        HL[(size_t)(row0 + t) * 512 + ch] = f2bf(hh);
        PPp[(size_t)(row0 + t) * 512 + ch] = f2bf(P);
      }
    }
    if (tq * 16 + 16 == Lc) {
      ((float*)(p.ws + O_CA))[(size_t)ci * 512 + ch] = P;
      ((float*)(p.ws + O_CH))[(size_t)ci * 512 + ch] = hh;
    }
  }
}
constexpr int L2_ITEMS = 8 + 32;
DI void lru2_item(const Params& p, int l, int it) {
  const float* CA = (const float*)(p.ws + O_CA);
  const float* CH = (const float*)(p.ws + O_CH);
  float* HS = (float*)(p.ws + O_HS);
  if (it < 8) {
    const int e = it * 256 + TID(), b = e >> 9, ch = e & 511;
    float hh = 0.f;
    for (int c0 = 0; c0 < 128; c0 += 16) {
      float ca[16], chv[16];
#pragma unroll
      for (int c = 0; c < 16; ++c) { const size_t o = (size_t)(b * 128 + c0 + c) * 512 + ch; ca[c] = CA[o]; chv[c] = CH[o]; }
#pragma unroll
      for (int c = 0; c < 16; ++c) { const size_t o = (size_t)(b * 128 + c0 + c) * 512 + ch; HS[o] = hh; hh = ca[c] * hh + chv[c]; }
    }
    p.out[LH_P + ((size_t)l * PB + b) * 512 + ch] = hh;
  } else {
    const int e = (it - 8) * 256 + TID(), b = e >> 9, ch = e & 511;
    const float h0 = p.in[6][((size_t)l * SBT + b) * 512 + ch];
    const size_t o = (size_t)(MP / 64 + b) * 512 + ch;
    HS[o] = h0;
    p.out[LH_S + ((size_t)l * SBT + b) * 512 + ch] = CA[o] * h0 + CH[o];
  }
}
constexpr int L3_ITEMS = MT / 8;
DI void lru3_item(const Params& p, int it) {
  const u16* HL = (const u16*)(p.ws + O_HL);
  const u16* PPp = (const u16*)(p.ws + O_PP);
  const u16* LG = (const u16*)(p.ws + O_LG);
  const float* HS = (const float*)(p.ws + O_HS);
  u16* OL = (u16*)(p.ws + O_OL);
#pragma unroll
  for (int i = 0; i < 4; ++i) {
    const int id = TID() + i * 256;
    const int row = it * 8 + (id >> 7), c4 = (id & 127) * 4;
    const int ci = row < MP ? (row >> 6) : MP / 64 + ((row - MP) >> 5);
    const size_t o = (size_t)row * 512 + c4;
    const uint2 hl = *(const uint2*)(HL + o), pp = *(const uint2*)(PPp + o), lg = *(const uint2*)(LG + o);
    const float4 hs = *(const float4*)(HS + (size_t)ci * 512 + c4);
    float y0 = (bf2f(hl.x & 0xffff) + bf2f(pp.x & 0xffff) * hs.x) * gelu_tanh(bf2f(lg.x & 0xffff));
    float y1 = (bf2f(hl.x >> 16) + bf2f(pp.x >> 16) * hs.y) * gelu_tanh(bf2f(lg.x >> 16));
    float y2 = (bf2f(hl.y & 0xffff) + bf2f(pp.y & 0xffff) * hs.z) * gelu_tanh(bf2f(lg.y & 0xffff));
    float y3 = (bf2f(hl.y >> 16) + bf2f(pp.y >> 16) * hs.w) * gelu_tanh(bf2f(lg.y >> 16));
    *(uint2*)(OL + o) = uint2{pack2(y0, y1), pack2(y2, y3)};
  }
}

DI void ybr_tile(const Params& p, int l, int mt, int nt, char* smem) {
  const int row0 = mt * 256, col0 = nt * 256, br = nt >> 2;
  const u16* W = (const u16*)(p.ws + O_WT) + (size_t)l * W_LAYER + W_BR + (size_t)br * 1024 * 512 + (size_t)((nt & 3) * 256) * 512;
  const u16* O = (const u16*)(p.ws + (br == 0 ? O_OA : (br == 1 ? O_OG : O_OL))) + (size_t)row0 * 512;
  f32x4 acc[8][4];
  zero_acc8(acc);
  gemm512(O, 512, W, 512, 512, acc, smem);
  tile_out_bf16<false>(acc, (u16*)(p.ws + O_YP) + (size_t)row0 * 3072 + col0, 3072, smem, 1.f, 0, nullptr);
}
DI void gate_tile(const Params& p, int l, int mt, int nt, char* smem) {
  const int row0 = mt * 256, col0 = nt * 256;
  const u16* W = (const u16*)(p.ws + O_WT) + (size_t)l * W_LAYER + W_MG + (size_t)col0 * LDK;
  f32x4 acc[8][4];
  zero_acc8(acc);
  gemm512((const u16*)(p.ws + O_XN) + (size_t)row0 * LDK, LDK, W, LDK, 1024, acc, smem);
  EPI_IDS;
  u16* Y = (u16*)(p.ws + O_YP) + (size_t)row0 * 3072 + col0;
  const float* bm = p.in[26] + (size_t)l * 3072 + col0 + wc * 64 + fr;
  img_load_bf16(Y, 3072, smem, 256, 0);
  img_barrier();
  u16* img = (u16*)smem + (wr * 128 + fq * 4) * IMG_LD + wc * 64 + fr;
#pragma unroll
  for (int n = 0; n < 4; ++n) {
    const float bv = bm[n * 16];
#pragma unroll
    for (int m = 0; m < 8; ++m)
#pragma unroll
      for (int j = 0; j < 4; ++j) {
        u16* q = img + (m * 16 + j) * IMG_LD + n * 16;
        *q = f2bf(sigmoidf_(acc[m][n][j] + bv) * bf2f(*q));
      }
  }
  img_barrier();
  img_store_bf16(Y, 3072, smem, 0);
}
DI void resid_tile(const Params& p, const u16* A, int ldk, const u16* W, int mt, int nt, int k0, int klen, bool atomic, const float* xsrc, char* smem) {
  const int row0 = mt * 256, col0 = nt * 256;
  f32x4 acc[8][4];
  zero_acc8(acc);
  gemm512(A + (size_t)row0 * ldk + k0, ldk, W + (size_t)col0 * ldk + k0, ldk, klen, acc, smem);
  if (!atomic) { tile_out_f32<true, false>(acc, p.out + (size_t)row0 * 1024 + col0, 1024, smem, 0, nullptr, xsrc + (size_t)row0 * 1024 + col0); return; }
  EPI_IDS;
#pragma unroll
  for (int m = 0; m < 8; ++m) {
    asm volatile("" ::: "memory");
#pragma unroll
    for (int n = 0; n < 4; ++n)
#pragma unroll
      for (int j = 0; j < 4; ++j) {
        const int row = row0 + wr * 128 + m * 16 + fq * 4 + j, col = col0 + wc * 64 + n * 16 + fr;
        float* q = p.out + (size_t)row * 1024 + col;
        if (atomic) unsafeAtomicAdd(q, acc[m][n][j]); else *q += acc[m][n][j];
      }
  }
}
DI void resid_phase(const Params& p, const u16* A, int ldk, const u16* W, int B, int G, const float* xsrc, char* smem) {
  const int ns = ldk / 256;
  int k = 0, u = B;
  while (true) {
    int mt, nt, k0 = 0, kl = ldk;
    bool at = false;
    if (xcd_tile(B, G, k, 128, 4, mt, nt)) { ++k; }
    else if (u < 8 * ns) { const int t = u / ns, sl = u - t * ns; mt = 128 + (t >> 2); nt = t & 3; k0 = sl * 256; kl = 256; at = true; u += G; }
    else break;
    asm volatile("" : "+s"(kl));
    resid_tile(p, A, ldk, W, mt, nt, k0, kl, at, xsrc, smem);
  }
}

DI void ffgate_tile(const Params& p, int l, int mt, int nt, char* smem) {
  const int row0 = mt * 256, col0 = nt * 256;
  const u16* W = (const u16*)(p.ws + O_WT) + (size_t)l * W_LAYER + W_FG;
  f32x4 acc[8][4];
  zero_acc8(acc);
  gemm512((const u16*)(p.ws + O_XN) + (size_t)row0 * LDK, LDK, W + (size_t)col0 * LDK, LDK, 1024, acc, smem);
  if (mt < 128) {
    EPI_IDS;
    tile_out_bf16<false>(acc, (u16*)(p.ws + O_GU) + (size_t)row0 * DFF + col0, DFF, smem, 1.f, 0, nullptr);
    if (((row0 + 256) & 8191) == 0 && wr == 1 && fq == 3) {
      const int b = row0 >> 13;
#pragma unroll
      for (int n = 0; n < 4; ++n) {
        const int col = col0 + wc * 64 + n * 16 + fr;
        p.out[FC_P + (((size_t)l * PB + b) * 2 + 0) * DFF + col] = acc[7][n][2];
        p.out[FC_P + (((size_t)l * PB + b) * 2 + 1) * DFF + col] = acc[7][n][3];
      }
    }
    return;
  }
  EPI_IDS;
  u16* GU = (u16*)(p.ws + O_GU);
  const bool isS = row0 >= MP;
#pragma unroll
  for (int m = 0; m < 8; ++m) {
    asm volatile("" ::: "memory");
#pragma unroll
    for (int n = 0; n < 4; ++n)
#pragma unroll
      for (int j = 0; j < 4; ++j) {
        const int row = row0 + wr * 128 + m * 16 + fq * 4 + j, col = col0 + wc * 64 + n * 16 + fr;
        const float v = acc[m][n][j];
        GU[(size_t)row * DFF + col] = f2bf(v);
        if (isS) {
          const int rs = row - MP, b = rs >> 5, t = rs & 31;
          if (t >= STT - 2) p.out[FC_S + (((size_t)l * SBT + b) * 2 + (t - (STT - 2))) * DFF + col] = v;
        } else {
          const int b = row >> 13, t = row & 8191;
          if (t >= PT - 2) p.out[FC_P + (((size_t)l * PB + b) * 2 + (t - (PT - 2))) * DFF + col] = v;
        }
      }
  }
}
DI void ffup_tile(const Params& p, int l, int mt, int nt, char* smem) {
  const int row0 = mt * 256, col0 = nt * 256;
  const u16* W = (const u16*)(p.ws + O_WT) + (size_t)l * W_LAYER + W_FU;
  f32x4 acc[8][4];
  zero_acc8(acc);
  gemm512((const u16*)(p.ws + O_XN) + (size_t)row0 * LDK, LDK, W + (size_t)col0 * LDK, LDK, 1024, acc, smem);
  if (mt < 128) {
    EPI_IDS;
    const u16* GUt = (const u16*)(p.ws + O_GU) + (size_t)row0 * DFF + col0;
    if (row0 >= 2) img_load_bf16(GUt - 2 * DFF, DFF, smem, 258, 0); else img_load_bf16(GUt, DFF, smem, 256, 2);
    img_barrier();
    const u16* img = (const u16*)smem + (wr * 128 + fq * 4) * IMG_LD + wc * 64 + fr;
#pragma unroll
    for (int n = 0; n < 4; ++n) {
      const int col = col0 + wc * 64 + n * 16 + fr;
      const float* cw = p.in[30] + (size_t)l * 3 * DFF + col;
      const float w0 = cw[0], w1 = cw[DFF], w2 = cw[2 * DFF], cb = p.in[31][(size_t)l * DFF + col];
#pragma unroll
      for (int m = 0; m < 8; ++m) {
        if ((m & 1) == 0) asm volatile("" ::: "memory");
        const int t = (row0 + wr * 128 + m * 16 + fq * 4) & 8191;
        float g[6];
#pragma unroll
        for (int d = 0; d < 6; ++d) { const float gv = bf2f(img[(m * 16 + d) * IMG_LD + n * 16]); g[d] = (d >= 2 || t - 2 + d >= 0) ? gv : 0.f; }
#pragma unroll
        for (int j = 0; j < 4; ++j) acc[m][n][j] *= gelu_tanh(cb + w0 * g[j] + w1 * g[j + 1] + w2 * g[j + 2]);
      }
    }
    img_barrier();
    img_put_bf16<false>(acc, smem, 2, 1.f, 0, nullptr);
    img_barrier();
    img_store_bf16((u16*)(p.ws + O_FF) + (size_t)row0 * DFF + col0, DFF, smem, 2);
    return;
  }
  EPI_IDS;
  const u16* GU = (const u16*)(p.ws + O_GU);
  u16* FF = (u16*)(p.ws + O_FF);
  const bool isS = row0 >= MP;
  const int rowq = row0 + wr * 128 + fq * 4;
  const unsigned gbase = (unsigned)rowq * (unsigned)DFF + (unsigned)(col0 + wc * 64 + fr);
#pragma unroll
  for (int n = 0; n < 4; ++n) {
    const int col = col0 + wc * 64 + n * 16 + fr;
    const float* cw = p.in[30] + (size_t)l * 3 * DFF + col;
    const float w0 = cw[0], w1 = cw[DFF], w2 = cw[2 * DFF], cb = p.in[31][(size_t)l * DFF + col];
#pragma unroll
    for (int mh = 0; mh < 2; ++mh) {
      asm volatile("" ::: "memory");
      float g[4][6];
#pragma unroll
      for (int m = 0; m < 4; ++m) {
        const int rowb = rowq + (mh * 4 + m) * 16;
        int b, t;
        if (isS) { int rs = rowb - MP; b = rs >> 5; t = rs & 31; } else { b = rowb >> 13; t = rowb & 8191; }
#pragma unroll
        for (int d = 0; d < 6; ++d) {
          const int tt = t - 2 + d;
          if (tt >= 0) g[m][d] = bf2f(GU[gbase + (unsigned)((((mh * 4 + m) * 16 + d) * DFF) + n * 16) - 2u * (unsigned)DFF]);
          else g[m][d] = isS ? p.in[7][(((size_t)l * SBT + b) * 2 + (2 + tt)) * DFF + col] : 0.f;
        }
      }
#pragma unroll
      for (int m = 0; m < 4; ++m)
#pragma unroll
        for (int j = 0; j < 4; ++j) {
          const float gc = cb + w0 * g[m][j] + w1 * g[m][j + 1] + w2 * g[m][j + 2];
          FF[gbase + (unsigned)((((mh * 4 + m) * 16 + j) * DFF) + n * 16)] = f2bf(gelu_tanh(gc) * acc[mh * 4 + m][n][j]);
        }
    }
  }
}

DI void norm_phase(const Params& p, int l, int mode, int B, int G, char* smem) {
  const int tid = TID512(), lane = tid & 63, wid = tid >> 6;
  const float* gamma = mode == 0 ? p.in[8] + (size_t)l * 1024 : (mode == 1 ? p.in[28] + (size_t)l * 1024 : p.in[34]);
  float* wga = (float*)smem;
  if (mode == 0) {
    __syncthreads();
    const float* src = p.in[9] + (size_t)l * 1024 * PW + 3072;
#pragma unroll
    for (int i = 0; i < 8; ++i) {
      const int id = tid + i * 512, k = id >> 2, part = id & 3;
      ((float4*)wga)[(((k >> 8) * 4 + (k & 3)) * 4 + part) * 64 + ((k >> 2) & 63)] = *(const float4*)(src + (size_t)k * PW + part * 4);
    }
    __syncthreads();
  }
  float4 g[4];
#pragma unroll
  for (int i = 0; i < 4; ++i) g[i] = *(const float4*)(gamma + i * 256 + lane * 4);
  for (int row = B * 8 + wid; row < MT; row += G * 8) {
    float* X = p.out + (size_t)row * 1024;
    const float* Xr = (mode == 0 && l == 0 && row < MP) ? p.in[0] + (size_t)row * 1024 : X;
    float4 v[4];
    float ss = 0.f;
#pragma unroll
    for (int i = 0; i < 4; ++i) { v[i] = *(const float4*)(Xr + i * 256 + lane * 4); ss += v[i].x * v[i].x + v[i].y * v[i].y + v[i].z * v[i].z + v[i].w * v[i].w; }
    ss = wave_sum(ss);
    const float rs = rsqrtf(ss * (1.f / 1024.f) + EPS);
    u16* XN = (u16*)(p.ws + O_XN) + (size_t)row * LDK;
#pragma unroll
    for (int i = 0; i < 4; ++i) {
      v[i] = float4{v[i].x * rs * g[i].x, v[i].y * rs * g[i].y, v[i].z * rs * g[i].z, v[i].w * rs * g[i].w};
      if (mode == 2) *(float4*)(X + i * 256 + lane * 4) = v[i];
      else *(uint2*)(XN + i * 256 + lane * 4) = uint2{pack2(v[i].x, v[i].y), pack2(v[i].z, v[i].w)};
    }
    if (mode == 0) {
      float ga[16];
#pragma unroll
      for (int r = 0; r < 16; ++r) ga[r] = 0.f;
#pragma unroll
      for (int i = 0; i < 4; ++i) {
        const float xv[4] = {v[i].x, v[i].y, v[i].z, v[i].w};
#pragma unroll
        for (int e = 0; e < 4; ++e) {
          asm volatile("" ::: "memory");
#pragma unroll
          for (int q = 0; q < 4; ++q) {
            const float4 w = ((const float4*)wga)[((i * 4 + e) * 4 + q) * 64 + lane];
            ga[q * 4 + 0] += xv[e] * w.x; ga[q * 4 + 1] += xv[e] * w.y; ga[q * 4 + 2] += xv[e] * w.z; ga[q * 4 + 3] += xv[e] * w.w;
          }
        }
      }
      float mine = 0.f;
#pragma unroll
      for (int r = 0; r < 16; ++r) { const float s = wave_sum(ga[r]); if (lane == r) mine = s; }
      if (lane < 16) ((float*)(p.ws + O_GA))[(size_t)row * 16 + lane] = mine;
    }
  }
}

#define XB_TMO      128
#define XB_XCNT(j)  (256  + 64 * (j))
#define XB_XSUB(j)  (1280 + 64 * (j))
#define XB_XGEN(j)  (2304 + 64 * (j))
#define XB_TOP      3328
#define XB_TOPGEN   3392
#define XCD_BAR_WORDS 3456
#define XB_SPIN_CAP (1u << 18)
#define LAS __attribute__((address_space(3)))

__device__ __forceinline__ unsigned xb_ld(unsigned* p)              { return __hip_atomic_load(p, __ATOMIC_RELAXED, __HIP_MEMORY_SCOPE_AGENT); }
__device__ __forceinline__ unsigned xb_add(unsigned* p, unsigned v) { return __hip_atomic_fetch_add(p, v, __ATOMIC_RELAXED, __HIP_MEMORY_SCOPE_AGENT); }
__device__ __forceinline__ unsigned xb_xcc_id() { return (unsigned)__builtin_amdgcn_s_getreg((3 << 11) | 20) & 0xFu; }
#define XB_SPIN(cond, bar) do { unsigned _sp = 0; while (cond) { __builtin_amdgcn_s_sleep(1); \
    if ((++_sp & 255u) == 0u) { if (xb_ld(&(bar)[XB_TMO])) break; if (_sp > XB_SPIN_CAP) { atomicAdd(&(bar)[XB_TMO], 1u); break; } } } } while (0)

struct XcdBarrier {
    unsigned* bar; unsigned x;
    volatile LAS unsigned* st;
};

__device__ __forceinline__ XcdBarrier xcd_barrier_post(unsigned* bar, volatile LAS unsigned* st) {
    XcdBarrier b; b.bar = bar; b.x = xb_xcc_id(); b.st = st;
    if (threadIdx.x == 0) (void)xb_add(&bar[XB_XCNT(b.x)], 1u);
    return b;
}
__device__ __forceinline__ void xcd_barrier_complete(unsigned* bar, unsigned x, unsigned& nloc, unsigned& nx) {
    const unsigned G = gridDim.x * gridDim.y * gridDim.z;
    unsigned sum, cnt, mine, sp = 0u;
    for (;;) {
        sum = 0u; cnt = 0u; mine = 0u;
#pragma unroll
        for (unsigned j = 0; j < 16; ++j) { const unsigned c = xb_ld(&bar[XB_XCNT(j)]); sum += c; cnt += (c > 0u) ? 1u : 0u; mine = (j == x) ? c : mine; }
        if (sum == G) break;
        __builtin_amdgcn_s_sleep(1);
        if ((++sp & 255u) == 0u) { if (xb_ld(&bar[XB_TMO])) break; if (sp > XB_SPIN_CAP) { atomicAdd(&bar[XB_TMO], 1u); break; } }
    }
    nloc = mine > 0u ? mine : 1u; nx = cnt > 0u ? cnt : 1u;
}

__device__ __forceinline__ void xcd_barrier(const XcdBarrier& b) {
    asm volatile("s_waitcnt vmcnt(0)" ::: "memory");
    __syncthreads();
    if (threadIdx.x == 0) {
        unsigned* bar = b.bar;
        __builtin_amdgcn_s_waitcnt(0);
        unsigned nloc = b.st[0], nx = b.st[1];
        if (nloc == 0u) { xcd_barrier_complete(bar, b.x, nloc, nx); b.st[0] = nloc; b.st[1] = nx; }
        const unsigned old = xb_add(&bar[XB_XSUB(b.x)], 1u);
        const unsigned gen = old / nloc;
        if (old + 1u == (gen + 1u) * nloc) {
            __builtin_amdgcn_fence(__ATOMIC_RELEASE, "agent");
            asm volatile("s_waitcnt vmcnt(0)" ::: "memory");
            const unsigned og = xb_add(&bar[XB_TOP], 1u);
            const unsigned tg = og / nx;
            if (og + 1u == (tg + 1u) * nx) xb_add(&bar[XB_TOPGEN], 1u);
            else XB_SPIN(xb_ld(&bar[XB_TOPGEN]) == tg, bar);
            __builtin_amdgcn_fence(__ATOMIC_ACQUIRE, "agent");
            xb_add(&bar[XB_XGEN(b.x)], 1u);
            asm volatile("s_waitcnt vmcnt(0)" ::: "memory");
        } else {
            XB_SPIN(xb_ld(&bar[XB_XGEN(b.x)]) == gen, bar);
            __builtin_amdgcn_fence(__ATOMIC_ACQUIRE, "agent");
            asm volatile("s_waitcnt vmcnt(0)" ::: "memory");
        }
    }
    __syncthreads();
}


#ifndef ONLY
#define ONLY -1
#endif
constexpr int HALF_LDS = 73728;
constexpr int SMEM_BYTES = 2 * HALF_LDS;
#define VB() (2 * B + (TID512() >> 8))
#define HS() (smem + (TID512() >> 8) * HALF_LDS)
__global__ void __launch_bounds__(512, 2) mega(Params p) {
  cg::grid_group grid = cg::this_grid();
  extern __shared__ __attribute__((aligned(16))) char smem[];
  const int G = gridDim.x, B = blockIdx.x;
  __shared__ __attribute__((aligned(16))) unsigned xb_words[4];
  if (threadIdx.x < 4) xb_words[threadIdx.x] = 0u;
  __syncthreads();
  const XcdBarrier xb = xcd_barrier_post((unsigned*)(p.ws + O_BAR), (volatile LAS unsigned*)xb_words);
  const int vG = 2 * G;
  if (ONLY < 0 || ONLY == 0) for (int it = VB(); it < PREP_ITEMS; it += vG) prep_item(p, it, HS());
  grid.sync();
  for (int l = 0; l < NL; ++l) {
    const u16* W = (const u16*)(p.ws + O_WT) + (size_t)l * W_LAYER;
    if (ONLY < 0 || ONLY == 1) norm_phase(p, l, 0, B, G, smem);
    xcd_barrier(xb);
    if (ONLY < 0 || ONLY == 2) { int mt, nt; for (int k = 0; xcd_tile(B, G, k, 130, 16, mt, nt); ++k) projin_tile(p, l, mt, nt, smem); for (int it = VB(); it < PB_KC + PB_VC; it += vG) cache_conv_item(p, l, it, HS()); }
    xcd_barrier(xb);
    if (ONLY < 0 || ONLY == 3) {
      for (int k = 0; k < (G == 256 ? 5 : (1088 + G - 1) / G); ++k) {
        bool isS = false; int bh = 0, cp = 0; bool have = true;
        if (G == 256) {
          const int q = B >> 4; bh = B & 15;
          if (k == 0) cp = 63 - q; else if (k == 1) cp = 32 + q; else if (k == 2) cp = 31 - q;
          else if (k == 3) { if (q <= 11) cp = q + 4; else { isS = true; bh = (q - 12) * 16 + (B & 15); } }
          else { if (q >= 12) cp = q - 12; else have = false; }
        } else {
          const int it = B + k * G;
          if (it >= 1088) have = false; else if (it < 1024) { cp = it >> 4; bh = it & 15; } else { isS = true; bh = it - 1024; }
        }
        if (have) attn_item(p, l, isS, isS ? (bh >> 2) : (bh >> 2), bh & 3, cp, smem);
      }
    }
    if (ONLY < 0 || ONLY == 13) for (int it = VB(); it < NGI; it += vG) gla1_item(p, l, it, HS());
    if (ONLY < 0 || ONLY == 14) for (int it = VB(); it < L1_ITEMS; it += vG) lru1_item(p, l, it, HS());
    xcd_barrier(xb);
    if (ONLY < 0 || ONLY == 4) for (int it = VB(); it < G2_ITEMS + L2_ITEMS; it += vG) { if (it < G2_ITEMS) gla2_item(p, l, it); else lru2_item(p, l, it - G2_ITEMS); }
    xcd_barrier(xb);
    if (ONLY < 0 || ONLY == 5) { for (int it = VB(); it < NGI; it += vG) gla3_item(p, l, it, HS()); for (int it = VB(); it < L3_ITEMS; it += vG) lru3_item(p, it); }
    xcd_barrier(xb);
    if (ONLY < 0 || ONLY == 6) { int mt, nt; for (int k = 0; xcd_tile(B, G, k, 130, 12, mt, nt); ++k) ybr_tile(p, l, mt, nt, smem); }
    xcd_barrier(xb);
    if (ONLY < 0 || ONLY == 7) { int mt, nt; for (int k = 0; xcd_tile(B, G, k, 130, 12, mt, nt); ++k) gate_tile(p, l, mt, nt, smem); }
    xcd_barrier(xb);
    if (ONLY < 0 || ONLY == 8) resid_phase(p, (const u16*)(p.ws + O_YP), 3072, W + W_OUT, B, G, l == 0 ? p.in[0] : p.out, smem);
    xcd_barrier(xb);
    if (ONLY < 0 || ONLY == 9) norm_phase(p, l, 1, B, G, smem);
    xcd_barrier(xb);
    if (ONLY < 0 || ONLY == 10) { int mt, nt; for (int k = 0; xcd_tile(B, G, k, 130, 11, mt, nt); ++k) ffgate_tile(p, l, mt, nt, smem); }
    xcd_barrier(xb);
    if (ONLY < 0 || ONLY == 11) { int mt, nt; for (int k = 0; xcd_tile(B, G, k, 130, 11, mt, nt); ++k) ffup_tile(p, l, mt, nt, smem); }
    xcd_barrier(xb);
    if (ONLY < 0 || ONLY == 12) resid_phase(p, (const u16*)(p.ws + O_FF), DFF, W + W_FD, B, G, p.out, smem);
    xcd_barrier(xb);
  }
  if (ONLY < 0 || ONLY == 15) norm_phase(p, 0, 2, B, G, smem);
}

extern "C" void kernel_launch(void* const* d_in, const int* in_sizes, int n_in, void* d_out, int out_size, void* d_ws, size_t ws_size,
                              hipStream_t stream) {
  static int grid_blocks = 0;
  if (!grid_blocks) {
    int dev = 0, cus = 0, per = 0;
    (void)hipGetDevice(&dev);
    (void)hipDeviceGetAttribute(&cus, hipDeviceAttributeMultiprocessorCount, dev);
    (void)hipFuncSetAttribute((const void*)mega, hipFuncAttributeMaxDynamicSharedMemorySize, SMEM_BYTES);
    (void)hipOccupancyMaxActiveBlocksPerMultiprocessor(&per, mega, 512, SMEM_BYTES);
    if (per < 1) per = 1;
    grid_blocks = cus;
  }
  if (ws_size < WS_NEED) fprintf(stderr, "workspace too small: %zu < %zu\n", ws_size, (size_t)WS_NEED);
  Params p{};
  for (int i = 0; i < 35; ++i) p.in[i] = (const float*)d_in[i];
  p.out = (float*)d_out;
  p.ws = (char*)d_ws;
  (void)hipMemsetAsync((char*)d_ws + O_BAR, 0, XCD_BAR_WORDS * sizeof(unsigned), stream);
  void* args[] = {&p};
  hipError_t e = hipLaunchCooperativeKernel((void*)mega, dim3(grid_blocks), dim3(512), args, SMEM_BYTES, stream);
  if (e != hipSuccess) fprintf(stderr, "cooperative launch failed: %s (grid %d)\n", hipGetErrorString(e), grid_blocks);
}
```

```cpp
#include <hip/hip_runtime.h>
#include <hip/hip_cooperative_groups.h>
#include <cstdio>
namespace cg = cooperative_groups;

#define DI __device__ __forceinline__
typedef unsigned short u16;
using bf16x8 = __attribute__((ext_vector_type(8))) short;
using f32x4 = __attribute__((ext_vector_type(4))) float;
using u32x4 = __attribute__((ext_vector_type(4))) unsigned;
#define MFMA16(a, b, c) __builtin_amdgcn_mfma_f32_16x16x32_bf16((a), (b), (c), 0, 0, 0)

constexpr int DM = 1024, PB = 4, PT = 8192, SBT = 16, STT = 32, PAST = 2048, NL = 4;
constexpr int MP = PB * PT, MS = SBT * STT, MT = MP + MS;
constexpr int SKP = 2112;
constexpr int SKV = PAST + STT;
constexpr int DFF = 2816, PW = 4112, PWP = 4224;
constexpr int NGI = PB * 4 * 128 + SBT * 4;
constexpr int NLC = MP / 64 + SBT;
constexpr float EPS = 1e-6f;
constexpr float QSCALE = 0.125f * 1.4426950408889634f;
constexpr int LDK = 1088;

constexpr size_t W_IN = 0, W_MG = W_IN + (size_t)4096 * LDK, W_BR = W_MG + (size_t)3072 * LDK, W_OUT = W_BR + (size_t)3 * 1024 * 512,
                 W_FG = W_OUT + (size_t)1024 * 3072, W_FU = W_FG + (size_t)DFF * LDK, W_FD = W_FU + (size_t)DFF * LDK,
                 W_WA = W_FD + (size_t)1024 * DFF, W_WX = W_WA + 32768, W_LAYER = W_WX + 32768;

struct Params {
  const float* in[35];
  float* out;
  char* ws;
};

constexpr size_t al(size_t x) { return (x + 255) & ~(size_t)255; }
constexpr size_t O_WT = 0;
constexpr size_t O_ROPE = al(O_WT + W_LAYER * NL * 2);
constexpr size_t O_LAM = al(O_ROPE + 2 * 8192 * 8 * 4);
constexpr size_t O_BAR = al(O_LAM + 256);
constexpr size_t O_XN = al(O_BAR + 4096 * 4);
constexpr size_t O_REG = al(O_XN + (size_t)MT * LDK * 2);
constexpr size_t O_QB = O_REG;
constexpr size_t O_KB = al(O_QB + (size_t)MT * 512 * 2);
constexpr size_t O_KS = al(O_KB + (size_t)MP * 512 * 2);
constexpr size_t O_VT = al(O_KS + (size_t)SBT * SKP * 512 * 2);
constexpr size_t O_VTS = al(O_VT + (size_t)MP * 512 * 2);
constexpr size_t O_GQ = al(O_VTS + (size_t)SBT * SKP * 512 * 2);
constexpr size_t O_GK = al(O_GQ + (size_t)MT * 256 * 2);
constexpr size_t O_GV = al(O_GK + (size_t)MT * 256 * 2);
constexpr size_t O_GR = al(O_GV + (size_t)MT * 512 * 2);
constexpr size_t O_GA = al(O_GR + (size_t)MT * 512 * 2);
constexpr size_t O_LX = al(O_GA + (size_t)MT * 16 * 4);
constexpr size_t O_LG = al(O_LX + (size_t)MT * 512 * 4);
constexpr size_t O_KVT = al(O_LG + (size_t)MT * 512 * 2);
constexpr size_t O_DEC = al(O_KVT + (size_t)NGI * 8192 * 2);
constexpr size_t O_HL = al(O_DEC + (size_t)NGI * 64 * 4);
constexpr size_t O_PP = al(O_HL + (size_t)MT * 512 * 2);
constexpr size_t O_CA = al(O_PP + (size_t)MT * 512 * 2);
constexpr size_t O_CH = al(O_CA + (size_t)NLC * 512 * 4);
constexpr size_t O_HS = al(O_CH + (size_t)NLC * 512 * 4);
constexpr size_t O_OA = al(O_HS + (size_t)NLC * 512 * 4);
constexpr size_t O_OG = al(O_OA + (size_t)MT * 512 * 2);
constexpr size_t O_OL = al(O_OG + (size_t)MT * 512 * 2);
constexpr size_t O_END1 = al(O_OL + (size_t)MT * 512 * 2);
constexpr size_t O_YP = O_QB;
static_assert(O_YP + (size_t)MT * 3072 * 2 <= O_OA, "Y buffer overlaps live mixer outputs");
constexpr size_t O_GU = O_REG;
constexpr size_t O_FF = al(O_GU + (size_t)MT * DFF * 2);
constexpr size_t O_END2 = al(O_FF + (size_t)MT * DFF * 2);
constexpr size_t WS_NEED = O_END1 > O_END2 ? O_END1 : O_END2;

constexpr size_t Y_P = 0, Y_S = Y_P + (size_t)MP * 1024, K_P = Y_S + (size_t)MS * 1024, V_P = K_P + (size_t)NL * MP * 512,
                 GLA_P = V_P + (size_t)NL * MP * 512, LC_P = GLA_P + (size_t)NL * PB * 32768, LH_P = LC_P + (size_t)NL * PB * 3 * 512,
                 FC_P = LH_P + (size_t)NL * PB * 512, K_S = FC_P + (size_t)NL * PB * 2 * DFF, V_S = K_S + (size_t)NL * MS * 512,
                 GLA_S = V_S + (size_t)NL * MS * 512, LC_S = GLA_S + (size_t)NL * SBT * 32768, LH_S = LC_S + (size_t)NL * SBT * 3 * 512,
                 FC_S = LH_S + (size_t)NL * SBT * 512, OUT_TOTAL = FC_S + (size_t)NL * SBT * 2 * DFF;

DI int TID() { int t = threadIdx.x & 255; asm volatile("" : "+v"(t)); return t; }
DI int TID512() { int t = threadIdx.x; asm volatile("" : "+v"(t)); return t; }
DI u16 f2bf(float x) { __bf16 h = (__bf16)x; return __builtin_bit_cast(u16, h); }
DI float bf2f(u16 h) { return __uint_as_float(((unsigned)h) << 16); }
typedef __bf16 bf16v2_t __attribute__((ext_vector_type(2)));
typedef float f32v2_t __attribute__((ext_vector_type(2)));
DI unsigned pack2(float a, float b) { f32v2_t v = {a, b}; bf16v2_t r = __builtin_convertvector(v, bf16v2_t); return __builtin_bit_cast(unsigned, r); }
DI float sigmoidf_(float x) { return __builtin_amdgcn_rcpf(1.f + __expf(-x)); }
DI float gelu_tanh(float x) { float u = 0.7978845608028654f * (x + 0.044715f * x * x * x); return x * sigmoidf_(2.f * u); }
DI float softplusf_(float x) { return fmaxf(x, 0.f) + __logf(1.f + __expf(-fabsf(x))); }
DI float quad_max(float v) {
  auto a = __builtin_amdgcn_permlane16_swap(__float_as_uint(v), __float_as_uint(v), false, false);
  v = fmaxf(__uint_as_float(a[0]), __uint_as_float(a[1]));
  auto b = __builtin_amdgcn_permlane32_swap(__float_as_uint(v), __float_as_uint(v), false, false);
  return fmaxf(__uint_as_float(b[0]), __uint_as_float(b[1]));
}
DI float wave_sum(float v) {
  for (int o = 32; o > 0; o >>= 1) v += __shfl_xor(v, o);
  return v;
}

DI void gemm512(const u16* __restrict__ A, int lda, const u16* __restrict__ B, int ldb, int K, f32x4 (&acc)[8][4], char* smem) {
  const int tid = TID512(), lane = tid & 63, wid = tid >> 6, wr = wid >> 2, wc = wid & 3, fr = lane & 15, fq = lane >> 4;
  const int lrow = tid >> 3;
  const int gch = (tid & 7) ^ ((lrow >> 1) & 7);
  const unsigned aov = (unsigned)(lrow * lda + gch * 8);
  const unsigned bov = (unsigned)(lrow * ldb + gch * 8);
  const int soff = tid * 16;
  const int sw = (fr >> 1) & 7;
  const int aoff = (wr * 128 + fr) * 128, boff = 32768 + (wc * 64 + fr) * 128;
  const int nk = K >> 6;
  asm volatile("s_waitcnt lgkmcnt(0)" ::: "memory");
  __builtin_amdgcn_s_barrier();
#pragma unroll
  for (int i = 0; i < 4; ++i) {
    __builtin_amdgcn_global_load_lds((const unsigned*)((A + (size_t)i * 64 * lda) + aov), (unsigned*)(smem + soff + i * 8192), 16, 0, 0);
    __builtin_amdgcn_global_load_lds((const unsigned*)((B + (size_t)i * 64 * ldb) + bov), (unsigned*)(smem + 32768 + soff + i * 8192), 16, 0, 0);
  }
  asm volatile("s_waitcnt vmcnt(0)" ::: "memory");
  __builtin_amdgcn_s_barrier();
  for (int kt = 0; kt < nk; ++kt) {
    const int buf = kt & 1;
    const bool more = kt + 1 < nk;
    char* st = smem + (buf ^ 1) * 65536 + soff;
    const u16* An = A + (kt + 1) * 64;
    const u16* Bn = B + (kt + 1) * 64;
    const char* Sb = smem + buf * 65536;
#pragma unroll
    for (int ks = 0; ks < 2; ++ks) {
      const int co = ((ks * 4 + fq) ^ sw) << 4;
      bf16x8 bfr[4], af[8];
#pragma unroll
      for (int n = 0; n < 4; ++n) bfr[n] = *(const bf16x8*)(Sb + boff + n * 2048 + co);
#pragma unroll
      for (int m = 0; m < 8; ++m) af[m] = *(const bf16x8*)(Sb + aoff + m * 2048 + co);
      __builtin_amdgcn_sched_barrier(0);
#pragma unroll
      for (int g = 0; g < 4; ++g) {
#pragma unroll
        for (int mm = 0; mm < 2; ++mm)
#pragma unroll
          for (int n = 0; n < 4; ++n) acc[g * 2 + mm][n] = MFMA16(af[g * 2 + mm], bfr[n], acc[g * 2 + mm][n]);
        __builtin_amdgcn_sched_barrier(0);
        if (more && ks == 0) {
          __builtin_amdgcn_global_load_lds((const unsigned*)((An + (size_t)g * 64 * lda) + aov), (unsigned*)(st + g * 8192), 16, 0, 0);
          __builtin_amdgcn_global_load_lds((const unsigned*)((Bn + (size_t)g * 64 * ldb) + bov), (unsigned*)(st + 32768 + g * 8192), 16, 0, 0);
        }
        __builtin_amdgcn_sched_barrier(0);
      }
    }
    asm volatile("s_waitcnt vmcnt(0) lgkmcnt(0)" ::: "memory");
    __builtin_amdgcn_s_barrier();
  }
}
DI void zero_acc8(f32x4 (&acc)[8][4]) {
#pragma unroll
  for (int m = 0; m < 8; ++m)
#pragma unroll
    for (int n = 0; n < 4; ++n) acc[m][n] = f32x4{0.f, 0.f, 0.f, 0.f};
}
#define EPI_IDS const int tid = TID512(), lane = tid & 63, wid = tid >> 6, wr = wid >> 2, wc = wid & 3, fr = lane & 15, fq = lane >> 4


constexpr int IMG_LD = 264;
constexpr int IMGF_LD = 260;
DI void img_barrier() { asm volatile("s_waitcnt lgkmcnt(0)" ::: "memory"); __builtin_amdgcn_s_barrier(); }
template <bool ROPE>
DI float epi_val(const f32x4 (&acc)[8][4], int m, int n, int j, const float* cs4, const float* sn4, int fr) {
  float v = acc[m][n][j];
  if (ROPE && n == 0) {
    const float pr = __shfl_xor(v, 8);
    v = (fr < 8) ? v * cs4[j] - pr * sn4[j] : v * cs4[j] + pr * sn4[j];
  }
  return v;
}
template <bool ROPE>
DI void img_put_bf16(const f32x4 (&acc)[8][4], char* smem, int rowoff, float scale, int prow0, const float* cosT) {
  EPI_IDS;
  u16* img = (u16*)smem + (wr * 128 + fq * 4 + rowoff) * IMG_LD + wc * 64 + fr;
#pragma unroll
  for (int m = 0; m < 8; ++m) {
    float cs4[4] = {0.f, 0.f, 0.f, 0.f}, sn4[4] = {0.f, 0.f, 0.f, 0.f};
    if (ROPE) {
#pragma unroll
      for (int j = 0; j < 4; ++j) { const int pos = prow0 + wr * 128 + m * 16 + fq * 4 + j; cs4[j] = cosT[pos * 8 + (fr & 7)]; sn4[j] = cosT[8192 * 8 + pos * 8 + (fr & 7)]; }
    }
#pragma unroll
    for (int n = 0; n < 4; ++n)
#pragma unroll
      for (int j = 0; j < 4; ++j) img[(m * 16 + j) * IMG_LD + n * 16] = f2bf(epi_val<ROPE>(acc, m, n, j, cs4, sn4, fr) * scale);
  }
}
DI void img_store_bf16(u16* dst, int ld, const char* smem, int rowoff) {
  const int tid = TID512();
#pragma unroll
  for (int q = 0; q < 16; ++q) {
    const int slot = tid + q * 512, row = slot >> 5, c16 = slot & 31;
    *(u32x4*)(dst + (size_t)row * ld + c16 * 8) = *(const u32x4*)(smem + (row + rowoff) * (IMG_LD * 2) + c16 * 16);
  }
}
DI void img_load_bf16(const u16* src, int ld, char* smem, int nrows, int rowoff) {
  for (int slot = TID512(); slot < nrows * 32; slot += 512) {
    const int row = slot >> 5, c16 = slot & 31;
    *(u32x4*)(smem + (row + rowoff) * (IMG_LD * 2) + c16 * 16) = *(const u32x4*)(src + (size_t)row * ld + c16 * 8);
  }
}
template <bool ROPE>
DI void imgf_put(const f32x4 (&acc)[8][4], int h, char* smem, int prow0, const float* cosT) {
  EPI_IDS;
  if (wr == h) {
    float* f = (float*)smem + (fq * 4) * IMGF_LD + wc * 64 + fr;
#pragma unroll
    for (int m = 0; m < 8; ++m) {
      float cs4[4] = {0.f, 0.f, 0.f, 0.f}, sn4[4] = {0.f, 0.f, 0.f, 0.f};
      if (ROPE) {
#pragma unroll
        for (int j = 0; j < 4; ++j) { const int pos = prow0 + wr * 128 + m * 16 + fq * 4 + j; cs4[j] = cosT[pos * 8 + (fr & 7)]; sn4[j] = cosT[8192 * 8 + pos * 8 + (fr & 7)]; }
      }
#pragma unroll
      for (int n = 0; n < 4; ++n)
#pragma unroll
        for (int j = 0; j < 4; ++j) f[(m * 16 + j) * IMGF_LD + n * 16] = epi_val<ROPE>(acc, m, n, j, cs4, sn4, fr);
    }
  }
}
template <bool ADD>
DI void imgf_store(float* dst, const float* rsrc, int ld, const char* smem) {
  const int tid = TID512();
  const unsigned o0 = (unsigned)((tid >> 6) * ld + (tid & 63) * 4);
  const char* src = smem + (tid >> 6) * (IMGF_LD * 4) + (tid & 63) * 16;
#pragma unroll
  for (int q = 0; q < 16; ++q) {
    if ((q & 3) == 0) asm volatile("" ::: "memory");
    float4 v = *(const float4*)(src + q * 8 * (IMGF_LD * 4));
    float4* d = (float4*)(dst + (o0 + (unsigned)(q * 8 * ld)));
    if (ADD) { const float4 x = *(const float4*)(rsrc + (o0 + (unsigned)(q * 8 * ld))); v.x += x.x; v.y += x.y; v.z += x.z; v.w += x.w; }
    if (ADD) *d = v;
    else __builtin_nontemporal_store(f32x4{v.x, v.y, v.z, v.w}, (f32x4*)d);
  }
}
template <bool ADD, bool ROPE>
DI void tile_out_f32(const f32x4 (&acc)[8][4], float* dst, int ld, char* smem, int prow0, const float* cosT, const float* rsrc = nullptr) {
#pragma unroll 1
  for (int h = 0; h < 2; ++h) {
    img_barrier();
    imgf_put<ROPE>(acc, h, smem, prow0, cosT);
    img_barrier();
    imgf_store<ADD>(dst + (size_t)h * 128 * ld, ADD ? rsrc + (size_t)h * 128 * ld : nullptr, ld, smem);
  }
}
template <bool ROPE>
DI void tile_out_bf16(const f32x4 (&acc)[8][4], u16* dst, int ld, char* smem, float scale, int prow0, const float* cosT) {
  img_barrier();
  img_put_bf16<ROPE>(acc, smem, 0, scale, prow0, cosT);
  img_barrier();
  img_store_bf16(dst, ld, smem, 0);
}

template <int KS>
DI f32x4 lds_mm(const u16* As, int lsa, int arow, const u16* Bs, int lsb, int brow, f32x4 acc) {
  const int lane = TID() & 63, fr = lane & 15, fq = lane >> 4;
#pragma unroll
  for (int ks = 0; ks < KS; ++ks) {
    bf16x8 a = *(const bf16x8*)(As + (arow + fr) * lsa + ks * 32 + fq * 8);
    bf16x8 b = *(const bf16x8*)(Bs + (brow + fr) * lsb + ks * 32 + fq * 8);
    acc = MFMA16(a, b, acc);
  }
  return acc;
}

constexpr int PREP_T_PER_LAYER = 64 * 16 + 48 * 16 + 3 * 128 + 3 * 256 + 3 * 704 + 16;
constexpr int PREP_T = PREP_T_PER_LAYER * NL;
constexpr int PREP_COPY = MS * 1024 / 4096;
constexpr int PREP_ROPE = 8192 * 8 / 256;
constexpr int PREP_ITEMS = PREP_T + PREP_COPY + PREP_ROPE + 2;

DI void transpose_tile(const float* src, int lds_, int k0, int c0, int ncols_valid, u16* dst, int ldd, int n0, float* tile) {
  const int tid = TID();
  __syncthreads();
#pragma unroll
  for (int i = 0; i < 16; ++i) {
    int e = tid + i * 256, r = e >> 6, c = e & 63;
    tile[r * 65 + c] = (c < ncols_valid) ? src[(size_t)(k0 + r) * lds_ + c0 + c] : 0.f;
  }
  __syncthreads();
#pragma unroll
  for (int i = 0; i < 16; ++i) {
    int e = tid + i * 256, c = e >> 6, r = e & 63;
    dst[(size_t)(n0 + c) * ldd + k0 + r] = f2bf(tile[r * 65 + c]);
  }
}

DI void prep_item(const Params& p, int it, char* smem) {
  const int tid = TID();
  if (it < PREP_T) {
    const int l = it / PREP_T_PER_LAYER;
    int t = it % PREP_T_PER_LAYER;
    u16* W = (u16*)(p.ws + O_WT) + (size_t)l * W_LAYER;
    float* tile = (float*)smem;
    if (t < 64 * 16) {
      int nt = t / 16, kt = t % 16, n0 = nt * 64;
      const int c0 = n0 < 3072 ? n0 : n0 + 16;
      transpose_tile(p.in[9] + (size_t)l * 1024 * PW, PW, kt * 64, c0, 64, W + W_IN, LDK, n0, tile);
      return;
    }
    t -= 64 * 16;
    if (t < 48 * 16) { transpose_tile(p.in[25] + (size_t)l * 1024 * 3072, 3072, (t % 16) * 64, (t / 16) * 64, 64, W + W_MG, LDK, (t / 16) * 64, tile); return; }
    t -= 48 * 16;
    if (t < 3 * 128) {
      int br = t / 128, tt = t % 128;
      transpose_tile(p.in[22 + br] + (size_t)l * 512 * 1024, 1024, (tt % 8) * 64, (tt / 8) * 64, 64, W + W_BR + (size_t)br * 1024 * 512, 512, (tt / 8) * 64, tile);
      return;
    }
    t -= 3 * 128;
    if (t < 768) { const int cp = t / 256, tt = t % 256; transpose_tile(p.in[27] + (size_t)l * 1024 * 1024, 1024, (tt % 16) * 64, (tt / 16) * 64, 64, W + W_OUT + cp * 1024, 3072, (tt / 16) * 64, tile); return; }
    t -= 768;
    if (t < 704) { transpose_tile(p.in[29] + (size_t)l * 1024 * DFF, DFF, (t % 16) * 64, (t / 16) * 64, 64, W + W_FG, LDK, (t / 16) * 64, tile); return; }
    t -= 704;
    if (t < 704) { transpose_tile(p.in[32] + (size_t)l * 1024 * DFF, DFF, (t % 16) * 64, (t / 16) * 64, 64, W + W_FU, LDK, (t / 16) * 64, tile); return; }
    t -= 704;
    if (t < 704) { transpose_tile(p.in[33] + (size_t)l * DFF * 1024, 1024, (t % 44) * 64, (t / 44) * 64, 64, W + W_FD, DFF, (t / 44) * 64, tile); return; }
    t -= 704;
    if (t < 8) { transpose_tile(p.in[17] + (size_t)l * 32768 + t * 4096, 64, 0, 0, 64, W + W_WA + t * 4096, 64, 0, tile); return; }
    t -= 8;
    transpose_tile(p.in[19] + (size_t)l * 32768 + t * 4096, 64, 0, 0, 64, W + W_WX + t * 4096, 64, 0, tile);
    return;
  }
  it -= PREP_T;
  if (it < PREP_COPY) {
    const size_t base = (size_t)it * 4096;
#pragma unroll
    for (int i = 0; i < 4; ++i) {
      const size_t e = base + (size_t)(tid + i * 256) * 4;
      *(float4*)(p.out + (size_t)MP * 1024 + e) = *(const float4*)(p.in[1] + e);
    }
    return;
  }
  it -= PREP_COPY;
  if (it < PREP_ROPE) {
    int e = it * 256 + tid, pos = e >> 3, i = e & 7;
    double inv = pow(500000.0, -(double)i / 8.0);
    double ang = (double)pos * inv;
    double kq = rint(ang * 0.15915494309189535);
    double r = ang - kq * 6.283185307179586;
    float rf = (float)r;
    float* cs = (float*)(p.ws + O_ROPE);
    cs[e] = cosf(rf);
    cs[8192 * 8 + e] = sinf(rf);
    return;
  }
  if (it == PREP_ROPE && tid < 64 * NL) {
    int l = tid >> 6, i = tid & 63;
    const float* lq = p.in[10] + (size_t)l * 256;
    float a = lq[i] * lq[64 + i], b = lq[128 + i] * lq[192 + i];
    a = wave_sum(a); b = wave_sum(b);
    if (i == 0) {
      float lam_init = 0.8f - 0.6f * __expf(-0.3f * (float)l);
      ((float*)(p.ws + O_LAM))[l] = __expf(a) - __expf(b) + lam_init;
    }
  }
}

DI bool xcd_tile(int B, int G, int iter, int MTILES, int NT, int& mt, int& nt) {
  const int nxb = G >> 3;
  const int x = B & 7, lb = B >> 3;
  const int q = MTILES >> 3, r = MTILES & 7;
  const int mx = q + (x < r ? 1 : 0);
  const int mbase = x * q + (x < r ? x : r);
  const int j = lb + iter * nxb;
  if (j >= mx * NT) return false;
  const int band = j / (8 * NT);
  const int rem = j - band * 8 * NT;
  const int nb = (mx - band * 8) < 8 ? (mx - band * 8) : 8;
  mt = mbase + band * 8 + rem % nb;
  nt = rem / nb;
  return true;
}

constexpr int PB_KC = SBT * PAST * 512 / 4096;
constexpr int PB_VC = SBT * 32 * 8;

DI void projin_tile(const Params& p, int l, int mt, int nt, char* smem) {
  const int row0 = mt * 256, col0 = nt * 256;
  const u16* W = (const u16*)(p.ws + O_WT) + (size_t)l * W_LAYER + W_IN;
  const u16* XN = (const u16*)(p.ws + O_XN);
  f32x4 acc[8][4];
  zero_acc8(acc);
  gemm512(XN + (size_t)row0 * LDK, LDK, W + (size_t)col0 * LDK, LDK, 1024, acc, smem);
  const float* cosT = (const float*)(p.ws + O_ROPE);
  const float* sinT = cosT + 8192 * 8;
  if (mt < 128) {
    const int prow0 = row0 & 8191;
    if (nt < 2) {
      tile_out_bf16<true>(acc, (u16*)(p.ws + O_QB) + (size_t)row0 * 512 + col0, 512, smem, QSCALE, prow0, cosT);
    } else if (nt < 4) {
      tile_out_f32<false, true>(acc, p.out + K_P + ((size_t)l * MP + row0) * 512 + (col0 - 512), 512, smem, prow0, cosT);
      tile_out_bf16<true>(acc, (u16*)(p.ws + O_KB) + (size_t)row0 * 512 + (col0 - 512), 512, smem, 1.f, prow0, cosT);
    } else if (nt < 6) {
      tile_out_f32<false, false>(acc, p.out + V_P + ((size_t)l * MP + row0) * 512 + (col0 - 1024), 512, smem, 0, nullptr);
      EPI_IDS;
      u16* VT = (u16*)(p.ws + O_VT);
      const unsigned vb = (unsigned)((row0 >> 13) * 512 + (col0 - 1024) + wc * 64 + fr) * (unsigned)PT + (unsigned)((row0 & 8191) + wr * 128 + fq * 4);
#pragma unroll
      for (int m = 0; m < 8; ++m) {
        asm volatile("" ::: "memory");
#pragma unroll
        for (int n = 0; n < 4; ++n) {
          const uint2 pk = {pack2(acc[m][n][0], acc[m][n][1]), pack2(acc[m][n][2], acc[m][n][3])};
          *(uint2*)(VT + (vb + (unsigned)(n * 16 * PT + m * 16))) = pk;
        }
      }
    } else if (nt >= 12 && nt < 14) {
      tile_out_f32<false, false>(acc, (float*)(p.ws + O_LX) + (size_t)row0 * 512 + (col0 - 3072), 512, smem, 0, nullptr);
    } else {
      u16* dst; int ld = 512, cbase;
      if (nt == 6) { dst = (u16*)(p.ws + O_GQ); ld = 256; cbase = 1536; }
      else if (nt == 7) { dst = (u16*)(p.ws + O_GK); ld = 256; cbase = 1792; }
      else if (nt < 10) { dst = (u16*)(p.ws + O_GV); cbase = 2048; }
      else if (nt < 12) { dst = (u16*)(p.ws + O_GR); cbase = 2560; }
      else { dst = (u16*)(p.ws + O_LG); cbase = 3584; }
      tile_out_bf16<false>(acc, dst + (size_t)row0 * ld + (col0 - cbase), ld, smem, nt == 6 ? 0.125f : 1.f, 0, nullptr);
    }
    return;
  }
  EPI_IDS;
  const bool isS = row0 >= MP;
  if (nt < 4) {
    const bool isq = nt < 2;
    u16* QB = (u16*)(p.ws + O_QB);
    u16* KB = (u16*)(p.ws + O_KB);
    u16* KS = (u16*)(p.ws + O_KS);
#pragma unroll
    for (int m = 0; m < 8; ++m) {
      asm volatile("" ::: "memory");
#pragma unroll
      for (int n = 0; n < 4; ++n)
#pragma unroll
        for (int j = 0; j < 4; ++j) {
          const int row = row0 + wr * 128 + m * 16 + fq * 4 + j;
          const int col = col0 + wc * 64 + n * 16 + fr;
          float v = acc[m][n][j];
          int b, t;
          if (isS) { int rs = row - MP; b = rs >> 5; t = rs & 31; } else { b = row >> 13; t = row & 8191; }
          const int pos = isS ? PAST + t : t;
          if (n == 0) {
            float pr = __shfl_xor(v, 8);
            float cs = cosT[pos * 8 + (fr & 7)], sn = sinT[pos * 8 + (fr & 7)];
            v = (fr < 8) ? v * cs - pr * sn : v * cs + pr * sn;
          }
          if (isq) {
            QB[(size_t)row * 512 + col] = f2bf(v * QSCALE);
          } else {
            const int ck = col - 512;
            if (isS) {
              p.out[K_S + ((size_t)l * MS + (row - MP)) * 512 + ck] = v;
              KS[((size_t)b * SKP + PAST + t) * 512 + ck] = f2bf(v);
            } else {
              p.out[K_P + ((size_t)l * MP + row) * 512 + ck] = v;
              KB[(size_t)row * 512 + ck] = f2bf(v);
            }
          }
        }
    }
  } else if (nt < 6) {
    u16* VT = (u16*)(p.ws + O_VT);
    u16* VTS = (u16*)(p.ws + O_VTS);
#pragma unroll
    for (int m = 0; m < 8; ++m) {
      asm volatile("" ::: "memory");
#pragma unroll
      for (int n = 0; n < 4; ++n) {
        const int rowb = row0 + wr * 128 + m * 16 + fq * 4;
        const int cv = col0 - 1024 + wc * 64 + n * 16 + fr;
        const int h = cv >> 7, vd = cv & 127;
        int b, t;
        if (isS) { int rs = rowb - MP; b = rs >> 5; t = rs & 31; } else { b = rowb >> 13; t = rowb & 8191; }
#pragma unroll
        for (int j = 0; j < 4; ++j) {
          if (isS) p.out[V_S + ((size_t)l * MS + (rowb + j - MP)) * 512 + cv] = acc[m][n][j];
          else p.out[V_P + ((size_t)l * MP + rowb + j) * 512 + cv] = acc[m][n][j];
        }
        uint2 pk = {pack2(acc[m][n][0], acc[m][n][1]), pack2(acc[m][n][2], acc[m][n][3])};
        if (isS) *(uint2*)(VTS + ((size_t)(b * 4 + h) * 128 + vd) * SKP + PAST + t) = pk;
        else *(uint2*)(VT + ((size_t)(b * 4 + h) * 128 + vd) * PT + t) = pk;
      }
    }
  } else {
    u16* dst16 = nullptr; float* dst32 = nullptr; int ld = 512, cbase = 0; float scale = 1.f;
    if (nt == 6) { dst16 = (u16*)(p.ws + O_GQ); ld = 256; cbase = 1536; scale = 0.125f; }
    else if (nt == 7) { dst16 = (u16*)(p.ws + O_GK); ld = 256; cbase = 1792; }
    else if (nt < 10) { dst16 = (u16*)(p.ws + O_GV); cbase = 2048; }
    else if (nt < 12) { dst16 = (u16*)(p.ws + O_GR); cbase = 2560; }
    else if (nt < 14) { dst32 = (float*)(p.ws + O_LX); cbase = 3072; }
    else { dst16 = (u16*)(p.ws + O_LG); cbase = 3584; }
#pragma unroll
    for (int m = 0; m < 8; ++m) {
      asm volatile("" ::: "memory");
#pragma unroll
      for (int n = 0; n < 4; ++n)
#pragma unroll
        for (int j = 0; j < 4; ++j) {
          const int row = row0 + wr * 128 + m * 16 + fq * 4 + j;
          const int c = col0 + wc * 64 + n * 16 + fr - cbase;
          const float v = acc[m][n][j] * scale;
          if (dst16) dst16[(size_t)row * ld + c] = f2bf(v);
          else dst32[(size_t)row * ld + c] = v;
        }
    }
  }
}

DI void cache_conv_item(const Params& p, int l, int it, char* smem) {
  const int tid = TID();
  if (it < PB_KC) {
    const float* src = p.in[2] + (size_t)l * SBT * PAST * 512;
    u16* KS = (u16*)(p.ws + O_KS);
#pragma unroll
    for (int i = 0; i < 4; ++i) {
      size_t e = (size_t)it * 4096 + (size_t)(tid + i * 256) * 4;
      float4 v = *(const float4*)(src + e);
      size_t b = e / ((size_t)PAST * 512), r = e % ((size_t)PAST * 512);
      *(uint2*)(KS + b * SKP * 512 + r) = uint2{pack2(v.x, v.y), pack2(v.z, v.w)};
    }
    return;
  }
  it -= PB_KC;
  const int b = it / 256, r = it % 256, ptile = r / 8, ctile = r % 8;
  const float* src = p.in[3] + ((size_t)l * SBT + b) * PAST * 512;
  u16* VTS = (u16*)(p.ws + O_VTS);
  transpose_tile(src, 512, ptile * 64, ctile * 64, 64, VTS + (size_t)b * 512 * SKP, SKP, ctile * 64, (float*)smem);
}

DI int kswz(int key) { return (((key >> 3) & 3) << 2) | (key & 3); }

DI void attn_item(const Params& p, int l, bool isS, int b, int h, int cp, char* smem) {
  const int tid = TID512(), lane = tid & 63, wid = tid >> 6, fr = lane & 15, fq = lane >> 4;
  const int nkt = isS ? 33 : 2 * cp + 2;
  const int klen = isS ? SKV : nkt * 64;
  const int mykt = isS ? 33 : (wid < 4 ? 2 * cp + 1 : 2 * cp + 2);
  const u16* QB = (const u16*)(p.ws + O_QB);
  const u16* Kg = isS ? (const u16*)(p.ws + O_KS) + (size_t)b * SKP * 512 + h * 128 : (const u16*)(p.ws + O_KB) + (size_t)b * PT * 512 + h * 128;
  const int vstride = isS ? SKP : PT;
  const u16* Vg = (isS ? (const u16*)(p.ws + O_VTS) : (const u16*)(p.ws + O_VT)) + (size_t)(b * 4 + h) * 128 * vstride;
  const int qrow0 = isS ? MP + b * 32 : b * PT + cp * 128;
  const bool wactive = isS ? (wid < 2) : true;
  const int qrow = qrow0 + wid * 16 + fr;
  bf16x8 qf[2][2];
#pragma unroll
  for (int mp = 0; mp < 2; ++mp)
#pragma unroll
    for (int ks = 0; ks < 2; ++ks)
      qf[mp][ks] = wactive ? *(const bf16x8*)(QB + (size_t)qrow * 512 + h * 128 + mp * 64 + ks * 32 + fq * 8) : bf16x8{0, 0, 0, 0, 0, 0, 0, 0};
  f32x4 ot[2][8];
#pragma unroll
  for (int mp = 0; mp < 2; ++mp)
#pragma unroll
    for (int n = 0; n < 8; ++n) ot[mp][n] = f32x4{0.f, 0.f, 0.f, 0.f};
  float mrun[2] = {-INFINITY, -INFINITY}, lrun[2] = {0.f, 0.f};
  char* Ks = smem;
  char* Vs = smem + 32768;
  const int kkey = tid >> 4, vvd = tid >> 3;
  const int kgch = (tid & 15) ^ kswz(kkey);
  const int vgch = (tid & 7) ^ ((vvd >> 1) & 7);
  const int soff = tid * 16;
  auto issue_k = [&](int kt) {
#pragma unroll
    for (int i = 0; i < 2; ++i)
      __builtin_amdgcn_global_load_lds((const unsigned*)(Kg + (size_t)(kt * 64 + kkey + i * 32) * 512 + kgch * 8), (unsigned*)(Ks + (kt & 1) * 16384 + soff + i * 8192), 16, 0, 0);
  };
  auto issue_v = [&](int kt) {
#pragma unroll
    for (int i = 0; i < 2; ++i)
      __builtin_amdgcn_global_load_lds((const unsigned*)(Vg + (size_t)(vvd + i * 64) * vstride + kt * 64 + vgch * 8), (unsigned*)(Vs + (kt & 1) * 16384 + soff + i * 8192), 16, 0, 0);
  };
  auto qk_tile = [&](int kt, f32x4 (&st)[2][4]) {
    const char* Kb = Ks + (kt & 1) * 16384;
    bf16x8 kf[2][4][2];
#pragma unroll
    for (int mp = 0; mp < 2; ++mp)
#pragma unroll
      for (int mt = 0; mt < 4; ++mt) {
        const int key = 32 * (mt >> 1) + 8 * (fr >> 2) + 4 * (mt & 1) + (fr & 3);
#pragma unroll
        for (int ks = 0; ks < 2; ++ks) kf[mp][mt][ks] = *(const bf16x8*)(Kb + key * 256 + (((mp * 8 + ks * 4 + fq) ^ kswz(key)) << 4));
      }
#pragma unroll
    for (int mp = 0; mp < 2; ++mp)
#pragma unroll
      for (int mt = 0; mt < 4; ++mt) {
        f32x4 a = MFMA16(kf[mp][mt][0], qf[mp][0], (f32x4{0.f, 0.f, 0.f, 0.f}));
        st[mp][mt] = MFMA16(kf[mp][mt][1], qf[mp][1], a);
      }
    if ((kt + 1) * 64 > klen) {
      asm volatile("" ::: "memory");
#pragma unroll
      for (int mp = 0; mp < 2; ++mp)
#pragma unroll
        for (int mt = 0; mt < 4; ++mt)
#pragma unroll
          for (int j = 0; j < 4; ++j) {
            const int key = kt * 64 + 32 * (mt >> 1) + 8 * fq + 4 * (mt & 1) + j;
            if (key >= klen) st[mp][mt][j] = -INFINITY;
          }
    }
  };
  auto softmax_tile = [&](f32x4 (&st)[2][4], bf16x8 (&pfn)[2][2], float (&alpha)[2], float (&psum)[2], bool (&moved)[2]) {
#pragma unroll
    for (int mp = 0; mp < 2; ++mp) {
      float mx = -INFINITY;
#pragma unroll
      for (int mt = 0; mt < 4; ++mt)
#pragma unroll
        for (int j = 0; j < 4; ++j) mx = fmaxf(mx, st[mp][mt][j]);
      mx = quad_max(mx);
      const float mold = mrun[mp];
      const float mnew = fmaxf(mold, mx);
      mrun[mp] = mnew;
      float ps = 0.f;
#pragma unroll
      for (int mt = 0; mt < 4; ++mt)
#pragma unroll
        for (int j = 0; j < 4; ++j) { float e = __builtin_amdgcn_exp2f(st[mp][mt][j] - mnew); st[mp][mt][j] = e; ps += e; }
      psum[mp] = ps;
      moved[mp] = __any(mnew > mold);
      alpha[mp] = __builtin_amdgcn_exp2f(mold - mnew);
#pragma unroll
      for (int s = 0; s < 2; ++s) {
        uint4 u = {pack2(st[mp][2 * s][0], st[mp][2 * s][1]), pack2(st[mp][2 * s][2], st[mp][2 * s][3]),
                   pack2(st[mp][2 * s + 1][0], st[mp][2 * s + 1][1]), pack2(st[mp][2 * s + 1][2], st[mp][2 * s + 1][3])};
        pfn[mp][s] = __builtin_bit_cast(bf16x8, u);
      }
    }
  };
  auto apply_scale = [&](const float (&alpha)[2], const float (&psum)[2], const bool (&moved)[2]) {
#pragma unroll
    for (int mp = 0; mp < 2; ++mp) {
      if (moved[mp]) {
        lrun[mp] *= alpha[mp];
#pragma unroll
        for (int n = 0; n < 8; ++n) { ot[mp][n][0] *= alpha[mp]; ot[mp][n][1] *= alpha[mp]; ot[mp][n][2] *= alpha[mp]; ot[mp][n][3] *= alpha[mp]; }
      }
      lrun[mp] += psum[mp];
    }
  };
  asm volatile("s_waitcnt vmcnt(0) lgkmcnt(0)" ::: "memory");
  __builtin_amdgcn_s_barrier();
  issue_k(0); issue_v(0);
  if (nkt > 1) issue_k(1);
  asm volatile("s_waitcnt vmcnt(0)" ::: "memory");
  asm volatile("" ::"v"(qf[0][0]), "v"(qf[0][1]), "v"(qf[1][0]), "v"(qf[1][1]));
  __builtin_amdgcn_s_barrier();
  bf16x8 pf[2][2];
#pragma unroll
  for (int mp = 0; mp < 2; ++mp)
#pragma unroll
    for (int s = 0; s < 2; ++s) pf[mp][s] = bf16x8{0, 0, 0, 0, 0, 0, 0, 0};
  if (wactive) {
    f32x4 st[2][4];
    float alpha[2], psum[2]; bool moved[2];
    qk_tile(0, st);
    softmax_tile(st, pf, alpha, psum, moved);
    apply_scale(alpha, psum, moved);
  }
  asm volatile("s_waitcnt lgkmcnt(0)" ::: "memory");
  __builtin_amdgcn_s_barrier();
  for (int j = 0; j < nkt; ++j) {
    if (j + 2 < nkt) issue_k(j + 2);
    if (j + 1 < nkt) issue_v(j + 1);
    const bool doPV = wactive && j < mykt;
    const bool doQK = wactive && j + 1 < mykt;
    f32x4 st[2][4];
    bf16x8 pfn[2][2];
    float alpha[2] = {1.f, 1.f}, psum[2] = {0.f, 0.f}; bool moved[2] = {false, false};
    auto pv_tile = [&]() {
      const char* Vb = Vs + (j & 1) * 16384;
#pragma unroll
      for (int nh = 0; nh < 2; ++nh) {
        bf16x8 vf[4][2];
#pragma unroll
        for (int n = 0; n < 4; ++n) {
          const int vd = (nh * 4 + n) * 16 + fr;
#pragma unroll
          for (int s = 0; s < 2; ++s) vf[n][s] = *(const bf16x8*)(Vb + vd * 128 + (((s * 4 + fq) ^ ((vd >> 1) & 7)) << 4));
        }
#pragma unroll
        for (int n = 0; n < 4; ++n)
#pragma unroll
          for (int s = 0; s < 2; ++s) {
            ot[0][nh * 4 + n] = MFMA16(vf[n][s], pf[0][s], ot[0][nh * 4 + n]);
            ot[1][nh * 4 + n] = MFMA16(vf[n][s], pf[1][s], ot[1][nh * 4 + n]);
          }
      }
    };
    if (doQK) {
      qk_tile(j + 1, st);
      pv_tile();
      softmax_tile(st, pfn, alpha, psum, moved);
      apply_scale(alpha, psum, moved);
#pragma unroll
      for (int mp = 0; mp < 2; ++mp)
#pragma unroll
        for (int s = 0; s < 2; ++s) pf[mp][s] = pfn[mp][s];
    } else if (doPV) {
      pv_tile();
    }
    asm volatile("s_waitcnt vmcnt(0) lgkmcnt(0)" ::: "memory");
    __builtin_amdgcn_s_barrier();
  }
  if (wactive) {
    float l0 = lrun[0], l1 = lrun[1];
    l0 += __shfl_xor(l0, 16); l0 += __shfl_xor(l0, 32);
    l1 += __shfl_xor(l1, 16); l1 += __shfl_xor(l1, 32);
    const float lam = ((const float*)(p.ws + O_LAM))[l];
    const float lam_init = 0.8f - 0.6f * __expf(-0.3f * (float)l);
    const float i0 = 1.f / l0, i1 = lam / l1;
    float ss = 0.f;
#pragma unroll
    for (int n = 0; n < 8; ++n)
#pragma unroll
      for (int j = 0; j < 4; ++j) { float o = ot[0][n][j] * i0 - ot[1][n][j] * i1; ot[0][n][j] = o; ss += o * o; }
    ss += __shfl_xor(ss, 16); ss += __shfl_xor(ss, 32);
    const float rs = rsqrtf(ss * (1.f / 128.f) + EPS) * (1.f - lam_init);
    const float* g = p.in[11] + (size_t)l * 128;
    u16* OA = (u16*)(p.ws + O_OA) + (size_t)qrow * 512 + h * 128;
#pragma unroll
    for (int n = 0; n < 8; ++n) {
      const int vd = n * 16 + fq * 4;
      float4 gg = *(const float4*)(g + vd);
      *(uint2*)(OA + vd) = uint2{pack2(ot[0][n][0] * rs * gg.x, ot[0][n][1] * rs * gg.y), pack2(ot[0][n][2] * rs * gg.z, ot[0][n][3] * rs * gg.w)};
    }
  }
}

constexpr int LP = 72;
constexpr int BCS = 68;
DI void gla_decode(int gi, bool& isS, int& b, int& h, int& c, int& row0, int& Lc) {
  if (gi < PB * 4 * 128) { isS = false; c = gi & 127; h = (gi >> 7) & 3; b = gi >> 9; row0 = b * PT + c * 64; Lc = 64; }
  else { isS = true; int s = gi - PB * 4 * 128; b = s >> 2; h = s & 3; c = 0; row0 = MP + b * 32; Lc = 32; }
}
DI void gla_bcum(const Params& p, int l, int row0, int Lc, int h, float* bc, float* tot, float* gas) {
  const int tid = TID(), kd = tid & 63, tq = tid >> 6;
  const float* W2 = p.in[12] + (size_t)l * 16 * 256 + h * 64 + kd;
  const float b2 = p.in[13][(size_t)l * 256 + h * 64 + kd];
  const float* GA = (const float*)(p.ws + O_GA);
  {
    const int r = tid >> 2, part = tid & 3;
    float4 v = {0.f, 0.f, 0.f, 0.f};
    if (r < Lc) v = *(const float4*)(GA + (size_t)(row0 + r) * 16 + part * 4);
    *(float4*)(gas + r * 16 + part * 4) = v;
  }
  float w[16];
#pragma unroll
  for (int r = 0; r < 16; ++r) w[r] = W2[r * 256];
  __syncthreads();
  float run = 0.f;
#pragma unroll
  for (int i = 0; i < 16; ++i) {
    const int t = tq * 16 + i;
    const float4* ga = (const float4*)(gas + t * 16);
    const float4 g0 = ga[0], g1 = ga[1], g2 = ga[2], g3 = ga[3];
    const float x = b2 + g0.x * w[0] + g0.y * w[1] + g0.z * w[2] + g0.w * w[3] + g1.x * w[4] + g1.y * w[5] + g1.z * w[6] + g1.w * w[7] +
                    g2.x * w[8] + g2.y * w[9] + g2.z * w[10] + g2.w * w[11] + g3.x * w[12] + g3.y * w[13] + g3.z * w[14] + g3.w * w[15];
    const float la = (t < Lc) ? -softplusf_(-x) * (1.f / 16.f) : 0.f;
    run += la;
    bc[t * BCS + kd] = run;
  }
  tot[tq * 64 + kd] = run;
  __syncthreads();
  float off = 0.f;
  for (int g = 0; g < tq; ++g) off += tot[g * 64 + kd];
#pragma unroll
  for (int i = 0; i < 16; ++i) bc[(tq * 16 + i) * BCS + kd] += off;
  __syncthreads();
}
DI void gla_load_vt(const Params& p, int row0, int Lc, int h, u16* vt) {
  const int tid = TID(), s = tid & 63, cg4 = tid >> 6;
  const u16* GV = (const u16*)(p.ws + O_GV) + (size_t)(row0 + s) * 512 + h * 128;
  u32x4 v[4];
#pragma unroll
  for (int i = 0; i < 4; ++i) v[i] = (s < Lc) ? *(const u32x4*)(GV + (cg4 + 4 * i) * 8) : u32x4{0u, 0u, 0u, 0u};
#pragma unroll
  for (int i = 0; i < 4; ++i) {
    const int vd0 = (cg4 + 4 * i) * 8;
#pragma unroll
    for (int e = 0; e < 4; ++e) {
      vt[(vd0 + 2 * e) * LP + s] = (u16)(v[i][e] & 0xffffu);
      vt[(vd0 + 2 * e + 1) * LP + s] = (u16)(v[i][e] >> 16);
    }
  }
}

DI void gla1_item(const Params& p, int l, int gi, char* smem) {
  bool isS; int b, h, c, row0, Lc;
  gla_decode(gi, isS, b, h, c, row0, Lc);
  const int tid = TID(), lane = tid & 63, wid = tid >> 6, fr = lane & 15, fq = lane >> 4;
  float* bc = (float*)smem;
  float* tot = (float*)(smem + 17408);
  u16* kh = (u16*)(smem + 18432);
  u16* vt = (u16*)(smem + 18432 + 9216);
  __syncthreads();
  gla_bcum(p, l, row0, Lc, h, bc, tot, (float*)kh);
  {
    const int s = tid & 63, c2 = tid >> 6;
    const u16* GK = (const u16*)(p.ws + O_GK) + (size_t)(row0 + s) * 256 + h * 64;
    u32x4 kv[2];
#pragma unroll
    for (int i = 0; i < 2; ++i) kv[i] = (s < Lc) ? *(const u32x4*)(GK + (c2 + 4 * i) * 8) : u32x4{0u, 0u, 0u, 0u};
#pragma unroll
    for (int i = 0; i < 2; ++i) {
      const int kd0 = (c2 + 4 * i) * 8;
#pragma unroll
      for (int e = 0; e < 8; ++e) {
        const unsigned w = kv[i][e >> 1];
        const float kf = bf2f((u16)((e & 1) ? (w >> 16) : (w & 0xffffu)));
        const float bl = bc[63 * BCS + kd0 + e];
        kh[(kd0 + e) * LP + s] = f2bf(kf * __expf(bl - bc[s * BCS + kd0 + e]));
      }
    }
    if (tid < 64) ((float*)(p.ws + O_DEC))[(size_t)gi * 64 + tid] = __expf(bc[63 * BCS + tid]);
  }
  gla_load_vt(p, row0, Lc, h, vt);
  __syncthreads();
  u16* KVT = (u16*)(p.ws + O_KVT) + (size_t)gi * 8192;
#pragma unroll
  for (int mi = 0; mi < 2; ++mi)
#pragma unroll
    for (int n = 0; n < 4; ++n) {
      const int m = wid * 2 + mi;
      f32x4 a = lds_mm<2>(vt, LP, m * 16, kh, LP, n * 16, f32x4{0.f, 0.f, 0.f, 0.f});
#pragma unroll
      for (int j = 0; j < 4; ++j) KVT[(m * 16 + fq * 4 + j) * 64 + n * 16 + fr] = f2bf(a[j]);
    }
}

constexpr int G2_ITEMS = (PB * 4 + SBT * 4) * 32;
DI void gla2_item(const Params& p, int l, int it) {
  const int seq = it >> 5, e = (it & 31) * 256 + TID();
  const int vd = e >> 6, kd = e & 63;
  u16* KVT = (u16*)(p.ws + O_KVT);
  const float* DEC = (const float*)(p.ws + O_DEC);
  if (seq < PB * 4) {
    float S = 0.f;
    const int gi0 = seq * 128;
    for (int c0 = 0; c0 < 128; c0 += 32) {
      u16 kvv[32]; float dd[32];
#pragma unroll
      for (int c = 0; c < 32; ++c) { kvv[c] = KVT[(size_t)(gi0 + c0 + c) * 8192 + e]; dd[c] = DEC[(size_t)(gi0 + c0 + c) * 64 + kd]; }
#pragma unroll
      for (int c = 0; c < 32; ++c) { KVT[(size_t)(gi0 + c0 + c) * 8192 + e] = f2bf(S); S = dd[c] * S + bf2f(kvv[c]); }
    }
    p.out[GLA_P + ((size_t)l * PB * 4 + seq) * 8192 + kd * 128 + vd] = S;
  } else {
    const int s = seq - PB * 4, gi = PB * 4 * 128 + s;
    const float S0 = p.in[4][((size_t)l * SBT * 4 + s) * 8192 + kd * 128 + vd];
    u16* q = KVT + (size_t)gi * 8192 + e;
    const float kv = bf2f(*q);
    const float d = DEC[(size_t)gi * 64 + kd];
    *q = f2bf(S0);
    p.out[GLA_S + ((size_t)l * SBT * 4 + s) * 8192 + kd * 128 + vd] = d * S0 + kv;
  }
}

DI void gla3_item(const Params& p, int l, int gi, char* smem) {
  bool isS; int b, h, c, row0, Lc;
  gla_decode(gi, isS, b, h, c, row0, Lc);
  const int tid = TID(), lane = tid & 63, wid = tid >> 6, fr = lane & 15, fq = lane >> 4;
  float* bc = (float*)smem;
  u16* att = (u16*)smem;
  float* tot = (float*)(smem + 17408);
  u16* qt = (u16*)(smem + 18432);
  u16* kt_ = (u16*)(smem + 18432 + 9216);
  u16* vt = (u16*)(smem + 18432 + 2 * 9216);
  u16* st = (u16*)(smem + 18432 + 2 * 9216 + 18432);
  __syncthreads();
  gla_bcum(p, l, row0, Lc, h, bc, tot, (float*)qt);
  const u16* KVT = (const u16*)(p.ws + O_KVT) + (size_t)gi * 8192;
  {
    const int s = tid & 63, c2 = tid >> 6;
    const u16* GQ = (const u16*)(p.ws + O_GQ) + (size_t)(row0 + s) * 256 + h * 64;
    const u16* GK = (const u16*)(p.ws + O_GK) + (size_t)(row0 + s) * 256 + h * 64;
    u32x4 qv[2], kv[2], sv[4];
#pragma unroll
    for (int i = 0; i < 2; ++i) {
      qv[i] = (s < Lc) ? *(const u32x4*)(GQ + (c2 + 4 * i) * 8) : u32x4{0u, 0u, 0u, 0u};
      kv[i] = (s < Lc) ? *(const u32x4*)(GK + (c2 + 4 * i) * 8) : u32x4{0u, 0u, 0u, 0u};
    }
#pragma unroll
    for (int i = 0; i < 4; ++i) { const int id = tid + i * 256; sv[i] = *(const u32x4*)(KVT + (id >> 3) * 64 + (id & 7) * 8); }
#pragma unroll
    for (int i = 0; i < 2; ++i) {
      const int kd0 = (c2 + 4 * i) * 8;
      u32x4 qo, ko;
#pragma unroll
      for (int e2 = 0; e2 < 4; ++e2) {
        const float b0 = bc[s * BCS + kd0 + 2 * e2], b1 = bc[s * BCS + kd0 + 2 * e2 + 1];
        const float e0 = __expf(b0), e1 = __expf(b1);
        const float q0 = bf2f((u16)(qv[i][e2] & 0xffffu)) * e0, q1 = bf2f((u16)(qv[i][e2] >> 16)) * e1;
        const float k0 = bf2f((u16)(kv[i][e2] & 0xffffu)) / e0, k1 = bf2f((u16)(kv[i][e2] >> 16)) / e1;
        qo[e2] = pack2(q0, q1);
        ko[e2] = pack2(k0, k1);
      }
      *(u32x4*)(qt + s * LP + kd0) = qo;
      *(u32x4*)(kt_ + s * LP + kd0) = ko;
    }
#pragma unroll
    for (int i = 0; i < 4; ++i) { const int id = tid + i * 256; *(u32x4*)(st + (id >> 3) * LP + (id & 7) * 8) = sv[i]; }
  }
  gla_load_vt(p, row0, Lc, h, vt);
  __syncthreads();
  {
    f32x4 a[4];
#pragma unroll
    for (int n = 0; n < 4; ++n) a[n] = lds_mm<2>(qt, LP, wid * 16, kt_, LP, n * 16, f32x4{0.f, 0.f, 0.f, 0.f});
#pragma unroll
    for (int n = 0; n < 4; ++n)
#pragma unroll
      for (int j = 0; j < 4; ++j) {
        const int t = wid * 16 + fq * 4 + j, s = n * 16 + fr;
        att[t * LP + s] = f2bf(t >= s ? a[n][j] : 0.f);
      }
  }
  __syncthreads();
  f32x4 o[8];
#pragma unroll
  for (int n = 0; n < 8; ++n) {
    f32x4 a = lds_mm<2>(att, LP, wid * 16, vt, LP, n * 16, f32x4{0.f, 0.f, 0.f, 0.f});
    o[n] = lds_mm<2>(qt, LP, wid * 16, st, LP, n * 16, a);
  }
  const float* gn = p.in[14] + (size_t)l * 128;
  const u16* GR = (const u16*)(p.ws + O_GR);
  u16* OG = (u16*)(p.ws + O_OG);
  float gnv[8];
#pragma unroll
  for (int n = 0; n < 8; ++n) gnv[n] = gn[n * 16 + fr];
#pragma unroll
  for (int j = 0; j < 4; ++j) {
    float ss = 0.f;
#pragma unroll
    for (int n = 0; n < 8; ++n) ss += o[n][j] * o[n][j];
    ss += __shfl_xor(ss, 1); ss += __shfl_xor(ss, 2); ss += __shfl_xor(ss, 4); ss += __shfl_xor(ss, 8);
    const float rs = rsqrtf(ss * (1.f / 128.f) + EPS);
    const int t = wid * 16 + fq * 4 + j;
    if (t < Lc) {
      const size_t ro = (size_t)(row0 + t) * 512 + h * 128;
      u16 grv[8];
#pragma unroll
      for (int n = 0; n < 8; ++n) grv[n] = GR[ro + n * 16 + fr];
#pragma unroll
      for (int n = 0; n < 8; ++n) {
        const float gr = bf2f(grv[n]);
        OG[ro + n * 16 + fr] = f2bf(o[n][j] * rs * gnv[n] * gr * sigmoidf_(gr));
      }
    }
  }
}

constexpr int L1_ITEMS = NLC * 8;
DI void lru_decode(int ci, bool& isS, int& b, int& row0, int& Lc, int& t0) {
  if (ci < MP / 64) { isS = false; b = ci >> 7; t0 = (ci & 127) * 64; row0 = ci * 64; Lc = 64; }
  else { isS = true; b = ci - MP / 64; t0 = 0; row0 = MP + b * 32; Lc = 32; }
}
DI void lru1_item(const Params& p, int l, int it, char* smem) {
  const int ci = it >> 3, nb = it & 7;
  bool isS; int b, row0, Lc, t0;
  lru_decode(ci, isS, b, row0, Lc, t0);
  const int tid = TID(), lane = tid & 63, wid = tid >> 6, fr = lane & 15, fq = lane >> 4;
  u16* xcs = (u16*)smem;
  u16* was = (u16*)(smem + 9216);
  u16* wxs = (u16*)(smem + 2 * 9216);
  float* as_ = (float*)(smem + 3 * 9216);
  float* us_ = (float*)(smem + 3 * 9216 + 16384);
  float* segP = (float*)(smem + 3 * 9216 + 32768);
  float* segH = (float*)(smem + 3 * 9216 + 32768 + 1024);
  const float* LX = (const float*)(p.ws + O_LX);
  const u16* Wl = (const u16*)(p.ws + O_WT) + (size_t)l * W_LAYER;
  const int i = tid & 63, tq = tid >> 6, ch = nb * 64 + i;
  __syncthreads();
  {
    const float* cw = p.in[15] + (size_t)l * 4 * 512 + ch;
    const float w0 = cw[0], w1 = cw[512], w2 = cw[1024], w3 = cw[1536], cb = p.in[16][(size_t)l * 512 + ch];
    const float* buf = isS ? p.in[5] + ((size_t)l * SBT + b) * 3 * 512 + ch : nullptr;
    float x[19];
#pragma unroll
    for (int j = 0; j < 19; ++j) {
      const int tl = tq * 16 - 3 + j;
      const int tt = t0 + tl;
      float v = 0.f;
      if (tl < Lc) {
        if (tt >= 0) v = LX[(size_t)(row0 + tl) * 512 + ch];
        else if (isS) v = buf[(3 + tt) * 512];
      }
      x[j] = v;
    }
#pragma unroll
    for (int k = 0; k < 16; ++k) {
      const int t = tq * 16 + k;
      const float xv = (t < Lc) ? cb + w0 * x[k] + w1 * x[k + 1] + w2 * x[k + 2] + w3 * x[k + 3] : 0.f;
      xcs[t * LP + i] = f2bf(xv);
    }
#pragma unroll
    for (int k = 0; k < 2; ++k) {
      const int id = tid + k * 256, r = id >> 3, c8 = id & 7;
      *(uint4*)(was + r * LP + c8 * 8) = *(const uint4*)(Wl + W_WA + nb * 4096 + r * 64 + c8 * 8);
      *(uint4*)(wxs + r * LP + c8 * 8) = *(const uint4*)(Wl + W_WX + nb * 4096 + r * 64 + c8 * 8);
    }
    const int T = isS ? STT : PT;
    if (t0 + Lc == T && tid < 192) {
      const int k = tid >> 6;
      const float v = LX[(size_t)(row0 + Lc - 3 + k) * 512 + ch];
      if (isS) p.out[LC_S + (((size_t)l * SBT + b) * 3 + k) * 512 + ch] = v;
      else p.out[LC_P + (((size_t)l * PB + b) * 3 + k) * 512 + ch] = v;
    }
  }
  __syncthreads();
  {
    const float* ba = p.in[18] + (size_t)l * 512 + nb * 64;
    const float* bx = p.in[20] + (size_t)l * 512 + nb * 64;
    const float* lm = p.in[21] + (size_t)l * 512 + nb * 64;
#pragma unroll
    for (int n = 0; n < 4; ++n) {
      f32x4 r = lds_mm<2>(xcs, LP, wid * 16, was, LP, n * 16, f32x4{0.f, 0.f, 0.f, 0.f});
      f32x4 g = lds_mm<2>(xcs, LP, wid * 16, wxs, LP, n * 16, f32x4{0.f, 0.f, 0.f, 0.f});
      const int j = n * 16 + fr;
      const float sp = softplusf_(-lm[j]), bav = ba[j], bxv = bx[j];
#pragma unroll
      for (int q = 0; q < 4; ++q) {
        const int t = wid * 16 + fq * 4 + q;
        const float rr = sigmoidf_(r[q] + bav), ii = sigmoidf_(g[q] + bxv);
        const float la = -8.f * rr * sp;
        const float a = __expf(la);
        const float x2 = 2.f * la;
        const float om = (x2 > -0.01f) ? -x2 * (1.f + x2 * (0.5f + x2 * (1.f / 6.f))) : 1.f - __expf(x2);
        const float u = sqrtf(om) * ii * bf2f(xcs[t * LP + j]);
        as_[t * 64 + j] = a;
        us_[t * 64 + j] = u;
      }
    }
  }
  __syncthreads();
  {
    float av[16], uv[16];
#pragma unroll
    for (int k = 0; k < 16; ++k) { av[k] = as_[(tq * 16 + k) * 64 + i]; uv[k] = us_[(tq * 16 + k) * 64 + i]; }
    float P = 1.f, hh = 0.f;
#pragma unroll
    for (int k = 0; k < 16; ++k) { P *= av[k]; hh = av[k] * hh + uv[k]; }
    segP[tq * 64 + i] = P; segH[tq * 64 + i] = hh;
    __syncthreads();
    float Pin = 1.f, hin = 0.f;
    for (int g = 0; g < tq; ++g) { const float pg = segP[g * 64 + i], hg = segH[g * 64 + i]; hin = pg * hin + hg; Pin *= pg; }
    u16* HL = (u16*)(p.ws + O_HL);
    u16* PPp = (u16*)(p.ws + O_PP);
    P = Pin; hh = hin;
#pragma unroll
    for (int k = 0; k < 16; ++k) {
      const int t = tq * 16 + k;
      P *= av[k]; hh = av[k] * hh + uv[k];
      if (t < Lc) {
        HL[(size_t)(row0 + t) * 512 + ch] = f2bf(hh);
        PPp[(size_t)(row0 + t) * 512 + ch] = f2bf(P);
      }
    }
    if (tq * 16 + 16 == Lc) {
      ((float*)(p.ws + O_CA))[(size_t)ci * 512 + ch] = P;
      ((float*)(p.ws + O_CH))[(size_t)ci * 512 + ch] = hh;
    }
  }
}
constexpr int L2_ITEMS = 8 + 32;
DI void lru2_item(const Params& p, int l, int it) {
  const float* CA = (const float*)(p.ws + O_CA);
  const float* CH = (const float*)(p.ws + O_CH);
  float* HS = (float*)(p.ws + O_HS);
  if (it < 8) {
    const int e = it * 256 + TID(), b = e >> 9, ch = e & 511;
    float hh = 0.f;
    for (int c0 = 0; c0 < 128; c0 += 16) {
      float ca[16], chv[16];
#pragma unroll
      for (int c = 0; c < 16; ++c) { const size_t o = (size_t)(b * 128 + c0 + c) * 512 + ch; ca[c] = CA[o]; chv[c] = CH[o]; }
#pragma unroll
      for (int c = 0; c < 16; ++c) { const size_t o = (size_t)(b * 128 + c0 + c) * 512 + ch; HS[o] = hh; hh = ca[c] * hh + chv[c]; }
    }
    p.out[LH_P + ((size_t)l * PB + b) * 512 + ch] = hh;
  } else {
    const int e = (it - 8) * 256 + TID(), b = e >> 9, ch = e & 511;
    const float h0 = p.in[6][((size_t)l * SBT + b) * 512 + ch];
    const size_t o = (size_t)(MP / 64 + b) * 512 + ch;
    HS[o] = h0;
    p.out[LH_S + ((size_t)l * SBT + b) * 512 + ch] = CA[o] * h0 + CH[o];
  }
}
constexpr int L3_ITEMS = MT / 8;
DI void lru3_item(const Params& p, int it) {
  const u16* HL = (const u16*)(p.ws + O_HL);
  const u16* PPp = (const u16*)(p.ws + O_PP);
  const u16* LG = (const u16*)(p.ws + O_LG);
  const float* HS = (const float*)(p.ws + O_HS);
  u16* OL = (u16*)(p.ws + O_OL);
#pragma unroll
  for (int i = 0; i < 4; ++i) {
    const int id = TID() + i * 256;
    const int row = it * 8 + (id >> 7), c4 = (id & 127) * 4;
    const int ci = row < MP ? (row >> 6) : MP / 64 + ((row - MP) >> 5);
    const size_t o = (size_t)row * 512 + c4;
    const uint2 hl = *(const uint2*)(HL + o), pp = *(const uint2*)(PPp + o), lg = *(const uint2*)(LG + o);
    const float4 hs = *(const float4*)(HS + (size_t)ci * 512 + c4);
    float y0 = (bf2f(hl.x & 0xffff) + bf2f(pp.x & 0xffff) * hs.x) * gelu_tanh(bf2f(lg.x & 0xffff));
    float y1 = (bf2f(hl.x >> 16) + bf2f(pp.x >> 16) * hs.y) * gelu_tanh(bf2f(lg.x >> 16));
    float y2 = (bf2f(hl.y & 0xffff) + bf2f(pp.y & 0xffff) * hs.z) * gelu_tanh(bf2f(lg.y & 0xffff));
    float y3 = (bf2f(hl.y >> 16) + bf2f(pp.y >> 16) * hs.w) * gelu_tanh(bf2f(lg.y >> 16));
    *(uint2*)(OL + o) = uint2{pack2(y0, y1), pack2(y2, y3)};
  }
}

DI void ybr_tile(const Params& p, int l, int mt, int nt, char* smem) {
  const int row0 = mt * 256, col0 = nt * 256, br = nt >> 2;
  const u16* W = (const u16*)(p.ws + O_WT) + (size_t)l * W_LAYER + W_BR + (size_t)br * 1024 * 512 + (size_t)((nt & 3) * 256) * 512;
  const u16* O = (const u16*)(p.ws + (br == 0 ? O_OA : (br == 1 ? O_OG : O_OL))) + (size_t)row0 * 512;
  f32x4 acc[8][4];
  zero_acc8(acc);
  gemm512(O, 512, W, 512, 512, acc, smem);
  tile_out_bf16<false>(acc, (u16*)(p.ws + O_YP) + (size_t)row0 * 3072 + col0, 3072, smem, 1.f, 0, nullptr);
}
DI void gate_tile(const Params& p, int l, int mt, int nt, char* smem) {
  const int row0 = mt * 256, col0 = nt * 256;
  const u16* W = (const u16*)(p.ws + O_WT) + (size_t)l * W_LAYER + W_MG + (size_t)col0 * LDK;
  f32x4 acc[8][4];
  zero_acc8(acc);
  gemm512((const u16*)(p.ws + O_XN) + (size_t)row0 * LDK, LDK, W, LDK, 1024, acc, smem);
  EPI_IDS;
  u16* Y = (u16*)(p.ws + O_YP) + (size_t)row0 * 3072 + col0;
  const float* bm = p.in[26] + (size_t)l * 3072 + col0 + wc * 64 + fr;
  img_load_bf16(Y, 3072, smem, 256, 0);
  img_barrier();
  u16* img = (u16*)smem + (wr * 128 + fq * 4) * IMG_LD + wc * 64 + fr;
#pragma unroll
  for (int n = 0; n < 4; ++n) {
    const float bv = bm[n * 16];
#pragma unroll
    for (int m = 0; m < 8; ++m)
#pragma unroll
      for (int j = 0; j < 4; ++j) {
        u16* q = img + (m * 16 + j) * IMG_LD + n * 16;
        *q = f2bf(sigmoidf_(acc[m][n][j] + bv) * bf2f(*q));
      }
  }
  img_barrier();
  img_store_bf16(Y, 3072, smem, 0);
}
DI void resid_tile(const Params& p, const u16* A, int ldk, const u16* W, int mt, int nt, int k0, int klen, bool atomic, const float* xsrc, char* smem) {
  const int row0 = mt * 256, col0 = nt * 256;
  f32x4 acc[8][4];
  zero_acc8(acc);
  gemm512(A + (size_t)row0 * ldk + k0, ldk, W + (size_t)col0 * ldk + k0, ldk, klen, acc, smem);
  if (!atomic) { tile_out_f32<true, false>(acc, p.out + (size_t)row0 * 1024 + col0, 1024, smem, 0, nullptr, xsrc + (size_t)row0 * 1024 + col0); return; }
  EPI_IDS;
#pragma unroll
  for (int m = 0; m < 8; ++m) {
    asm volatile("" ::: "memory");
#pragma unroll
    for (int n = 0; n < 4; ++n)
#pragma unroll
      for (int j = 0; j < 4; ++j) {
        const int row = row0 + wr * 128 + m * 16 + fq * 4 + j, col = col0 + wc * 64 + n * 16 + fr;
        float* q = p.out + (size_t)row * 1024 + col;
        if (atomic) unsafeAtomicAdd(q, acc[m][n][j]); else *q += acc[m][n][j];
      }
  }
}
DI void resid_phase(const Params& p, const u16* A, int ldk, const u16* W, int B, int G, const float* xsrc, char* smem) {
  const int ns = ldk / 256;
  int k = 0, u = B;
  while (true) {
    int mt, nt, k0 = 0, kl = ldk;
    bool at = false;
    if (xcd_tile(B, G, k, 128, 4, mt, nt)) { ++k; }
    else if (u < 8 * ns) { const int t = u / ns, sl = u - t * ns; mt = 128 + (t >> 2); nt = t & 3; k0 = sl * 256; kl = 256; at = true; u += G; }
    else break;
    asm volatile("" : "+s"(kl));
    resid_tile(p, A, ldk, W, mt, nt, k0, kl, at, xsrc, smem);
  }
}

DI void ffgate_tile(const Params& p, int l, int mt, int nt, char* smem) {
  const int row0 = mt * 256, col0 = nt * 256;
  const u16* W = (const u16*)(p.ws + O_WT) + (size_t)l * W_LAYER + W_FG;
  f32x4 acc[8][4];
  zero_acc8(acc);
  gemm512((const u16*)(p.ws + O_XN) + (size_t)row0 * LDK, LDK, W + (size_t)col0 * LDK, LDK, 1024, acc, smem);
  if (mt < 128) {
    EPI_IDS;
    tile_out_bf16<false>(acc, (u16*)(p.ws + O_GU) + (size_t)row0 * DFF + col0, DFF, smem, 1.f, 0, nullptr);
    if (((row0 + 256) & 8191) == 0 && wr == 1 && fq == 3) {
      const int b = row0 >> 13;
#pragma unroll
      for (int n = 0; n < 4; ++n) {
        const int col = col0 + wc * 64 + n * 16 + fr;
        p.out[FC_P + (((size_t)l * PB + b) * 2 + 0) * DFF + col] = acc[7][n][2];
        p.out[FC_P + (((size_t)l * PB + b) * 2 + 1) * DFF + col] = acc[7][n][3];
      }
    }
    return;
  }
  EPI_IDS;
  u16* GU = (u16*)(p.ws + O_GU);
  const bool isS = row0 >= MP;
#pragma unroll
  for (int m = 0; m < 8; ++m) {
    asm volatile("" ::: "memory");
#pragma unroll
    for (int n = 0; n < 4; ++n)
#pragma unroll
      for (int j = 0; j < 4; ++j) {
        const int row = row0 + wr * 128 + m * 16 + fq * 4 + j, col = col0 + wc * 64 + n * 16 + fr;
        const float v = acc[m][n][j];
        GU[(size_t)row * DFF + col] = f2bf(v);
        if (isS) {
          const int rs = row - MP, b = rs >> 5, t = rs & 31;
          if (t >= STT - 2) p.out[FC_S + (((size_t)l * SBT + b) * 2 + (t - (STT - 2))) * DFF + col] = v;
        } else {
          const int b = row >> 13, t = row & 8191;
          if (t >= PT - 2) p.out[FC_P + (((size_t)l * PB + b) * 2 + (t - (PT - 2))) * DFF + col] = v;
        }
      }
  }
}
DI void ffup_tile(const Params& p, int l, int mt, int nt, char* smem) {
  const int row0 = mt * 256, col0 = nt * 256;
  const u16* W = (const u16*)(p.ws + O_WT) + (size_t)l * W_LAYER + W_FU;
  f32x4 acc[8][4];
  zero_acc8(acc);
  gemm512((const u16*)(p.ws + O_XN) + (size_t)row0 * LDK, LDK, W + (size_t)col0 * LDK, LDK, 1024, acc, smem);
  if (mt < 128) {
    EPI_IDS;
    const u16* GUt = (const u16*)(p.ws + O_GU) + (size_t)row0 * DFF + col0;
    if (row0 >= 2) img_load_bf16(GUt - 2 * DFF, DFF, smem, 258, 0); else img_load_bf16(GUt, DFF, smem, 256, 2);
    img_barrier();
    const u16* img = (const u16*)smem + (wr * 128 + fq * 4) * IMG_LD + wc * 64 + fr;
#pragma unroll
    for (int n = 0; n < 4; ++n) {
      const int col = col0 + wc * 64 + n * 16 + fr;
      const float* cw = p.in[30] + (size_t)l * 3 * DFF + col;
      const float w0 = cw[0], w1 = cw[DFF], w2 = cw[2 * DFF], cb = p.in[31][(size_t)l * DFF + col];
#pragma unroll
      for (int m = 0; m < 8; ++m) {
        if ((m & 1) == 0) asm volatile("" ::: "memory");
        const int t = (row0 + wr * 128 + m * 16 + fq * 4) & 8191;
        float g[6];
#pragma unroll
        for (int d = 0; d < 6; ++d) { const float gv = bf2f(img[(m * 16 + d) * IMG_LD + n * 16]); g[d] = (d >= 2 || t - 2 + d >= 0) ? gv : 0.f; }
#pragma unroll
        for (int j = 0; j < 4; ++j) acc[m][n][j] *= gelu_tanh(cb + w0 * g[j] + w1 * g[j + 1] + w2 * g[j + 2]);
      }
    }
    img_barrier();
    img_put_bf16<false>(acc, smem, 2, 1.f, 0, nullptr);
    img_barrier();
    img_store_bf16((u16*)(p.ws + O_FF) + (size_t)row0 * DFF + col0, DFF, smem, 2);
    return;
  }
  EPI_IDS;
  const u16* GU = (const u16*)(p.ws + O_GU);
  u16* FF = (u16*)(p.ws + O_FF);
  const bool isS = row0 >= MP;
  const int rowq = row0 + wr * 128 + fq * 4;
  const unsigned gbase = (unsigned)rowq * (unsigned)DFF + (unsigned)(col0 + wc * 64 + fr);
#pragma unroll
  for (int n = 0; n < 4; ++n) {
    const int col = col0 + wc * 64 + n * 16 + fr;
    const float* cw = p.in[30] + (size_t)l * 3 * DFF + col;
    const float w0 = cw[0], w1 = cw[DFF], w2 = cw[2 * DFF], cb = p.in[31][(size_t)l * DFF + col];
#pragma unroll
    for (int mh = 0; mh < 2; ++mh) {
      asm volatile("" ::: "memory");
      float g[4][6];
#pragma unroll
      for (int m = 0; m < 4; ++m) {
        const int rowb = rowq + (mh * 4 + m) * 16;
        int b, t;
        if (isS) { int rs = rowb - MP; b = rs >> 5; t = rs & 31; } else { b = rowb >> 13; t = rowb & 8191; }
#pragma unroll
        for (int d = 0; d < 6; ++d) {
          const int tt = t - 2 + d;
          if (tt >= 0) g[m][d] = bf2f(GU[gbase + (unsigned)((((mh * 4 + m) * 16 + d) * DFF) + n * 16) - 2u * (unsigned)DFF]);
          else g[m][d] = isS ? p.in[7][(((size_t)l * SBT + b) * 2 + (2 + tt)) * DFF + col] : 0.f;
        }
      }
#pragma unroll
      for (int m = 0; m < 4; ++m)
#pragma unroll
        for (int j = 0; j < 4; ++j) {
          const float gc = cb + w0 * g[m][j] + w1 * g[m][j + 1] + w2 * g[m][j + 2];
          FF[gbase + (unsigned)((((mh * 4 + m) * 16 + j) * DFF) + n * 16)] = f2bf(gelu_tanh(gc) * acc[mh * 4 + m][n][j]);
        }
    }
  }
}

DI void norm_phase(const Params& p, int l, int mode, int B, int G, char* smem) {
  const int tid = TID512(), lane = tid & 63, wid = tid >> 6;
  const float* gamma = mode == 0 ? p.in[8] + (size_t)l * 1024 : (mode == 1 ? p.in[28] + (size_t)l * 1024 : p.in[34]);
  float* wga = (float*)smem;
  if (mode == 0) {
    __syncthreads();
    const float* src = p.in[9] + (size_t)l * 1024 * PW + 3072;
#pragma unroll
    for (int i = 0; i < 8; ++i) {
      const int id = tid + i * 512, k = id >> 2, part = id & 3;
      ((float4*)wga)[(((k >> 8) * 4 + (k & 3)) * 4 + part) * 64 + ((k >> 2) & 63)] = *(const float4*)(src + (size_t)k * PW + part * 4);
    }
    __syncthreads();
  }
  float4 g[4];
#pragma unroll
  for (int i = 0; i < 4; ++i) g[i] = *(const float4*)(gamma + i * 256 + lane * 4);
  for (int row = B * 8 + wid; row < MT; row += G * 8) {
    float* X = p.out + (size_t)row * 1024;
    const float* Xr = (mode == 0 && l == 0 && row < MP) ? p.in[0] + (size_t)row * 1024 : X;
    float4 v[4];
    float ss = 0.f;
#pragma unroll
    for (int i = 0; i < 4; ++i) { v[i] = *(const float4*)(Xr + i * 256 + lane * 4); ss += v[i].x * v[i].x + v[i].y * v[i].y + v[i].z * v[i].z + v[i].w * v[i].w; }
    ss = wave_sum(ss);
    const float rs = rsqrtf(ss * (1.f / 1024.f) + EPS);
    u16* XN = (u16*)(p.ws + O_XN) + (size_t)row * LDK;
#pragma unroll
    for (int i = 0; i < 4; ++i) {
      v[i] = float4{v[i].x * rs * g[i].x, v[i].y * rs * g[i].y, v[i].z * rs * g[i].z, v[i].w * rs * g[i].w};
      if (mode == 2) *(float4*)(X + i * 256 + lane * 4) = v[i];
      else *(uint2*)(XN + i * 256 + lane * 4) = uint2{pack2(v[i].x, v[i].y), pack2(v[i].z, v[i].w)};
    }
    if (mode == 0) {
      float ga[16];
#pragma unroll
      for (int r = 0; r < 16; ++r) ga[r] = 0.f;
#pragma unroll
      for (int i = 0; i < 4; ++i) {
        const float xv[4] = {v[i].x, v[i].y, v[i].z, v[i].w};
#pragma unroll
        for (int e = 0; e < 4; ++e) {
          asm volatile("" ::: "memory");
#pragma unroll
          for (int q = 0; q < 4; ++q) {
            const float4 w = ((const float4*)wga)[((i * 4 + e) * 4 + q) * 64 + lane];
            ga[q * 4 + 0] += xv[e] * w.x; ga[q * 4 + 1] += xv[e] * w.y; ga[q * 4 + 2] += xv[e] * w.z; ga[q * 4 + 3] += xv[e] * w.w;
          }
        }
      }
      float mine = 0.f;
#pragma unroll
      for (int r = 0; r < 16; ++r) { const float s = wave_sum(ga[r]); if (lane == r) mine = s; }
      if (lane < 16) ((float*)(p.ws + O_GA))[(size_t)row * 16 + lane] = mine;
    }
  }
}

#define XB_TMO      128
#define XB_XCNT(j)  (256  + 64 * (j))
#define XB_XSUB(j)  (1280 + 64 * (j))
#define XB_XGEN(j)  (2304 + 64 * (j))
#define XB_TOP      3328
#define XB_TOPGEN   3392
#define XCD_BAR_WORDS 3456
#define XB_SPIN_CAP (1u << 18)
#define LAS __attribute__((address_space(3)))

__device__ __forceinline__ unsigned xb_ld(unsigned* p)              { return __hip_atomic_load(p, __ATOMIC_RELAXED, __HIP_MEMORY_SCOPE_AGENT); }
__device__ __forceinline__ unsigned xb_add(unsigned* p, unsigned v) { return __hip_atomic_fetch_add(p, v, __ATOMIC_RELAXED, __HIP_MEMORY_SCOPE_AGENT); }
__device__ __forceinline__ unsigned xb_xcc_id() { return (unsigned)__builtin_amdgcn_s_getreg((3 << 11) | 20) & 0xFu; }
#define XB_SPIN(cond, bar) do { unsigned _sp = 0; while (cond) { __builtin_amdgcn_s_sleep(1); \
    if ((++_sp & 255u) == 0u) { if (xb_ld(&(bar)[XB_TMO])) break; if (_sp > XB_SPIN_CAP) { atomicAdd(&(bar)[XB_TMO], 1u); break; } } } } while (0)

struct XcdBarrier {
    unsigned* bar; unsigned x;
    volatile LAS unsigned* st;
};

__device__ __forceinline__ XcdBarrier xcd_barrier_post(unsigned* bar, volatile LAS unsigned* st) {
    XcdBarrier b; b.bar = bar; b.x = xb_xcc_id(); b.st = st;
    if (threadIdx.x == 0) (void)xb_add(&bar[XB_XCNT(b.x)], 1u);
    return b;
}
__device__ __forceinline__ void xcd_barrier_complete(unsigned* bar, unsigned x, unsigned& nloc, unsigned& nx) {
    const unsigned G = gridDim.x * gridDim.y * gridDim.z;
    unsigned sum, cnt, mine, sp = 0u;
    for (;;) {
        sum = 0u; cnt = 0u; mine = 0u;
#pragma unroll
        for (unsigned j = 0; j < 16; ++j) { const unsigned c = xb_ld(&bar[XB_XCNT(j)]); sum += c; cnt += (c > 0u) ? 1u : 0u; mine = (j == x) ? c : mine; }
        if (sum == G) break;
        __builtin_amdgcn_s_sleep(1);
        if ((++sp & 255u) == 0u) { if (xb_ld(&bar[XB_TMO])) break; if (sp > XB_SPIN_CAP) { atomicAdd(&bar[XB_TMO], 1u); break; } }
    }
    nloc = mine > 0u ? mine : 1u; nx = cnt > 0u ? cnt : 1u;
}

__device__ __forceinline__ void xcd_barrier(const XcdBarrier& b) {
    asm volatile("s_waitcnt vmcnt(0)" ::: "memory");
    __syncthreads();
    if (threadIdx.x == 0) {
        unsigned* bar = b.bar;
        __builtin_amdgcn_s_waitcnt(0);
        unsigned nloc = b.st[0], nx = b.st[1];
        if (nloc == 0u) { xcd_barrier_complete(bar, b.x, nloc, nx); b.st[0] = nloc; b.st[1] = nx; }
        const unsigned old = xb_add(&bar[XB_XSUB(b.x)], 1u);
        const unsigned gen = old / nloc;
        if (old + 1u == (gen + 1u) * nloc) {
            __builtin_amdgcn_fence(__ATOMIC_RELEASE, "agent");
            asm volatile("s_waitcnt vmcnt(0)" ::: "memory");
            const unsigned og = xb_add(&bar[XB_TOP], 1u);
            const unsigned tg = og / nx;
            if (og + 1u == (tg + 1u) * nx) xb_add(&bar[XB_TOPGEN], 1u);
            else XB_SPIN(xb_ld(&bar[XB_TOPGEN]) == tg, bar);
            __builtin_amdgcn_fence(__ATOMIC_ACQUIRE, "agent");
            xb_add(&bar[XB_XGEN(b.x)], 1u);
            asm volatile("s_waitcnt vmcnt(0)" ::: "memory");
        } else {
            XB_SPIN(xb_ld(&bar[XB_XGEN(b.x)]) == gen, bar);
            __builtin_amdgcn_fence(__ATOMIC_ACQUIRE, "agent");
            asm volatile("s_waitcnt vmcnt(0)" ::: "memory");
        }
    }
    __syncthreads();
}


#ifndef ONLY
#define ONLY -1
#endif
constexpr int HALF_LDS = 73728;
constexpr int SMEM_BYTES = 2 * HALF_LDS;
#define VB() (2 * B + (TID512() >> 8))
#define HS() (smem + (TID512() >> 8) * HALF_LDS)
__global__ void __launch_bounds__(512, 2) mega(Params p) {
  cg::grid_group grid = cg::this_grid();
  extern __shared__ __attribute__((aligned(16))) char smem[];
  const int G = gridDim.x, B = blockIdx.x;
  __shared__ __attribute__((aligned(16))) unsigned xb_words[4];
  if (threadIdx.x < 4) xb_words[threadIdx.x] = 0u;
  __syncthreads();
  const XcdBarrier xb = xcd_barrier_post((unsigned*)(p.ws + O_BAR), (volatile LAS unsigned*)xb_words);
  const int vG = 2 * G;
  if (ONLY < 0 || ONLY == 0) for (int it = VB(); it < PREP_ITEMS; it += vG) prep_item(p, it, HS());
  grid.sync();
  for (int l = 0; l < NL; ++l) {
    const u16* W = (const u16*)(p.ws + O_WT) + (size_t)l * W_LAYER;
    if (ONLY < 0 || ONLY == 1) norm_phase(p, l, 0, B, G, smem);
    xcd_barrier(xb);
    if (ONLY < 0 || ONLY == 2) { int mt, nt; for (int k = 0; xcd_tile(B, G, k, 130, 16, mt, nt); ++k) projin_tile(p, l, mt, nt, smem); for (int it = VB(); it < PB_KC + PB_VC; it += vG) cache_conv_item(p, l, it, HS()); }
    xcd_barrier(xb);
    if (ONLY < 0 || ONLY == 3) {
      for (int k = 0; k < (G == 256 ? 5 : (1088 + G - 1) / G); ++k) {
        bool isS = false; int bh = 0, cp = 0; bool have = true;
        if (G == 256) {
          const int q = B >> 4; bh = B & 15;
          if (k == 0) cp = 63 - q; else if (k == 1) cp = 32 + q; else if (k == 2) cp = 31 - q;
          else if (k == 3) { if (q <= 11) cp = q + 4; else { isS = true; bh = (q - 12) * 16 + (B & 15); } }
          else { if (q >= 12) cp = q - 12; else have = false; }
        } else {
          const int it = B + k * G;
          if (it >= 1088) have = false; else if (it < 1024) { cp = it >> 4; bh = it & 15; } else { isS = true; bh = it - 1024; }
        }
        if (have) attn_item(p, l, isS, isS ? (bh >> 2) : (bh >> 2), bh & 3, cp, smem);
      }
    }
    if (ONLY < 0 || ONLY == 13) for (int it = VB(); it < NGI; it += vG) gla1_item(p, l, it, HS());
    if (ONLY < 0 || ONLY == 14) for (int it = VB(); it < L1_ITEMS; it += vG) lru1_item(p, l, it, HS());
    xcd_barrier(xb);
    if (ONLY < 0 || ONLY == 4) for (int it = VB(); it < G2_ITEMS + L2_ITEMS; it += vG) { if (it < G2_ITEMS) gla2_item(p, l, it); else lru2_item(p, l, it - G2_ITEMS); }
    xcd_barrier(xb);
    if (ONLY < 0 || ONLY == 5) { for (int it = VB(); it < NGI; it += vG) gla3_item(p, l, it, HS()); for (int it = VB(); it < L3_ITEMS; it += vG) lru3_item(p, it); }
    xcd_barrier(xb);
    if (ONLY < 0 || ONLY == 6) { int mt, nt; for (int k = 0; xcd_tile(B, G, k, 130, 12, mt, nt); ++k) ybr_tile(p, l, mt, nt, smem); }
    xcd_barrier(xb);
    if (ONLY < 0 || ONLY == 7) { int mt, nt; for (int k = 0; xcd_tile(B, G, k, 130, 12, mt, nt); ++k) gate_tile(p, l, mt, nt, smem); }
    xcd_barrier(xb);
    if (ONLY < 0 || ONLY == 8) resid_phase(p, (const u16*)(p.ws + O_YP), 3072, W + W_OUT, B, G, l == 0 ? p.in[0] : p.out, smem);
    xcd_barrier(xb);
    if (ONLY < 0 || ONLY == 9) norm_phase(p, l, 1, B, G, smem);
    xcd_barrier(xb);
    if (ONLY < 0 || ONLY == 10) { int mt, nt; for (int k = 0; xcd_tile(B, G, k, 130, 11, mt, nt); ++k) ffgate_tile(p, l, mt, nt, smem); }
    xcd_barrier(xb);
    if (ONLY < 0 || ONLY == 11) { int mt, nt; for (int k = 0; xcd_tile(B, G, k, 130, 11, mt, nt); ++k) ffup_tile(p, l, mt, nt, smem); }
    xcd_barrier(xb);
    if (ONLY < 0 || ONLY == 12) resid_phase(p, (const u16*)(p.ws + O_FF), DFF, W + W_FD, B, G, p.out, smem);
    xcd_barrier(xb);
  }
  if (ONLY < 0 || ONLY == 15) norm_phase(p, 0, 2, B, G, smem);
}

extern "C" void kernel_launch(void* const* d_in, const int* in_sizes, int n_in, void* d_out, int out_size, void* d_ws, size_t ws_size,
                              hipStream_t stream) {
  static int grid_blocks = 0;
  if (!grid_blocks) {
    int dev = 0, cus = 0, per = 0;
    (void)hipGetDevice(&dev);
    (void)hipDeviceGetAttribute(&cus, hipDeviceAttributeMultiprocessorCount, dev);
    (void)hipFuncSetAttribute((const void*)mega, hipFuncAttributeMaxDynamicSharedMemorySize, SMEM_BYTES);
    (void)hipOccupancyMaxActiveBlocksPerMultiprocessor(&per, mega, 512, SMEM_BYTES);
    if (per < 1) per = 1;
    grid_blocks = cus;
  }
  if (ws_size < WS_NEED) fprintf(stderr, "workspace too small: %zu < %zu\n", ws_size, (size_t)WS_NEED);
  Params p{};
  for (int i = 0; i < 35; ++i) p.in[i] = (const float*)d_in[i];
  p.out = (float*)d_out;
  p.ws = (char*)d_ws;
  (void)hipMemsetAsync((char*)d_ws + O_BAR, 0, XCD_BAR_WORDS * sizeof(unsigned), stream);
  void* args[] = {&p};
  hipError_t e = hipLaunchCooperativeKernel((void*)mega, dim3(grid_blocks), dim3(512), args, SMEM_BYTES, stream);
  if (e != hipSuccess) fprintf(stderr, "cooperative launch failed: %s (grid %d)\n", hipGetErrorString(e), grid_blocks);
}
```

```cpp
#include <hip/hip_runtime.h>
#include <hip/hip_cooperative_groups.h>
#include <cstdio>
namespace cg = cooperative_groups;

#define DI __device__ __forceinline__
typedef unsigned short u16;
using bf16x8 = __attribute__((ext_vector_type(8))) short;
using f32x4 = __attribute__((ext_vector_type(4))) float;
using u32x4 = __attribute__((ext_vector_type(4))) unsigned;
#define MFMA16(a, b, c) __builtin_amdgcn_mfma_f32_16x16x32_bf16((a), (b), (c), 0, 0, 0)

constexpr int DM = 1024, PB = 4, PT = 8192, SBT = 16, STT = 32, PAST = 2048, NL = 4;
constexpr int MP = PB * PT, MS = SBT * STT, MT = MP + MS;
constexpr int SKP = 2112;
constexpr int SKV = PAST + STT;
constexpr int DFF = 2816, PW = 4112, PWP = 4224;
constexpr int NGI = PB * 4 * 128 + SBT * 4;
constexpr int NLC = MP / 64 + SBT;
constexpr float EPS = 1e-6f;
constexpr float QSCALE = 0.125f * 1.4426950408889634f;
constexpr int LDK = 1088;

constexpr size_t W_IN = 0, W_MG = W_IN + (size_t)4096 * LDK, W_BR = W_MG + (size_t)3072 * LDK, W_OUT = W_BR + (size_t)3 * 1024 * 512,
                 W_FG = W_OUT + (size_t)1024 * 3072, W_FU = W_FG + (size_t)DFF * LDK, W_FD = W_FU + (size_t)DFF * LDK,
                 W_WA = W_FD + (size_t)1024 * DFF, W_WX = W_WA + 32768, W_LAYER = W_WX + 32768;

struct Params {
  const float* in[35];
  float* out;
  char* ws;
};

constexpr size_t al(size_t x) { return (x + 255) & ~(size_t)255; }
constexpr size_t O_WT = 0;
constexpr size_t O_ROPE = al(O_WT + W_LAYER * NL * 2);
constexpr size_t O_LAM = al(O_ROPE + 2 * 8192 * 8 * 4);
constexpr size_t O_BAR = al(O_LAM + 256);
constexpr size_t O_XN = al(O_BAR + 4096 * 4);
constexpr size_t O_REG = al(O_XN + (size_t)MT * LDK * 2);
constexpr size_t O_QB = O_REG;
constexpr size_t O_KB = al(O_QB + (size_t)MT * 512 * 2);
constexpr size_t O_KS = al(O_KB + (size_t)MP * 512 * 2);
constexpr size_t O_VT = al(O_KS + (size_t)SBT * SKP * 512 * 2);
constexpr size_t O_VTS = al(O_VT + (size_t)MP * 512 * 2);
constexpr size_t O_GQ = al(O_VTS + (size_t)SBT * SKP * 512 * 2);
constexpr size_t O_GK = al(O_GQ + (size_t)MT * 256 * 2);
constexpr size_t O_GV = al(O_GK + (size_t)MT * 256 * 2);
constexpr size_t O_GR = al(O_GV + (size_t)MT * 512 * 2);
constexpr size_t O_GA = al(O_GR + (size_t)MT * 512 * 2);
constexpr size_t O_LX = al(O_GA + (size_t)MT * 16 * 4);
constexpr size_t O_LG = al(O_LX + (size_t)MT * 512 * 4);
constexpr size_t O_KVT = al(O_LG + (size_t)MT * 512 * 2);
constexpr size_t O_DEC = al(O_KVT + (size_t)NGI * 8192 * 2);
constexpr size_t O_HL = al(O_DEC + (size_t)NGI * 64 * 4);
constexpr size_t O_PP = al(O_HL + (size_t)MT * 512 * 2);
constexpr size_t O_CA = al(O_PP + (size_t)MT * 512 * 2);
constexpr size_t O_CH = al(O_CA + (size_t)NLC * 512 * 4);
constexpr size_t O_HS = al(O_CH + (size_t)NLC * 512 * 4);
constexpr size_t O_OA = al(O_HS + (size_t)NLC * 512 * 4);
constexpr size_t O_OG = al(O_OA + (size_t)MT * 512 * 2);
constexpr size_t O_OL = al(O_OG + (size_t)MT * 512 * 2);
constexpr size_t O_END1 = al(O_OL + (size_t)MT * 512 * 2);
constexpr size_t O_YP = O_QB;
static_assert(O_YP + (size_t)MT * 3072 * 2 <= O_OA, "Y buffer overlaps live mixer outputs");
constexpr size_t O_GU = O_REG;
constexpr size_t O_FF = al(O_GU + (size_t)MT * DFF * 2);
constexpr size_t O_END2 = al(O_FF + (size_t)MT * DFF * 2);
constexpr size_t WS_NEED = O_END1 > O_END2 ? O_END1 : O_END2;

constexpr size_t Y_P = 0, Y_S = Y_P + (size_t)MP * 1024, K_P = Y_S + (size_t)MS * 1024, V_P = K_P + (size_t)NL * MP * 512,
                 GLA_P = V_P + (size_t)NL * MP * 512, LC_P = GLA_P + (size_t)NL * PB * 32768, LH_P = LC_P + (size_t)NL * PB * 3 * 512,
                 FC_P = LH_P + (size_t)NL * PB * 512, K_S = FC_P + (size_t)NL * PB * 2 * DFF, V_S = K_S + (size_t)NL * MS * 512,
                 GLA_S = V_S + (size_t)NL * MS * 512, LC_S = GLA_S + (size_t)NL * SBT * 32768, LH_S = LC_S + (size_t)NL * SBT * 3 * 512,
                 FC_S = LH_S + (size_t)NL * SBT * 512, OUT_TOTAL = FC_S + (size_t)NL * SBT * 2 * DFF;

DI int TID() { int t = threadIdx.x & 255; asm volatile("" : "+v"(t)); return t; }
DI int TID512() { int t = threadIdx.x; asm volatile("" : "+v"(t)); return t; }
DI u16 f2bf(float x) { __bf16 h = (__bf16)x; return __builtin_bit_cast(u16, h); }
DI float bf2f(u16 h) { return __uint_as_float(((unsigned)h) << 16); }
typedef __bf16 bf16v2_t __attribute__((ext_vector_type(2)));
typedef float f32v2_t __attribute__((ext_vector_type(2)));
DI unsigned pack2(float a, float b) { f32v2_t v = {a, b}; bf16v2_t r = __builtin_convertvector(v, bf16v2_t); return __builtin_bit_cast(unsigned, r); }
DI float sigmoidf_(float x) { return __builtin_amdgcn_rcpf(1.f + __expf(-x)); }
DI float gelu_tanh(float x) { float u = 0.7978845608028654f * (x + 0.044715f * x * x * x); return x * sigmoidf_(2.f * u); }
DI float softplusf_(float x) { return fmaxf(x, 0.f) + __logf(1.f + __expf(-fabsf(x))); }
DI float quad_max(float v) {
  auto a = __builtin_amdgcn_permlane16_swap(__float_as_uint(v), __float_as_uint(v), false, false);
  v = fmaxf(__uint_as_float(a[0]), __uint_as_float(a[1]));
  auto b = __builtin_amdgcn_permlane32_swap(__float_as_uint(v), __float_as_uint(v), false, false);
  return fmaxf(__uint_as_float(b[0]), __uint_as_float(b[1]));
}
DI float wave_sum(float v) {
  for (int o = 32; o > 0; o >>= 1) v += __shfl_xor(v, o);
  return v;
}

DI void gemm512(const u16* __restrict__ A, int lda, const u16* __restrict__ B, int ldb, int K, f32x4 (&acc)[8][4], char* smem) {
  const int tid = TID512(), lane = tid & 63, wid = tid >> 6, wr = wid >> 2, wc = wid & 3, fr = lane & 15, fq = lane >> 4;
  const int lrow = tid >> 3;
  const int gch = (tid & 7) ^ ((lrow >> 1) & 7);
  const unsigned aov = (unsigned)(lrow * lda + gch * 8);
  const unsigned bov = (unsigned)(lrow * ldb + gch * 8);
  const int soff = tid * 16;
  const int sw = (fr >> 1) & 7;
  const int aoff = (wr * 128 + fr) * 128, boff = 32768 + (wc * 64 + fr) * 128;
  const int nk = K >> 6;
  asm volatile("s_waitcnt lgkmcnt(0)" ::: "memory");
  __builtin_amdgcn_s_barrier();
#pragma unroll
  for (int i = 0; i < 4; ++i) {
    __builtin_amdgcn_global_load_lds((const unsigned*)((A + (size_t)i * 64 * lda) + aov), (unsigned*)(smem + soff + i * 8192), 16, 0, 0);
    __builtin_amdgcn_global_load_lds((const unsigned*)((B + (size_t)i * 64 * ldb) + bov), (unsigned*)(smem + 32768 + soff + i * 8192), 16, 0, 0);
  }
  asm volatile("s_waitcnt vmcnt(0)" ::: "memory");
  __builtin_amdgcn_s_barrier();
  for (int kt = 0; kt < nk; ++kt) {
    const int buf = kt & 1;
    const bool more = kt + 1 < nk;
    char* st = smem + (buf ^ 1) * 65536 + soff;
    const u16* An = A + (kt + 1) * 64;
    const u16* Bn = B + (kt + 1) * 64;
    const char* Sb = smem + buf * 65536;
#pragma unroll
    for (int ks = 0; ks < 2; ++ks) {
      const int co = ((ks * 4 + fq) ^ sw) << 4;
      bf16x8 bfr[4], af[8];
#pragma unroll
      for (int n = 0; n < 4; ++n) bfr[n] = *(const bf16x8*)(Sb + boff + n * 2048 + co);
#pragma unroll
      for (int m = 0; m < 8; ++m) af[m] = *(const bf16x8*)(Sb + aoff + m * 2048 + co);
      __builtin_amdgcn_sched_barrier(0);
#pragma unroll
      for (int g = 0; g < 4; ++g) {
#pragma unroll
        for (int mm = 0; mm < 2; ++mm)
#pragma unroll
          for (int n = 0; n < 4; ++n) acc[g * 2 + mm][n] = MFMA16(af[g * 2 + mm], bfr[n], acc[g * 2 + mm][n]);
        __builtin_amdgcn_sched_barrier(0);
        if (more && ks == 0) {
          __builtin_amdgcn_global_load_lds((const unsigned*)((An + (size_t)g * 64 * lda) + aov), (unsigned*)(st + g * 8192), 16, 0, 0);
          __builtin_amdgcn_global_load_lds((const unsigned*)((Bn + (size_t)g * 64 * ldb) + bov), (unsigned*)(st + 32768 + g * 8192), 16, 0, 0);
        }
        __builtin_amdgcn_sched_barrier(0);
      }
    }
    asm volatile("s_waitcnt vmcnt(0) lgkmcnt(0)" ::: "memory");
    __builtin_amdgcn_s_barrier();
  }
}
DI void zero_acc8(f32x4 (&acc)[8][4]) {
#pragma unroll
  for (int m = 0; m < 8; ++m)
#pragma unroll
    for (int n = 0; n < 4; ++n) acc[m][n] = f32x4{0.f, 0.f, 0.f, 0.f};
}
#define EPI_IDS const int tid = TID512(), lane = tid & 63, wid = tid >> 6, wr = wid >> 2, wc = wid & 3, fr = lane & 15, fq = lane >> 4


constexpr int IMG_LD = 264;
constexpr int IMGF_LD = 260;
DI void img_barrier() { asm volatile("s_waitcnt lgkmcnt(0)" ::: "memory"); __builtin_amdgcn_s_barrier(); }
template <bool ROPE>
DI float epi_val(const f32x4 (&acc)[8][4], int m, int n, int j, const float* cs4, const float* sn4, int fr) {
  float v = acc[m][n][j];
  if (ROPE && n == 0) {
    const float pr = __shfl_xor(v, 8);
    v = (fr < 8) ? v * cs4[j] - pr * sn4[j] : v * cs4[j] + pr * sn4[j];
  }
  return v;
}
template <bool ROPE>
DI void img_put_bf16(const f32x4 (&acc)[8][4], char* smem, int rowoff, float scale, int prow0, const float* cosT) {
  EPI_IDS;
  u16* img = (u16*)smem + (wr * 128 + fq * 4 + rowoff) * IMG_LD + wc * 64 + fr;
#pragma unroll
  for (int m = 0; m < 8; ++m) {
    float cs4[4] = {0.f, 0.f, 0.f, 0.f}, sn4[4] = {0.f, 0.f, 0.f, 0.f};
    if (ROPE) {
#pragma unroll
      for (int j = 0; j < 4; ++j) { const int pos = prow0 + wr * 128 + m * 16 + fq * 4 + j; cs4[j] = cosT[pos * 8 + (fr & 7)]; sn4[j] = cosT[8192 * 8 + pos * 8 + (fr & 7)]; }
    }
#pragma unroll
    for (int n = 0; n < 4; ++n)
#pragma unroll
      for (int j = 0; j < 4; ++j) img[(m * 16 + j) * IMG_LD + n * 16] = f2bf(epi_val<ROPE>(acc, m, n, j, cs4, sn4, fr) * scale);
  }
}
DI void img_store_bf16(u16* dst, int ld, const char* smem, int rowoff) {
  const int tid = TID512();
#pragma unroll
  for (int q = 0; q < 16; ++q) {
    const int slot = tid + q * 512, row = slot >> 5, c16 = slot & 31;
    *(u32x4*)(dst + (size_t)row * ld + c16 * 8) = *(const u32x4*)(smem + (row + rowoff) * (IMG_LD * 2) + c16 * 16);
  }
}
DI void img_load_bf16(const u16* src, int ld, char* smem, int nrows, int rowoff) {
  for (int slot = TID512(); slot < nrows * 32; slot += 512) {
    const int row = slot >> 5, c16 = slot & 31;
    *(u32x4*)(smem + (row + rowoff) * (IMG_LD * 2) + c16 * 16) = *(const u32x4*)(src + (size_t)row * ld + c16 * 8);
  }
}
template <bool ROPE>
DI void imgf_put(const f32x4 (&acc)[8][4], int h, char* smem, int prow0, const float* cosT) {
  EPI_IDS;
  if (wr == h) {
    float* f = (float*)smem + (fq * 4) * IMGF_LD + wc * 64 + fr;
#pragma unroll
    for (int m = 0; m < 8; ++m) {
      float cs4[4] = {0.f, 0.f, 0.f, 0.f}, sn4[4] = {0.f, 0.f, 0.f, 0.f};
      if (ROPE) {
#pragma unroll
        for (int j = 0; j < 4; ++j) { const int pos = prow0 + wr * 128 + m * 16 + fq * 4 + j; cs4[j] = cosT[pos * 8 + (fr & 7)]; sn4[j] = cosT[8192 * 8 + pos * 8 + (fr & 7)]; }
      }
#pragma unroll
      for (int n = 0; n < 4; ++n)
#pragma unroll
        for (int j = 0; j < 4; ++j) f[(m * 16 + j) * IMGF_LD + n * 16] = epi_val<ROPE>(acc, m, n, j, cs4, sn4, fr);
    }
  }
}
template <bool ADD>
DI void imgf_store(float* dst, const float* rsrc, int ld, const char* smem) {
  const int tid = TID512();
  const unsigned o0 = (unsigned)((tid >> 6) * ld + (tid & 63) * 4);
  const char* src = smem + (tid >> 6) * (IMGF_LD * 4) + (tid & 63) * 16;
#pragma unroll
  for (int q = 0; q < 16; ++q) {
    if ((q & 3) == 0) asm volatile("" ::: "memory");
    float4 v = *(const float4*)(src + q * 8 * (IMGF_LD * 4));
    float4* d = (float4*)(dst + (o0 + (unsigned)(q * 8 * ld)));
    if (ADD) { const float4 x = *(const float4*)(rsrc + (o0 + (unsigned)(q * 8 * ld))); v.x += x.x; v.y += x.y; v.z += x.z; v.w += x.w; }
    if (ADD) *d = v;
    else __builtin_nontemporal_store(f32x4{v.x, v.y, v.z, v.w}, (f32x4*)d);
  }
}
template <bool ADD, bool ROPE>
DI void tile_out_f32(const f32x4 (&acc)[8][4], float* dst, int ld, char* smem, int prow0, const float* cosT, const float* rsrc = nullptr) {
#pragma unroll 1
  for (int h = 0; h < 2; ++h) {
    img_barrier();
    imgf_put<ROPE>(acc, h, smem, prow0, cosT);
    img_barrier();
    imgf_store<ADD>(dst + (size_t)h * 128 * ld, ADD ? rsrc + (size_t)h * 128 * ld : nullptr, ld, smem);
  }
}
template <bool ROPE>
DI void tile_out_bf16(const f32x4 (&acc)[8][4], u16* dst, int ld, char* smem, float scale, int prow0, const float* cosT) {
  img_barrier();
  img_put_bf16<ROPE>(acc, smem, 0, scale, prow0, cosT);
  img_barrier();
  img_store_bf16(dst, ld, smem, 0);
}

template <int KS>
DI f32x4 lds_mm(const u16* As, int lsa, int arow, const u16* Bs, int lsb, int brow, f32x4 acc) {
  const int lane = TID() & 63, fr = lane & 15, fq = lane >> 4;
#pragma unroll
  for (int ks = 0; ks < KS; ++ks) {
    bf16x8 a = *(const bf16x8*)(As + (arow + fr) * lsa + ks * 32 + fq * 8);
    bf16x8 b = *(const bf16x8*)(Bs + (brow + fr) * lsb + ks * 32 + fq * 8);
    acc = MFMA16(a, b, acc);
  }
  return acc;
}

constexpr int PREP_T_PER_LAYER = 64 * 16 + 48 * 16 + 3 * 128 + 3 * 256 + 3 * 704 + 16;
constexpr int PREP_T = PREP_T_PER_LAYER * NL;
constexpr int PREP_COPY = MS * 1024 / 4096;
constexpr int PREP_ROPE = 8192 * 8 / 256;
constexpr int PREP_ITEMS = PREP_T + PREP_COPY + PREP_ROPE + 2;

DI void transpose_tile(const float* src, int lds_, int k0, int c0, int ncols_valid, u16* dst, int ldd, int n0, float* tile) {
  const int tid = TID();
  __syncthreads();
#pragma unroll
  for (int i = 0; i < 16; ++i) {
    int e = tid + i * 256, r = e >> 6, c = e & 63;
    tile[r * 65 + c] = (c < ncols_valid) ? __builtin_nontemporal_load(&src[(size_t)(k0 + r) * lds_ + c0 + c]) : 0.f;
  }
  __syncthreads();
#pragma unroll
  for (int i = 0; i < 16; ++i) {
    int e = tid + i * 256, c = e >> 6, r = e & 63;
    dst[(size_t)(n0 + c) * ldd + k0 + r] = f2bf(tile[r * 65 + c]);
  }
}

DI void prep_item(const Params& p, int it, char* smem) {
  const int tid = TID();
  if (it < PREP_T) {
    const int l = it / PREP_T_PER_LAYER;
    int t = it % PREP_T_PER_LAYER;
    u16* W = (u16*)(p.ws + O_WT) + (size_t)l * W_LAYER;
    float* tile = (float*)smem;
    if (t < 64 * 16) {
      int nt = t / 16, kt = t % 16, n0 = nt * 64;
      const int c0 = n0 < 3072 ? n0 : n0 + 16;
      transpose_tile(p.in[9] + (size_t)l * 1024 * PW, PW, kt * 64, c0, 64, W + W_IN, LDK, n0, tile);
      return;
    }
    t -= 64 * 16;
    if (t < 48 * 16) { transpose_tile(p.in[25] + (size_t)l * 1024 * 3072, 3072, (t % 16) * 64, (t / 16) * 64, 64, W + W_MG, LDK, (t / 16) * 64, tile); return; }
    t -= 48 * 16;
    if (t < 3 * 128) {
      int br = t / 128, tt = t % 128;
      transpose_tile(p.in[22 + br] + (size_t)l * 512 * 1024, 1024, (tt % 8) * 64, (tt / 8) * 64, 64, W + W_BR + (size_t)br * 1024 * 512, 512, (tt / 8) * 64, tile);
      return;
    }
    t -= 3 * 128;
    if (t < 768) { const int cp = t / 256, tt = t % 256; transpose_tile(p.in[27] + (size_t)l * 1024 * 1024, 1024, (tt % 16) * 64, (tt / 16) * 64, 64, W + W_OUT + cp * 1024, 3072, (tt / 16) * 64, tile); return; }
    t -= 768;
    if (t < 704) { transpose_tile(p.in[29] + (size_t)l * 1024 * DFF, DFF, (t % 16) * 64, (t / 16) * 64, 64, W + W_FG, LDK, (t / 16) * 64, tile); return; }
    t -= 704;
    if (t < 704) { transpose_tile(p.in[32] + (size_t)l * 1024 * DFF, DFF, (t % 16) * 64, (t / 16) * 64, 64, W + W_FU, LDK, (t / 16) * 64, tile); return; }
    t -= 704;
    if (t < 704) { transpose_tile(p.in[33] + (size_t)l * DFF * 1024, 1024, (t % 44) * 64, (t / 44) * 64, 64, W + W_FD, DFF, (t / 44) * 64, tile); return; }
    t -= 704;
    if (t < 8) { transpose_tile(p.in[17] + (size_t)l * 32768 + t * 4096, 64, 0, 0, 64, W + W_WA + t * 4096, 64, 0, tile); return; }
    t -= 8;
    transpose_tile(p.in[19] + (size_t)l * 32768 + t * 4096, 64, 0, 0, 64, W + W_WX + t * 4096, 64, 0, tile);
    return;
  }
  it -= PREP_T;
  if (it < PREP_COPY) {
    const size_t base = (size_t)it * 4096;
#pragma unroll
    for (int i = 0; i < 4; ++i) {
      const size_t e = base + (size_t)(tid + i * 256) * 4;
      *(float4*)(p.out + (size_t)MP * 1024 + e) = *(const float4*)(p.in[1] + e);
    }
    return;
  }
  it -= PREP_COPY;
  if (it < PREP_ROPE) {
    int e = it * 256 + tid, pos = e >> 3, i = e & 7;
    double inv = pow(500000.0, -(double)i / 8.0);
    double ang = (double)pos * inv;
    double kq = rint(ang * 0.15915494309189535);
    double r = ang - kq * 6.283185307179586;
    float rf = (float)r;
    float* cs = (float*)(p.ws + O_ROPE);
    cs[e] = cosf(rf);
    cs[8192 * 8 + e] = sinf(rf);
    return;
  }
  if (it == PREP_ROPE && tid < 64 * NL) {
    int l = tid >> 6, i = tid & 63;
    const float* lq = p.in[10] + (size_t)l * 256;
    float a = lq[i] * lq[64 + i], b = lq[128 + i] * lq[192 + i];
    a = wave_sum(a); b = wave_sum(b);
    if (i == 0) {
      float lam_init = 0.8f - 0.6f * __expf(-0.3f * (float)l);
      ((float*)(p.ws + O_LAM))[l] = __expf(a) - __expf(b) + lam_init;
    }
  }
}

DI bool xcd_tile(int B, int G, int iter, int MTILES, int NT, int& mt, int& nt) {
  const int nxb = G >> 3;
  const int x = B & 7, lb = B >> 3;
  const int q = MTILES >> 3, r = MTILES & 7;
  const int mx = q + (x < r ? 1 : 0);
  const int mbase = x * q + (x < r ? x : r);
  const int j = lb + iter * nxb;
  if (j >= mx * NT) return false;
  const int band = j / (8 * NT);
  const int rem = j - band * 8 * NT;
  const int nb = (mx - band * 8) < 8 ? (mx - band * 8) : 8;
  mt = mbase + band * 8 + rem % nb;
  nt = rem / nb;
  return true;
}

constexpr int PB_KC = SBT * PAST * 512 / 4096;
constexpr int PB_VC = SBT * 32 * 8;

DI void projin_tile(const Params& p, int l, int mt, int nt, char* smem) {
  const int row0 = mt * 256, col0 = nt * 256;
  const u16* W = (const u16*)(p.ws + O_WT) + (size_t)l * W_LAYER + W_IN;
  const u16* XN = (const u16*)(p.ws + O_XN);
  f32x4 acc[8][4];
  zero_acc8(acc);
  gemm512(XN + (size_t)row0 * LDK, LDK, W + (size_t)col0 * LDK, LDK, 1024, acc, smem);
  const float* cosT = (const float*)(p.ws + O_ROPE);
  const float* sinT = cosT + 8192 * 8;
  if (mt < 128) {
    const int prow0 = row0 & 8191;
    if (nt < 2) {
      tile_out_bf16<true>(acc, (u16*)(p.ws + O_QB) + (size_t)row0 * 512 + col0, 512, smem, QSCALE, prow0, cosT);
    } else if (nt < 4) {
      tile_out_f32<false, true>(acc, p.out + K_P + ((size_t)l * MP + row0) * 512 + (col0 - 512), 512, smem, prow0, cosT);
      tile_out_bf16<true>(acc, (u16*)(p.ws + O_KB) + (size_t)row0 * 512 + (col0 - 512), 512, smem, 1.f, prow0, cosT);
    } else if (nt < 6) {
      tile_out_f32<false, false>(acc, p.out + V_P + ((size_t)l * MP + row0) * 512 + (col0 - 1024), 512, smem, 0, nullptr);
      EPI_IDS;
      u16* VT = (u16*)(p.ws + O_VT);
      const unsigned vb = (unsigned)((row0 >> 13) * 512 + (col0 - 1024) + wc * 64 + fr) * (unsigned)PT + (unsigned)((row0 & 8191) + wr * 128 + fq * 4);
#pragma unroll
      for (int m = 0; m < 8; ++m) {
        asm volatile("" ::: "memory");
#pragma unroll
        for (int n = 0; n < 4; ++n) {
          const uint2 pk = {pack2(acc[m][n][0], acc[m][n][1]), pack2(acc[m][n][2], acc[m][n][3])};
          *(uint2*)(VT + (vb + (unsigned)(n * 16 * PT + m * 16))) = pk;
        }
      }
    } else if (nt >= 12 && nt < 14) {
      tile_out_f32<false, false>(acc, (float*)(p.ws + O_LX) + (size_t)row0 * 512 + (col0 - 3072), 512, smem, 0, nullptr);
    } else {
      u16* dst; int ld = 512, cbase;
      if (nt == 6) { dst = (u16*)(p.ws + O_GQ); ld = 256; cbase = 1536; }
      else if (nt == 7) { dst = (u16*)(p.ws + O_GK); ld = 256; cbase = 1792; }
      else if (nt < 10) { dst = (u16*)(p.ws + O_GV); cbase = 2048; }
      else if (nt < 12) { dst = (u16*)(p.ws + O_GR); cbase = 2560; }
      else { dst = (u16*)(p.ws + O_LG); cbase = 3584; }
      tile_out_bf16<false>(acc, dst + (size_t)row0 * ld + (col0 - cbase), ld, smem, nt == 6 ? 0.125f : 1.f, 0, nullptr);
    }
    return;
  }
  EPI_IDS;
  const bool isS = row0 >= MP;
  if (nt < 4) {
    const bool isq = nt < 2;
    u16* QB = (u16*)(p.ws + O_QB);
    u16* KB = (u16*)(p.ws + O_KB);
    u16* KS = (u16*)(p.ws + O_KS);
#pragma unroll
    for (int m = 0; m < 8; ++m) {
      asm volatile("" ::: "memory");
#pragma unroll
      for (int n = 0; n < 4; ++n)
#pragma unroll
        for (int j = 0; j < 4; ++j) {
          const int row = row0 + wr * 128 + m * 16 + fq * 4 + j;
          const int col = col0 + wc * 64 + n * 16 + fr;
          float v = acc[m][n][j];
          int b, t;
          if (isS) { int rs = row - MP; b = rs >> 5; t = rs & 31; } else { b = row >> 13; t = row & 8191; }
          const int pos = isS ? PAST + t : t;
          if (n == 0) {
            float pr = __shfl_xor(v, 8);
            float cs = cosT[pos * 8 + (fr & 7)], sn = sinT[pos * 8 + (fr & 7)];
            v = (fr < 8) ? v * cs - pr * sn : v * cs + pr * sn;
          }
          if (isq) {
            QB[(size_t)row * 512 + col] = f2bf(v * QSCALE);
          } else {
            const int ck = col - 512;
            if (isS) {
              p.out[K_S + ((size_t)l * MS + (row - MP)) * 512 + ck] = v;
              KS[((size_t)b * SKP + PAST + t) * 512 + ck] = f2bf(v);
            } else {
              p.out[K_P + ((size_t)l * MP + row) * 512 + ck] = v;
              KB[(size_t)row * 512 + ck] = f2bf(v);
            }
          }
        }
    }
  } else if (nt < 6) {
    u16* VT = (u16*)(p.ws + O_VT);
    u16* VTS = (u16*)(p.ws + O_VTS);
#pragma unroll
    for (int m = 0; m < 8; ++m) {
      asm volatile("" ::: "memory");
#pragma unroll
      for (int n = 0; n < 4; ++n) {
        const int rowb = row0 + wr * 128 + m * 16 + fq * 4;
        const int cv = col0 - 1024 + wc * 64 + n * 16 + fr;
        const int h = cv >> 7, vd = cv & 127;
        int b, t;
        if (isS) { int rs = rowb - MP; b = rs >> 5; t = rs & 31; } else { b = rowb >> 13; t = rowb & 8191; }
#pragma unroll
        for (int j = 0; j < 4; ++j) {
          if (isS) p.out[V_S + ((size_t)l * MS + (rowb + j - MP)) * 512 + cv] = acc[m][n][j];
          else p.out[V_P + ((size_t)l * MP + rowb + j) * 512 + cv] = acc[m][n][j];
        }
        uint2 pk = {pack2(acc[m][n][0], acc[m][n][1]), pack2(acc[m][n][2], acc[m][n][3])};
        if (isS) *(uint2*)(VTS + ((size_t)(b * 4 + h) * 128 + vd) * SKP + PAST + t) = pk;
        else *(uint2*)(VT + ((size_t)(b * 4 + h) * 128 + vd) * PT + t) = pk;
      }
    }
  } else {
    u16* dst16 = nullptr; float* dst32 = nullptr; int ld = 512, cbase = 0; float scale = 1.f;
    if (nt == 6) { dst16 = (u16*)(p.ws + O_GQ); ld = 256; cbase = 1536; scale = 0.125f; }
    else if (nt == 7) { dst16 = (u16*)(p.ws + O_GK); ld = 256; cbase = 1792; }
    else if (nt < 10) { dst16 = (u16*)(p.ws + O_GV); cbase = 2048; }
    else if (nt < 12) { dst16 = (u16*)(p.ws + O_GR); cbase = 2560; }
    else if (nt < 14) { dst32 = (float*)(p.ws + O_LX); cbase = 3072; }
    else { dst16 = (u16*)(p.ws + O_LG); cbase = 3584; }
#pragma unroll
    for (int m = 0; m < 8; ++m) {
      asm volatile("" ::: "memory");
#pragma unroll
      for (int n = 0; n < 4; ++n)
#pragma unroll
        for (int j = 0; j < 4; ++j) {
          const int row = row0 + wr * 128 + m * 16 + fq * 4 + j;
          const int c = col0 + wc * 64 + n * 16 + fr - cbase;
          const float v = acc[m][n][j] * scale;
          if (dst16) dst16[(size_t)row * ld + c] = f2bf(v);
          else dst32[(size_t)row * ld + c] = v;
        }
    }
  }
}

DI void cache_conv_item(const Params& p, int l, int it, char* smem) {
  const int tid = TID();
  if (it < PB_KC) {
    const float* src = p.in[2] + (size_t)l * SBT * PAST * 512;
    u16* KS = (u16*)(p.ws + O_KS);
#pragma unroll
    for (int i = 0; i < 4; ++i) {
      size_t e = (size_t)it * 4096 + (size_t)(tid + i * 256) * 4;
      const f32x4 vv = __builtin_nontemporal_load((const f32x4*)(src + e));
      const float4 v = {vv[0], vv[1], vv[2], vv[3]};
      size_t b = e / ((size_t)PAST * 512), r = e % ((size_t)PAST * 512);
      *(uint2*)(KS + b * SKP * 512 + r) = uint2{pack2(v.x, v.y), pack2(v.z, v.w)};
    }
    return;
  }
  it -= PB_KC;
  const int b = it / 256, r = it % 256, ptile = r / 8, ctile = r % 8;
  const float* src = p.in[3] + ((size_t)l * SBT + b) * PAST * 512;
  u16* VTS = (u16*)(p.ws + O_VTS);
  transpose_tile(src, 512, ptile * 64, ctile * 64, 64, VTS + (size_t)b * 512 * SKP, SKP, ctile * 64, (float*)smem);
}

DI int kswz(int key) { return (((key >> 3) & 3) << 2) | (key & 3); }

DI void attn_item(const Params& p, int l, bool isS, int b, int h, int cp, char* smem) {
  const int tid = TID512(), lane = tid & 63, wid = tid >> 6, fr = lane & 15, fq = lane >> 4;
  const int nkt = isS ? 33 : 2 * cp + 2;
  const int klen = isS ? SKV : nkt * 64;
  const int mykt = isS ? 33 : (wid < 4 ? 2 * cp + 1 : 2 * cp + 2);
  const u16* QB = (const u16*)(p.ws + O_QB);
  const u16* Kg = isS ? (const u16*)(p.ws + O_KS) + (size_t)b * SKP * 512 + h * 128 : (const u16*)(p.ws + O_KB) + (size_t)b * PT * 512 + h * 128;
  const int vstride = isS ? SKP : PT;
  const u16* Vg = (isS ? (const u16*)(p.ws + O_VTS) : (const u16*)(p.ws + O_VT)) + (size_t)(b * 4 + h) * 128 * vstride;
  const int qrow0 = isS ? MP + b * 32 : b * PT + cp * 128;
  const bool wactive = isS ? (wid < 2) : true;
  const int qrow = qrow0 + wid * 16 + fr;
  bf16x8 qf[2][2];
#pragma unroll
  for (int mp = 0; mp < 2; ++mp)
#pragma unroll
    for (int ks = 0; ks < 2; ++ks)
      qf[mp][ks] = wactive ? *(const bf16x8*)(QB + (size_t)qrow * 512 + h * 128 + mp * 64 + ks * 32 + fq * 8) : bf16x8{0, 0, 0, 0, 0, 0, 0, 0};
  f32x4 ot[2][8];
#pragma unroll
  for (int mp = 0; mp < 2; ++mp)
#pragma unroll
    for (int n = 0; n < 8; ++n) ot[mp][n] = f32x4{0.f, 0.f, 0.f, 0.f};
  float mrun[2] = {-INFINITY, -INFINITY}, lrun[2] = {0.f, 0.f};
  char* Ks = smem;
  char* Vs = smem + 32768;
  const int kkey = tid >> 4, vvd = tid >> 3;
  const int kgch = (tid & 15) ^ kswz(kkey);
  const int vgch = (tid & 7) ^ ((vvd >> 1) & 7);
  const int soff = tid * 16;
  auto issue_k = [&](int kt) {
#pragma unroll
    for (int i = 0; i < 2; ++i)
      __builtin_amdgcn_global_load_lds((const unsigned*)(Kg + (size_t)(kt * 64 + kkey + i * 32) * 512 + kgch * 8), (unsigned*)(Ks + (kt & 1) * 16384 + soff + i * 8192), 16, 0, 0);
  };
  auto issue_v = [&](int kt) {
#pragma unroll
    for (int i = 0; i < 2; ++i)
      __builtin_amdgcn_global_load_lds((const unsigned*)(Vg + (size_t)(vvd + i * 64) * vstride + kt * 64 + vgch * 8), (unsigned*)(Vs + (kt & 1) * 16384 + soff + i * 8192), 16, 0, 0);
  };
  auto qk_tile = [&](int kt, f32x4 (&st)[2][4]) {
    const char* Kb = Ks + (kt & 1) * 16384;
    bf16x8 kf[2][4][2];
#pragma unroll
    for (int mp = 0; mp < 2; ++mp)
#pragma unroll
      for (int mt = 0; mt < 4; ++mt) {
        const int key = 32 * (mt >> 1) + 8 * (fr >> 2) + 4 * (mt & 1) + (fr & 3);
#pragma unroll
        for (int ks = 0; ks < 2; ++ks) kf[mp][mt][ks] = *(const bf16x8*)(Kb + key * 256 + (((mp * 8 + ks * 4 + fq) ^ kswz(key)) << 4));
      }
#pragma unroll
    for (int mp = 0; mp < 2; ++mp)
#pragma unroll
      for (int mt = 0; mt < 4; ++mt) {
        f32x4 a = MFMA16(kf[mp][mt][0], qf[mp][0], (f32x4{0.f, 0.f, 0.f, 0.f}));
        st[mp][mt] = MFMA16(kf[mp][mt][1], qf[mp][1], a);
      }
    if ((kt + 1) * 64 > klen) {
      asm volatile("" ::: "memory");
#pragma unroll
      for (int mp = 0; mp < 2; ++mp)
#pragma unroll
        for (int mt = 0; mt < 4; ++mt)
#pragma unroll
          for (int j = 0; j < 4; ++j) {
            const int key = kt * 64 + 32 * (mt >> 1) + 8 * fq + 4 * (mt & 1) + j;
            if (key >= klen) st[mp][mt][j] = -INFINITY;
          }
    }
  };
  auto softmax_tile = [&](f32x4 (&st)[2][4], bf16x8 (&pfn)[2][2], float (&alpha)[2], float (&psum)[2], bool (&moved)[2]) {
#pragma unroll
    for (int mp = 0; mp < 2; ++mp) {
      float mx = -INFINITY;
#pragma unroll
      for (int mt = 0; mt < 4; ++mt)
#pragma unroll
        for (int j = 0; j < 4; ++j) mx = fmaxf(mx, st[mp][mt][j]);
      mx = quad_max(mx);
      const float mold = mrun[mp];
      const float mnew = fmaxf(mold, mx);
      mrun[mp] = mnew;
      float ps = 0.f;
#pragma unroll
      for (int mt = 0; mt < 4; ++mt)
#pragma unroll
        for (int j = 0; j < 4; ++j) { float e = __builtin_amdgcn_exp2f(st[mp][mt][j] - mnew); st[mp][mt][j] = e; ps += e; }
      psum[mp] = ps;
      moved[mp] = __any(mnew > mold);
      alpha[mp] = __builtin_amdgcn_exp2f(mold - mnew);
#pragma unroll
      for (int s = 0; s < 2; ++s) {
        uint4 u = {pack2(st[mp][2 * s][0], st[mp][2 * s][1]), pack2(st[mp][2 * s][2], st[mp][2 * s][3]),
                   pack2(st[mp][2 * s + 1][0], st[mp][2 * s + 1][1]), pack2(st[mp][2 * s + 1][2], st[mp][2 * s + 1][3])};
        pfn[mp][s] = __builtin_bit_cast(bf16x8, u);
      }
    }
  };
  auto apply_scale = [&](const float (&alpha)[2], const float (&psum)[2], const bool (&moved)[2]) {
#pragma unroll
    for (int mp = 0; mp < 2; ++mp) {
      if (moved[mp]) {
        lrun[mp] *= alpha[mp];
#pragma unroll
        for (int n = 0; n < 8; ++n) { ot[mp][n][0] *= alpha[mp]; ot[mp][n][1] *= alpha[mp]; ot[mp][n][2] *= alpha[mp]; ot[mp][n][3] *= alpha[mp]; }
      }
      lrun[mp] += psum[mp];
    }
  };
  asm volatile("s_waitcnt vmcnt(0) lgkmcnt(0)" ::: "memory");
  __builtin_amdgcn_s_barrier();
  issue_k(0); issue_v(0);
  if (nkt > 1) issue_k(1);
  asm volatile("s_waitcnt vmcnt(0)" ::: "memory");
  asm volatile("" ::"v"(qf[0][0]), "v"(qf[0][1]), "v"(qf[1][0]), "v"(qf[1][1]));
  __builtin_amdgcn_s_barrier();
  bf16x8 pf[2][2];
#pragma unroll
  for (int mp = 0; mp < 2; ++mp)
#pragma unroll
    for (int s = 0; s < 2; ++s) pf[mp][s] = bf16x8{0, 0, 0, 0, 0, 0, 0, 0};
  if (wactive) {
    f32x4 st[2][4];
    float alpha[2], psum[2]; bool moved[2];
    qk_tile(0, st);
    softmax_tile(st, pf, alpha, psum, moved);
    apply_scale(alpha, psum, moved);
  }
  asm volatile("s_waitcnt lgkmcnt(0)" ::: "memory");
  __builtin_amdgcn_s_barrier();
  for (int j = 0; j < nkt; ++j) {
    if (j + 2 < nkt) issue_k(j + 2);
    if (j + 1 < nkt) issue_v(j + 1);
    const bool doPV = wactive && j < mykt;
    const bool doQK = wactive && j + 1 < mykt;
    f32x4 st[2][4];
    bf16x8 pfn[2][2];
    float alpha[2] = {1.f, 1.f}, psum[2] = {0.f, 0.f}; bool moved[2] = {false, false};
    auto pv_tile = [&]() {
      const char* Vb = Vs + (j & 1) * 16384;
#pragma unroll
      for (int nh = 0; nh < 2; ++nh) {
        bf16x8 vf[4][2];
#pragma unroll
        for (int n = 0; n < 4; ++n) {
          const int vd = (nh * 4 + n) * 16 + fr;
#pragma unroll
          for (int s = 0; s < 2; ++s) vf[n][s] = *(const bf16x8*)(Vb + vd * 128 + (((s * 4 + fq) ^ ((vd >> 1) & 7)) << 4));
        }
#pragma unroll
        for (int n = 0; n < 4; ++n)
#pragma unroll
          for (int s = 0; s < 2; ++s) {
            ot[0][nh * 4 + n] = MFMA16(vf[n][s], pf[0][s], ot[0][nh * 4 + n]);
            ot[1][nh * 4 + n] = MFMA16(vf[n][s], pf[1][s], ot[1][nh * 4 + n]);
          }
      }
    };
    if (doQK) {
      qk_tile(j + 1, st);
      pv_tile();
      softmax_tile(st, pfn, alpha, psum, moved);
      apply_scale(alpha, psum, moved);
#pragma unroll
      for (int mp = 0; mp < 2; ++mp)
#pragma unroll
        for (int s = 0; s < 2; ++s) pf[mp][s] = pfn[mp][s];
    } else if (doPV) {
      pv_tile();
    }
    asm volatile("s_waitcnt vmcnt(0) lgkmcnt(0)" ::: "memory");
    __builtin_amdgcn_s_barrier();
  }
  if (wactive) {
    float l0 = lrun[0], l1 = lrun[1];
    l0 += __shfl_xor(l0, 16); l0 += __shfl_xor(l0, 32);
    l1 += __shfl_xor(l1, 16); l1 += __shfl_xor(l1, 32);
    const float lam = ((const float*)(p.ws + O_LAM))[l];
    const float lam_init = 0.8f - 0.6f * __expf(-0.3f * (float)l);
    const float i0 = 1.f / l0, i1 = lam / l1;
    float ss = 0.f;
#pragma unroll
    for (int n = 0; n < 8; ++n)
#pragma unroll
      for (int j = 0; j < 4; ++j) { float o = ot[0][n][j] * i0 - ot[1][n][j] * i1; ot[0][n][j] = o; ss += o * o; }
    ss += __shfl_xor(ss, 16); ss += __shfl_xor(ss, 32);
    const float rs = rsqrtf(ss * (1.f / 128.f) + EPS) * (1.f - lam_init);
    const float* g = p.in[11] + (size_t)l * 128;
    u16* OA = (u16*)(p.ws + O_OA) + (size_t)qrow * 512 + h * 128;
#pragma unroll
    for (int n = 0; n < 8; ++n) {
      const int vd = n * 16 + fq * 4;
      float4 gg = *(const float4*)(g + vd);
      *(uint2*)(OA + vd) = uint2{pack2(ot[0][n][0] * rs * gg.x, ot[0][n][1] * rs * gg.y), pack2(ot[0][n][2] * rs * gg.z, ot[0][n][3] * rs * gg.w)};
    }
  }
}

constexpr int LP = 72;
constexpr int BCS = 68;
DI void gla_decode(int gi, bool& isS, int& b, int& h, int& c, int& row0, int& Lc) {
  if (gi < PB * 4 * 128) { isS = false; c = gi & 127; h = (gi >> 7) & 3; b = gi >> 9; row0 = b * PT + c * 64; Lc = 64; }
  else { isS = true; int s = gi - PB * 4 * 128; b = s >> 2; h = s & 3; c = 0; row0 = MP + b * 32; Lc = 32; }
}
DI void gla_bcum(const Params& p, int l, int row0, int Lc, int h, float* bc, float* tot, float* gas) {
  const int tid = TID(), kd = tid & 63, tq = tid >> 6;
  const float* W2 = p.in[12] + (size_t)l * 16 * 256 + h * 64 + kd;
  const float b2 = p.in[13][(size_t)l * 256 + h * 64 + kd];
  const float* GA = (const float*)(p.ws + O_GA);
  {
    const int r = tid >> 2, part = tid & 3;
    float4 v = {0.f, 0.f, 0.f, 0.f};
    if (r < Lc) v = *(const float4*)(GA + (size_t)(row0 + r) * 16 + part * 4);
    *(float4*)(gas + r * 16 + part * 4) = v;
  }
  float w[16];
#pragma unroll
  for (int r = 0; r < 16; ++r) w[r] = W2[r * 256];
  __syncthreads();
  float run = 0.f;
#pragma unroll
  for (int i = 0; i < 16; ++i) {
    const int t = tq * 16 + i;
    const float4* ga = (const float4*)(gas + t * 16);
    const float4 g0 = ga[0], g1 = ga[1], g2 = ga[2], g3 = ga[3];
    const float x = b2 + g0.x * w[0] + g0.y * w[1] + g0.z * w[2] + g0.w * w[3] + g1.x * w[4] + g1.y * w[5] + g1.z * w[6] + g1.w * w[7] +
                    g2.x * w[8] + g2.y * w[9] + g2.z * w[10] + g2.w * w[11] + g3.x * w[12] + g3.y * w[13] + g3.z * w[14] + g3.w * w[15];
    const float la = (t < Lc) ? -softplusf_(-x) * (1.f / 16.f) : 0.f;
    run += la;
    bc[t * BCS + kd] = run;
  }
  tot[tq * 64 + kd] = run;
  __syncthreads();
  float off = 0.f;
  for (int g = 0; g < tq; ++g) off += tot[g * 64 + kd];
#pragma unroll
  for (int i = 0; i < 16; ++i) bc[(tq * 16 + i) * BCS + kd] += off;
  __syncthreads();
}
DI void gla_load_vt(const Params& p, int row0, int Lc, int h, u16* vt) {
  const int tid = TID(), s = tid & 63, cg4 = tid >> 6;
  const u16* GV = (const u16*)(p.ws + O_GV) + (size_t)(row0 + s) * 512 + h * 128;
  u32x4 v[4];
#pragma unroll
  for (int i = 0; i < 4; ++i) v[i] = (s < Lc) ? *(const u32x4*)(GV + (cg4 + 4 * i) * 8) : u32x4{0u, 0u, 0u, 0u};
#pragma unroll
  for (int i = 0; i < 4; ++i) {
    const int vd0 = (cg4 + 4 * i) * 8;
#pragma unroll
    for (int e = 0; e < 4; ++e) {
      vt[(vd0 + 2 * e) * LP + s] = (u16)(v[i][e] & 0xffffu);
      vt[(vd0 + 2 * e + 1) * LP + s] = (u16)(v[i][e] >> 16);
    }
  }
}

DI void gla1_item(const Params& p, int l, int gi, char* smem) {
  bool isS; int b, h, c, row0, Lc;
  gla_decode(gi, isS, b, h, c, row0, Lc);
  const int tid = TID(), lane = tid & 63, wid = tid >> 6, fr = lane & 15, fq = lane >> 4;
  float* bc = (float*)smem;
  float* tot = (float*)(smem + 17408);
  u16* kh = (u16*)(smem + 18432);
  u16* vt = (u16*)(smem + 18432 + 9216);
  __syncthreads();
  gla_bcum(p, l, row0, Lc, h, bc, tot, (float*)kh);
  {
    const int s = tid & 63, c2 = tid >> 6;
    const u16* GK = (const u16*)(p.ws + O_GK) + (size_t)(row0 + s) * 256 + h * 64;
    u32x4 kv[2];
#pragma unroll
    for (int i = 0; i < 2; ++i) kv[i] = (s < Lc) ? *(const u32x4*)(GK + (c2 + 4 * i) * 8) : u32x4{0u, 0u, 0u, 0u};
#pragma unroll
    for (int i = 0; i < 2; ++i) {
      const int kd0 = (c2 + 4 * i) * 8;
#pragma unroll
      for (int e = 0; e < 8; ++e) {
        const unsigned w = kv[i][e >> 1];
        const float kf = bf2f((u16)((e & 1) ? (w >> 16) : (w & 0xffffu)));
        const float bl = bc[63 * BCS + kd0 + e];
        kh[(kd0 + e) * LP + s] = f2bf(kf * __expf(bl - bc[s * BCS + kd0 + e]));
      }
    }
    if (tid < 64) ((float*)(p.ws + O_DEC))[(size_t)gi * 64 + tid] = __expf(bc[63 * BCS + tid]);
  }
  gla_load_vt(p, row0, Lc, h, vt);
  __syncthreads();
  u16* KVT = (u16*)(p.ws + O_KVT) + (size_t)gi * 8192;
#pragma unroll
  for (int mi = 0; mi < 2; ++mi)
#pragma unroll
    for (int n = 0; n < 4; ++n) {
      const int m = wid * 2 + mi;
      f32x4 a = lds_mm<2>(vt, LP, m * 16, kh, LP, n * 16, f32x4{0.f, 0.f, 0.f, 0.f});
#pragma unroll
      for (int j = 0; j < 4; ++j) KVT[(m * 16 + fq * 4 + j) * 64 + n * 16 + fr] = f2bf(a[j]);
    }
}

constexpr int G2_ITEMS = (PB * 4 + SBT * 4) * 32;
DI void gla2_item(const Params& p, int l, int it) {
  const int seq = it >> 5, e = (it & 31) * 256 + TID();
  const int vd = e >> 6, kd = e & 63;
  u16* KVT = (u16*)(p.ws + O_KVT);
  const float* DEC = (const float*)(p.ws + O_DEC);
  if (seq < PB * 4) {
    float S = 0.f;
    const int gi0 = seq * 128;
    for (int c0 = 0; c0 < 128; c0 += 32) {
      u16 kvv[32]; float dd[32];
#pragma unroll
      for (int c = 0; c < 32; ++c) { kvv[c] = KVT[(size_t)(gi0 + c0 + c) * 8192 + e]; dd[c] = DEC[(size_t)(gi0 + c0 + c) * 64 + kd]; }
#pragma unroll
      for (int c = 0; c < 32; ++c) { KVT[(size_t)(gi0 + c0 + c) * 8192 + e] = f2bf(S); S = dd[c] * S + bf2f(kvv[c]); }
    }
    p.out[GLA_P + ((size_t)l * PB * 4 + seq) * 8192 + kd * 128 + vd] = S;
  } else {
    const int s = seq - PB * 4, gi = PB * 4 * 128 + s;
    const float S0 = p.in[4][((size_t)l * SBT * 4 + s) * 8192 + kd * 128 + vd];
    u16* q = KVT + (size_t)gi * 8192 + e;
    const float kv = bf2f(*q);
    const float d = DEC[(size_t)gi * 64 + kd];
    *q = f2bf(S0);
    p.out[GLA_S + ((size_t)l * SBT * 4 + s) * 8192 + kd * 128 + vd] = d * S0 + kv;
  }
}

DI void gla3_item(const Params& p, int l, int gi, char* smem) {
  bool isS; int b, h, c, row0, Lc;
  gla_decode(gi, isS, b, h, c, row0, Lc);
  const int tid = TID(), lane = tid & 63, wid = tid >> 6, fr = lane & 15, fq = lane >> 4;
  float* bc = (float*)smem;
  u16* att = (u16*)smem;
  float* tot = (float*)(smem + 17408);
  u16* qt = (u16*)(smem + 18432);
  u16* kt_ = (u16*)(smem + 18432 + 9216);
  u16* vt = (u16*)(smem + 18432 + 2 * 9216);
  u16* st = (u16*)(smem + 18432 + 2 * 9216 + 18432);
  __syncthreads();
  gla_bcum(p, l, row0, Lc, h, bc, tot, (float*)qt);
  const u16* KVT = (const u16*)(p.ws + O_KVT) + (size_t)gi * 8192;
  {
    const int s = tid & 63, c2 = tid >> 6;
    const u16* GQ = (const u16*)(p.ws + O_GQ) + (size_t)(row0 + s) * 256 + h * 64;
    const u16* GK = (const u16*)(p.ws + O_GK) + (size_t)(row0 + s) * 256 + h * 64;
    u32x4 qv[2], kv[2], sv[4];
#pragma unroll
    for (int i = 0; i < 2; ++i) {
      qv[i] = (s < Lc) ? *(const u32x4*)(GQ + (c2 + 4 * i) * 8) : u32x4{0u, 0u, 0u, 0u};
      kv[i] = (s < Lc) ? *(const u32x4*)(GK + (c2 + 4 * i) * 8) : u32x4{0u, 0u, 0u, 0u};
    }
#pragma unroll
    for (int i = 0; i < 4; ++i) { const int id = tid + i * 256; sv[i] = *(const u32x4*)(KVT + (id >> 3) * 64 + (id & 7) * 8); }
#pragma unroll
    for (int i = 0; i < 2; ++i) {
      const int kd0 = (c2 + 4 * i) * 8;
      u32x4 qo, ko;
#pragma unroll
      for (int e2 = 0; e2 < 4; ++e2) {
        const float b0 = bc[s * BCS + kd0 + 2 * e2], b1 = bc[s * BCS + kd0 + 2 * e2 + 1];
        const float e0 = __expf(b0), e1 = __expf(b1);
        const float q0 = bf2f((u16)(qv[i][e2] & 0xffffu)) * e0, q1 = bf2f((u16)(qv[i][e2] >> 16)) * e1;
        const float k0 = bf2f((u16)(kv[i][e2] & 0xffffu)) / e0, k1 = bf2f((u16)(kv[i][e2] >> 16)) / e1;
        qo[e2] = pack2(q0, q1);
        ko[e2] = pack2(k0, k1);
      }
      *(u32x4*)(qt + s * LP + kd0) = qo;
      *(u32x4*)(kt_ + s * LP + kd0) = ko;
    }
#pragma unroll
    for (int i = 0; i < 4; ++i) { const int id = tid + i * 256; *(u32x4*)(st + (id >> 3) * LP + (id & 7) * 8) = sv[i]; }
  }
  gla_load_vt(p, row0, Lc, h, vt);
  __syncthreads();
  {
    f32x4 a[4];
#pragma unroll
    for (int n = 0; n < 4; ++n) a[n] = lds_mm<2>(qt, LP, wid * 16, kt_, LP, n * 16, f32x4{0.f, 0.f, 0.f, 0.f});
#pragma unroll
    for (int n = 0; n < 4; ++n)
#pragma unroll
      for (int j = 0; j < 4; ++j) {
        const int t = wid * 16 + fq * 4 + j, s = n * 16 + fr;
        att[t * LP + s] = f2bf(t >= s ? a[n][j] : 0.f);
      }
  }
  __syncthreads();
  f32x4 o[8];
#pragma unroll
  for (int n = 0; n < 8; ++n) {
    f32x4 a = lds_mm<2>(att, LP, wid * 16, vt, LP, n * 16, f32x4{0.f, 0.f, 0.f, 0.f});
    o[n] = lds_mm<2>(qt, LP, wid * 16, st, LP, n * 16, a);
  }
  const float* gn = p.in[14] + (size_t)l * 128;
  const u16* GR = (const u16*)(p.ws + O_GR);
  u16* OG = (u16*)(p.ws + O_OG);
  float gnv[8];
#pragma unroll
  for (int n = 0; n < 8; ++n) gnv[n] = gn[n * 16 + fr];
#pragma unroll
  for (int j = 0; j < 4; ++j) {
    float ss = 0.f;
#pragma unroll
    for (int n = 0; n < 8; ++n) ss += o[n][j] * o[n][j];
    ss += __shfl_xor(ss, 1); ss += __shfl_xor(ss, 2); ss += __shfl_xor(ss, 4); ss += __shfl_xor(ss, 8);
    const float rs = rsqrtf(ss * (1.f / 128.f) + EPS);
    const int t = wid * 16 + fq * 4 + j;
    if (t < Lc) {
      const size_t ro = (size_t)(row0 + t) * 512 + h * 128;
      u16 grv[8];
#pragma unroll
      for (int n = 0; n < 8; ++n) grv[n] = GR[ro + n * 16 + fr];
#pragma unroll
      for (int n = 0; n < 8; ++n) {
        const float gr = bf2f(grv[n]);
        OG[ro + n * 16 + fr] = f2bf(o[n][j] * rs * gnv[n] * gr * sigmoidf_(gr));
      }
    }
  }
}

constexpr int L1_ITEMS = NLC * 8;
DI void lru_decode(int ci, bool& isS, int& b, int& row0, int& Lc, int& t0) {
  if (ci < MP / 64) { isS = false; b = ci >> 7; t0 = (ci & 127) * 64; row0 = ci * 64; Lc = 64; }
  else { isS = true; b = ci - MP / 64; t0 = 0; row0 = MP + b * 32; Lc = 32; }
}
DI void lru1_item(const Params& p, int l, int it, char* smem) {
  const int ci = it >> 3, nb = it & 7;
  bool isS; int b, row0, Lc, t0;
  lru_decode(ci, isS, b, row0, Lc, t0);
  const int tid = TID(), lane = tid & 63, wid = tid >> 6, fr = lane & 15, fq = lane >> 4;
  u16* xcs = (u16*)smem;
  u16* was = (u16*)(smem + 9216);
  u16* wxs = (u16*)(smem + 2 * 9216);
  float* as_ = (float*)(smem + 3 * 9216);
  float* us_ = (float*)(smem + 3 * 9216 + 16384);
  float* segP = (float*)(smem + 3 * 9216 + 32768);
  float* segH = (float*)(smem + 3 * 9216 + 32768 + 1024);
  const float* LX = (const float*)(p.ws + O_LX);
  const u16* Wl = (const u16*)(p.ws + O_WT) + (size_t)l * W_LAYER;
  const int i = tid & 63, tq = tid >> 6, ch = nb * 64 + i;
  __syncthreads();
  {
    const float* cw = p.in[15] + (size_t)l * 4 * 512 + ch;
    const float w0 = cw[0], w1 = cw[512], w2 = cw[1024], w3 = cw[1536], cb = p.in[16][(size_t)l * 512 + ch];
    const float* buf = isS ? p.in[5] + ((size_t)l * SBT + b) * 3 * 512 + ch : nullptr;
    float x[19];
#pragma unroll
    for (int j = 0; j < 19; ++j) {
      const int tl = tq * 16 - 3 + j;
      const int tt = t0 + tl;
      float v = 0.f;
      if (tl < Lc) {
        if (tt >= 0) v = LX[(size_t)(row0 + tl) * 512 + ch];
        else if (isS) v = buf[(3 + tt) * 512];
      }
      x[j] = v;
    }
#pragma unroll
    for (int k = 0; k < 16; ++k) {
      const int t = tq * 16 + k;
      const float xv = (t < Lc) ? cb + w0 * x[k] + w1 * x[k + 1] + w2 * x[k + 2] + w3 * x[k + 3] : 0.f;
      xcs[t * LP + i] = f2bf(xv);
    }
#pragma unroll
    for (int k = 0; k < 2; ++k) {
      const int id = tid + k * 256, r = id >> 3, c8 = id & 7;
      *(uint4*)(was + r * LP + c8 * 8) = *(const uint4*)(Wl + W_WA + nb * 4096 + r * 64 + c8 * 8);
      *(uint4*)(wxs + r * LP + c8 * 8) = *(const uint4*)(Wl + W_WX + nb * 4096 + r * 64 + c8 * 8);
    }
    const int T = isS ? STT : PT;
    if (t0 + Lc == T && tid < 192) {
      const int k = tid >> 6;
      const float v = LX[(size_t)(row0 + Lc - 3 + k) * 512 + ch];
      if (isS) p.out[LC_S + (((size_t)l * SBT + b) * 3 + k) * 512 + ch] = v;
      else p.out[LC_P + (((size_t)l * PB + b) * 3 + k) * 512 + ch] = v;
    }
  }
  __syncthreads();
  {
    const float* ba = p.in[18] + (size_t)l * 512 + nb * 64;
    const float* bx = p.in[20] + (size_t)l * 512 + nb * 64;
    const float* lm = p.in[21] + (size_t)l * 512 + nb * 64;
#pragma unroll
    for (int n = 0; n < 4; ++n) {
      f32x4 r = lds_mm<2>(xcs, LP, wid * 16, was, LP, n * 16, f32x4{0.f, 0.f, 0.f, 0.f});
      f32x4 g = lds_mm<2>(xcs, LP, wid * 16, wxs, LP, n * 16, f32x4{0.f, 0.f, 0.f, 0.f});
      const int j = n * 16 + fr;
      const float sp = softplusf_(-lm[j]), bav = ba[j], bxv = bx[j];
#pragma unroll
      for (int q = 0; q < 4; ++q) {
        const int t = wid * 16 + fq * 4 + q;
        const float rr = sigmoidf_(r[q] + bav), ii = sigmoidf_(g[q] + bxv);
        const float la = -8.f * rr * sp;
        const float a = __expf(la);
        const float x2 = 2.f * la;
        const float om = (x2 > -0.01f) ? -x2 * (1.f + x2 * (0.5f + x2 * (1.f / 6.f))) : 1.f - __expf(x2);
        const float u = sqrtf(om) * ii * bf2f(xcs[t * LP + j]);
        as_[t * 64 + j] = a;
        us_[t * 64 + j] = u;
      }
    }
  }
  __syncthreads();
  {
    float av[16], uv[16];
#pragma unroll
    for (int k = 0; k < 16; ++k) { av[k] = as_[(tq * 16 + k) * 64 + i]; uv[k] = us_[(tq * 16 + k) * 64 + i]; }
    float P = 1.f, hh = 0.f;
#pragma unroll
    for (int k = 0; k < 16; ++k) { P *= av[k]; hh = av[k] * hh + uv[k]; }
    segP[tq * 64 + i] = P; segH[tq * 64 + i] = hh;
    __syncthreads();
    float Pin = 1.f, hin = 0.f;
    for (int g = 0; g < tq; ++g) { const float pg = segP[g * 64 + i], hg = segH[g * 64 + i]; hin = pg * hin + hg; Pin *= pg; }
    u16* HL = (u16*)(p.ws + O_HL);
    u16* PPp = (u16*)(p.ws + O_PP);
    P = Pin; hh = hin;
#pragma unroll
    for (int k = 0; k < 16; ++k) {
      const int t = tq * 16 + k;
      P *= av[k]; hh = av[k] * hh + uv[k];
      if (t < Lc) {
        HL[(size_t)(row0 + t) * 512 + ch] = f2bf(hh);
        PPp[(size_t)(row0 + t) * 512 + ch] = f2bf(P);
      }
    }
    if (tq * 16 + 16 == Lc) {
      ((float*)(p.ws + O_CA))[(size_t)ci * 512 + ch] = P;
      ((float*)(p.ws + O_CH))[(size_t)ci * 512 + ch] = hh;
    }
  }
}
constexpr int L2_ITEMS = 8 + 32;
DI void lru2_item(const Params& p, int l, int it) {
  const float* CA = (const float*)(p.ws + O_CA);
  const float* CH = (const float*)(p.ws + O_CH);
  float* HS = (float*)(p.ws + O_HS);
  if (it < 8) {
    const int e = it * 256 + TID(), b = e >> 9, ch = e & 511;
    float hh = 0.f;
    for (int c0 = 0; c0 < 128; c0 += 16) {
      float ca[16], chv[16];
#pragma unroll
      for (int c = 0; c < 16; ++c) { const size_t o = (size_t)(b * 128 + c0 + c) * 512 + ch; ca[c] = CA[o]; chv[c] = CH[o]; }
#pragma unroll
      for (int c = 0; c < 16; ++c) { const size_t o = (size_t)(b * 128 + c0 + c) * 512 + ch; HS[o] = hh; hh = ca[c] * hh + chv[c]; }
    }
    p.out[LH_P + ((size_t)l * PB + b) * 512 + ch] = hh;
  } else {
    const int e = (it - 8) * 256 + TID(), b = e >> 9, ch = e & 511;
    const float h0 = p.in[6][((size_t)l * SBT + b) * 512 + ch];
    const size_t o = (size_t)(MP / 64 + b) * 512 + ch;
    HS[o] = h0;
    p.out[LH_S + ((size_t)l * SBT + b) * 512 + ch] = CA[o] * h0 + CH[o];
  }
}
constexpr int L3_ITEMS = MT / 8;
DI void lru3_item(const Params& p, int it) {
  const u16* HL = (const u16*)(p.ws + O_HL);
  const u16* PPp = (const u16*)(p.ws + O_PP);
  const u16* LG = (const u16*)(p.ws + O_LG);
  const float* HS = (const float*)(p.ws + O_HS);
  u16* OL = (u16*)(p.ws + O_OL);
#pragma unroll
  for (int i = 0; i < 4; ++i) {
    const int id = TID() + i * 256;
    const int row = it * 8 + (id >> 7), c4 = (id & 127) * 4;
    const int ci = row < MP ? (row >> 6) : MP / 64 + ((row - MP) >> 5);
    const size_t o = (size_t)row * 512 + c4;
    const uint2 hl = *(const uint2*)(HL + o), pp = *(const uint2*)(PPp + o), lg = *(const uint2*)(LG + o);
    const float4 hs = *(const float4*)(HS + (size_t)ci * 512 + c4);
    float y0 = (bf2f(hl.x & 0xffff) + bf2f(pp.x & 0xffff) * hs.x) * gelu_tanh(bf2f(lg.x & 0xffff));
    float y1 = (bf2f(hl.x >> 16) + bf2f(pp.x >> 16) * hs.y) * gelu_tanh(bf2f(lg.x >> 16));
    float y2 = (bf2f(hl.y & 0xffff) + bf2f(pp.y & 0xffff) * hs.z) * gelu_tanh(bf2f(lg.y & 0xffff));
    float y3 = (bf2f(hl.y >> 16) + bf2f(pp.y >> 16) * hs.w) * gelu_tanh(bf2f(lg.y >> 16));
    *(uint2*)(OL + o) = uint2{pack2(y0, y1), pack2(y2, y3)};
  }
}

DI void ybr_tile(const Params& p, int l, int mt, int nt, char* smem) {
  const int row0 = mt * 256, col0 = nt * 256, br = nt >> 2;
  const u16* W = (const u16*)(p.ws + O_WT) + (size_t)l * W_LAYER + W_BR + (size_t)br * 1024 * 512 + (size_t)((nt & 3) * 256) * 512;
  const u16* O = (const u16*)(p.ws + (br == 0 ? O_OA : (br == 1 ? O_OG : O_OL))) + (size_t)row0 * 512;
  f32x4 acc[8][4];
  zero_acc8(acc);
  gemm512(O, 512, W, 512, 512, acc, smem);
  tile_out_bf16<false>(acc, (u16*)(p.ws + O_YP) + (size_t)row0 * 3072 + col0, 3072, smem, 1.f, 0, nullptr);
}
DI void gate_tile(const Params& p, int l, int mt, int nt, char* smem) {
  const int row0 = mt * 256, col0 = nt * 256;
  const u16* W = (const u16*)(p.ws + O_WT) + (size_t)l * W_LAYER + W_MG + (size_t)col0 * LDK;
  f32x4 acc[8][4];
  zero_acc8(acc);
  gemm512((const u16*)(p.ws + O_XN) + (size_t)row0 * LDK, LDK, W, LDK, 1024, acc, smem);
  EPI_IDS;
  u16* Y = (u16*)(p.ws + O_YP) + (size_t)row0 * 3072 + col0;
  const float* bm = p.in[26] + (size_t)l * 3072 + col0 + wc * 64 + fr;
  img_load_bf16(Y, 3072, smem, 256, 0);
  img_barrier();
  u16* img = (u16*)smem + (wr * 128 + fq * 4) * IMG_LD + wc * 64 + fr;
#pragma unroll
  for (int n = 0; n < 4; ++n) {
    const float bv = bm[n * 16];
#pragma unroll
    for (int m = 0; m < 8; ++m)
#pragma unroll
      for (int j = 0; j < 4; ++j) {
        u16* q = img + (m * 16 + j) * IMG_LD + n * 16;
        *q = f2bf(sigmoidf_(acc[m][n][j] + bv) * bf2f(*q));
      }
  }
  img_barrier();
  img_store_bf16(Y, 3072, smem, 0);
}
DI void resid_tile(const Params& p, const u16* A, int ldk, const u16* W, int mt, int nt, int k0, int klen, bool atomic, const float* xsrc, char* smem) {
  const int row0 = mt * 256, col0 = nt * 256;
  f32x4 acc[8][4];
  zero_acc8(acc);
  gemm512(A + (size_t)row0 * ldk + k0, ldk, W + (size_t)col0 * ldk + k0, ldk, klen, acc, smem);
  if (!atomic) { tile_out_f32<true, false>(acc, p.out + (size_t)row0 * 1024 + col0, 1024, smem, 0, nullptr, xsrc + (size_t)row0 * 1024 + col0); return; }
  EPI_IDS;
#pragma unroll
  for (int m = 0; m < 8; ++m) {
    asm volatile("" ::: "memory");
#pragma unroll
    for (int n = 0; n < 4; ++n)
#pragma unroll
      for (int j = 0; j < 4; ++j) {
        const int row = row0 + wr * 128 + m * 16 + fq * 4 + j, col = col0 + wc * 64 + n * 16 + fr;
        float* q = p.out + (size_t)row * 1024 + col;
        if (atomic) unsafeAtomicAdd(q, acc[m][n][j]); else *q += acc[m][n][j];
      }
  }
}
DI void resid_phase(const Params& p, const u16* A, int ldk, const u16* W, int B, int G, const float* xsrc, char* smem) {
  const int ns = ldk / 256;
  int k = 0, u = B;
  while (true) {
    int mt, nt, k0 = 0, kl = ldk;
    bool at = false;
    if (xcd_tile(B, G, k, 128, 4, mt, nt)) { ++k; }
    else if (u < 8 * ns) { const int t = u / ns, sl = u - t * ns; mt = 128 + (t >> 2); nt = t & 3; k0 = sl * 256; kl = 256; at = true; u += G; }
    else break;
    asm volatile("" : "+s"(kl));
    resid_tile(p, A, ldk, W, mt, nt, k0, kl, at, xsrc, smem);
  }
}

DI void ffgate_tile(const Params& p, int l, int mt, int nt, char* smem) {
  const int row0 = mt * 256, col0 = nt * 256;
  const u16* W = (const u16*)(p.ws + O_WT) + (size_t)l * W_LAYER + W_FG;
  f32x4 acc[8][4];
  zero_acc8(acc);
  gemm512((const u16*)(p.ws + O_XN) + (size_t)row0 * LDK, LDK, W + (size_t)col0 * LDK, LDK, 1024, acc, smem);
  if (mt < 128) {
    EPI_IDS;
    tile_out_bf16<false>(acc, (u16*)(p.ws + O_GU) + (size_t)row0 * DFF + col0, DFF, smem, 1.f, 0, nullptr);
    if (((row0 + 256) & 8191) == 0 && wr == 1 && fq == 3) {
      const int b = row0 >> 13;
#pragma unroll
      for (int n = 0; n < 4; ++n) {
        const int col = col0 + wc * 64 + n * 16 + fr;
        p.out[FC_P + (((size_t)l * PB + b) * 2 + 0) * DFF + col] = acc[7][n][2];
        p.out[FC_P + (((size_t)l * PB + b) * 2 + 1) * DFF + col] = acc[7][n][3];
      }
    }
    return;
  }
  EPI_IDS;
  u16* GU = (u16*)(p.ws + O_GU);
  const bool isS = row0 >= MP;
#pragma unroll
  for (int m = 0; m < 8; ++m) {
    asm volatile("" ::: "memory");
#pragma unroll
    for (int n = 0; n < 4; ++n)
#pragma unroll
      for (int j = 0; j < 4; ++j) {
        const int row = row0 + wr * 128 + m * 16 + fq * 4 + j, col = col0 + wc * 64 + n * 16 + fr;
        const float v = acc[m][n][j];
        GU[(size_t)row * DFF + col] = f2bf(v);
        if (isS) {
          const int rs = row - MP, b = rs >> 5, t = rs & 31;
          if (t >= STT - 2) p.out[FC_S + (((size_t)l * SBT + b) * 2 + (t - (STT - 2))) * DFF + col] = v;
        } else {
          const int b = row >> 13, t = row & 8191;
          if (t >= PT - 2) p.out[FC_P + (((size_t)l * PB + b) * 2 + (t - (PT - 2))) * DFF + col] = v;
        }
      }
  }
}
DI void ffup_tile(const Params& p, int l, int mt, int nt, char* smem) {
  const int row0 = mt * 256, col0 = nt * 256;
  const u16* W = (const u16*)(p.ws + O_WT) + (size_t)l * W_LAYER + W_FU;
  f32x4 acc[8][4];
  zero_acc8(acc);
  gemm512((const u16*)(p.ws + O_XN) + (size_t)row0 * LDK, LDK, W + (size_t)col0 * LDK, LDK, 1024, acc, smem);
  if (mt < 128) {
    EPI_IDS;
    const u16* GUt = (const u16*)(p.ws + O_GU) + (size_t)row0 * DFF + col0;
    if (row0 >= 2) img_load_bf16(GUt - 2 * DFF, DFF, smem, 258, 0); else img_load_bf16(GUt, DFF, smem, 256, 2);
    img_barrier();
    const u16* img = (const u16*)smem + (wr * 128 + fq * 4) * IMG_LD + wc * 64 + fr;
#pragma unroll
    for (int n = 0; n < 4; ++n) {
      const int col = col0 + wc * 64 + n * 16 + fr;
      const float* cw = p.in[30] + (size_t)l * 3 * DFF + col;
      const float w0 = cw[0], w1 = cw[DFF], w2 = cw[2 * DFF], cb = p.in[31][(size_t)l * DFF + col];
#pragma unroll
      for (int m = 0; m < 8; ++m) {
        if ((m & 1) == 0) asm volatile("" ::: "memory");
        const int t = (row0 + wr * 128 + m * 16 + fq * 4) & 8191;
        float g[6];
#pragma unroll
        for (int d = 0; d < 6; ++d) { const float gv = bf2f(img[(m * 16 + d) * IMG_LD + n * 16]); g[d] = (d >= 2 || t - 2 + d >= 0) ? gv : 0.f; }
#pragma unroll
        for (int j = 0; j < 4; ++j) acc[m][n][j] *= gelu_tanh(cb + w0 * g[j] + w1 * g[j + 1] + w2 * g[j + 2]);
      }
    }
    img_barrier();
    img_put_bf16<false>(acc, smem, 2, 1.f, 0, nullptr);
    img_barrier();
    img_store_bf16((u16*)(p.ws + O_FF) + (size_t)row0 * DFF + col0, DFF, smem, 2);
    return;
  }
  EPI_IDS;
  const u16* GU = (const u16*)(p.ws + O_GU);
  u16* FF = (u16*)(p.ws + O_FF);
  const bool isS = row0 >= MP;
  const int rowq = row0 + wr * 128 + fq * 4;
  const unsigned gbase = (unsigned)rowq * (unsigned)DFF + (unsigned)(col0 + wc * 64 + fr);
#pragma unroll
  for (int n = 0; n < 4; ++n) {
    const int col = col0 + wc * 64 + n * 16 + fr;
    const float* cw = p.in[30] + (size_t)l * 3 * DFF + col;
    const float w0 = cw[0], w1 = cw[DFF], w2 = cw[2 * DFF], cb = p.in[31][(size_t)l * DFF + col];
#pragma unroll
    for (int mh = 0; mh < 2; ++mh) {
      asm volatile("" ::: "memory");
      float g[4][6];
#pragma unroll
      for (int m = 0; m < 4; ++m) {
        const int rowb = rowq + (mh * 4 + m) * 16;
        int b, t;
        if (isS) { int rs = rowb - MP; b = rs >> 5; t = rs & 31; } else { b = rowb >> 13; t = rowb & 8191; }
#pragma unroll
        for (int d = 0; d < 6; ++d) {
          const int tt = t - 2 + d;
          if (tt >= 0) g[m][d] = bf2f(GU[gbase + (unsigned)((((mh * 4 + m) * 16 + d) * DFF) + n * 16) - 2u * (unsigned)DFF]);
          else g[m][d] = isS ? p.in[7][(((size_t)l * SBT + b) * 2 + (2 + tt)) * DFF + col] : 0.f;
        }
      }
#pragma unroll
      for (int m = 0; m < 4; ++m)
#pragma unroll
        for (int j = 0; j < 4; ++j) {
          const float gc = cb + w0 * g[m][j] + w1 * g[m][j + 1] + w2 * g[m][j + 2];
          FF[gbase + (unsigned)((((mh * 4 + m) * 16 + j) * DFF) + n * 16)] = f2bf(gelu_tanh(gc) * acc[mh * 4 + m][n][j]);
        }
    }
  }
}

DI void norm_phase(const Params& p, int l, int mode, int B, int G, char* smem) {
  const int tid = TID512(), lane = tid & 63, wid = tid >> 6;
  const float* gamma = mode == 0 ? p.in[8] + (size_t)l * 1024 : (mode == 1 ? p.in[28] + (size_t)l * 1024 : p.in[34]);
  float* wga = (float*)smem;
  if (mode == 0) {
    __syncthreads();
    const float* src = p.in[9] + (size_t)l * 1024 * PW + 3072;
#pragma unroll
    for (int i = 0; i < 8; ++i) {
      const int id = tid + i * 512, k = id >> 2, part = id & 3;
      ((float4*)wga)[(((k >> 8) * 4 + (k & 3)) * 4 + part) * 64 + ((k >> 2) & 63)] = *(const float4*)(src + (size_t)k * PW + part * 4);
    }
    __syncthreads();
  }
  float4 g[4];
#pragma unroll
  for (int i = 0; i < 4; ++i) g[i] = *(const float4*)(gamma + i * 256 + lane * 4);
  for (int row = B * 8 + wid; row < MT; row += G * 8) {
    float* X = p.out + (size_t)row * 1024;
    const float* Xr = (mode == 0 && l == 0 && row < MP) ? p.in[0] + (size_t)row * 1024 : X;
    float4 v[4];
    float ss = 0.f;
#pragma unroll
    for (int i = 0; i < 4; ++i) { v[i] = *(const float4*)(Xr + i * 256 + lane * 4); ss += v[i].x * v[i].x + v[i].y * v[i].y + v[i].z * v[i].z + v[i].w * v[i].w; }
    ss = wave_sum(ss);
    const float rs = rsqrtf(ss * (1.f / 1024.f) + EPS);
    u16* XN = (u16*)(p.ws + O_XN) + (size_t)row * LDK;
#pragma unroll
    for (int i = 0; i < 4; ++i) {
      v[i] = float4{v[i].x * rs * g[i].x, v[i].y * rs * g[i].y, v[i].z * rs * g[i].z, v[i].w * rs * g[i].w};
      if (mode == 2) *(float4*)(X + i * 256 + lane * 4) = v[i];
      else *(uint2*)(XN + i * 256 + lane * 4) = uint2{pack2(v[i].x, v[i].y), pack2(v[i].z, v[i].w)};
    }
    if (mode == 0) {
      float ga[16];
#pragma unroll
      for (int r = 0; r < 16; ++r) ga[r] = 0.f;
#pragma unroll
      for (int i = 0; i < 4; ++i) {
        const float xv[4] = {v[i].x, v[i].y, v[i].z, v[i].w};
#pragma unroll
        for (int e = 0; e < 4; ++e) {
          asm volatile("" ::: "memory");
#pragma unroll
          for (int q = 0; q < 4; ++q) {
            const float4 w = ((const float4*)wga)[((i * 4 + e) * 4 + q) * 64 + lane];
            ga[q * 4 + 0] += xv[e] * w.x; ga[q * 4 + 1] += xv[e] * w.y; ga[q * 4 + 2] += xv[e] * w.z; ga[q * 4 + 3] += xv[e] * w.w;
          }
        }
      }
      float mine = 0.f;
#pragma unroll
      for (int r = 0; r < 16; ++r) { const float s = wave_sum(ga[r]); if (lane == r) mine = s; }
      if (lane < 16) ((float*)(p.ws + O_GA))[(size_t)row * 16 + lane] = mine;
    }
  }
}

#define XB_TMO      128
#define XB_XCNT(j)  (256  + 64 * (j))
#define XB_XSUB(j)  (1280 + 64 * (j))
#define XB_XGEN(j)  (2304 + 64 * (j))
#define XB_TOP      3328
#define XB_TOPGEN   3392
#define XCD_BAR_WORDS 3456
#define XB_SPIN_CAP (1u << 18)
#define LAS __attribute__((address_space(3)))

__device__ __forceinline__ unsigned xb_ld(unsigned* p)              { return __hip_atomic_load(p, __ATOMIC_RELAXED, __HIP_MEMORY_SCOPE_AGENT); }
__device__ __forceinline__ unsigned xb_add(unsigned* p, unsigned v) { return __hip_atomic_fetch_add(p, v, __ATOMIC_RELAXED, __HIP_MEMORY_SCOPE_AGENT); }
__device__ __forceinline__ unsigned xb_xcc_id() { return (unsigned)__builtin_amdgcn_s_getreg((3 << 11) | 20) & 0xFu; }
#define XB_SPIN(cond, bar) do { unsigned _sp = 0; while (cond) { __builtin_amdgcn_s_sleep(1); \
    if ((++_sp & 255u) == 0u) { if (xb_ld(&(bar)[XB_TMO])) break; if (_sp > XB_SPIN_CAP) { atomicAdd(&(bar)[XB_TMO], 1u); break; } } } } while (0)

struct XcdBarrier {
    unsigned* bar; unsigned x;
    volatile LAS unsigned* st;
};

__device__ __forceinline__ XcdBarrier xcd_barrier_post(unsigned* bar, volatile LAS unsigned* st) {
    XcdBarrier b; b.bar = bar; b.x = xb_xcc_id(); b.st = st;
    if (threadIdx.x == 0) (void)xb_add(&bar[XB_XCNT(b.x)], 1u);
    return b;
}
__device__ __forceinline__ void xcd_barrier_complete(unsigned* bar, unsigned x, unsigned& nloc, unsigned& nx) {
    const unsigned G = gridDim.x * gridDim.y * gridDim.z;
    unsigned sum, cnt, mine, sp = 0u;
    for (;;) {
        sum = 0u; cnt = 0u; mine = 0u;
#pragma unroll
        for (unsigned j = 0; j < 16; ++j) { const unsigned c = xb_ld(&bar[XB_XCNT(j)]); sum += c; cnt += (c > 0u) ? 1u : 0u; mine = (j == x) ? c : mine; }
        if (sum == G) break;
        __builtin_amdgcn_s_sleep(1);
        if ((++sp & 255u) == 0u) { if (xb_ld(&bar[XB_TMO])) break; if (sp > XB_SPIN_CAP) { atomicAdd(&bar[XB_TMO], 1u); break; } }
    }
    nloc = mine > 0u ? mine : 1u; nx = cnt > 0u ? cnt : 1u;
}

__device__ __forceinline__ void xcd_barrier(const XcdBarrier& b) {
    asm volatile("s_waitcnt vmcnt(0)" ::: "memory");
    __syncthreads();
    if (threadIdx.x == 0) {
        unsigned* bar = b.bar;
        __builtin_amdgcn_s_waitcnt(0);
        unsigned nloc = b.st[0], nx = b.st[1];
        if (nloc == 0u) { xcd_barrier_complete(bar, b.x, nloc, nx); b.st[0] = nloc; b.st[1] = nx; }
        const unsigned old = xb_add(&bar[XB_XSUB(b.x)], 1u);
        const unsigned gen = old / nloc;
        if (old + 1u == (gen + 1u) * nloc) {
            __builtin_amdgcn_fence(__ATOMIC_RELEASE, "agent");
            asm volatile("s_waitcnt vmcnt(0)" ::: "memory");
            const unsigned og = xb_add(&bar[XB_TOP], 1u);
            const unsigned tg = og / nx;
            if (og + 1u == (tg + 1u) * nx) xb_add(&bar[XB_TOPGEN], 1u);
            else XB_SPIN(xb_ld(&bar[XB_TOPGEN]) == tg, bar);
            __builtin_amdgcn_fence(__ATOMIC_ACQUIRE, "agent");
            xb_add(&bar[XB_XGEN(b.x)], 1u);
            asm volatile("s_waitcnt vmcnt(0)" ::: "memory");
        } else {
            XB_SPIN(xb_ld(&bar[XB_XGEN(b.x)]) == gen, bar);
            __builtin_amdgcn_fence(__ATOMIC_ACQUIRE, "agent");
            asm volatile("s_waitcnt vmcnt(0)" ::: "memory");
        }
    }
    __syncthreads();
}


#ifndef ONLY
#define ONLY -1
#endif
constexpr int HALF_LDS = 73728;
constexpr int SMEM_BYTES = 2 * HALF_LDS;
#define VB() (2 * B + (TID512() >> 8))
#define HS() (smem + (TID512() >> 8) * HALF_LDS)
__global__ void __launch_bounds__(512, 2) mega(Params p) {
  cg::grid_group grid = cg::this_grid();
  extern __shared__ __attribute__((aligned(16))) char smem[];
  const int G = gridDim.x, B = blockIdx.x;
  __shared__ __attribute__((aligned(16))) unsigned xb_words[4];
  if (threadIdx.x < 4) xb_words[threadIdx.x] = 0u;
  __syncthreads();
  const XcdBarrier xb = xcd_barrier_post((unsigned*)(p.ws + O_BAR), (volatile LAS unsigned*)xb_words);
  const int vG = 2 * G;
  if (ONLY < 0 || ONLY == 0) for (int it = VB(); it < PREP_ITEMS; it += vG) prep_item(p, it, HS());
  grid.sync();
  for (int l = 0; l < NL; ++l) {
    const u16* W = (const u16*)(p.ws + O_WT) + (size_t)l * W_LAYER;
    if (ONLY < 0 || ONLY == 1) norm_phase(p, l, 0, B, G, smem);
    xcd_barrier(xb);
    if (ONLY < 0 || ONLY == 2) { int mt, nt; for (int k = 0; xcd_tile(B, G, k, 130, 16, mt, nt); ++k) projin_tile(p, l, mt, nt, smem); for (int it = VB(); it < PB_KC + PB_VC; it += vG) cache_conv_item(p, l, it, HS()); }
    xcd_barrier(xb);
    if (ONLY < 0 || ONLY == 3) {
      for (int k = 0; k < (G == 256 ? 5 : (1088 + G - 1) / G); ++k) {
        bool isS = false; int bh = 0, cp = 0; bool have = true;
        if (G == 256) {
          const int q = B >> 4; bh = B & 15;
          if (k == 0) cp = 63 - q; else if (k == 1) cp = 32 + q; else if (k == 2) cp = 31 - q;
          else if (k == 3) { if (q <= 11) cp = q + 4; else { isS = true; bh = (q - 12) * 16 + (B & 15); } }
          else { if (q >= 12) cp = q - 12; else have = false; }
        } else {
          const int it = B + k * G;
          if (it >= 1088) have = false; else if (it < 1024) { cp = it >> 4; bh = it & 15; } else { isS = true; bh = it - 1024; }
        }
        if (have) attn_item(p, l, isS, isS ? (bh >> 2) : (bh >> 2), bh & 3, cp, smem);
      }
    }
    if (ONLY < 0 || ONLY == 13) for (int it = VB(); it < NGI; it += vG) gla1_item(p, l, it, HS());
    if (ONLY < 0 || ONLY == 14) for (int it = VB(); it < L1_ITEMS; it += vG) lru1_item(p, l, it, HS());
    xcd_barrier(xb);
    if (ONLY < 0 || ONLY == 4) for (int it = VB(); it < G2_ITEMS + L2_ITEMS; it += vG) { if (it < G2_ITEMS) gla2_item(p, l, it); else lru2_item(p, l, it - G2_ITEMS); }
    xcd_barrier(xb);
    if (ONLY < 0 || ONLY == 5) { for (int it = VB(); it < NGI; it += vG) gla3_item(p, l, it, HS()); for (int it = VB(); it < L3_ITEMS; it += vG) lru3_item(p, it); }
    xcd_barrier(xb);
    if (ONLY < 0 || ONLY == 6) { int mt, nt; for (int k = 0; xcd_tile(B, G, k, 130, 12, mt, nt); ++k) ybr_tile(p, l, mt, nt, smem); }
    xcd_barrier(xb);
    if (ONLY < 0 || ONLY == 7) { int mt, nt; for (int k = 0; xcd_tile(B, G, k, 130, 12, mt, nt); ++k) gate_tile(p, l, mt, nt, smem); }
    xcd_barrier(xb);
    if (ONLY < 0 || ONLY == 8) resid_phase(p, (const u16*)(p.ws + O_YP), 3072, W + W_OUT, B, G, l == 0 ? p.in[0] : p.out, smem);
    xcd_barrier(xb);
    if (ONLY < 0 || ONLY == 9) norm_phase(p, l, 1, B, G, smem);
    xcd_barrier(xb);
    if (ONLY < 0 || ONLY == 10) { int mt, nt; for (int k = 0; xcd_tile(B, G, k, 130, 11, mt, nt); ++k) ffgate_tile(p, l, mt, nt, smem); }
    xcd_barrier(xb);
    if (ONLY < 0 || ONLY == 11) { int mt, nt; for (int k = 0; xcd_tile(B, G, k, 130, 11, mt, nt); ++k) ffup_tile(p, l, mt, nt, smem); }
    xcd_barrier(xb);
    if (ONLY < 0 || ONLY == 12) resid_phase(p, (const u16*)(p.ws + O_FF), DFF, W + W_FD, B, G, p.out, smem);
    xcd_barrier(xb);
  }
  if (ONLY < 0 || ONLY == 15) norm_phase(p, 0, 2, B, G, smem);
}

extern "C" void kernel_launch(void* const* d_in, const int* in_sizes, int n_in, void* d_out, int out_size, void* d_ws, size_t ws_size,
                              hipStream_t stream) {
  static int grid_blocks = 0;
  if (!grid_blocks) {
    int dev = 0, cus = 0, per = 0;
    (void)hipGetDevice(&dev);
    (void)hipDeviceGetAttribute(&cus, hipDeviceAttributeMultiprocessorCount, dev);
    (void)hipFuncSetAttribute((const void*)mega, hipFuncAttributeMaxDynamicSharedMemorySize, SMEM_BYTES);
    (void)hipOccupancyMaxActiveBlocksPerMultiprocessor(&per, mega, 512, SMEM_BYTES);
    if (per < 1) per = 1;
    grid_blocks = cus;
  }
  if (ws_size < WS_NEED) fprintf(stderr, "workspace too small: %zu < %zu\n", ws_size, (size_t)WS_NEED);
  Params p{};
  for (int i = 0; i < 35; ++i) p.in[i] = (const float*)d_in[i];
  p.out = (float*)d_out;
  p.ws = (char*)d_ws;
  (void)hipMemsetAsync((char*)d_ws + O_BAR, 0, XCD_BAR_WORDS * sizeof(unsigned), stream);
  void* args[] = {&p};
  hipError_t e = hipLaunchCooperativeKernel((void*)mega, dim3(grid_blocks), dim3(512), args, SMEM_BYTES, stream);
  if (e != hipSuccess) fprintf(stderr, "cooperative launch failed: %s (grid %d)\n", hipGetErrorString(e), grid_blocks);
}
```

```cpp
#include <hip/hip_runtime.h>
#include <hip/hip_cooperative_groups.h>
#include <cstdio>
namespace cg = cooperative_groups;

#define DI __device__ __forceinline__
typedef unsigned short u16;
using bf16x8 = __attribute__((ext_vector_type(8))) short;
using f32x4 = __attribute__((ext_vector_type(4))) float;
using u32x4 = __attribute__((ext_vector_type(4))) unsigned;
#define MFMA16(a, b, c) __builtin_amdgcn_mfma_f32_16x16x32_bf16((a), (b), (c), 0, 0, 0)

constexpr int DM = 1024, PB = 4, PT = 8192, SBT = 16, STT = 32, PAST = 2048, NL = 4;
constexpr int MP = PB * PT, MS = SBT * STT, MT = MP + MS;
constexpr int SKP = 2112;
constexpr int SKV = PAST + STT;
constexpr int DFF = 2816, PW = 4112, PWP = 4224;
constexpr int NGI = PB * 4 * 128 + SBT * 4;
constexpr int NLC = MP / 64 + SBT;
constexpr float EPS = 1e-6f;
constexpr float QSCALE = 0.125f * 1.4426950408889634f;
constexpr int LDK = 1088;

constexpr size_t W_IN = 0, W_MG = W_IN + (size_t)4096 * LDK, W_BR = W_MG + (size_t)3072 * LDK, W_OUT = W_BR + (size_t)3 * 1024 * 512,
                 W_FG = W_OUT + (size_t)1024 * 3072, W_FU = W_FG + (size_t)DFF * LDK, W_FD = W_FU + (size_t)DFF * LDK,
                 W_WA = W_FD + (size_t)1024 * DFF, W_WX = W_WA + 32768, W_LAYER = W_WX + 32768;

struct Params {
  const float* in[35];
  float* out;
  char* ws;
};

constexpr size_t al(size_t x) { return (x + 255) & ~(size_t)255; }
constexpr size_t O_WT = 0;
constexpr size_t O_ROPE = al(O_WT + W_LAYER * NL * 2);
constexpr size_t O_LAM = al(O_ROPE + 2 * 8192 * 8 * 4);
constexpr size_t O_BAR = al(O_LAM + 256);
constexpr size_t O_XN = al(O_BAR + 4096 * 4);
constexpr size_t O_REG = al(O_XN + (size_t)MT * LDK * 2);
constexpr size_t O_QB = O_REG;
constexpr size_t O_KB = al(O_QB + (size_t)MT * 512 * 2);
constexpr size_t O_KS = al(O_KB + (size_t)MP * 512 * 2);
constexpr size_t O_VT = al(O_KS + (size_t)SBT * SKP * 512 * 2);
constexpr size_t O_VTS = al(O_VT + (size_t)MP * 512 * 2);
constexpr size_t O_GQ = al(O_VTS + (size_t)SBT * SKP * 512 * 2);
constexpr size_t O_GK = al(O_GQ + (size_t)MT * 256 * 2);
constexpr size_t O_GV = al(O_GK + (size_t)MT * 256 * 2);
constexpr size_t O_GR = al(O_GV + (size_t)MT * 512 * 2);
constexpr size_t O_GA = al(O_GR + (size_t)MT * 512 * 2);
constexpr size_t O_LX = al(O_GA + (size_t)MT * 16 * 4);
constexpr size_t O_LG = al(O_LX + (size_t)MT * 512 * 4);
constexpr size_t O_KVT = al(O_LG + (size_t)MT * 512 * 2);
constexpr size_t O_DEC = al(O_KVT + (size_t)NGI * 8192 * 2);
constexpr size_t O_HL = al(O_DEC + (size_t)NGI * 64 * 4);
constexpr size_t O_PP = al(O_HL + (size_t)MT * 512 * 2);
constexpr size_t O_CA = al(O_PP + (size_t)MT * 512 * 2);
constexpr size_t O_CH = al(O_CA + (size_t)NLC * 512 * 4);
constexpr size_t O_HS = al(O_CH + (size_t)NLC * 512 * 4);
constexpr size_t O_OA = al(O_HS + (size_t)NLC * 512 * 4);
constexpr size_t O_OG = al(O_OA + (size_t)MT * 512 * 2);
constexpr size_t O_OL = al(O_OG + (size_t)MT * 512 * 2);
constexpr size_t O_END1 = al(O_OL + (size_t)MT * 512 * 2);
constexpr size_t O_YP = O_QB;
static_assert(O_YP + (size_t)MT * 3072 * 2 <= O_OA, "Y buffer overlaps live mixer outputs");
constexpr size_t O_GU = O_REG;
constexpr size_t O_FF = al(O_GU + (size_t)MT * DFF * 2);
constexpr size_t O_END2 = al(O_FF + (size_t)MT * DFF * 2);
constexpr size_t WS_NEED = O_END1 > O_END2 ? O_END1 : O_END2;

constexpr size_t Y_P = 0, Y_S = Y_P + (size_t)MP * 1024, K_P = Y_S + (size_t)MS * 1024, V_P = K_P + (size_t)NL * MP * 512,
                 GLA_P = V_P + (size_t)NL * MP * 512, LC_P = GLA_P + (size_t)NL * PB * 32768, LH_P = LC_P + (size_t)NL * PB * 3 * 512,
                 FC_P = LH_P + (size_t)NL * PB * 512, K_S = FC_P + (size_t)NL * PB * 2 * DFF, V_S = K_S + (size_t)NL * MS * 512,
                 GLA_S = V_S + (size_t)NL * MS * 512, LC_S = GLA_S + (size_t)NL * SBT * 32768, LH_S = LC_S + (size_t)NL * SBT * 3 * 512,
                 FC_S = LH_S + (size_t)NL * SBT * 512, OUT_TOTAL = FC_S + (size_t)NL * SBT * 2 * DFF;

DI int TID() { int t = threadIdx.x & 255; asm volatile("" : "+v"(t)); return t; }
DI int TID512() { int t = threadIdx.x; asm volatile("" : "+v"(t)); return t; }
DI u16 f2bf(float x) { __bf16 h = (__bf16)x; return __builtin_bit_cast(u16, h); }
DI float bf2f(u16 h) { return __uint_as_float(((unsigned)h) << 16); }
typedef __bf16 bf16v2_t __attribute__((ext_vector_type(2)));
typedef float f32v2_t __attribute__((ext_vector_type(2)));
DI unsigned pack2(float a, float b) { f32v2_t v = {a, b}; bf16v2_t r = __builtin_convertvector(v, bf16v2_t); return __builtin_bit_cast(unsigned, r); }
DI float sigmoidf_(float x) { return __builtin_amdgcn_rcpf(1.f + __expf(-x)); }
DI float gelu_tanh(float x) { float u = 0.7978845608028654f * (x + 0.044715f * x * x * x); return x * sigmoidf_(2.f * u); }
DI float softplusf_(float x) { return fmaxf(x, 0.f) + __logf(1.f + __expf(-fabsf(x))); }
DI float quad_max(float v) {
  auto a = __builtin_amdgcn_permlane16_swap(__float_as_uint(v), __float_as_uint(v), false, false);
  v = fmaxf(__uint_as_float(a[0]), __uint_as_float(a[1]));
  auto b = __builtin_amdgcn_permlane32_swap(__float_as_uint(v), __float_as_uint(v), false, false);
  return fmaxf(__uint_as_float(b[0]), __uint_as_float(b[1]));
}
DI float wave_sum(float v) {
  for (int o = 32; o > 0; o >>= 1) v += __shfl_xor(v, o);
  return v;
}

DI void gemm512(const u16* __restrict__ A, int lda, const u16* __restrict__ B, int ldb, int K, f32x4 (&acc)[8][4], char* smem) {
  const int tid = TID512(), lane = tid & 63, wid = tid >> 6, wr = wid >> 2, wc = wid & 3, fr = lane & 15, fq = lane >> 4;
  const int lrow = tid >> 3;
  const int gch = (tid & 7) ^ ((lrow >> 1) & 7);
  const unsigned aov = (unsigned)(lrow * lda + gch * 8);
  const unsigned bov = (unsigned)(lrow * ldb + gch * 8);
  const int soff = tid * 16;
  const int sw = (fr >> 1) & 7;
  const int aoff = (wr * 128 + fr) * 128, boff = 32768 + (wc * 64 + fr) * 128;
  const int nk = K >> 6;
  asm volatile("s_waitcnt lgkmcnt(0)" ::: "memory");
  __builtin_amdgcn_s_barrier();
#pragma unroll
  for (int i = 0; i < 4; ++i) {
    __builtin_amdgcn_global_load_lds((const unsigned*)((A + (size_t)i * 64 * lda) + aov), (unsigned*)(smem + soff + i * 8192), 16, 0, 0);
    __builtin_amdgcn_global_load_lds((const unsigned*)((B + (size_t)i * 64 * ldb) + bov), (unsigned*)(smem + 32768 + soff + i * 8192), 16, 0, 0);
  }
  asm volatile("s_waitcnt vmcnt(0)" ::: "memory");
  __builtin_amdgcn_s_barrier();
  for (int kt = 0; kt < nk; ++kt) {
    const int buf = kt & 1;
    const bool more = kt + 1 < nk;
    char* st = smem + (buf ^ 1) * 65536 + soff;
    const u16* An = A + (kt + 1) * 64;
    const u16* Bn = B + (kt + 1) * 64;
    const char* Sb = smem + buf * 65536;
#pragma unroll
    for (int ks = 0; ks < 2; ++ks) {
      const int co = ((ks * 4 + fq) ^ sw) << 4;
      bf16x8 bfr[4], af[8];
#pragma unroll
      for (int n = 0; n < 4; ++n) bfr[n] = *(const bf16x8*)(Sb + boff + n * 2048 + co);
#pragma unroll
      for (int m = 0; m < 8; ++m) af[m] = *(const bf16x8*)(Sb + aoff + m * 2048 + co);
      __builtin_amdgcn_sched_barrier(0);
#pragma unroll
      for (int g = 0; g < 4; ++g) {
#pragma unroll
        for (int mm = 0; mm < 2; ++mm)
#pragma unroll
          for (int n = 0; n < 4; ++n) acc[g * 2 + mm][n] = MFMA16(af[g * 2 + mm], bfr[n], acc[g * 2 + mm][n]);
        __builtin_amdgcn_sched_barrier(0);
        if (more && ks == 0) {
          __builtin_amdgcn_global_load_lds((const unsigned*)((An + (size_t)g * 64 * lda) + aov), (unsigned*)(st + g * 8192), 16, 0, 0);
          __builtin_amdgcn_global_load_lds((const unsigned*)((Bn + (size_t)g * 64 * ldb) + bov), (unsigned*)(st + 32768 + g * 8192), 16, 0, 0);
        }
        __builtin_amdgcn_sched_barrier(0);
      }
    }
    asm volatile("s_waitcnt vmcnt(0) lgkmcnt(0)" ::: "memory");
    __builtin_amdgcn_s_barrier();
  }
}
DI void zero_acc8(f32x4 (&acc)[8][4]) {
#pragma unroll
  for (int m = 0; m < 8; ++m)
#pragma unroll
    for (int n = 0; n < 4; ++n) acc[m][n] = f32x4{0.f, 0.f, 0.f, 0.f};
}
#define EPI_IDS const int tid = TID512(), lane = tid & 63, wid = tid >> 6, wr = wid >> 2, wc = wid & 3, fr = lane & 15, fq = lane >> 4


constexpr int IMG_LD = 264;
constexpr int IMGF_LD = 260;
DI void img_barrier() { asm volatile("s_waitcnt lgkmcnt(0)" ::: "memory"); __builtin_amdgcn_s_barrier(); }
template <bool ROPE>
DI float epi_val(const f32x4 (&acc)[8][4], int m, int n, int j, const float* cs4, const float* sn4, int fr) {
  float v = acc[m][n][j];
  if (ROPE && n == 0) {
    const float pr = __shfl_xor(v, 8);
    v = (fr < 8) ? v * cs4[j] - pr * sn4[j] : v * cs4[j] + pr * sn4[j];
  }
  return v;
}
template <bool ROPE>
DI void img_put_bf16(const f32x4 (&acc)[8][4], char* smem, int rowoff, float scale, int prow0, const float* cosT) {
  EPI_IDS;
  u16* img = (u16*)smem + (wr * 128 + fq * 4 + rowoff) * IMG_LD + wc * 64 + fr;
#pragma unroll
  for (int m = 0; m < 8; ++m) {
    float cs4[4] = {0.f, 0.f, 0.f, 0.f}, sn4[4] = {0.f, 0.f, 0.f, 0.f};
    if (ROPE) {
#pragma unroll
      for (int j = 0; j < 4; ++j) { const int pos = prow0 + wr * 128 + m * 16 + fq * 4 + j; cs4[j] = cosT[pos * 8 + (fr & 7)]; sn4[j] = cosT[8192 * 8 + pos * 8 + (fr & 7)]; }
    }
#pragma unroll
    for (int n = 0; n < 4; ++n)
#pragma unroll
      for (int j = 0; j < 4; ++j) img[(m * 16 + j) * IMG_LD + n * 16] = f2bf(epi_val<ROPE>(acc, m, n, j, cs4, sn4, fr) * scale);
  }
}
DI void img_store_bf16(u16* dst, int ld, const char* smem, int rowoff) {
  const int tid = TID512();
#pragma unroll
  for (int q = 0; q < 16; ++q) {
    const int slot = tid + q * 512, row = slot >> 5, c16 = slot & 31;
    *(u32x4*)(dst + (size_t)row * ld + c16 * 8) = *(const u32x4*)(smem + (row + rowoff) * (IMG_LD * 2) + c16 * 16);
  }
}
DI void img_load_bf16(const u16* src, int ld, char* smem, int nrows, int rowoff) {
  for (int slot = TID512(); slot < nrows * 32; slot += 512) {
    const int row = slot >> 5, c16 = slot & 31;
    *(u32x4*)(smem + (row + rowoff) * (IMG_LD * 2) + c16 * 16) = *(const u32x4*)(src + (size_t)row * ld + c16 * 8);
  }
}
template <bool ROPE>
DI void imgf_put(const f32x4 (&acc)[8][4], int h, char* smem, int prow0, const float* cosT) {
  EPI_IDS;
  if (wr == h) {
    float* f = (float*)smem + (fq * 4) * IMGF_LD + wc * 64 + fr;
#pragma unroll
    for (int m = 0; m < 8; ++m) {
      float cs4[4] = {0.f, 0.f, 0.f, 0.f}, sn4[4] = {0.f, 0.f, 0.f, 0.f};
      if (ROPE) {
#pragma unroll
        for (int j = 0; j < 4; ++j) { const int pos = prow0 + wr * 128 + m * 16 + fq * 4 + j; cs4[j] = cosT[pos * 8 + (fr & 7)]; sn4[j] = cosT[8192 * 8 + pos * 8 + (fr & 7)]; }
      }
#pragma unroll
      for (int n = 0; n < 4; ++n)
#pragma unroll
        for (int j = 0; j < 4; ++j) f[(m * 16 + j) * IMGF_LD + n * 16] = epi_val<ROPE>(acc, m, n, j, cs4, sn4, fr);
    }
  }
}
template <bool ADD>
DI void imgf_store(float* dst, const float* rsrc, int ld, const char* smem) {
  const int tid = TID512();
  const unsigned o0 = (unsigned)((tid >> 6) * ld + (tid & 63) * 4);
  const char* src = smem + (tid >> 6) * (IMGF_LD * 4) + (tid & 63) * 16;
#pragma unroll
  for (int q = 0; q < 16; ++q) {
    if ((q & 3) == 0) asm volatile("" ::: "memory");
    float4 v = *(const float4*)(src + q * 8 * (IMGF_LD * 4));
    float4* d = (float4*)(dst + (o0 + (unsigned)(q * 8 * ld)));
    if (ADD) { const float4 x = *(const float4*)(rsrc + (o0 + (unsigned)(q * 8 * ld))); v.x += x.x; v.y += x.y; v.z += x.z; v.w += x.w; }
    if (ADD) *d = v;
    else __builtin_nontemporal_store(f32x4{v.x, v.y, v.z, v.w}, (f32x4*)d);
  }
}
template <bool ADD, bool ROPE>
DI void tile_out_f32(const f32x4 (&acc)[8][4], float* dst, int ld, char* smem, int prow0, const float* cosT, const float* rsrc = nullptr) {
#pragma unroll 1
  for (int h = 0; h < 2; ++h) {
    img_barrier();
    imgf_put<ROPE>(acc, h, smem, prow0, cosT);
    img_barrier();
    imgf_store<ADD>(dst + (size_t)h * 128 * ld, ADD ? rsrc + (size_t)h * 128 * ld : nullptr, ld, smem);
  }
}
template <bool ROPE>
DI void tile_out_bf16(const f32x4 (&acc)[8][4], u16* dst, int ld, char* smem, float scale, int prow0, const float* cosT) {
  img_barrier();
  img_put_bf16<ROPE>(acc, smem, 0, scale, prow0, cosT);
  img_barrier();
  img_store_bf16(dst, ld, smem, 0);
}

template <int KS>
DI f32x4 lds_mm(const u16* As, int lsa, int arow, const u16* Bs, int lsb, int brow, f32x4 acc) {
  const int lane = TID() & 63, fr = lane & 15, fq = lane >> 4;
#pragma unroll
  for (int ks = 0; ks < KS; ++ks) {
    bf16x8 a = *(const bf16x8*)(As + (arow + fr) * lsa + ks * 32 + fq * 8);
    bf16x8 b = *(const bf16x8*)(Bs + (brow + fr) * lsb + ks * 32 + fq * 8);
    acc = MFMA16(a, b, acc);
  }
  return acc;
}

constexpr int PREP_T_PER_LAYER = 64 * 16 + 48 * 16 + 3 * 128 + 3 * 256 + 3 * 704 + 16;
constexpr int PREP_T = PREP_T_PER_LAYER * NL;
constexpr int PREP_COPY = MS * 1024 / 4096;
constexpr int PREP_ROPE = 8192 * 8 / 256;
constexpr int PREP_ITEMS = PREP_T + PREP_COPY + PREP_ROPE + 2;

DI void transpose_tile(const float* src, int lds_, int k0, int c0, int ncols_valid, u16* dst, int ldd, int n0, float* tile) {
  const int tid = TID();
  __syncthreads();
#pragma unroll
  for (int i = 0; i < 16; ++i) {
    int e = tid + i * 256, r = e >> 6, c = e & 63;
    tile[r * 65 + c] = (c < ncols_valid) ? __builtin_nontemporal_load(&src[(size_t)(k0 + r) * lds_ + c0 + c]) : 0.f;
  }
  __syncthreads();
#pragma unroll
  for (int i = 0; i < 16; ++i) {
    int e = tid + i * 256, c = e >> 6, r = e & 63;
    dst[(size_t)(n0 + c) * ldd + k0 + r] = f2bf(tile[r * 65 + c]);
  }
}

DI void prep_item(const Params& p, int it, char* smem) {
  const int tid = TID();
  if (it < PREP_T) {
    const int l = it / PREP_T_PER_LAYER;
    int t = it % PREP_T_PER_LAYER;
    u16* W = (u16*)(p.ws + O_WT) + (size_t)l * W_LAYER;
    float* tile = (float*)smem;
    if (t < 64 * 16) {
      int nt = t / 16, kt = t % 16, n0 = nt * 64;
      const int c0 = n0 < 3072 ? n0 : n0 + 16;
      transpose_tile(p.in[9] + (size_t)l * 1024 * PW, PW, kt * 64, c0, 64, W + W_IN, LDK, n0, tile);
      return;
    }
    t -= 64 * 16;
    if (t < 48 * 16) { transpose_tile(p.in[25] + (size_t)l * 1024 * 3072, 3072, (t % 16) * 64, (t / 16) * 64, 64, W + W_MG, LDK, (t / 16) * 64, tile); return; }
    t -= 48 * 16;
    if (t < 3 * 128) {
      int br = t / 128, tt = t % 128;
      transpose_tile(p.in[22 + br] + (size_t)l * 512 * 1024, 1024, (tt % 8) * 64, (tt / 8) * 64, 64, W + W_BR + (size_t)br * 1024 * 512, 512, (tt / 8) * 64, tile);
      return;
    }
    t -= 3 * 128;
    if (t < 768) { const int cp = t / 256, tt = t % 256; transpose_tile(p.in[27] + (size_t)l * 1024 * 1024, 1024, (tt % 16) * 64, (tt / 16) * 64, 64, W + W_OUT + cp * 1024, 3072, (tt / 16) * 64, tile); return; }
    t -= 768;
    if (t < 704) { transpose_tile(p.in[29] + (size_t)l * 1024 * DFF, DFF, (t % 16) * 64, (t / 16) * 64, 64, W + W_FG, LDK, (t / 16) * 64, tile); return; }
    t -= 704;
    if (t < 704) { transpose_tile(p.in[32] + (size_t)l * 1024 * DFF, DFF, (t % 16) * 64, (t / 16) * 64, 64, W + W_FU, LDK, (t / 16) * 64, tile); return; }
    t -= 704;
    if (t < 704) { transpose_tile(p.in[33] + (size_t)l * DFF * 1024, 1024, (t % 44) * 64, (t / 44) * 64, 64, W + W_FD, DFF, (t / 44) * 64, tile); return; }
    t -= 704;
    if (t < 8) { transpose_tile(p.in[17] + (size_t)l * 32768 + t * 4096, 64, 0, 0, 64, W + W_WA + t * 4096, 64, 0, tile); return; }
    t -= 8;
    transpose_tile(p.in[19] + (size_t)l * 32768 + t * 4096, 64, 0, 0, 64, W + W_WX + t * 4096, 64, 0, tile);
    return;
  }
  it -= PREP_T;
  if (it < PREP_COPY) {
    const size_t base = (size_t)it * 4096;
#pragma unroll
    for (int i = 0; i < 4; ++i) {
      const size_t e = base + (size_t)(tid + i * 256) * 4;
      *(float4*)(p.out + (size_t)MP * 1024 + e) = *(const float4*)(p.in[1] + e);
    }
    return;
  }
  it -= PREP_COPY;
  if (it < PREP_ROPE) {
    int e = it * 256 + tid, pos = e >> 3, i = e & 7;
    double inv = pow(500000.0, -(double)i / 8.0);
    double ang = (double)pos * inv;
    double kq = rint(ang * 0.15915494309189535);
    double r = ang - kq * 6.283185307179586;
    float rf = (float)r;
    float* cs = (float*)(p.ws + O_ROPE);
    cs[e] = cosf(rf);
    cs[8192 * 8 + e] = sinf(rf);
    return;
  }
  if (it == PREP_ROPE && tid < 64 * NL) {
    int l = tid >> 6, i = tid & 63;
    const float* lq = p.in[10] + (size_t)l * 256;
    float a = lq[i] * lq[64 + i], b = lq[128 + i] * lq[192 + i];
    a = wave_sum(a); b = wave_sum(b);
    if (i == 0) {
      float lam_init = 0.8f - 0.6f * __expf(-0.3f * (float)l);
      ((float*)(p.ws + O_LAM))[l] = __expf(a) - __expf(b) + lam_init;
    }
  }
}

DI bool xcd_tile(int B, int G, int iter, int MTILES, int NT, int& mt, int& nt) {
  const int nxb = G >> 3;
  const int x = B & 7, lb = B >> 3;
  const int q = MTILES >> 3, r = MTILES & 7;
  const int mx = q + (x < r ? 1 : 0);
  const int mbase = x * q + (x < r ? x : r);
  const int j = lb + iter * nxb;
  if (j >= mx * NT) return false;
  const int band = j / (8 * NT);
  const int rem = j - band * 8 * NT;
  const int nb = (mx - band * 8) < 8 ? (mx - band * 8) : 8;
  mt = mbase + band * 8 + rem % nb;
  nt = rem / nb;
  return true;
}

constexpr int PB_KC = SBT * PAST * 512 / 4096;
constexpr int PB_VC = SBT * 32 * 8;

DI void projin_tile(const Params& p, int l, int mt, int nt, char* smem) {
  const int row0 = mt * 256, col0 = nt * 256;
  const u16* W = (const u16*)(p.ws + O_WT) + (size_t)l * W_LAYER + W_IN;
  const u16* XN = (const u16*)(p.ws + O_XN);
  f32x4 acc[8][4];
  zero_acc8(acc);
  gemm512(XN + (size_t)row0 * LDK, LDK, W + (size_t)col0 * LDK, LDK, 1024, acc, smem);
  const float* cosT = (const float*)(p.ws + O_ROPE);
  const float* sinT = cosT + 8192 * 8;
  if (mt < 128) {
    const int prow0 = row0 & 8191;
    if (nt < 2) {
      tile_out_bf16<true>(acc, (u16*)(p.ws + O_QB) + (size_t)row0 * 512 + col0, 512, smem, QSCALE, prow0, cosT);
    } else if (nt < 4) {
      tile_out_f32<false, true>(acc, p.out + K_P + ((size_t)l * MP + row0) * 512 + (col0 - 512), 512, smem, prow0, cosT);
      tile_out_bf16<true>(acc, (u16*)(p.ws + O_KB) + (size_t)row0 * 512 + (col0 - 512), 512, smem, 1.f, prow0, cosT);
    } else if (nt < 6) {
      tile_out_f32<false, false>(acc, p.out + V_P + ((size_t)l * MP + row0) * 512 + (col0 - 1024), 512, smem, 0, nullptr);
      EPI_IDS;
      u16* VT = (u16*)(p.ws + O_VT);
      const unsigned vb = (unsigned)((row0 >> 13) * 512 + (col0 - 1024) + wc * 64 + fr) * (unsigned)PT + (unsigned)((row0 & 8191) + wr * 128 + fq * 4);
#pragma unroll
      for (int m = 0; m < 8; ++m) {
        asm volatile("" ::: "memory");
#pragma unroll
        for (int n = 0; n < 4; ++n) {
          const uint2 pk = {pack2(acc[m][n][0], acc[m][n][1]), pack2(acc[m][n][2], acc[m][n][3])};
          *(uint2*)(VT + (vb + (unsigned)(n * 16 * PT + m * 16))) = pk;
        }
      }
    } else if (nt >= 12 && nt < 14) {
      tile_out_f32<false, false>(acc, (float*)(p.ws + O_LX) + (size_t)row0 * 512 + (col0 - 3072), 512, smem, 0, nullptr);
    } else {
      u16* dst; int ld = 512, cbase;
      if (nt == 6) { dst = (u16*)(p.ws + O_GQ); ld = 256; cbase = 1536; }
      else if (nt == 7) { dst = (u16*)(p.ws + O_GK); ld = 256; cbase = 1792; }
      else if (nt < 10) { dst = (u16*)(p.ws + O_GV); cbase = 2048; }
      else if (nt < 12) { dst = (u16*)(p.ws + O_GR); cbase = 2560; }
      else { dst = (u16*)(p.ws + O_LG); cbase = 3584; }
      tile_out_bf16<false>(acc, dst + (size_t)row0 * ld + (col0 - cbase), ld, smem, nt == 6 ? 0.125f : 1.f, 0, nullptr);
    }
    return;
  }
  EPI_IDS;
  const bool isS = row0 >= MP;
  if (nt < 4) {
    const bool isq = nt < 2;
    u16* QB = (u16*)(p.ws + O_QB);
    u16* KB = (u16*)(p.ws + O_KB);
    u16* KS = (u16*)(p.ws + O_KS);
#pragma unroll
    for (int m = 0; m < 8; ++m) {
      asm volatile("" ::: "memory");
#pragma unroll
      for (int n = 0; n < 4; ++n)
#pragma unroll
        for (int j = 0; j < 4; ++j) {
          const int row = row0 + wr * 128 + m * 16 + fq * 4 + j;
          const int col = col0 + wc * 64 + n * 16 + fr;
          float v = acc[m][n][j];
          int b, t;
          if (isS) { int rs = row - MP; b = rs >> 5; t = rs & 31; } else { b = row >> 13; t = row & 8191; }
          const int pos = isS ? PAST + t : t;
          if (n == 0) {
            float pr = __shfl_xor(v, 8);
            float cs = cosT[pos * 8 + (fr & 7)], sn = sinT[pos * 8 + (fr & 7)];
            v = (fr < 8) ? v * cs - pr * sn : v * cs + pr * sn;
          }
          if (isq) {
            QB[(size_t)row * 512 + col] = f2bf(v * QSCALE);
          } else {
            const int ck = col - 512;
            if (isS) {
              p.out[K_S + ((size_t)l * MS + (row - MP)) * 512 + ck] = v;
              KS[((size_t)b * SKP + PAST + t) * 512 + ck] = f2bf(v);
            } else {
              p.out[K_P + ((size_t)l * MP + row) * 512 + ck] = v;
              KB[(size_t)row * 512 + ck] = f2bf(v);
            }
          }
        }
    }
  } else if (nt < 6) {
    u16* VT = (u16*)(p.ws + O_VT);
    u16* VTS = (u16*)(p.ws + O_VTS);
#pragma unroll
    for (int m = 0; m < 8; ++m) {
      asm volatile("" ::: "memory");
#pragma unroll
      for (int n = 0; n < 4; ++n) {
        const int rowb = row0 + wr * 128 + m * 16 + fq * 4;
        const int cv = col0 - 1024 + wc * 64 + n * 16 + fr;
        const int h = cv >> 7, vd = cv & 127;
        int b, t;
        if (isS) { int rs = rowb - MP; b = rs >> 5; t = rs & 31; } else { b = rowb >> 13; t = rowb & 8191; }
#pragma unroll
        for (int j = 0; j < 4; ++j) {
          if (isS) p.out[V_S + ((size_t)l * MS + (rowb + j - MP)) * 512 + cv] = acc[m][n][j];
          else p.out[V_P + ((size_t)l * MP + rowb + j) * 512 + cv] = acc[m][n][j];
        }
        uint2 pk = {pack2(acc[m][n][0], acc[m][n][1]), pack2(acc[m][n][2], acc[m][n][3])};
        if (isS) *(uint2*)(VTS + ((size_t)(b * 4 + h) * 128 + vd) * SKP + PAST + t) = pk;
        else *(uint2*)(VT + ((size_t)(b * 4 + h) * 128 + vd) * PT + t) = pk;
      }
    }
  } else {
    u16* dst16 = nullptr; float* dst32 = nullptr; int ld = 512, cbase = 0; float scale = 1.f;
    if (nt == 6) { dst16 = (u16*)(p.ws + O_GQ); ld = 256; cbase = 1536; scale = 0.125f; }
    else if (nt == 7) { dst16 = (u16*)(p.ws + O_GK); ld = 256; cbase = 1792; }
    else if (nt < 10) { dst16 = (u16*)(p.ws + O_GV); cbase = 2048; }
    else if (nt < 12) { dst16 = (u16*)(p.ws + O_GR); cbase = 2560; }
    else if (nt < 14) { dst32 = (float*)(p.ws + O_LX); cbase = 3072; }
    else { dst16 = (u16*)(p.ws + O_LG); cbase = 3584; }
#pragma unroll
    for (int m = 0; m < 8; ++m) {
      asm volatile("" ::: "memory");
#pragma unroll
      for (int n = 0; n < 4; ++n)
#pragma unroll
        for (int j = 0; j < 4; ++j) {
          const int row = row0 + wr * 128 + m * 16 + fq * 4 + j;
          const int c = col0 + wc * 64 + n * 16 + fr - cbase;
          const float v = acc[m][n][j] * scale;
          if (dst16) dst16[(size_t)row * ld + c] = f2bf(v);
          else dst32[(size_t)row * ld + c] = v;
        }
    }
  }
}

DI void cache_conv_item(const Params& p, int l, int it, char* smem) {
  const int tid = TID();
  if (it < PB_KC) {
    const float* src = p.in[2] + (size_t)l * SBT * PAST * 512;
    u16* KS = (u16*)(p.ws + O_KS);
#pragma unroll
    for (int i = 0; i < 4; ++i) {
      size_t e = (size_t)it * 4096 + (size_t)(tid + i * 256) * 4;
      const f32x4 vv = __builtin_nontemporal_load((const f32x4*)(src + e));
      const float4 v = {vv[0], vv[1], vv[2], vv[3]};
      size_t b = e / ((size_t)PAST * 512), r = e % ((size_t)PAST * 512);
      *(uint2*)(KS + b * SKP * 512 + r) = uint2{pack2(v.x, v.y), pack2(v.z, v.w)};
    }
    return;
  }
  it -= PB_KC;
  const int b = it / 256, r = it % 256, ptile = r / 8, ctile = r % 8;
  const float* src = p.in[3] + ((size_t)l * SBT + b) * PAST * 512;
  u16* VTS = (u16*)(p.ws + O_VTS);
  transpose_tile(src, 512, ptile * 64, ctile * 64, 64, VTS + (size_t)b * 512 * SKP, SKP, ctile * 64, (float*)smem);
}

DI int kswz(int key) { return (((key >> 3) & 3) << 2) | (key & 3); }

DI void attn_item(const Params& p, int l, bool isS, int b, int h, int cp, char* smem) {
  const int tid = TID512(), lane = tid & 63, wid = tid >> 6, fr = lane & 15, fq = lane >> 4;
  const int nkt = isS ? 33 : 2 * cp + 2;
  const int klen = isS ? SKV : nkt * 64;
  const int mykt = isS ? 33 : (wid < 4 ? 2 * cp + 1 : 2 * cp + 2);
  const u16* QB = (const u16*)(p.ws + O_QB);
  const u16* Kg = isS ? (const u16*)(p.ws + O_KS) + (size_t)b * SKP * 512 + h * 128 : (const u16*)(p.ws + O_KB) + (size_t)b * PT * 512 + h * 128;
  const int vstride = isS ? SKP : PT;
  const u16* Vg = (isS ? (const u16*)(p.ws + O_VTS) : (const u16*)(p.ws + O_VT)) + (size_t)(b * 4 + h) * 128 * vstride;
  const int qrow0 = isS ? MP + b * 32 : b * PT + cp * 128;
  const bool wactive = isS ? (wid < 2) : true;
  const int qrow = qrow0 + wid * 16 + fr;
  bf16x8 qf[2][2];
#pragma unroll
  for (int mp = 0; mp < 2; ++mp)
#pragma unroll
    for (int ks = 0; ks < 2; ++ks)
      qf[mp][ks] = wactive ? *(const bf16x8*)(QB + (size_t)qrow * 512 + h * 128 + mp * 64 + ks * 32 + fq * 8) : bf16x8{0, 0, 0, 0, 0, 0, 0, 0};
  f32x4 ot[2][8];
#pragma unroll
  for (int mp = 0; mp < 2; ++mp)
#pragma unroll
    for (int n = 0; n < 8; ++n) ot[mp][n] = f32x4{0.f, 0.f, 0.f, 0.f};
  float mrun[2] = {-INFINITY, -INFINITY}, lrun[2] = {0.f, 0.f};
  char* Ks = smem;
  char* Vs = smem + 32768;
  const int kkey = tid >> 4, vvd = tid >> 3;
  const int kgch = (tid & 15) ^ kswz(kkey);
  const int vgch = (tid & 7) ^ ((vvd >> 1) & 7);
  const int soff = tid * 16;
  auto issue_k = [&](int kt) {
#pragma unroll
    for (int i = 0; i < 2; ++i)
      __builtin_amdgcn_global_load_lds((const unsigned*)(Kg + (size_t)(kt * 64 + kkey + i * 32) * 512 + kgch * 8), (unsigned*)(Ks + (kt & 1) * 16384 + soff + i * 8192), 16, 0, 0);
  };
  auto issue_v = [&](int kt) {
#pragma unroll
    for (int i = 0; i < 2; ++i)
      __builtin_amdgcn_global_load_lds((const unsigned*)(Vg + (size_t)(vvd + i * 64) * vstride + kt * 64 + vgch * 8), (unsigned*)(Vs + (kt & 1) * 16384 + soff + i * 8192), 16, 0, 0);
  };
  auto qk_tile = [&](int kt, f32x4 (&st)[2][4]) {
    const char* Kb = Ks + (kt & 1) * 16384;
    bf16x8 kf[2][4][2];
#pragma unroll
    for (int mp = 0; mp < 2; ++mp)
#pragma unroll
      for (int mt = 0; mt < 4; ++mt) {
        const int key = 32 * (mt >> 1) + 8 * (fr >> 2) + 4 * (mt & 1) + (fr & 3);
#pragma unroll
        for (int ks = 0; ks < 2; ++ks) kf[mp][mt][ks] = *(const bf16x8*)(Kb + key * 256 + (((mp * 8 + ks * 4 + fq) ^ kswz(key)) << 4));
      }
#pragma unroll
    for (int mp = 0; mp < 2; ++mp)
#pragma unroll
      for (int mt = 0; mt < 4; ++mt) {
        f32x4 a = MFMA16(kf[mp][mt][0], qf[mp][0], (f32x4{0.f, 0.f, 0.f, 0.f}));
        st[mp][mt] = MFMA16(kf[mp][mt][1], qf[mp][1], a);
      }
    if ((kt + 1) * 64 > klen) {
      asm volatile("" ::: "memory");
#pragma unroll
      for (int mp = 0; mp < 2; ++mp)
#pragma unroll
        for (int mt = 0; mt < 4; ++mt)
#pragma unroll
          for (int j = 0; j < 4; ++j) {
            const int key = kt * 64 + 32 * (mt >> 1) + 8 * fq + 4 * (mt & 1) + j;
            if (key >= klen) st[mp][mt][j] = -INFINITY;
          }
    }
  };
  auto softmax_tile = [&](f32x4 (&st)[2][4], bf16x8 (&pfn)[2][2], float (&alpha)[2], float (&psum)[2], bool (&moved)[2]) {
#pragma unroll
    for (int mp = 0; mp < 2; ++mp) {
      float mx = -INFINITY;
#pragma unroll
      for (int mt = 0; mt < 4; ++mt)
#pragma unroll
        for (int j = 0; j < 4; ++j) mx = fmaxf(mx, st[mp][mt][j]);
      mx = quad_max(mx);
      const float mold = mrun[mp];
      const float mnew = fmaxf(mold, mx);
      mrun[mp] = mnew;
      float ps = 0.f;
#pragma unroll
      for (int mt = 0; mt < 4; ++mt)
#pragma unroll
        for (int j = 0; j < 4; ++j) { float e = __builtin_amdgcn_exp2f(st[mp][mt][j] - mnew); st[mp][mt][j] = e; ps += e; }
      psum[mp] = ps;
      moved[mp] = __any(mnew > mold);
      alpha[mp] = __builtin_amdgcn_exp2f(mold - mnew);
#pragma unroll
      for (int s = 0; s < 2; ++s) {
        uint4 u = {pack2(st[mp][2 * s][0], st[mp][2 * s][1]), pack2(st[mp][2 * s][2], st[mp][2 * s][3]),
                   pack2(st[mp][2 * s + 1][0], st[mp][2 * s + 1][1]), pack2(st[mp][2 * s + 1][2], st[mp][2 * s + 1][3])};
        pfn[mp][s] = __builtin_bit_cast(bf16x8, u);
      }
    }
  };
  auto apply_scale = [&](const float (&alpha)[2], const float (&psum)[2], const bool (&moved)[2]) {
#pragma unroll
    for (int mp = 0; mp < 2; ++mp) {
      if (moved[mp]) {
        lrun[mp] *= alpha[mp];
#pragma unroll
        for (int n = 0; n < 8; ++n) { ot[mp][n][0] *= alpha[mp]; ot[mp][n][1] *= alpha[mp]; ot[mp][n][2] *= alpha[mp]; ot[mp][n][3] *= alpha[mp]; }
      }
      lrun[mp] += psum[mp];
    }
  };
  asm volatile("s_waitcnt vmcnt(0) lgkmcnt(0)" ::: "memory");
  __builtin_amdgcn_s_barrier();
  issue_k(0); issue_v(0);
  if (nkt > 1) issue_k(1);
  asm volatile("s_waitcnt vmcnt(0)" ::: "memory");
  asm volatile("" ::"v"(qf[0][0]), "v"(qf[0][1]), "v"(qf[1][0]), "v"(qf[1][1]));
  __builtin_amdgcn_s_barrier();
  bf16x8 pf[2][2];
#pragma unroll
  for (int mp = 0; mp < 2; ++mp)
#pragma unroll
    for (int s = 0; s < 2; ++s) pf[mp][s] = bf16x8{0, 0, 0, 0, 0, 0, 0, 0};
  if (wactive) {
    f32x4 st[2][4];
    float alpha[2], psum[2]; bool moved[2];
    qk_tile(0, st);
    softmax_tile(st, pf, alpha, psum, moved);
    apply_scale(alpha, psum, moved);
  }
  asm volatile("s_waitcnt lgkmcnt(0)" ::: "memory");
  __builtin_amdgcn_s_barrier();
  for (int j = 0; j < nkt; ++j) {
    if (j + 2 < nkt) issue_k(j + 2);
    if (j + 1 < nkt) issue_v(j + 1);
    const bool doPV = wactive && j < mykt;
    const bool doQK = wactive && j + 1 < mykt;
    f32x4 st[2][4];
    bf16x8 pfn[2][2];
    float alpha[2] = {1.f, 1.f}, psum[2] = {0.f, 0.f}; bool moved[2] = {false, false};
    auto pv_tile = [&]() {
      const char* Vb = Vs + (j & 1) * 16384;
#pragma unroll
      for (int nh = 0; nh < 2; ++nh) {
        bf16x8 vf[4][2];
#pragma unroll
        for (int n = 0; n < 4; ++n) {
          const int vd = (nh * 4 + n) * 16 + fr;
#pragma unroll
          for (int s = 0; s < 2; ++s) vf[n][s] = *(const bf16x8*)(Vb + vd * 128 + (((s * 4 + fq) ^ ((vd >> 1) & 7)) << 4));
        }
#pragma unroll
        for (int n = 0; n < 4; ++n)
#pragma unroll
          for (int s = 0; s < 2; ++s) {
            ot[0][nh * 4 + n] = MFMA16(vf[n][s], pf[0][s], ot[0][nh * 4 + n]);
            ot[1][nh * 4 + n] = MFMA16(vf[n][s], pf[1][s], ot[1][nh * 4 + n]);
          }
      }
    };
    if (doQK) {
      qk_tile(j + 1, st);
      pv_tile();
      softmax_tile(st, pfn, alpha, psum, moved);
      apply_scale(alpha, psum, moved);
#pragma unroll
      for (int mp = 0; mp < 2; ++mp)
#pragma unroll
        for (int s = 0; s < 2; ++s) pf[mp][s] = pfn[mp][s];
    } else if (doPV) {
      pv_tile();
    }
    asm volatile("s_waitcnt vmcnt(0) lgkmcnt(0)" ::: "memory");
    __builtin_amdgcn_s_barrier();
  }
  if (wactive) {
    float l0 = lrun[0], l1 = lrun[1];
    l0 += __shfl_xor(l0, 16); l0 += __shfl_xor(l0, 32);
    l1 += __shfl_xor(l1, 16); l1 += __shfl_xor(l1, 32);
    const float lam = ((const float*)(p.ws + O_LAM))[l];
    const float lam_init = 0.8f - 0.6f * __expf(-0.3f * (float)l);
    const float i0 = 1.f / l0, i1 = lam / l1;
    float ss = 0.f;
#pragma unroll
    for (int n = 0; n < 8; ++n)
#pragma unroll
      for (int j = 0; j < 4; ++j) { float o = ot[0][n][j] * i0 - ot[1][n][j] * i1; ot[0][n][j] = o; ss += o * o; }
    ss += __shfl_xor(ss, 16); ss += __shfl_xor(ss, 32);
    const float rs = rsqrtf(ss * (1.f / 128.f) + EPS) * (1.f - lam_init);
    const float* g = p.in[11] + (size_t)l * 128;
    u16* OA = (u16*)(p.ws + O_OA) + (size_t)qrow * 512 + h * 128;
#pragma unroll
    for (int n = 0; n < 8; ++n) {
      const int vd = n * 16 + fq * 4;
      float4 gg = *(const float4*)(g + vd);
      *(uint2*)(OA + vd) = uint2{pack2(ot[0][n][0] * rs * gg.x, ot[0][n][1] * rs * gg.y), pack2(ot[0][n][2] * rs * gg.z, ot[0][n][3] * rs * gg.w)};
    }
  }
}

constexpr int LP = 72;
constexpr int BCS = 68;
DI void gla_decode(int gi, bool& isS, int& b, int& h, int& c, int& row0, int& Lc) {
  if (gi < PB * 4 * 128) { isS = false; c = gi & 127; h = (gi >> 7) & 3; b = gi >> 9; row0 = b * PT + c * 64; Lc = 64; }
  else { isS = true; int s = gi - PB * 4 * 128; b = s >> 2; h = s & 3; c = 0; row0 = MP + b * 32; Lc = 32; }
}
DI void gla_bcum(const Params& p, int l, int row0, int Lc, int h, float* bc, float* tot, float* gas) {
  const int tid = TID(), kd = tid & 63, tq = tid >> 6;
  const float* W2 = p.in[12] + (size_t)l * 16 * 256 + h * 64 + kd;
  const float b2 = p.in[13][(size_t)l * 256 + h * 64 + kd];
  const float* GA = (const float*)(p.ws + O_GA);
  {
    const int r = tid >> 2, part = tid & 3;
    float4 v = {0.f, 0.f, 0.f, 0.f};
    if (r < Lc) v = *(const float4*)(GA + (size_t)(row0 + r) * 16 + part * 4);
    *(float4*)(gas + r * 16 + part * 4) = v;
  }
  float w[16];
#pragma unroll
  for (int r = 0; r < 16; ++r) w[r] = W2[r * 256];
  __syncthreads();
  float run = 0.f;
#pragma unroll
  for (int i = 0; i < 16; ++i) {
    const int t = tq * 16 + i;
    const float4* ga = (const float4*)(gas + t * 16);
    const float4 g0 = ga[0], g1 = ga[1], g2 = ga[2], g3 = ga[3];
    const float x = b2 + g0.x * w[0] + g0.y * w[1] + g0.z * w[2] + g0.w * w[3] + g1.x * w[4] + g1.y * w[5] + g1.z * w[6] + g1.w * w[7] +
                    g2.x * w[8] + g2.y * w[9] + g2.z * w[10] + g2.w * w[11] + g3.x * w[12] + g3.y * w[13] + g3.z * w[14] + g3.w * w[15];
    const float la = (t < Lc) ? -softplusf_(-x) * (1.f / 16.f) : 0.f;
    run += la;
    bc[t * BCS + kd] = run;
  }
  tot[tq * 64 + kd] = run;
  __syncthreads();
  float off = 0.f;
  for (int g = 0; g < tq; ++g) off += tot[g * 64 + kd];
#pragma unroll
  for (int i = 0; i < 16; ++i) bc[(tq * 16 + i) * BCS + kd] += off;
  __syncthreads();
}
DI void gla_load_vt(const Params& p, int row0, int Lc, int h, u16* vt) {
  const int tid = TID(), s = tid & 63, cg4 = tid >> 6;
  const u16* GV = (const u16*)(p.ws + O_GV) + (size_t)(row0 + s) * 512 + h * 128;
  u32x4 v[4];
#pragma unroll
  for (int i = 0; i < 4; ++i) v[i] = (s < Lc) ? *(const u32x4*)(GV + (cg4 + 4 * i) * 8) : u32x4{0u, 0u, 0u, 0u};
#pragma unroll
  for (int i = 0; i < 4; ++i) {
    const int vd0 = (cg4 + 4 * i) * 8;
#pragma unroll
    for (int e = 0; e < 4; ++e) {
      vt[(vd0 + 2 * e) * LP + s] = (u16)(v[i][e] & 0xffffu);
      vt[(vd0 + 2 * e + 1) * LP + s] = (u16)(v[i][e] >> 16);
    }
  }
}

DI void gla1_item(const Params& p, int l, int gi, char* smem) {
  bool isS; int b, h, c, row0, Lc;
  gla_decode(gi, isS, b, h, c, row0, Lc);
  const int tid = TID(), lane = tid & 63, wid = tid >> 6, fr = lane & 15, fq = lane >> 4;
  float* bc = (float*)smem;
  float* tot = (float*)(smem + 17408);
  u16* kh = (u16*)(smem + 18432);
  u16* vt = (u16*)(smem + 18432 + 9216);
  __syncthreads();
  gla_bcum(p, l, row0, Lc, h, bc, tot, (float*)kh);
  {
    const int s = tid & 63, c2 = tid >> 6;
    const u16* GK = (const u16*)(p.ws + O_GK) + (size_t)(row0 + s) * 256 + h * 64;
    u32x4 kv[2];
#pragma unroll
    for (int i = 0; i < 2; ++i) kv[i] = (s < Lc) ? *(const u32x4*)(GK + (c2 + 4 * i) * 8) : u32x4{0u, 0u, 0u, 0u};
#pragma unroll
    for (int i = 0; i < 2; ++i) {
      const int kd0 = (c2 + 4 * i) * 8;
#pragma unroll
      for (int e = 0; e < 8; ++e) {
        const unsigned w = kv[i][e >> 1];
        const float kf = bf2f((u16)((e & 1) ? (w >> 16) : (w & 0xffffu)));
        const float bl = bc[63 * BCS + kd0 + e];
        kh[(kd0 + e) * LP + s] = f2bf(kf * __expf(bl - bc[s * BCS + kd0 + e]));
      }
    }
    if (tid < 64) ((float*)(p.ws + O_DEC))[(size_t)gi * 64 + tid] = __expf(bc[63 * BCS + tid]);
  }
  gla_load_vt(p, row0, Lc, h, vt);
  __syncthreads();
  u16* KVT = (u16*)(p.ws + O_KVT) + (size_t)gi * 8192;
#pragma unroll
  for (int mi = 0; mi < 2; ++mi)
#pragma unroll
    for (int n = 0; n < 4; ++n) {
      const int m = wid * 2 + mi;
      f32x4 a = lds_mm<2>(vt, LP, m * 16, kh, LP, n * 16, f32x4{0.f, 0.f, 0.f, 0.f});
#pragma unroll
      for (int j = 0; j < 4; ++j) KVT[(m * 16 + fq * 4 + j) * 64 + n * 16 + fr] = f2bf(a[j]);
    }
}

constexpr int G2_ITEMS = (PB * 4 + SBT * 4) * 32;
DI void gla2_item(const Params& p, int l, int it) {
  const int seq = it >> 5, e = (it & 31) * 256 + TID();
  const int vd = e >> 6, kd = e & 63;
  u16* KVT = (u16*)(p.ws + O_KVT);
  const float* DEC = (const float*)(p.ws + O_DEC);
  if (seq < PB * 4) {
    float S = 0.f;
    const int gi0 = seq * 128;
    for (int c0 = 0; c0 < 128; c0 += 32) {
      u16 kvv[32]; float dd[32];
#pragma unroll
      for (int c = 0; c < 32; ++c) { kvv[c] = KVT[(size_t)(gi0 + c0 + c) * 8192 + e]; dd[c] = DEC[(size_t)(gi0 + c0 + c) * 64 + kd]; }
#pragma unroll
      for (int c = 0; c < 32; ++c) { KVT[(size_t)(gi0 + c0 + c) * 8192 + e] = f2bf(S); S = dd[c] * S + bf2f(kvv[c]); }
    }
    p.out[GLA_P + ((size_t)l * PB * 4 + seq) * 8192 + kd * 128 + vd] = S;
  } else {
    const int s = seq - PB * 4, gi = PB * 4 * 128 + s;
    const float S0 = p.in[4][((size_t)l * SBT * 4 + s) * 8192 + kd * 128 + vd];
    u16* q = KVT + (size_t)gi * 8192 + e;
    const float kv = bf2f(*q);
    const float d = DEC[(size_t)gi * 64 + kd];
    *q = f2bf(S0);
    p.out[GLA_S + ((size_t)l * SBT * 4 + s) * 8192 + kd * 128 + vd] = d * S0 + kv;
  }
}

DI void gla3_item(const Params& p, int l, int gi, char* smem) {
  bool isS; int b, h, c, row0, Lc;
  gla_decode(gi, isS, b, h, c, row0, Lc);
  const int tid = TID(), lane = tid & 63, wid = tid >> 6, fr = lane & 15, fq = lane >> 4;
  float* bc = (float*)smem;
  u16* att = (u16*)smem;
  float* tot = (float*)(smem + 17408);
  u16* qt = (u16*)(smem + 18432);
  u16* kt_ = (u16*)(smem + 18432 + 9216);
  u16* vt = (u16*)(smem + 18432 + 2 * 9216);
  u16* st = (u16*)(smem + 18432 + 2 * 9216 + 18432);
  __syncthreads();
  gla_bcum(p, l, row0, Lc, h, bc, tot, (float*)qt);
  const u16* KVT = (const u16*)(p.ws + O_KVT) + (size_t)gi * 8192;
  {
    const int s = tid & 63, c2 = tid >> 6;
    const u16* GQ = (const u16*)(p.ws + O_GQ) + (size_t)(row0 + s) * 256 + h * 64;
    const u16* GK = (const u16*)(p.ws + O_GK) + (size_t)(row0 + s) * 256 + h * 64;
    u32x4 qv[2], kv[2], sv[4];
#pragma unroll
    for (int i = 0; i < 2; ++i) {
      qv[i] = (s < Lc) ? *(const u32x4*)(GQ + (c2 + 4 * i) * 8) : u32x4{0u, 0u, 0u, 0u};
      kv[i] = (s < Lc) ? *(const u32x4*)(GK + (c2 + 4 * i) * 8) : u32x4{0u, 0u, 0u, 0u};
    }
#pragma unroll
    for (int i = 0; i < 4; ++i) { const int id = tid + i * 256; sv[i] = *(const u32x4*)(KVT + (id >> 3) * 64 + (id & 7) * 8); }
#pragma unroll
    for (int i = 0; i < 2; ++i) {
      const int kd0 = (c2 + 4 * i) * 8;
      u32x4 qo, ko;
#pragma unroll
      for (int e2 = 0; e2 < 4; ++e2) {
        const float b0 = bc[s * BCS + kd0 + 2 * e2], b1 = bc[s * BCS + kd0 + 2 * e2 + 1];
        const float e0 = __expf(b0), e1 = __expf(b1);
        const float q0 = bf2f((u16)(qv[i][e2] & 0xffffu)) * e0, q1 = bf2f((u16)(qv[i][e2] >> 16)) * e1;
        const float k0 = bf2f((u16)(kv[i][e2] & 0xffffu)) / e0, k1 = bf2f((u16)(kv[i][e2] >> 16)) / e1;
        qo[e2] = pack2(q0, q1);
        ko[e2] = pack2(k0, k1);
      }
      *(u32x4*)(qt + s * LP + kd0) = qo;
      *(u32x4*)(kt_ + s * LP + kd0) = ko;
    }
#pragma unroll
    for (int i = 0; i < 4; ++i) { const int id = tid + i * 256; *(u32x4*)(st + (id >> 3) * LP + (id & 7) * 8) = sv[i]; }
  }
  gla_load_vt(p, row0, Lc, h, vt);
  __syncthreads();
  {
    f32x4 a[4];
#pragma unroll
    for (int n = 0; n < 4; ++n) a[n] = lds_mm<2>(qt, LP, wid * 16, kt_, LP, n * 16, f32x4{0.f, 0.f, 0.f, 0.f});
#pragma unroll
    for (int n = 0; n < 4; ++n)
#pragma unroll
      for (int j = 0; j < 4; ++j) {
        const int t = wid * 16 + fq * 4 + j, s = n * 16 + fr;
        att[t * LP + s] = f2bf(t >= s ? a[n][j] : 0.f);
      }
  }
  __syncthreads();
  f32x4 o[8];
#pragma unroll
  for (int n = 0; n < 8; ++n) {
    f32x4 a = lds_mm<2>(att, LP, wid * 16, vt, LP, n * 16, f32x4{0.f, 0.f, 0.f, 0.f});
    o[n] = lds_mm<2>(qt, LP, wid * 16, st, LP, n * 16, a);
  }
  const float* gn = p.in[14] + (size_t)l * 128;
  const u16* GR = (const u16*)(p.ws + O_GR);
  u16* OG = (u16*)(p.ws + O_OG);
  float gnv[8];
#pragma unroll
  for (int n = 0; n < 8; ++n) gnv[n] = gn[n * 16 + fr];
#pragma unroll
  for (int j = 0; j < 4; ++j) {
    float ss = 0.f;
#pragma unroll
    for (int n = 0; n < 8; ++n) ss += o[n][j] * o[n][j];
    ss += __shfl_xor(ss, 1); ss += __shfl_xor(ss, 2); ss += __shfl_xor(ss, 4); ss += __shfl_xor(ss, 8);
    const float rs = rsqrtf(ss * (1.f / 128.f) + EPS);
    const int t = wid * 16 + fq * 4 + j;
    if (t < Lc) {
      const size_t ro = (size_t)(row0 + t) * 512 + h * 128;
      u16 grv[8];
#pragma unroll
      for (int n = 0; n < 8; ++n) grv[n] = GR[ro + n * 16 + fr];
#pragma unroll
      for (int n = 0; n < 8; ++n) {
        const float gr = bf2f(grv[n]);
        OG[ro + n * 16 + fr] = f2bf(o[n][j] * rs * gnv[n] * gr * sigmoidf_(gr));
      }
    }
  }
}

constexpr int L1_ITEMS = NLC * 8;
DI void lru_decode(int ci, bool& isS, int& b, int& row0, int& Lc, int& t0) {
  if (ci < MP / 64) { isS = false; b = ci >> 7; t0 = (ci & 127) * 64; row0 = ci * 64; Lc = 64; }
  else { isS = true; b = ci - MP / 64; t0 = 0; row0 = MP + b * 32; Lc = 32; }
}
DI void lru1_item(const Params& p, int l, int it, char* smem) {
  const int ci = it >> 3, nb = it & 7;
  bool isS; int b, row0, Lc, t0;
  lru_decode(ci, isS, b, row0, Lc, t0);
  const int tid = TID(), lane = tid & 63, wid = tid >> 6, fr = lane & 15, fq = lane >> 4;
  u16* xcs = (u16*)smem;
  u16* was = (u16*)(smem + 9216);
  u16* wxs = (u16*)(smem + 2 * 9216);
  float* as_ = (float*)(smem + 3 * 9216);
  float* us_ = (float*)(smem + 3 * 9216 + 16384);
  float* segP = (float*)(smem + 3 * 9216 + 32768);
  float* segH = (float*)(smem + 3 * 9216 + 32768 + 1024);
  const float* LX = (const float*)(p.ws + O_LX);
  const u16* Wl = (const u16*)(p.ws + O_WT) + (size_t)l * W_LAYER;
  const int i = tid & 63, tq = tid >> 6, ch = nb * 64 + i;
  __syncthreads();
  {
    const float* cw = p.in[15] + (size_t)l * 4 * 512 + ch;
    const float w0 = cw[0], w1 = cw[512], w2 = cw[1024], w3 = cw[1536], cb = p.in[16][(size_t)l * 512 + ch];
    const float* buf = isS ? p.in[5] + ((size_t)l * SBT + b) * 3 * 512 + ch : nullptr;
    float x[19];
#pragma unroll
    for (int j = 0; j < 19; ++j) {
      const int tl = tq * 16 - 3 + j;
      const int tt = t0 + tl;
      float v = 0.f;
      if (tl < Lc) {
        if (tt >= 0) v = LX[(size_t)(row0 + tl) * 512 + ch];
        else if (isS) v = buf[(3 + tt) * 512];
      }
      x[j] = v;
    }
#pragma unroll
    for (int k = 0; k < 16; ++k) {
      const int t = tq * 16 + k;
      const float xv = (t < Lc) ? cb + w0 * x[k] + w1 * x[k + 1] + w2 * x[k + 2] + w3 * x[k + 3] : 0.f;
      xcs[t * LP + i] = f2bf(xv);
    }
#pragma unroll
    for (int k = 0; k < 2; ++k) {
      const int id = tid + k * 256, r = id >> 3, c8 = id & 7;
      *(uint4*)(was + r * LP + c8 * 8) = *(const uint4*)(Wl + W_WA + nb * 4096 + r * 64 + c8 * 8);
      *(uint4*)(wxs + r * LP + c8 * 8) = *(const uint4*)(Wl + W_WX + nb * 4096 + r * 64 + c8 * 8);
    }
    const int T = isS ? STT : PT;
    if (t0 + Lc == T && tid < 192) {
      const int k = tid >> 6;
      const float v = LX[(size_t)(row0 + Lc - 3 + k) * 512 + ch];
      if (isS) p.out[LC_S + (((size_t)l * SBT + b) * 3 + k) * 512 + ch] = v;
      else p.out[LC_P + (((size_t)l * PB + b) * 3 + k) * 512 + ch] = v;
    }
  }
  __syncthreads();
  {
    const float* ba = p.in[18] + (size_t)l * 512 + nb * 64;
    const float* bx = p.in[20] + (size_t)l * 512 + nb * 64;
    const float* lm = p.in[21] + (size_t)l * 512 + nb * 64;
#pragma unroll
    for (int n = 0; n < 4; ++n) {
      f32x4 r = lds_mm<2>(xcs, LP, wid * 16, was, LP, n * 16, f32x4{0.f, 0.f, 0.f, 0.f});
      f32x4 g = lds_mm<2>(xcs, LP, wid * 16, wxs, LP, n * 16, f32x4{0.f, 0.f, 0.f, 0.f});
      const int j = n * 16 + fr;
      const float sp = softplusf_(-lm[j]), bav = ba[j], bxv = bx[j];
#pragma unroll
      for (int q = 0; q < 4; ++q) {
        const int t = wid * 16 + fq * 4 + q;
        const float rr = sigmoidf_(r[q] + bav), ii = sigmoidf_(g[q] + bxv);
        const float la = -8.f * rr * sp;
        const float a = __expf(la);
        const float x2 = 2.f * la;
        const float om = (x2 > -0.01f) ? -x2 * (1.f + x2 * (0.5f + x2 * (1.f / 6.f))) : 1.f - __expf(x2);
        const float u = sqrtf(om) * ii * bf2f(xcs[t * LP + j]);
        as_[t * 64 + j] = a;
        us_[t * 64 + j] = u;
      }
    }
  }
  __syncthreads();
  {
    float av[16], uv[16];
#pragma unroll
    for (int k = 0; k < 16; ++k) { av[k] = as_[(tq * 16 + k) * 64 + i]; uv[k] = us_[(tq * 16 + k) * 64 + i]; }
    float P = 1.f, hh = 0.f;
#pragma unroll
    for (int k = 0; k < 16; ++k) { P *= av[k]; hh = av[k] * hh + uv[k]; }
    segP[tq * 64 + i] = P; segH[tq * 64 + i] = hh;
    __syncthreads();
    float Pin = 1.f, hin = 0.f;
    for (int g = 0; g < tq; ++g) { const float pg = segP[g * 64 + i], hg = segH[g * 64 + i]; hin = pg * hin + hg; Pin *= pg; }
    u16* HL = (u16*)(p.ws + O_HL);
    u16* PPp = (u16*)(p.ws + O_PP);
    P = Pin; hh = hin;
#pragma unroll
    for (int k = 0; k < 16; ++k) {
      const int t = tq * 16 + k;
      P *= av[k]; hh = av[k] * hh + uv[k];
      if (t < Lc) {
        HL[(size_t)(row0 + t) * 512 + ch] = f2bf(hh);
        PPp[(size_t)(row0 + t) * 512 + ch] = f2bf(P);
      }
    }
    if (tq * 16 + 16 == Lc) {
      ((float*)(p.ws + O_CA))[(size_t)ci * 512 + ch] = P;
      ((float*)(p.ws + O_CH))[(size_t)ci * 512 + ch] = hh;
    }
  }
}
constexpr int L2_ITEMS = 8 + 32;
DI void lru2_item(const Params& p, int l, int it) {
  const float* CA = (const float*)(p.ws + O_CA);
  const float* CH = (const float*)(p.ws + O_CH);
  float* HS = (float*)(p.ws + O_HS);
  if (it < 8) {
    const int e = it * 256 + TID(), b = e >> 9, ch = e & 511;
    float hh = 0.f;
    for (int c0 = 0; c0 < 128; c0 += 16) {
      float ca[16], chv[16];
#pragma unroll
      for (int c = 0; c < 16; ++c) { const size_t o = (size_t)(b * 128 + c0 + c) * 512 + ch; ca[c] = CA[o]; chv[c] = CH[o]; }
#pragma unroll
      for (int c = 0; c < 16; ++c) { const size_t o = (size_t)(b * 128 + c0 + c) * 512 + ch; HS[o] = hh; hh = ca[c] * hh + chv[c]; }
    }
    p.out[LH_P + ((size_t)l * PB + b) * 512 + ch] = hh;
  } else {
    const int e = (it - 8) * 256 + TID(), b = e >> 9, ch = e & 511;
    const float h0 = p.in[6][((size_t)l * SBT + b) * 512 + ch];
    const size_t o = (size_t)(MP / 64 + b) * 512 + ch;
    HS[o] = h0;
    p.out[LH_S + ((size_t)l * SBT + b) * 512 + ch] = CA[o] * h0 + CH[o];
  }
}
constexpr int L3_ITEMS = MT / 8;
DI void lru3_item(const Params& p, int it) {
  const u16* HL = (const u16*)(p.ws + O_HL);
  const u16* PPp = (const u16*)(p.ws + O_PP);
  const u16* LG = (const u16*)(p.ws + O_LG);
  const float* HS = (const float*)(p.ws + O_HS);
  u16* OL = (u16*)(p.ws + O_OL);
#pragma unroll
  for (int i = 0; i < 4; ++i) {
    const int id = TID() + i * 256;
    const int row = it * 8 + (id >> 7), c4 = (id & 127) * 4;
    const int ci = row < MP ? (row >> 6) : MP / 64 + ((row - MP) >> 5);
    const size_t o = (size_t)row * 512 + c4;
    const uint2 hl = *(const uint2*)(HL + o), pp = *(const uint2*)(PPp + o), lg = *(const uint2*)(LG + o);
    const float4 hs = *(const float4*)(HS + (size_t)ci * 512 + c4);
    float y0 = (bf2f(hl.x & 0xffff) + bf2f(pp.x & 0xffff) * hs.x) * gelu_tanh(bf2f(lg.x & 0xffff));
    float y1 = (bf2f(hl.x >> 16) + bf2f(pp.x >> 16) * hs.y) * gelu_tanh(bf2f(lg.x >> 16));
    float y2 = (bf2f(hl.y & 0xffff) + bf2f(pp.y & 0xffff) * hs.z) * gelu_tanh(bf2f(lg.y & 0xffff));
    float y3 = (bf2f(hl.y >> 16) + bf2f(pp.y >> 16) * hs.w) * gelu_tanh(bf2f(lg.y >> 16));
    *(uint2*)(OL + o) = uint2{pack2(y0, y1), pack2(y2, y3)};
  }
}

DI void ybr_tile(const Params& p, int l, int mt, int nt, char* smem) {
  const int row0 = mt * 256, col0 = nt * 256, br = nt >> 2;
  const u16* W = (const u16*)(p.ws + O_WT) + (size_t)l * W_LAYER + W_BR + (size_t)br * 1024 * 512 + (size_t)((nt & 3) * 256) * 512;
  const u16* O = (const u16*)(p.ws + (br == 0 ? O_OA : (br == 1 ? O_OG : O_OL))) + (size_t)row0 * 512;
  f32x4 acc[8][4];
  zero_acc8(acc);
  gemm512(O, 512, W, 512, 512, acc, smem);
  tile_out_bf16<false>(acc, (u16*)(p.ws + O_YP) + (size_t)row0 * 3072 + col0, 3072, smem, 1.f, 0, nullptr);
}
DI void gate_tile(const Params& p, int l, int mt, int nt, char* smem) {
  const int row0 = mt * 256, col0 = nt * 256;
  const u16* W = (const u16*)(p.ws + O_WT) + (size_t)l * W_LAYER + W_MG + (size_t)col0 * LDK;
  f32x4 acc[8][4];
  zero_acc8(acc);
  gemm512((const u16*)(p.ws + O_XN) + (size_t)row0 * LDK, LDK, W, LDK, 1024, acc, smem);
  EPI_IDS;
  u16* Y = (u16*)(p.ws + O_YP) + (size_t)row0 * 3072 + col0;
  const float* bm = p.in[26] + (size_t)l * 3072 + col0 + wc * 64 + fr;
  img_load_bf16(Y, 3072, smem, 256, 0);
  img_barrier();
  u16* img = (u16*)smem + (wr * 128 + fq * 4) * IMG_LD + wc * 64 + fr;
#pragma unroll
  for (int n = 0; n < 4; ++n) {
    const float bv = bm[n * 16];
#pragma unroll
    for (int m = 0; m < 8; ++m)
#pragma unroll
      for (int j = 0; j < 4; ++j) {
        u16* q = img + (m * 16 + j) * IMG_LD + n * 16;
        *q = f2bf(sigmoidf_(acc[m][n][j] + bv) * bf2f(*q));
      }
  }
  img_barrier();
  img_store_bf16(Y, 3072, smem, 0);
}
DI void resid_tile(const Params& p, const u16* A, int ldk, const u16* W, int mt, int nt, int k0, int klen, bool atomic, const float* xsrc, char* smem) {
  const int row0 = mt * 256, col0 = nt * 256;
  f32x4 acc[8][4];
  zero_acc8(acc);
  gemm512(A + (size_t)row0 * ldk + k0, ldk, W + (size_t)col0 * ldk + k0, ldk, klen, acc, smem);
  if (!atomic) { tile_out_f32<true, false>(acc, p.out + (size_t)row0 * 1024 + col0, 1024, smem, 0, nullptr, xsrc + (size_t)row0 * 1024 + col0); return; }
  EPI_IDS;
#pragma unroll
  for (int m = 0; m < 8; ++m) {
    asm volatile("" ::: "memory");
#pragma unroll
    for (int n = 0; n < 4; ++n)
#pragma unroll
      for (int j = 0; j < 4; ++j) {
        const int row = row0 + wr * 128 + m * 16 + fq * 4 + j, col = col0 + wc * 64 + n * 16 + fr;
        float* q = p.out + (size_t)row * 1024 + col;
        if (atomic) unsafeAtomicAdd(q, acc[m][n][j]); else *q += acc[m][n][j];
      }
  }
}
DI void resid_phase(const Params& p, const u16* A, int ldk, const u16* W, int B, int G, const float* xsrc, char* smem) {
  const int ns = ldk / 256;
  int k = 0, u = B;
  while (true) {
    int mt, nt, k0 = 0, kl = ldk;
    bool at = false;
    if (xcd_tile(B, G, k, 128, 4, mt, nt)) { ++k; }
    else if (u < 8 * ns) { const int t = u / ns, sl = u - t * ns; mt = 128 + (t >> 2); nt = t & 3; k0 = sl * 256; kl = 256; at = true; u += G; }
    else break;
    asm volatile("" : "+s"(kl));
    resid_tile(p, A, ldk, W, mt, nt, k0, kl, at, xsrc, smem);
  }
}

DI void ffgate_tile(const Params& p, int l, int mt, int nt, char* smem) {
  const int row0 = mt * 256, col0 = nt * 256;
  const u16* W = (const u16*)(p.ws + O_WT) + (size_t)l * W_LAYER + W_FG;
  f32x4 acc[8][4];
  zero_acc8(acc);
  gemm512((const u16*)(p.ws + O_XN) + (size_t)row0 * LDK, LDK, W + (size_t)col0 * LDK, LDK, 1024, acc, smem);
  if (mt < 128) {
    EPI_IDS;
    tile_out_bf16<false>(acc, (u16*)(p.ws + O_GU) + (size_t)row0 * DFF + col0, DFF, smem, 1.f, 0, nullptr);
    if (((row0 + 256) & 8191) == 0 && wr == 1 && fq == 3) {
      const int b = row0 >> 13;
#pragma unroll
      for (int n = 0; n < 4; ++n) {
        const int col = col0 + wc * 64 + n * 16 + fr;
        p.out[FC_P + (((size_t)l * PB + b) * 2 + 0) * DFF + col] = acc[7][n][2];
        p.out[FC_P + (((size_t)l * PB + b) * 2 + 1) * DFF + col] = acc[7][n][3];
      }
    }
    return;
  }
  EPI_IDS;
  u16* GU = (u16*)(p.ws + O_GU);
  const bool isS = row0 >= MP;
#pragma unroll
  for (int m = 0; m < 8; ++m) {
    asm volatile("" ::: "memory");
#pragma unroll
    for (int n = 0; n < 4; ++n)
#pragma unroll
      for (int j = 0; j < 4; ++j) {
        const int row = row0 + wr * 128 + m * 16 + fq * 4 + j, col = col0 + wc * 64 + n * 16 + fr;
        const float v = acc[m][n][j];
        GU[(size_t)row * DFF + col] = f2bf(v);
        if (isS) {
          const int rs = row - MP, b = rs >> 5, t = rs & 31;
          if (t >= STT - 2) p.out[FC_S + (((size_t)l * SBT + b) * 2 + (t - (STT - 2))) * DFF + col] = v;
        } else {
          const int b = row >> 13, t = row & 8191;
          if (t >= PT - 2) p.out[FC_P + (((size_t)l * PB + b) * 2 + (t - (PT - 2))) * DFF + col] = v;
        }
      }
  }
}
DI void ffup_tile(const Params& p, int l, int mt, int nt, char* smem) {
  const int row0 = mt * 256, col0 = nt * 256;
  const u16* W = (const u16*)(p.ws + O_WT) + (size_t)l * W_LAYER + W_FU;
  f32x4 acc[8][4];
  zero_acc8(acc);
  gemm512((const u16*)(p.ws + O_XN) + (size_t)row0 * LDK, LDK, W + (size_t)col0 * LDK, LDK, 1024, acc, smem);
  if (mt < 128) {
    EPI_IDS;
    const u16* GUt = (const u16*)(p.ws + O_GU) + (size_t)row0 * DFF + col0;
    if (row0 >= 2) img_load_bf16(GUt - 2 * DFF, DFF, smem, 258, 0); else img_load_bf16(GUt, DFF, smem, 256, 2);
    img_barrier();
    const u16* img = (const u16*)smem + (wr * 128 + fq * 4) * IMG_LD + wc * 64 + fr;
#pragma unroll
    for (int n = 0; n < 4; ++n) {
      const int col = col0 + wc * 64 + n * 16 + fr;
      const float* cw = p.in[30] + (size_t)l * 3 * DFF + col;
      const float w0 = cw[0], w1 = cw[DFF], w2 = cw[2 * DFF], cb = p.in[31][(size_t)l * DFF + col];
#pragma unroll
      for (int m = 0; m < 8; ++m) {
        if ((m & 1) == 0) asm volatile("" ::: "memory");
        const int t = (row0 + wr * 128 + m * 16 + fq * 4) & 8191;
        float g[6];
#pragma unroll
        for (int d = 0; d < 6; ++d) { const float gv = bf2f(img[(m * 16 + d) * IMG_LD + n * 16]); g[d] = (d >= 2 || t - 2 + d >= 0) ? gv : 0.f; }
#pragma unroll
        for (int j = 0; j < 4; ++j) acc[m][n][j] *= gelu_tanh(cb + w0 * g[j] + w1 * g[j + 1] + w2 * g[j + 2]);
      }
    }
    img_barrier();
    img_put_bf16<false>(acc, smem, 2, 1.f, 0, nullptr);
    img_barrier();
    img_store_bf16((u16*)(p.ws + O_FF) + (size_t)row0 * DFF + col0, DFF, smem, 2);
    return;
  }
  EPI_IDS;
  const u16* GU = (const u16*)(p.ws + O_GU);
  u16* FF = (u16*)(p.ws + O_FF);
  const bool isS = row0 >= MP;
  const int rowq = row0 + wr * 128 + fq * 4;
  const unsigned gbase = (unsigned)rowq * (unsigned)DFF + (unsigned)(col0 + wc * 64 + fr);
#pragma unroll
  for (int n = 0; n < 4; ++n) {
    const int col = col0 + wc * 64 + n * 16 + fr;
    const float* cw = p.in[30] + (size_t)l * 3 * DFF + col;
    const float w0 = cw[0], w1 = cw[DFF], w2 = cw[2 * DFF], cb = p.in[31][(size_t)l * DFF + col];
#pragma unroll
    for (int mh = 0; mh < 2; ++mh) {
      asm volatile("" ::: "memory");
      float g[4][6];
#pragma unroll
      for (int m = 0; m < 4; ++m) {
        const int rowb = rowq + (mh * 4 + m) * 16;
        int b, t;
        if (isS) { int rs = rowb - MP; b = rs >> 5; t = rs & 31; } else { b = rowb >> 13; t = rowb & 8191; }
#pragma unroll
        for (int d = 0; d < 6; ++d) {
          const int tt = t - 2 + d;
          if (tt >= 0) g[m][d] = bf2f(GU[gbase + (unsigned)((((mh * 4 + m) * 16 + d) * DFF) + n * 16) - 2u * (unsigned)DFF]);
          else g[m][d] = isS ? p.in[7][(((size_t)l * SBT + b) * 2 + (2 + tt)) * DFF + col] : 0.f;
        }
      }
#pragma unroll
      for (int m = 0; m < 4; ++m)
#pragma unroll
        for (int j = 0; j < 4; ++j) {
          const float gc = cb + w0 * g[m][j] + w1 * g[m][j + 1] + w2 * g[m][j + 2];
          FF[gbase + (unsigned)((((mh * 4 + m) * 16 + j) * DFF) + n * 16)] = f2bf(gelu_tanh(gc) * acc[mh * 4 + m][n][j]);
        }
    }
  }
}

DI void norm_phase(const Params& p, int l, int mode, int B, int G, char* smem) {
  const int tid = TID512(), lane = tid & 63, wid = tid >> 6;
  const float* gamma = mode == 0 ? p.in[8] + (size_t)l * 1024 : (mode == 1 ? p.in[28] + (size_t)l * 1024 : p.in[34]);
  float* wga = (float*)smem;
  if (mode == 0) {
    __syncthreads();
    const float* src = p.in[9] + (size_t)l * 1024 * PW + 3072;
#pragma unroll
    for (int i = 0; i < 8; ++i) {
      const int id = tid + i * 512, k = id >> 2, part = id & 3;
      ((float4*)wga)[(((k >> 8) * 4 + (k & 3)) * 4 + part) * 64 + ((k >> 2) & 63)] = *(const float4*)(src + (size_t)k * PW + part * 4);
    }
    __syncthreads();
  }
  float4 g[4];
#pragma unroll
  for (int i = 0; i < 4; ++i) g[i] = *(const float4*)(gamma + i * 256 + lane * 4);
  for (int row = B * 8 + wid; row < MT; row += G * 8) {
    float* X = p.out + (size_t)row * 1024;
    const float* Xr = (mode == 0 && l == 0 && row < MP) ? p.in[0] + (size_t)row * 1024 : X;
    float4 v[4];
    float ss = 0.f;
#pragma unroll
    for (int i = 0; i < 4; ++i) { { const f32x4 t4 = __builtin_nontemporal_load((const f32x4*)(Xr + i * 256 + lane * 4)); v[i] = float4{t4[0], t4[1], t4[2], t4[3]}; } ss += v[i].x * v[i].x + v[i].y * v[i].y + v[i].z * v[i].z + v[i].w * v[i].w; }
    ss = wave_sum(ss);
    const float rs = rsqrtf(ss * (1.f / 1024.f) + EPS);
    u16* XN = (u16*)(p.ws + O_XN) + (size_t)row * LDK;
#pragma unroll
    for (int i = 0; i < 4; ++i) {
      v[i] = float4{v[i].x * rs * g[i].x, v[i].y * rs * g[i].y, v[i].z * rs * g[i].z, v[i].w * rs * g[i].w};
      if (mode == 2) *(float4*)(X + i * 256 + lane * 4) = v[i];
      else *(uint2*)(XN + i * 256 + lane * 4) = uint2{pack2(v[i].x, v[i].y), pack2(v[i].z, v[i].w)};
    }
    if (mode == 0) {
      float ga[16];
#pragma unroll
      for (int r = 0; r < 16; ++r) ga[r] = 0.f;
#pragma unroll
      for (int i = 0; i < 4; ++i) {
        const float xv[4] = {v[i].x, v[i].y, v[i].z, v[i].w};
#pragma unroll
        for (int e = 0; e < 4; ++e) {
          asm volatile("" ::: "memory");
#pragma unroll
          for (int q = 0; q < 4; ++q) {
            const float4 w = ((const float4*)wga)[((i * 4 + e) * 4 + q) * 64 + lane];
            ga[q * 4 + 0] += xv[e] * w.x; ga[q * 4 + 1] += xv[e] * w.y; ga[q * 4 + 2] += xv[e] * w.z; ga[q * 4 + 3] += xv[e] * w.w;
          }
        }
      }
      float mine = 0.f;
#pragma unroll
      for (int r = 0; r < 16; ++r) { const float s = wave_sum(ga[r]); if (lane == r) mine = s; }
      if (lane < 16) ((float*)(p.ws + O_GA))[(size_t)row * 16 + lane] = mine;
    }
  }
}

#define XB_TMO      128
#define XB_XCNT(j)  (256  + 64 * (j))
#define XB_XSUB(j)  (1280 + 64 * (j))
#define XB_XGEN(j)  (2304 + 64 * (j))
#define XB_TOP      3328
#define XB_TOPGEN   3392
#define XCD_BAR_WORDS 3456
#define XB_SPIN_CAP (1u << 18)
#define LAS __attribute__((address_space(3)))

__device__ __forceinline__ unsigned xb_ld(unsigned* p)              { return __hip_atomic_load(p, __ATOMIC_RELAXED, __HIP_MEMORY_SCOPE_AGENT); }
__device__ __forceinline__ unsigned xb_add(unsigned* p, unsigned v) { return __hip_atomic_fetch_add(p, v, __ATOMIC_RELAXED, __HIP_MEMORY_SCOPE_AGENT); }
__device__ __forceinline__ unsigned xb_xcc_id() { return (unsigned)__builtin_amdgcn_s_getreg((3 << 11) | 20) & 0xFu; }
#define XB_SPIN(cond, bar) do { unsigned _sp = 0; while (cond) { __builtin_amdgcn_s_sleep(1); \
    if ((++_sp & 255u) == 0u) { if (xb_ld(&(bar)[XB_TMO])) break; if (_sp > XB_SPIN_CAP) { atomicAdd(&(bar)[XB_TMO], 1u); break; } } } } while (0)

struct XcdBarrier {
    unsigned* bar; unsigned x;
    volatile LAS unsigned* st;
};

__device__ __forceinline__ XcdBarrier xcd_barrier_post(unsigned* bar, volatile LAS unsigned* st) {
    XcdBarrier b; b.bar = bar; b.x = xb_xcc_id(); b.st = st;
    if (threadIdx.x == 0) (void)xb_add(&bar[XB_XCNT(b.x)], 1u);
    return b;
}
__device__ __forceinline__ void xcd_barrier_complete(unsigned* bar, unsigned x, unsigned& nloc, unsigned& nx) {
    const unsigned G = gridDim.x * gridDim.y * gridDim.z;
    unsigned sum, cnt, mine, sp = 0u;
    for (;;) {
        sum = 0u; cnt = 0u; mine = 0u;
#pragma unroll
        for (unsigned j = 0; j < 16; ++j) { const unsigned c = xb_ld(&bar[XB_XCNT(j)]); sum += c; cnt += (c > 0u) ? 1u : 0u; mine = (j == x) ? c : mine; }
        if (sum == G) break;
        __builtin_amdgcn_s_sleep(1);
        if ((++sp & 255u) == 0u) { if (xb_ld(&bar[XB_TMO])) break; if (sp > XB_SPIN_CAP) { atomicAdd(&bar[XB_TMO], 1u); break; } }
    }
    nloc = mine > 0u ? mine : 1u; nx = cnt > 0u ? cnt : 1u;
}

__device__ __forceinline__ void xcd_barrier(const XcdBarrier& b) {
    asm volatile("s_waitcnt vmcnt(0)" ::: "memory");
    __syncthreads();
    if (threadIdx.x == 0) {
        unsigned* bar = b.bar;
        __builtin_amdgcn_s_waitcnt(0);
        unsigned nloc = b.st[0], nx = b.st[1];
        if (nloc == 0u) { xcd_barrier_complete(bar, b.x, nloc, nx); b.st[0] = nloc; b.st[1] = nx; }
        const unsigned old = xb_add(&bar[XB_XSUB(b.x)], 1u);
        const unsigned gen = old / nloc;
        if (old + 1u == (gen + 1u) * nloc) {
            __builtin_amdgcn_fence(__ATOMIC_RELEASE, "agent");
            asm volatile("s_waitcnt vmcnt(0)" ::: "memory");
            const unsigned og = xb_add(&bar[XB_TOP], 1u);
            const unsigned tg = og / nx;
            if (og + 1u == (tg + 1u) * nx) xb_add(&bar[XB_TOPGEN], 1u);
            else XB_SPIN(xb_ld(&bar[XB_TOPGEN]) == tg, bar);
            __builtin_amdgcn_fence(__ATOMIC_ACQUIRE, "agent");
            xb_add(&bar[XB_XGEN(b.x)], 1u);
            asm volatile("s_waitcnt vmcnt(0)" ::: "memory");
        } else {
            XB_SPIN(xb_ld(&bar[XB_XGEN(b.x)]) == gen, bar);
            __builtin_amdgcn_fence(__ATOMIC_ACQUIRE, "agent");
            asm volatile("s_waitcnt vmcnt(0)" ::: "memory");
        }
    }
    __syncthreads();
}


#ifndef ONLY
#define ONLY -1
#endif
constexpr int HALF_LDS = 73728;
constexpr int SMEM_BYTES = 2 * HALF_LDS;
#define VB() (2 * B + (TID512() >> 8))
#define HS() (smem + (TID512() >> 8) * HALF_LDS)
__global__ void __launch_bounds__(512, 2) mega(Params p) {
  cg::grid_group grid = cg::this_grid();
  extern __shared__ __attribute__((aligned(16))) char smem[];
  const int G = gridDim.x, B = blockIdx.x;
  __shared__ __attribute__((aligned(16))) unsigned xb_words[4];
  if (threadIdx.x < 4) xb_words[threadIdx.x] = 0u;
  __syncthreads();
  const XcdBarrier xb = xcd_barrier_post((unsigned*)(p.ws + O_BAR), (volatile LAS unsigned*)xb_words);
  const int vG = 2 * G;
  if (ONLY < 0 || ONLY == 0) for (int it = VB(); it < PREP_ITEMS; it += vG) prep_item(p, it, HS());
  grid.sync();
  for (int l = 0; l < NL; ++l) {
    const u16* W = (const u16*)(p.ws + O_WT) + (size_t)l * W_LAYER;
    if (ONLY < 0 || ONLY == 1) norm_phase(p, l, 0, B, G, smem);
    xcd_barrier(xb);
    if (ONLY < 0 || ONLY == 2) { int mt, nt; for (int k = 0; xcd_tile(B, G, k, 130, 16, mt, nt); ++k) projin_tile(p, l, mt, nt, smem); for (int it = VB(); it < PB_KC + PB_VC; it += vG) cache_conv_item(p, l, it, HS()); }
    xcd_barrier(xb);
    if (ONLY < 0 || ONLY == 3) {
      for (int k = 0; k < (G == 256 ? 5 : (1088 + G - 1) / G); ++k) {
        bool isS = false; int bh = 0, cp = 0; bool have = true;
        if (G == 256) {
          const int q = B >> 4; bh = B & 15;
          if (k == 0) cp = 63 - q; else if (k == 1) cp = 32 + q; else if (k == 2) cp = 31 - q;
          else if (k == 3) { if (q <= 11) cp = q + 4; else { isS = true; bh = (q - 12) * 16 + (B & 15); } }
          else { if (q >= 12) cp = q - 12; else have = false; }
        } else {
          const int it = B + k * G;
          if (it >= 1088) have = false; else if (it < 1024) { cp = it >> 4; bh = it & 15; } else { isS = true; bh = it - 1024; }
        }
        if (have) attn_item(p, l, isS, isS ? (bh >> 2) : (bh >> 2), bh & 3, cp, smem);
      }
    }
    if (ONLY < 0 || ONLY == 13) for (int it = VB(); it < NGI; it += vG) gla1_item(p, l, it, HS());
    if (ONLY < 0 || ONLY == 14) for (int it = VB(); it < L1_ITEMS; it += vG) lru1_item(p, l, it, HS());
    xcd_barrier(xb);
    if (ONLY < 0 || ONLY == 4) for (int it = VB(); it < G2_ITEMS + L2_ITEMS; it += vG) { if (it < G2_ITEMS) gla2_item(p, l, it); else lru2_item(p, l, it - G2_ITEMS); }
    xcd_barrier(xb);
    if (ONLY < 0 || ONLY == 5) { for (int it = VB(); it < NGI; it += vG) gla3_item(p, l, it, HS()); for (int it = VB(); it < L3_ITEMS; it += vG) lru3_item(p, it); }
    xcd_barrier(xb);
    if (ONLY < 0 || ONLY == 6) { int mt, nt; for (int k = 0; xcd_tile(B, G, k, 130, 12, mt, nt); ++k) ybr_tile(p, l, mt, nt, smem); }
    xcd_barrier(xb);
    if (ONLY < 0 || ONLY == 7) { int mt, nt; for (int k = 0; xcd_tile(B, G, k, 130, 12, mt, nt); ++k) gate_tile(p, l, mt, nt, smem); }
    xcd_barrier(xb);
    if (ONLY < 0 || ONLY == 8) resid_phase(p, (const u16*)(p.ws + O_YP), 3072, W + W_OUT, B, G, l == 0 ? p.in[0] : p.out, smem);
    xcd_barrier(xb);
    if (ONLY < 0 || ONLY == 9) norm_phase(p, l, 1, B, G, smem);
    xcd_barrier(xb);
    if (ONLY < 0 || ONLY == 10) { int mt, nt; for (int k = 0; xcd_tile(B, G, k, 130, 11, mt, nt); ++k) ffgate_tile(p, l, mt, nt, smem); }
    xcd_barrier(xb);
    if (ONLY < 0 || ONLY == 11) { int mt, nt; for (int k = 0; xcd_tile(B, G, k, 130, 11, mt, nt); ++k) ffup_tile(p, l, mt, nt, smem); }
    xcd_barrier(xb);
    if (ONLY < 0 || ONLY == 12) resid_phase(p, (const u16*)(p.ws + O_FF), DFF, W + W_FD, B, G, p.out, smem);
    xcd_barrier(xb);
  }
  if (ONLY < 0 || ONLY == 15) norm_phase(p, 0, 2, B, G, smem);
}

extern "C" void kernel_launch(void* const* d_in, const int* in_sizes, int n_in, void* d_out, int out_size, void* d_ws, size_t ws_size,
                              hipStream_t stream) {
  static int grid_blocks = 0;
  if (!grid_blocks) {
    int dev = 0, cus = 0, per = 0;
    (void)hipGetDevice(&dev);
    (void)hipDeviceGetAttribute(&cus, hipDeviceAttributeMultiprocessorCount, dev);
    (void)hipFuncSetAttribute((const void*)mega, hipFuncAttributeMaxDynamicSharedMemorySize, SMEM_BYTES);
    (void)hipOccupancyMaxActiveBlocksPerMultiprocessor(&per, mega, 512, SMEM_BYTES);
    if (per < 1) per = 1;
    grid_blocks = cus;
  }
  if (ws_size < WS_NEED) fprintf(stderr, "workspace too small: %zu < %zu\n", ws_size, (size_t)WS_NEED);
  Params p{};
  for (int i = 0; i < 35; ++i) p.in[i] = (const float*)d_in[i];
  p.out = (float*)d_out;
  p.ws = (char*)d_ws;
  (void)hipMemsetAsync((char*)d_ws + O_BAR, 0, XCD_BAR_WORDS * sizeof(unsigned), stream);
  void* args[] = {&p};
  hipError_t e = hipLaunchCooperativeKernel((void*)mega, dim3(grid_blocks), dim3(512), args, SMEM_BYTES, stream);
  if (e != hipSuccess) fprintf(stderr, "cooperative launch failed: %s (grid %d)\n", hipGetErrorString(e), grid_blocks);
}
```

```cpp
#include <hip/hip_runtime.h>
#include <hip/hip_cooperative_groups.h>
#include <cstdio>
namespace cg = cooperative_groups;

#define DI __device__ __forceinline__
typedef unsigned short u16;
using bf16x8 = __attribute__((ext_vector_type(8))) short;
using f32x4 = __attribute__((ext_vector_type(4))) float;
using u32x4 = __attribute__((ext_vector_type(4))) unsigned;
#define MFMA16(a, b, c) __builtin_amdgcn_mfma_f32_16x16x32_bf16((a), (b), (c), 0, 0, 0)

constexpr int DM = 1024, PB = 4, PT = 8192, SBT = 16, STT = 32, PAST = 2048, NL = 4;
constexpr int MP = PB * PT, MS = SBT * STT, MT = MP + MS;
constexpr int SKP = 2112;
constexpr int SKV = PAST + STT;
constexpr int DFF = 2816, PW = 4112, PWP = 4224;
constexpr int NGI = PB * 4 * 128 + SBT * 4;
constexpr int NLC = MP / 64 + SBT;
constexpr float EPS = 1e-6f;
constexpr float QSCALE = 0.125f * 1.4426950408889634f;
constexpr int LDK = 1088;

constexpr size_t W_IN = 0, W_MG = W_IN + (size_t)4096 * LDK, W_BR = W_MG + (size_t)3072 * LDK, W_OUT = W_BR + (size_t)3 * 1024 * 512,
                 W_FG = W_OUT + (size_t)1024 * 3072, W_FU = W_FG + (size_t)DFF * LDK, W_FD = W_FU + (size_t)DFF * LDK,
                 W_WA = W_FD + (size_t)1024 * DFF, W_WX = W_WA + 32768, W_LAYER = W_WX + 32768;

struct Params {
  const float* in[35];
  float* out;
  char* ws;
};

constexpr size_t al(size_t x) { return (x + 255) & ~(size_t)255; }
constexpr size_t O_WT = 0;
constexpr size_t O_ROPE = al(O_WT + W_LAYER * NL * 2);
constexpr size_t O_LAM = al(O_ROPE + 2 * 8192 * 8 * 4);
constexpr size_t O_BAR = al(O_LAM + 256);
constexpr size_t O_XN = al(O_BAR + 4096 * 4);
constexpr size_t O_REG = al(O_XN + (size_t)MT * LDK * 2);
constexpr size_t O_QB = O_REG;
constexpr size_t O_KB = al(O_QB + (size_t)MT * 512 * 2);
constexpr size_t O_KS = al(O_KB + (size_t)MP * 512 * 2);
constexpr size_t O_VT = al(O_KS + (size_t)SBT * SKP * 512 * 2);
constexpr size_t O_VTS = al(O_VT + (size_t)MP * 512 * 2);
constexpr size_t O_GQ = al(O_VTS + (size_t)SBT * SKP * 512 * 2);
constexpr size_t O_GK = al(O_GQ + (size_t)MT * 256 * 2);
constexpr size_t O_GV = al(O_GK + (size_t)MT * 256 * 2);
constexpr size_t O_GR = al(O_GV + (size_t)MT * 512 * 2);
constexpr size_t O_GA = al(O_GR + (size_t)MT * 512 * 2);
constexpr size_t O_LX = al(O_GA + (size_t)MT * 16 * 4);
constexpr size_t O_LG = al(O_LX + (size_t)MT * 512 * 4);
constexpr size_t O_KVT = al(O_LG + (size_t)MT * 512 * 2);
constexpr size_t O_DEC = al(O_KVT + (size_t)NGI * 8192 * 2);
constexpr size_t O_HL = al(O_DEC + (size_t)NGI * 64 * 4);
constexpr size_t O_PP = al(O_HL + (size_t)MT * 512 * 2);
constexpr size_t O_CA = al(O_PP + (size_t)MT * 512 * 2);
constexpr size_t O_CH = al(O_CA + (size_t)NLC * 512 * 4);
constexpr size_t O_HS = al(O_CH + (size_t)NLC * 512 * 4);
constexpr size_t O_OA = al(O_HS + (size_t)NLC * 512 * 4);
constexpr size_t O_OG = al(O_OA + (size_t)MT * 512 * 2);
constexpr size_t O_OL = al(O_OG + (size_t)MT * 512 * 2);
constexpr size_t O_END1 = al(O_OL + (size_t)MT * 512 * 2);
constexpr size_t O_YP = O_QB;
static_assert(O_YP + (size_t)MT * 3072 * 2 <= O_OA, "Y buffer overlaps live mixer outputs");
constexpr size_t O_GU = O_REG;
constexpr size_t O_FF = al(O_GU + (size_t)MT * DFF * 2);
constexpr size_t O_END2 = al(O_FF + (size_t)MT * DFF * 2);
constexpr size_t WS_NEED = O_END1 > O_END2 ? O_END1 : O_END2;

constexpr size_t Y_P = 0, Y_S = Y_P + (size_t)MP * 1024, K_P = Y_S + (size_t)MS * 1024, V_P = K_P + (size_t)NL * MP * 512,
                 GLA_P = V_P + (size_t)NL * MP * 512, LC_P = GLA_P + (size_t)NL * PB * 32768, LH_P = LC_P + (size_t)NL * PB * 3 * 512,
                 FC_P = LH_P + (size_t)NL * PB * 512, K_S = FC_P + (size_t)NL * PB * 2 * DFF, V_S = K_S + (size_t)NL * MS * 512,
                 GLA_S = V_S + (size_t)NL * MS * 512, LC_S = GLA_S + (size_t)NL * SBT * 32768, LH_S = LC_S + (size_t)NL * SBT * 3 * 512,
                 FC_S = LH_S + (size_t)NL * SBT * 512, OUT_TOTAL = FC_S + (size_t)NL * SBT * 2 * DFF;

DI int TID() { int t = threadIdx.x & 255; asm volatile("" : "+v"(t)); return t; }
DI int TID512() { int t = threadIdx.x; asm volatile("" : "+v"(t)); return t; }
DI u16 f2bf(float x) { __bf16 h = (__bf16)x; return __builtin_bit_cast(u16, h); }
DI float bf2f(u16 h) { return __uint_as_float(((unsigned)h) << 16); }
typedef __bf16 bf16v2_t __attribute__((ext_vector_type(2)));
typedef float f32v2_t __attribute__((ext_vector_type(2)));
DI unsigned pack2(float a, float b) { f32v2_t v = {a, b}; bf16v2_t r = __builtin_convertvector(v, bf16v2_t); return __builtin_bit_cast(unsigned, r); }
DI float sigmoidf_(float x) { return __builtin_amdgcn_rcpf(1.f + __expf(-x)); }
DI float gelu_tanh(float x) { float u = 0.7978845608028654f * (x + 0.044715f * x * x * x); return x * sigmoidf_(2.f * u); }
DI float softplusf_(float x) { return fmaxf(x, 0.f) + __logf(1.f + __expf(-fabsf(x))); }
DI float quad_max(float v) {
  auto a = __builtin_amdgcn_permlane16_swap(__float_as_uint(v), __float_as_uint(v), false, false);
  v = fmaxf(__uint_as_float(a[0]), __uint_as_float(a[1]));
  auto b = __builtin_amdgcn_permlane32_swap(__float_as_uint(v), __float_as_uint(v), false, false);
  return fmaxf(__uint_as_float(b[0]), __uint_as_float(b[1]));
}
DI float wave_sum(float v) {
  for (int o = 32; o > 0; o >>= 1) v += __shfl_xor(v, o);
  return v;
}

DI void gemm512(const u16* __restrict__ A, int lda, const u16* __restrict__ B, int ldb, int K, f32x4 (&acc)[8][4], char* smem) {
  const int tid = TID512(), lane = tid & 63, wid = tid >> 6, wr = wid >> 2, wc = wid & 3, fr = lane & 15, fq = lane >> 4;
  const int lrow = tid >> 3;
  const int gch = (tid & 7) ^ ((lrow >> 1) & 7);
  const unsigned aov = (unsigned)(lrow * lda + gch * 8);
  const unsigned bov = (unsigned)(lrow * ldb + gch * 8);
  const int soff = tid * 16;
  const int sw = (fr >> 1) & 7;
  const int aoff = (wr * 128 + fr) * 128, boff = 32768 + (wc * 64 + fr) * 128;
  const int nk = K >> 6;
  asm volatile("s_waitcnt lgkmcnt(0)" ::: "memory");
  __builtin_amdgcn_s_barrier();
#pragma unroll
  for (int i = 0; i < 4; ++i) {
    __builtin_amdgcn_global_load_lds((const unsigned*)((A + (size_t)i * 64 * lda) + aov), (unsigned*)(smem + soff + i * 8192), 16, 0, 0);
    __builtin_amdgcn_global_load_lds((const unsigned*)((B + (size_t)i * 64 * ldb) + bov), (unsigned*)(smem + 32768 + soff + i * 8192), 16, 0, 0);
  }
  asm volatile("s_waitcnt vmcnt(0)" ::: "memory");
  __builtin_amdgcn_s_barrier();
  for (int kt = 0; kt < nk; ++kt) {
    const int buf = kt & 1;
    const bool more = kt + 1 < nk;
    char* st = smem + (buf ^ 1) * 65536 + soff;
    const u16* An = A + (kt + 1) * 64;
    const u16* Bn = B + (kt + 1) * 64;
    const char* Sb = smem + buf * 65536;
#pragma unroll
    for (int ks = 0; ks < 2; ++ks) {
      const int co = ((ks * 4 + fq) ^ sw) << 4;
      bf16x8 bfr[4], af[8];
#pragma unroll
      for (int n = 0; n < 4; ++n) bfr[n] = *(const bf16x8*)(Sb + boff + n * 2048 + co);
#pragma unroll
      for (int m = 0; m < 8; ++m) af[m] = *(const bf16x8*)(Sb + aoff + m * 2048 + co);
      __builtin_amdgcn_sched_barrier(0);
#pragma unroll
      for (int g = 0; g < 4; ++g) {
#pragma unroll
        for (int mm = 0; mm < 2; ++mm)
#pragma unroll
          for (int n = 0; n < 4; ++n) acc[g * 2 + mm][n] = MFMA16(af[g * 2 + mm], bfr[n], acc[g * 2 + mm][n]);
        __builtin_amdgcn_sched_barrier(0);
        if (more && ks == 0) {
          __builtin_amdgcn_global_load_lds((const unsigned*)((An + (size_t)g * 64 * lda) + aov), (unsigned*)(st + g * 8192), 16, 0, 0);
          __builtin_amdgcn_global_load_lds((const unsigned*)((Bn + (size_t)g * 64 * ldb) + bov), (unsigned*)(st + 32768 + g * 8192), 16, 0, 0);
        }
        __builtin_amdgcn_sched_barrier(0);
      }
    }
    asm volatile("s_waitcnt vmcnt(0) lgkmcnt(0)" ::: "memory");
    __builtin_amdgcn_s_barrier();
  }
}
DI void zero_acc8(f32x4 (&acc)[8][4]) {
#pragma unroll
  for (int m = 0; m < 8; ++m)
#pragma unroll
    for (int n = 0; n < 4; ++n) acc[m][n] = f32x4{0.f, 0.f, 0.f, 0.f};
}
#define EPI_IDS const int tid = TID512(), lane = tid & 63, wid = tid >> 6, wr = wid >> 2, wc = wid & 3, fr = lane & 15, fq = lane >> 4


constexpr int IMG_LD = 264;
constexpr int IMGF_LD = 260;
DI void img_barrier() { asm volatile("s_waitcnt lgkmcnt(0)" ::: "memory"); __builtin_amdgcn_s_barrier(); }
template <bool ROPE>
DI float epi_val(const f32x4 (&acc)[8][4], int m, int n, int j, const float* cs4, const float* sn4, int fr) {
  float v = acc[m][n][j];
  if (ROPE && n == 0) {
    const float pr = __shfl_xor(v, 8);
    v = (fr < 8) ? v * cs4[j] - pr * sn4[j] : v * cs4[j] + pr * sn4[j];
  }
  return v;
}
template <bool ROPE>
DI void img_put_bf16(const f32x4 (&acc)[8][4], char* smem, int rowoff, float scale, int prow0, const float* cosT) {
  EPI_IDS;
  u16* img = (u16*)smem + (wr * 128 + fq * 4 + rowoff) * IMG_LD + wc * 64 + fr;
#pragma unroll
  for (int m = 0; m < 8; ++m) {
    float cs4[4] = {0.f, 0.f, 0.f, 0.f}, sn4[4] = {0.f, 0.f, 0.f, 0.f};
    if (ROPE) {
#pragma unroll
      for (int j = 0; j < 4; ++j) { const int pos = prow0 + wr * 128 + m * 16 + fq * 4 + j; cs4[j] = cosT[pos * 8 + (fr & 7)]; sn4[j] = cosT[8192 * 8 + pos * 8 + (fr & 7)]; }
    }
#pragma unroll
    for (int n = 0; n < 4; ++n)
#pragma unroll
      for (int j = 0; j < 4; ++j) img[(m * 16 + j) * IMG_LD + n * 16] = f2bf(epi_val<ROPE>(acc, m, n, j, cs4, sn4, fr) * scale);
  }
}
DI void img_store_bf16(u16* dst, int ld, const char* smem, int rowoff) {
  const int tid = TID512();
#pragma unroll
  for (int q = 0; q < 16; ++q) {
    const int slot = tid + q * 512, row = slot >> 5, c16 = slot & 31;
    *(u32x4*)(dst + (size_t)row * ld + c16 * 8) = *(const u32x4*)(smem + (row + rowoff) * (IMG_LD * 2) + c16 * 16);
  }
}
DI void img_load_bf16(const u16* src, int ld, char* smem, int nrows, int rowoff) {
  for (int slot = TID512(); slot < nrows * 32; slot += 512) {
    const int row = slot >> 5, c16 = slot & 31;
    *(u32x4*)(smem + (row + rowoff) * (IMG_LD * 2) + c16 * 16) = __builtin_nontemporal_load((const u32x4*)(src + (size_t)row * ld + c16 * 8));
  }
}
template <bool ROPE>
DI void imgf_put(const f32x4 (&acc)[8][4], int h, char* smem, int prow0, const float* cosT) {
  EPI_IDS;
  if (wr == h) {
    float* f = (float*)smem + (fq * 4) * IMGF_LD + wc * 64 + fr;
#pragma unroll
    for (int m = 0; m < 8; ++m) {
      float cs4[4] = {0.f, 0.f, 0.f, 0.f}, sn4[4] = {0.f, 0.f, 0.f, 0.f};
      if (ROPE) {
#pragma unroll
        for (int j = 0; j < 4; ++j) { const int pos = prow0 + wr * 128 + m * 16 + fq * 4 + j; cs4[j] = cosT[pos * 8 + (fr & 7)]; sn4[j] = cosT[8192 * 8 + pos * 8 + (fr & 7)]; }
      }
#pragma unroll
      for (int n = 0; n < 4; ++n)
#pragma unroll
        for (int j = 0; j < 4; ++j) f[(m * 16 + j) * IMGF_LD + n * 16] = epi_val<ROPE>(acc, m, n, j, cs4, sn4, fr);
    }
  }
}
template <bool ADD>
DI void imgf_store(float* dst, const float* rsrc, int ld, const char* smem) {
  const int tid = TID512();
  const unsigned o0 = (unsigned)((tid >> 6) * ld + (tid & 63) * 4);
  const char* src = smem + (tid >> 6) * (IMGF_LD * 4) + (tid & 63) * 16;
#pragma unroll
  for (int q = 0; q < 16; ++q) {
    if ((q & 3) == 0) asm volatile("" ::: "memory");
    float4 v = *(const float4*)(src + q * 8 * (IMGF_LD * 4));
    float4* d = (float4*)(dst + (o0 + (unsigned)(q * 8 * ld)));
    if (ADD) { const f32x4 x = __builtin_nontemporal_load((const f32x4*)(rsrc + (o0 + (unsigned)(q * 8 * ld)))); v.x += x[0]; v.y += x[1]; v.z += x[2]; v.w += x[3]; }
    if (ADD) *d = v;
    else __builtin_nontemporal_store(f32x4{v.x, v.y, v.z, v.w}, (f32x4*)d);
  }
}
template <bool ADD, bool ROPE>
DI void tile_out_f32(const f32x4 (&acc)[8][4], float* dst, int ld, char* smem, int prow0, const float* cosT, const float* rsrc = nullptr) {
#pragma unroll 1
  for (int h = 0; h < 2; ++h) {
    img_barrier();
    imgf_put<ROPE>(acc, h, smem, prow0, cosT);
    img_barrier();
    imgf_store<ADD>(dst + (size_t)h * 128 * ld, ADD ? rsrc + (size_t)h * 128 * ld : nullptr, ld, smem);
  }
}
template <bool ROPE>
DI void tile_out_bf16(const f32x4 (&acc)[8][4], u16* dst, int ld, char* smem, float scale, int prow0, const float* cosT) {
  img_barrier();
  img_put_bf16<ROPE>(acc, smem, 0, scale, prow0, cosT);
  img_barrier();
  img_store_bf16(dst, ld, smem, 0);
}

template <int KS>
DI f32x4 lds_mm(const u16* As, int lsa, int arow, const u16* Bs, int lsb, int brow, f32x4 acc) {
  const int lane = TID() & 63, fr = lane & 15, fq = lane >> 4;
#pragma unroll
  for (int ks = 0; ks < KS; ++ks) {
    bf16x8 a = *(const bf16x8*)(As + (arow + fr) * lsa + ks * 32 + fq * 8);
    bf16x8 b = *(const bf16x8*)(Bs + (brow + fr) * lsb + ks * 32 + fq * 8);
    acc = MFMA16(a, b, acc);
  }
  return acc;
}

constexpr int PREP_T_PER_LAYER = 64 * 16 + 48 * 16 + 3 * 128 + 3 * 256 + 3 * 704 + 16;
constexpr int PREP_T = PREP_T_PER_LAYER * NL;
constexpr int PREP_COPY = MS * 1024 / 4096;
constexpr int PREP_ROPE = 8192 * 8 / 256;
constexpr int PREP_ITEMS = PREP_T + PREP_COPY + PREP_ROPE + 2;

DI void transpose_tile(const float* src, int lds_, int k0, int c0, int ncols_valid, u16* dst, int ldd, int n0, float* tile) {
  const int tid = TID();
  __syncthreads();
#pragma unroll
  for (int i = 0; i < 16; ++i) {
    int e = tid + i * 256, r = e >> 6, c = e & 63;
    tile[r * 65 + c] = (c < ncols_valid) ? __builtin_nontemporal_load(&src[(size_t)(k0 + r) * lds_ + c0 + c]) : 0.f;
  }
  __syncthreads();
#pragma unroll
  for (int i = 0; i < 16; ++i) {
    int e = tid + i * 256, c = e >> 6, r = e & 63;
    dst[(size_t)(n0 + c) * ldd + k0 + r] = f2bf(tile[r * 65 + c]);
  }
}

DI void prep_item(const Params& p, int it, char* smem) {
  const int tid = TID();
  if (it < PREP_T) {
    const int l = it / PREP_T_PER_LAYER;
    int t = it % PREP_T_PER_LAYER;
    u16* W = (u16*)(p.ws + O_WT) + (size_t)l * W_LAYER;
    float* tile = (float*)smem;
    if (t < 64 * 16) {
      int nt = t / 16, kt = t % 16, n0 = nt * 64;
      const int c0 = n0 < 3072 ? n0 : n0 + 16;
      transpose_tile(p.in[9] + (size_t)l * 1024 * PW, PW, kt * 64, c0, 64, W + W_IN, LDK, n0, tile);
      return;
    }
    t -= 64 * 16;
    if (t < 48 * 16) { transpose_tile(p.in[25] + (size_t)l * 1024 * 3072, 3072, (t % 16) * 64, (t / 16) * 64, 64, W + W_MG, LDK, (t / 16) * 64, tile); return; }
    t -= 48 * 16;
    if (t < 3 * 128) {
      int br = t / 128, tt = t % 128;
      transpose_tile(p.in[22 + br] + (size_t)l * 512 * 1024, 1024, (tt % 8) * 64, (tt / 8) * 64, 64, W + W_BR + (size_t)br * 1024 * 512, 512, (tt / 8) * 64, tile);
      return;
    }
    t -= 3 * 128;
    if (t < 768) { const int cp = t / 256, tt = t % 256; transpose_tile(p.in[27] + (size_t)l * 1024 * 1024, 1024, (tt % 16) * 64, (tt / 16) * 64, 64, W + W_OUT + cp * 1024, 3072, (tt / 16) * 64, tile); return; }
    t -= 768;
    if (t < 704) { transpose_tile(p.in[29] + (size_t)l * 1024 * DFF, DFF, (t % 16) * 64, (t / 16) * 64, 64, W + W_FG, LDK, (t / 16) * 64, tile); return; }
    t -= 704;
    if (t < 704) { transpose_tile(p.in[32] + (size_t)l * 1024 * DFF, DFF, (t % 16) * 64, (t / 16) * 64, 64, W + W_FU, LDK, (t / 16) * 64, tile); return; }
    t -= 704;
    if (t < 704) { transpose_tile(p.in[33] + (size_t)l * DFF * 1024, 1024, (t % 44) * 64, (t / 44) * 64, 64, W + W_FD, DFF, (t / 44) * 64, tile); return; }
    t -= 704;
    if (t < 8) { transpose_tile(p.in[17] + (size_t)l * 32768 + t * 4096, 64, 0, 0, 64, W + W_WA + t * 4096, 64, 0, tile); return; }
    t -= 8;
    transpose_tile(p.in[19] + (size_t)l * 32768 + t * 4096, 64, 0, 0, 64, W + W_WX + t * 4096, 64, 0, tile);
    return;
  }
  it -= PREP_T;
  if (it < PREP_COPY) {
    const size_t base = (size_t)it * 4096;
#pragma unroll
    for (int i = 0; i < 4; ++i) {
      const size_t e = base + (size_t)(tid + i * 256) * 4;
      *(float4*)(p.out + (size_t)MP * 1024 + e) = *(const float4*)(p.in[1] + e);
    }
    return;
  }
  it -= PREP_COPY;
  if (it < PREP_ROPE) {
    int e = it * 256 + tid, pos = e >> 3, i = e & 7;
    double inv = pow(500000.0, -(double)i / 8.0);
    double ang = (double)pos * inv;
    double kq = rint(ang * 0.15915494309189535);
    double r = ang - kq * 6.283185307179586;
    float rf = (float)r;
    float* cs = (float*)(p.ws + O_ROPE);
    cs[e] = cosf(rf);
    cs[8192 * 8 + e] = sinf(rf);
    return;
  }
  if (it == PREP_ROPE && tid < 64 * NL) {
    int l = tid >> 6, i = tid & 63;
    const float* lq = p.in[10] + (size_t)l * 256;
    float a = lq[i] * lq[64 + i], b = lq[128 + i] * lq[192 + i];
    a = wave_sum(a); b = wave_sum(b);
    if (i == 0) {
      float lam_init = 0.8f - 0.6f * __expf(-0.3f * (float)l);
      ((float*)(p.ws + O_LAM))[l] = __expf(a) - __expf(b) + lam_init;
    }
  }
}

DI bool xcd_tile(int B, int G, int iter, int MTILES, int NT, int& mt, int& nt) {
  const int nxb = G >> 3;
  const int x = B & 7, lb = B >> 3;
  const int q = MTILES >> 3, r = MTILES & 7;
  const int mx = q + (x < r ? 1 : 0);
  const int mbase = x * q + (x < r ? x : r);
  const int j = lb + iter * nxb;
  if (j >= mx * NT) return false;
  const int band = j / (8 * NT);
  const int rem = j - band * 8 * NT;
  const int nb = (mx - band * 8) < 8 ? (mx - band * 8) : 8;
  mt = mbase + band * 8 + rem % nb;
  nt = rem / nb;
  return true;
}

constexpr int PB_KC = SBT * PAST * 512 / 4096;
constexpr int PB_VC = SBT * 32 * 8;

DI void projin_tile(const Params& p, int l, int mt, int nt, char* smem) {
  const int row0 = mt * 256, col0 = nt * 256;
  const u16* W = (const u16*)(p.ws + O_WT) + (size_t)l * W_LAYER + W_IN;
  const u16* XN = (const u16*)(p.ws + O_XN);
  f32x4 acc[8][4];
  zero_acc8(acc);
  gemm512(XN + (size_t)row0 * LDK, LDK, W + (size_t)col0 * LDK, LDK, 1024, acc, smem);
  const float* cosT = (const float*)(p.ws + O_ROPE);
  const float* sinT = cosT + 8192 * 8;
  if (mt < 128) {
    const int prow0 = row0 & 8191;
    if (nt < 2) {
      tile_out_bf16<true>(acc, (u16*)(p.ws + O_QB) + (size_t)row0 * 512 + col0, 512, smem, QSCALE, prow0, cosT);
    } else if (nt < 4) {
      tile_out_f32<false, true>(acc, p.out + K_P + ((size_t)l * MP + row0) * 512 + (col0 - 512), 512, smem, prow0, cosT);
      tile_out_bf16<true>(acc, (u16*)(p.ws + O_KB) + (size_t)row0 * 512 + (col0 - 512), 512, smem, 1.f, prow0, cosT);
    } else if (nt < 6) {
      tile_out_f32<false, false>(acc, p.out + V_P + ((size_t)l * MP + row0) * 512 + (col0 - 1024), 512, smem, 0, nullptr);
      EPI_IDS;
      u16* VT = (u16*)(p.ws + O_VT);
      const unsigned vb = (unsigned)((row0 >> 13) * 512 + (col0 - 1024) + wc * 64 + fr) * (unsigned)PT + (unsigned)((row0 & 8191) + wr * 128 + fq * 4);
#pragma unroll
      for (int m = 0; m < 8; ++m) {
        asm volatile("" ::: "memory");
#pragma unroll
        for (int n = 0; n < 4; ++n) {
          const uint2 pk = {pack2(acc[m][n][0], acc[m][n][1]), pack2(acc[m][n][2], acc[m][n][3])};
          *(uint2*)(VT + (vb + (unsigned)(n * 16 * PT + m * 16))) = pk;
        }
      }
    } else if (nt >= 12 && nt < 14) {
      tile_out_f32<false, false>(acc, (float*)(p.ws + O_LX) + (size_t)row0 * 512 + (col0 - 3072), 512, smem, 0, nullptr);
    } else {
      u16* dst; int ld = 512, cbase;
      if (nt == 6) { dst = (u16*)(p.ws + O_GQ); ld = 256; cbase = 1536; }
      else if (nt == 7) { dst = (u16*)(p.ws + O_GK); ld = 256; cbase = 1792; }
      else if (nt < 10) { dst = (u16*)(p.ws + O_GV); cbase = 2048; }
      else if (nt < 12) { dst = (u16*)(p.ws + O_GR); cbase = 2560; }
      else { dst = (u16*)(p.ws + O_LG); cbase = 3584; }
      tile_out_bf16<false>(acc, dst + (size_t)row0 * ld + (col0 - cbase), ld, smem, nt == 6 ? 0.125f : 1.f, 0, nullptr);
    }
    return;
  }
  EPI_IDS;
  const bool isS = row0 >= MP;
  if (nt < 4) {
    const bool isq = nt < 2;
    u16* QB = (u16*)(p.ws + O_QB);
    u16* KB = (u16*)(p.ws + O_KB);
    u16* KS = (u16*)(p.ws + O_KS);
#pragma unroll
    for (int m = 0; m < 8; ++m) {
      asm volatile("" ::: "memory");
#pragma unroll
      for (int n = 0; n < 4; ++n)
#pragma unroll
        for (int j = 0; j < 4; ++j) {
          const int row = row0 + wr * 128 + m * 16 + fq * 4 + j;
          const int col = col0 + wc * 64 + n * 16 + fr;
          float v = acc[m][n][j];
          int b, t;
          if (isS) { int rs = row - MP; b = rs >> 5; t = rs & 31; } else { b = row >> 13; t = row & 8191; }
          const int pos = isS ? PAST + t : t;
          if (n == 0) {
            float pr = __shfl_xor(v, 8);
            float cs = cosT[pos * 8 + (fr & 7)], sn = sinT[pos * 8 + (fr & 7)];
            v = (fr < 8) ? v * cs - pr * sn : v * cs + pr * sn;
          }
          if (isq) {
            QB[(size_t)row * 512 + col] = f2bf(v * QSCALE);
          } else {
            const int ck = col - 512;
            if (isS) {
              p.out[K_S + ((size_t)l * MS + (row - MP)) * 512 + ck] = v;
              KS[((size_t)b * SKP + PAST + t) * 512 + ck] = f2bf(v);
            } else {
              p.out[K_P + ((size_t)l * MP + row) * 512 + ck] = v;
              KB[(size_t)row * 512 + ck] = f2bf(v);
            }
          }
        }
    }
  } else if (nt < 6) {
    u16* VT = (u16*)(p.ws + O_VT);
    u16* VTS = (u16*)(p.ws + O_VTS);
#pragma unroll
    for (int m = 0; m < 8; ++m) {
      asm volatile("" ::: "memory");
#pragma unroll
      for (int n = 0; n < 4; ++n) {
        const int rowb = row0 + wr * 128 + m * 16 + fq * 4;
        const int cv = col0 - 1024 + wc * 64 + n * 16 + fr;
        const int h = cv >> 7, vd = cv & 127;
        int b, t;
        if (isS) { int rs = rowb - MP; b = rs >> 5; t = rs & 31; } else { b = rowb >> 13; t = rowb & 8191; }
#pragma unroll
        for (int j = 0; j < 4; ++j) {
          if (isS) p.out[V_S + ((size_t)l * MS + (rowb + j - MP)) * 512 + cv] = acc[m][n][j];
          else p.out[V_P + ((size_t)l * MP + rowb + j) * 512 + cv] = acc[m][n][j];
        }
        uint2 pk = {pack2(acc[m][n][0], acc[m][n][1]), pack2(acc[m][n][2], acc[m][n][3])};
        if (isS) *(uint2*)(VTS + ((size_t)(b * 4 + h) * 128 + vd) * SKP + PAST + t) = pk;
        else *(uint2*)(VT + ((size_t)(b * 4 + h) * 128 + vd) * PT + t) = pk;
      }
    }
  } else {
    u16* dst16 = nullptr; float* dst32 = nullptr; int ld = 512, cbase = 0; float scale = 1.f;
    if (nt == 6) { dst16 = (u16*)(p.ws + O_GQ); ld = 256; cbase = 1536; scale = 0.125f; }
    else if (nt == 7) { dst16 = (u16*)(p.ws + O_GK); ld = 256; cbase = 1792; }
    else if (nt < 10) { dst16 = (u16*)(p.ws + O_GV); cbase = 2048; }
    else if (nt < 12) { dst16 = (u16*)(p.ws + O_GR); cbase = 2560; }
    else if (nt < 14) { dst32 = (float*)(p.ws + O_LX); cbase = 3072; }
    else { dst16 = (u16*)(p.ws + O_LG); cbase = 3584; }
#pragma unroll
    for (int m = 0; m < 8; ++m) {
      asm volatile("" ::: "memory");
#pragma unroll
      for (int n = 0; n < 4; ++n)
#pragma unroll
        for (int j = 0; j < 4; ++j) {
          const int row = row0 + wr * 128 + m * 16 + fq * 4 + j;
          const int c = col0 + wc * 64 + n * 16 + fr - cbase;
          const float v = acc[m][n][j] * scale;
          if (dst16) dst16[(size_t)row * ld + c] = f2bf(v);
          else dst32[(size_t)row * ld + c] = v;
        }
    }
  }
}

DI void cache_conv_item(const Params& p, int l, int it, char* smem) {
  const int tid = TID();
  if (it < PB_KC) {
    const float* src = p.in[2] + (size_t)l * SBT * PAST * 512;
    u16* KS = (u16*)(p.ws + O_KS);
#pragma unroll
    for (int i = 0; i < 4; ++i) {
      size_t e = (size_t)it * 4096 + (size_t)(tid + i * 256) * 4;
      const f32x4 vv = __builtin_nontemporal_load((const f32x4*)(src + e));
      const float4 v = {vv[0], vv[1], vv[2], vv[3]};
      size_t b = e / ((size_t)PAST * 512), r = e % ((size_t)PAST * 512);
      *(uint2*)(KS + b * SKP * 512 + r) = uint2{pack2(v.x, v.y), pack2(v.z, v.w)};
    }
    return;
  }
  it -= PB_KC;
  const int b = it / 256, r = it % 256, ptile = r / 8, ctile = r % 8;
  const float* src = p.in[3] + ((size_t)l * SBT + b) * PAST * 512;
  u16* VTS = (u16*)(p.ws + O_VTS);
  transpose_tile(src, 512, ptile * 64, ctile * 64, 64, VTS + (size_t)b * 512 * SKP, SKP, ctile * 64, (float*)smem);
}

DI int kswz(int key) { return (((key >> 3) & 3) << 2) | (key & 3); }

DI void attn_item(const Params& p, int l, bool isS, int b, int h, int cp, char* smem) {
  const int tid = TID512(), lane = tid & 63, wid = tid >> 6, fr = lane & 15, fq = lane >> 4;
  const int nkt = isS ? 33 : 2 * cp + 2;
  const int klen = isS ? SKV : nkt * 64;
  const int mykt = isS ? 33 : (wid < 4 ? 2 * cp + 1 : 2 * cp + 2);
  const u16* QB = (const u16*)(p.ws + O_QB);
  const u16* Kg = isS ? (const u16*)(p.ws + O_KS) + (size_t)b * SKP * 512 + h * 128 : (const u16*)(p.ws + O_KB) + (size_t)b * PT * 512 + h * 128;
  const int vstride = isS ? SKP : PT;
  const u16* Vg = (isS ? (const u16*)(p.ws + O_VTS) : (const u16*)(p.ws + O_VT)) + (size_t)(b * 4 + h) * 128 * vstride;
  const int qrow0 = isS ? MP + b * 32 : b * PT + cp * 128;
  const bool wactive = isS ? (wid < 2) : true;
  const int qrow = qrow0 + wid * 16 + fr;
  bf16x8 qf[2][2];
#pragma unroll
  for (int mp = 0; mp < 2; ++mp)
#pragma unroll
    for (int ks = 0; ks < 2; ++ks)
      qf[mp][ks] = wactive ? *(const bf16x8*)(QB + (size_t)qrow * 512 + h * 128 + mp * 64 + ks * 32 + fq * 8) : bf16x8{0, 0, 0, 0, 0, 0, 0, 0};
  f32x4 ot[2][8];
#pragma unroll
  for (int mp = 0; mp < 2; ++mp)
#pragma unroll
    for (int n = 0; n < 8; ++n) ot[mp][n] = f32x4{0.f, 0.f, 0.f, 0.f};
  float mrun[2] = {-INFINITY, -INFINITY}, lrun[2] = {0.f, 0.f};
  char* Ks = smem;
  char* Vs = smem + 32768;
  const int kkey = tid >> 4, vvd = tid >> 3;
  const int kgch = (tid & 15) ^ kswz(kkey);
  const int vgch = (tid & 7) ^ ((vvd >> 1) & 7);
  const int soff = tid * 16;
  auto issue_k = [&](int kt) {
#pragma unroll
    for (int i = 0; i < 2; ++i)
      __builtin_amdgcn_global_load_lds((const unsigned*)(Kg + (size_t)(kt * 64 + kkey + i * 32) * 512 + kgch * 8), (unsigned*)(Ks + (kt & 1) * 16384 + soff + i * 8192), 16, 0, 0);
  };
  auto issue_v = [&](int kt) {
#pragma unroll
    for (int i = 0; i < 2; ++i)
      __builtin_amdgcn_global_load_lds((const unsigned*)(Vg + (size_t)(vvd + i * 64) * vstride + kt * 64 + vgch * 8), (unsigned*)(Vs + (kt & 1) * 16384 + soff + i * 8192), 16, 0, 0);
  };
  auto qk_tile = [&](int kt, f32x4 (&st)[2][4]) {
    const char* Kb = Ks + (kt & 1) * 16384;
    bf16x8 kf[2][4][2];
#pragma unroll
    for (int mp = 0; mp < 2; ++mp)
#pragma unroll
      for (int mt = 0; mt < 4; ++mt) {
        const int key = 32 * (mt >> 1) + 8 * (fr >> 2) + 4 * (mt & 1) + (fr & 3);
#pragma unroll
        for (int ks = 0; ks < 2; ++ks) kf[mp][mt][ks] = *(const bf16x8*)(Kb + key * 256 + (((mp * 8 + ks * 4 + fq) ^ kswz(key)) << 4));
      }
#pragma unroll
    for (int mp = 0; mp < 2; ++mp)
#pragma unroll
      for (int mt = 0; mt < 4; ++mt) {
        f32x4 a = MFMA16(kf[mp][mt][0], qf[mp][0], (f32x4{0.f, 0.f, 0.f, 0.f}));
        st[mp][mt] = MFMA16(kf[mp][mt][1], qf[mp][1], a);
      }
    if ((kt + 1) * 64 > klen) {
      asm volatile("" ::: "memory");
#pragma unroll
      for (int mp = 0; mp < 2; ++mp)
#pragma unroll
        for (int mt = 0; mt < 4; ++mt)
#pragma unroll
          for (int j = 0; j < 4; ++j) {
            const int key = kt * 64 + 32 * (mt >> 1) + 8 * fq + 4 * (mt & 1) + j;
            if (key >= klen) st[mp][mt][j] = -INFINITY;
          }
    }
  };
  auto softmax_tile = [&](f32x4 (&st)[2][4], bf16x8 (&pfn)[2][2], float (&alpha)[2], float (&psum)[2], bool (&moved)[2]) {
#pragma unroll
    for (int mp = 0; mp < 2; ++mp) {
      float mx = -INFINITY;
#pragma unroll
      for (int mt = 0; mt < 4; ++mt)
#pragma unroll
        for (int j = 0; j < 4; ++j) mx = fmaxf(mx, st[mp][mt][j]);
      mx = quad_max(mx);
      const float mold = mrun[mp];
      const float mnew = fmaxf(mold, mx);
      mrun[mp] = mnew;
      float ps = 0.f;
#pragma unroll
      for (int mt = 0; mt < 4; ++mt)
#pragma unroll
        for (int j = 0; j < 4; ++j) { float e = __builtin_amdgcn_exp2f(st[mp][mt][j] - mnew); st[mp][mt][j] = e; ps += e; }
      psum[mp] = ps;
      moved[mp] = __any(mnew > mold);
      alpha[mp] = __builtin_amdgcn_exp2f(mold - mnew);
#pragma unroll
      for (int s = 0; s < 2; ++s) {
        uint4 u = {pack2(st[mp][2 * s][0], st[mp][2 * s][1]), pack2(st[mp][2 * s][2], st[mp][2 * s][3]),
                   pack2(st[mp][2 * s + 1][0], st[mp][2 * s + 1][1]), pack2(st[mp][2 * s + 1][2], st[mp][2 * s + 1][3])};
        pfn[mp][s] = __builtin_bit_cast(bf16x8, u);
      }
    }
  };
  auto apply_scale = [&](const float (&alpha)[2], const float (&psum)[2], const bool (&moved)[2]) {
#pragma unroll
    for (int mp = 0; mp < 2; ++mp) {
      if (moved[mp]) {
        lrun[mp] *= alpha[mp];
#pragma unroll
        for (int n = 0; n < 8; ++n) { ot[mp][n][0] *= alpha[mp]; ot[mp][n][1] *= alpha[mp]; ot[mp][n][2] *= alpha[mp]; ot[mp][n][3] *= alpha[mp]; }
      }
      lrun[mp] += psum[mp];
    }
  };
  asm volatile("s_waitcnt vmcnt(0) lgkmcnt(0)" ::: "memory");
  __builtin_amdgcn_s_barrier();
  issue_k(0); issue_v(0);
  if (nkt > 1) issue_k(1);
  asm volatile("s_waitcnt vmcnt(0)" ::: "memory");
  asm volatile("" ::"v"(qf[0][0]), "v"(qf[0][1]), "v"(qf[1][0]), "v"(qf[1][1]));
  __builtin_amdgcn_s_barrier();
  bf16x8 pf[2][2];
#pragma unroll
  for (int mp = 0; mp < 2; ++mp)
#pragma unroll
    for (int s = 0; s < 2; ++s) pf[mp][s] = bf16x8{0, 0, 0, 0, 0, 0, 0, 0};
  if (wactive) {
    f32x4 st[2][4];
    float alpha[2], psum[2]; bool moved[2];
    qk_tile(0, st);
    softmax_tile(st, pf, alpha, psum, moved);
    apply_scale(alpha, psum, moved);
  }
  asm volatile("s_waitcnt lgkmcnt(0)" ::: "memory");
  __builtin_amdgcn_s_barrier();
  for (int j = 0; j < nkt; ++j) {
    if (j + 2 < nkt) issue_k(j + 2);
    if (j + 1 < nkt) issue_v(j + 1);
    const bool doPV = wactive && j < mykt;
    const bool doQK = wactive && j + 1 < mykt;
    f32x4 st[2][4];
    bf16x8 pfn[2][2];
    float alpha[2] = {1.f, 1.f}, psum[2] = {0.f, 0.f}; bool moved[2] = {false, false};
    auto pv_tile = [&]() {
      const char* Vb = Vs + (j & 1) * 16384;
#pragma unroll
      for (int nh = 0; nh < 2; ++nh) {
        bf16x8 vf[4][2];
#pragma unroll
        for (int n = 0; n < 4; ++n) {
          const int vd = (nh * 4 + n) * 16 + fr;
#pragma unroll
          for (int s = 0; s < 2; ++s) vf[n][s] = *(const bf16x8*)(Vb + vd * 128 + (((s * 4 + fq) ^ ((vd >> 1) & 7)) << 4));
        }
#pragma unroll
        for (int n = 0; n < 4; ++n)
#pragma unroll
          for (int s = 0; s < 2; ++s) {
            ot[0][nh * 4 + n] = MFMA16(vf[n][s], pf[0][s], ot[0][nh * 4 + n]);
            ot[1][nh * 4 + n] = MFMA16(vf[n][s], pf[1][s], ot[1][nh * 4 + n]);
          }
      }
    };
    if (doQK) {
      qk_tile(j + 1, st);
      pv_tile();
      softmax_tile(st, pfn, alpha, psum, moved);
      apply_scale(alpha, psum, moved);
#pragma unroll
      for (int mp = 0; mp < 2; ++mp)
#pragma unroll
        for (int s = 0; s < 2; ++s) pf[mp][s] = pfn[mp][s];
    } else if (doPV) {
      pv_tile();
    }
    asm volatile("s_waitcnt vmcnt(0) lgkmcnt(0)" ::: "memory");
    __builtin_amdgcn_s_barrier();
  }
  if (wactive) {
    float l0 = lrun[0], l1 = lrun[1];
    l0 += __shfl_xor(l0, 16); l0 += __shfl_xor(l0, 32);
    l1 += __shfl_xor(l1, 16); l1 += __shfl_xor(l1, 32);
    const float lam = ((const float*)(p.ws + O_LAM))[l];
    const float lam_init = 0.8f - 0.6f * __expf(-0.3f * (float)l);
    const float i0 = 1.f / l0, i1 = lam / l1;
    float ss = 0.f;
#pragma unroll
    for (int n = 0; n < 8; ++n)
#pragma unroll
      for (int j = 0; j < 4; ++j) { float o = ot[0][n][j] * i0 - ot[1][n][j] * i1; ot[0][n][j] = o; ss += o * o; }
    ss += __shfl_xor(ss, 16); ss += __shfl_xor(ss, 32);
    const float rs = rsqrtf(ss * (1.f / 128.f) + EPS) * (1.f - lam_init);
    const float* g = p.in[11] + (size_t)l * 128;
    u16* OA = (u16*)(p.ws + O_OA) + (size_t)qrow * 512 + h * 128;
#pragma unroll
    for (int n = 0; n < 8; ++n) {
      const int vd = n * 16 + fq * 4;
      float4 gg = *(const float4*)(g + vd);
      *(uint2*)(OA + vd) = uint2{pack2(ot[0][n][0] * rs * gg.x, ot[0][n][1] * rs * gg.y), pack2(ot[0][n][2] * rs * gg.z, ot[0][n][3] * rs * gg.w)};
    }
  }
}

constexpr int LP = 72;
constexpr int BCS = 68;
DI void gla_decode(int gi, bool& isS, int& b, int& h, int& c, int& row0, int& Lc) {
  if (gi < PB * 4 * 128) { isS = false; c = gi & 127; h = (gi >> 7) & 3; b = gi >> 9; row0 = b * PT + c * 64; Lc = 64; }
  else { isS = true; int s = gi - PB * 4 * 128; b = s >> 2; h = s & 3; c = 0; row0 = MP + b * 32; Lc = 32; }
}
DI void gla_bcum(const Params& p, int l, int row0, int Lc, int h, float* bc, float* tot, float* gas) {
  const int tid = TID(), kd = tid & 63, tq = tid >> 6;
  const float* W2 = p.in[12] + (size_t)l * 16 * 256 + h * 64 + kd;
  const float b2 = p.in[13][(size_t)l * 256 + h * 64 + kd];
  const float* GA = (const float*)(p.ws + O_GA);
  {
    const int r = tid >> 2, part = tid & 3;
    float4 v = {0.f, 0.f, 0.f, 0.f};
    if (r < Lc) v = *(const float4*)(GA + (size_t)(row0 + r) * 16 + part * 4);
    *(float4*)(gas + r * 16 + part * 4) = v;
  }
  float w[16];
#pragma unroll
  for (int r = 0; r < 16; ++r) w[r] = W2[r * 256];
  __syncthreads();
  float run = 0.f;
#pragma unroll
  for (int i = 0; i < 16; ++i) {
    const int t = tq * 16 + i;
    const float4* ga = (const float4*)(gas + t * 16);
    const float4 g0 = ga[0], g1 = ga[1], g2 = ga[2], g3 = ga[3];
    const float x = b2 + g0.x * w[0] + g0.y * w[1] + g0.z * w[2] + g0.w * w[3] + g1.x * w[4] + g1.y * w[5] + g1.z * w[6] + g1.w * w[7] +
                    g2.x * w[8] + g2.y * w[9] + g2.z * w[10] + g2.w * w[11] + g3.x * w[12] + g3.y * w[13] + g3.z * w[14] + g3.w * w[15];
    const float la = (t < Lc) ? -softplusf_(-x) * (1.f / 16.f) : 0.f;
    run += la;
    bc[t * BCS + kd] = run;
  }
  tot[tq * 64 + kd] = run;
  __syncthreads();
  float off = 0.f;
  for (int g = 0; g < tq; ++g) off += tot[g * 64 + kd];
#pragma unroll
  for (int i = 0; i < 16; ++i) bc[(tq * 16 + i) * BCS + kd] += off;
  __syncthreads();
}
DI void gla_load_vt(const Params& p, int row0, int Lc, int h, u16* vt) {
  const int tid = TID(), s = tid & 63, cg4 = tid >> 6;
  const u16* GV = (const u16*)(p.ws + O_GV) + (size_t)(row0 + s) * 512 + h * 128;
  u32x4 v[4];
#pragma unroll
  for (int i = 0; i < 4; ++i) v[i] = (s < Lc) ? *(const u32x4*)(GV + (cg4 + 4 * i) * 8) : u32x4{0u, 0u, 0u, 0u};
#pragma unroll
  for (int i = 0; i < 4; ++i) {
    const int vd0 = (cg4 + 4 * i) * 8;
#pragma unroll
    for (int e = 0; e < 4; ++e) {
      vt[(vd0 + 2 * e) * LP + s] = (u16)(v[i][e] & 0xffffu);
      vt[(vd0 + 2 * e + 1) * LP + s] = (u16)(v[i][e] >> 16);
    }
  }
}

DI void gla1_item(const Params& p, int l, int gi, char* smem) {
  bool isS; int b, h, c, row0, Lc;
  gla_decode(gi, isS, b, h, c, row0, Lc);
  const int tid = TID(), lane = tid & 63, wid = tid >> 6, fr = lane & 15, fq = lane >> 4;
  float* bc = (float*)smem;
  float* tot = (float*)(smem + 17408);
  u16* kh = (u16*)(smem + 18432);
  u16* vt = (u16*)(smem + 18432 + 9216);
  __syncthreads();
  gla_bcum(p, l, row0, Lc, h, bc, tot, (float*)kh);
  {
    const int s = tid & 63, c2 = tid >> 6;
    const u16* GK = (const u16*)(p.ws + O_GK) + (size_t)(row0 + s) * 256 + h * 64;
    u32x4 kv[2];
#pragma unroll
    for (int i = 0; i < 2; ++i) kv[i] = (s < Lc) ? *(const u32x4*)(GK + (c2 + 4 * i) * 8) : u32x4{0u, 0u, 0u, 0u};
#pragma unroll
    for (int i = 0; i < 2; ++i) {
      const int kd0 = (c2 + 4 * i) * 8;
#pragma unroll
      for (int e = 0; e < 8; ++e) {
        const unsigned w = kv[i][e >> 1];
        const float kf = bf2f((u16)((e & 1) ? (w >> 16) : (w & 0xffffu)));
        const float bl = bc[63 * BCS + kd0 + e];
        kh[(kd0 + e) * LP + s] = f2bf(kf * __expf(bl - bc[s * BCS + kd0 + e]));
      }
    }
    if (tid < 64) ((float*)(p.ws + O_DEC))[(size_t)gi * 64 + tid] = __expf(bc[63 * BCS + tid]);
  }
  gla_load_vt(p, row0, Lc, h, vt);
  __syncthreads();
  u16* KVT = (u16*)(p.ws + O_KVT) + (size_t)gi * 8192;
#pragma unroll
  for (int mi = 0; mi < 2; ++mi)
#pragma unroll
    for (int n = 0; n < 4; ++n) {
      const int m = wid * 2 + mi;
      f32x4 a = lds_mm<2>(vt, LP, m * 16, kh, LP, n * 16, f32x4{0.f, 0.f, 0.f, 0.f});
#pragma unroll
      for (int j = 0; j < 4; ++j) KVT[(m * 16 + fq * 4 + j) * 64 + n * 16 + fr] = f2bf(a[j]);
    }
}

constexpr int G2_ITEMS = (PB * 4 + SBT * 4) * 32;
DI void gla2_item(const Params& p, int l, int it) {
  const int seq = it >> 5, e = (it & 31) * 256 + TID();
  const int vd = e >> 6, kd = e & 63;
  u16* KVT = (u16*)(p.ws + O_KVT);
  const float* DEC = (const float*)(p.ws + O_DEC);
  if (seq < PB * 4) {
    float S = 0.f;
    const int gi0 = seq * 128;
    for (int c0 = 0; c0 < 128; c0 += 32) {
      u16 kvv[32]; float dd[32];
#pragma unroll
      for (int c = 0; c < 32; ++c) { kvv[c] = KVT[(size_t)(gi0 + c0 + c) * 8192 + e]; dd[c] = DEC[(size_t)(gi0 + c0 + c) * 64 + kd]; }
#pragma unroll
      for (int c = 0; c < 32; ++c) { KVT[(size_t)(gi0 + c0 + c) * 8192 + e] = f2bf(S); S = dd[c] * S + bf2f(kvv[c]); }
    }
    p.out[GLA_P + ((size_t)l * PB * 4 + seq) * 8192 + kd * 128 + vd] = S;
  } else {
    const int s = seq - PB * 4, gi = PB * 4 * 128 + s;
    const float S0 = p.in[4][((size_t)l * SBT * 4 + s) * 8192 + kd * 128 + vd];
    u16* q = KVT + (size_t)gi * 8192 + e;
    const float kv = bf2f(*q);
    const float d = DEC[(size_t)gi * 64 + kd];
    *q = f2bf(S0);
    p.out[GLA_S + ((size_t)l * SBT * 4 + s) * 8192 + kd * 128 + vd] = d * S0 + kv;
  }
}

DI void gla3_item(const Params& p, int l, int gi, char* smem) {
  bool isS; int b, h, c, row0, Lc;
  gla_decode(gi, isS, b, h, c, row0, Lc);
  const int tid = TID(), lane = tid & 63, wid = tid >> 6, fr = lane & 15, fq = lane >> 4;
  float* bc = (float*)smem;
  u16* att = (u16*)smem;
  float* tot = (float*)(smem + 17408);
  u16* qt = (u16*)(smem + 18432);
  u16* kt_ = (u16*)(smem + 18432 + 9216);
  u16* vt = (u16*)(smem + 18432 + 2 * 9216);
  u16* st = (u16*)(smem + 18432 + 2 * 9216 + 18432);
  __syncthreads();
  gla_bcum(p, l, row0, Lc, h, bc, tot, (float*)qt);
  const u16* KVT = (const u16*)(p.ws + O_KVT) + (size_t)gi * 8192;
  {
    const int s = tid & 63, c2 = tid >> 6;
    const u16* GQ = (const u16*)(p.ws + O_GQ) + (size_t)(row0 + s) * 256 + h * 64;
    const u16* GK = (const u16*)(p.ws + O_GK) + (size_t)(row0 + s) * 256 + h * 64;
    u32x4 qv[2], kv[2], sv[4];
#pragma unroll
    for (int i = 0; i < 2; ++i) {
      qv[i] = (s < Lc) ? *(const u32x4*)(GQ + (c2 + 4 * i) * 8) : u32x4{0u, 0u, 0u, 0u};
      kv[i] = (s < Lc) ? *(const u32x4*)(GK + (c2 + 4 * i) * 8) : u32x4{0u, 0u, 0u, 0u};
    }
#pragma unroll
    for (int i = 0; i < 4; ++i) { const int id = tid + i * 256; sv[i] = *(const u32x4*)(KVT + (id >> 3) * 64 + (id & 7) * 8); }
#pragma unroll
    for (int i = 0; i < 2; ++i) {
      const int kd0 = (c2 + 4 * i) * 8;
      u32x4 qo, ko;
#pragma unroll
      for (int e2 = 0; e2 < 4; ++e2) {
        const float b0 = bc[s * BCS + kd0 + 2 * e2], b1 = bc[s * BCS + kd0 + 2 * e2 + 1];
        const float e0 = __expf(b0), e1 = __expf(b1);
        const float q0 = bf2f((u16)(qv[i][e2] & 0xffffu)) * e0, q1 = bf2f((u16)(qv[i][e2] >> 16)) * e1;
        const float k0 = bf2f((u16)(kv[i][e2] & 0xffffu)) / e0, k1 = bf2f((u16)(kv[i][e2] >> 16)) / e1;
        qo[e2] = pack2(q0, q1);
        ko[e2] = pack2(k0, k1);
      }
      *(u32x4*)(qt + s * LP + kd0) = qo;
      *(u32x4*)(kt_ + s * LP + kd0) = ko;
    }
#pragma unroll
    for (int i = 0; i < 4; ++i) { const int id = tid + i * 256; *(u32x4*)(st + (id >> 3) * LP + (id & 7) * 8) = sv[i]; }
  }
  gla_load_vt(p, row0, Lc, h, vt);
  __syncthreads();
  {
    f32x4 a[4];
#pragma unroll
    for (int n = 0; n < 4; ++n) a[n] = lds_mm<2>(qt, LP, wid * 16, kt_, LP, n * 16, f32x4{0.f, 0.f, 0.f, 0.f});
#pragma unroll
    for (int n = 0; n < 4; ++n)
#pragma unroll
      for (int j = 0; j < 4; ++j) {
        const int t = wid * 16 + fq * 4 + j, s = n * 16 + fr;
        att[t * LP + s] = f2bf(t >= s ? a[n][j] : 0.f);
      }
  }
  __syncthreads();
  f32x4 o[8];
#pragma unroll
  for (int n = 0; n < 8; ++n) {
    f32x4 a = lds_mm<2>(att, LP, wid * 16, vt, LP, n * 16, f32x4{0.f, 0.f, 0.f, 0.f});
    o[n] = lds_mm<2>(qt, LP, wid * 16, st, LP, n * 16, a);
  }
  const float* gn = p.in[14] + (size_t)l * 128;
  const u16* GR = (const u16*)(p.ws + O_GR);
  u16* OG = (u16*)(p.ws + O_OG);
  float gnv[8];
#pragma unroll
  for (int n = 0; n < 8; ++n) gnv[n] = gn[n * 16 + fr];
#pragma unroll
  for (int j = 0; j < 4; ++j) {
    float ss = 0.f;
#pragma unroll
    for (int n = 0; n < 8; ++n) ss += o[n][j] * o[n][j];
    ss += __shfl_xor(ss, 1); ss += __shfl_xor(ss, 2); ss += __shfl_xor(ss, 4); ss += __shfl_xor(ss, 8);
    const float rs = rsqrtf(ss * (1.f / 128.f) + EPS);
    const int t = wid * 16 + fq * 4 + j;
    if (t < Lc) {
      const size_t ro = (size_t)(row0 + t) * 512 + h * 128;
      u16 grv[8];
#pragma unroll
      for (int n = 0; n < 8; ++n) grv[n] = GR[ro + n * 16 + fr];
#pragma unroll
      for (int n = 0; n < 8; ++n) {
        const float gr = bf2f(grv[n]);
        OG[ro + n * 16 + fr] = f2bf(o[n][j] * rs * gnv[n] * gr * sigmoidf_(gr));
      }
    }
  }
}

constexpr int L1_ITEMS = NLC * 8;
DI void lru_decode(int ci, bool& isS, int& b, int& row0, int& Lc, int& t0) {
  if (ci < MP / 64) { isS = false; b = ci >> 7; t0 = (ci & 127) * 64; row0 = ci * 64; Lc = 64; }
  else { isS = true; b = ci - MP / 64; t0 = 0; row0 = MP + b * 32; Lc = 32; }
}
DI void lru1_item(const Params& p, int l, int it, char* smem) {
  const int ci = it >> 3, nb = it & 7;
  bool isS; int b, row0, Lc, t0;
  lru_decode(ci, isS, b, row0, Lc, t0);
  const int tid = TID(), lane = tid & 63, wid = tid >> 6, fr = lane & 15, fq = lane >> 4;
  u16* xcs = (u16*)smem;
  u16* was = (u16*)(smem + 9216);
  u16* wxs = (u16*)(smem + 2 * 9216);
  float* as_ = (float*)(smem + 3 * 9216);
  float* us_ = (float*)(smem + 3 * 9216 + 16384);
  float* segP = (float*)(smem + 3 * 9216 + 32768);
  float* segH = (float*)(smem + 3 * 9216 + 32768 + 1024);
  const float* LX = (const float*)(p.ws + O_LX);
  const u16* Wl = (const u16*)(p.ws + O_WT) + (size_t)l * W_LAYER;
  const int i = tid & 63, tq = tid >> 6, ch = nb * 64 + i;
  __syncthreads();
  {
    const float* cw = p.in[15] + (size_t)l * 4 * 512 + ch;
    const float w0 = cw[0], w1 = cw[512], w2 = cw[1024], w3 = cw[1536], cb = p.in[16][(size_t)l * 512 + ch];
    const float* buf = isS ? p.in[5] + ((size_t)l * SBT + b) * 3 * 512 + ch : nullptr;
    float x[19];
#pragma unroll
    for (int j = 0; j < 19; ++j) {
      const int tl = tq * 16 - 3 + j;
      const int tt = t0 + tl;
      float v = 0.f;
      if (tl < Lc) {
        if (tt >= 0) v = LX[(size_t)(row0 + tl) * 512 + ch];
        else if (isS) v = buf[(3 + tt) * 512];
      }
      x[j] = v;
    }
#pragma unroll
    for (int k = 0; k < 16; ++k) {
      const int t = tq * 16 + k;
      const float xv = (t < Lc) ? cb + w0 * x[k] + w1 * x[k + 1] + w2 * x[k + 2] + w3 * x[k + 3] : 0.f;
      xcs[t * LP + i] = f2bf(xv);
    }
#pragma unroll
    for (int k = 0; k < 2; ++k) {
      const int id = tid + k * 256, r = id >> 3, c8 = id & 7;
      *(uint4*)(was + r * LP + c8 * 8) = *(const uint4*)(Wl + W_WA + nb * 4096 + r * 64 + c8 * 8);
      *(uint4*)(wxs + r * LP + c8 * 8) = *(const uint4*)(Wl + W_WX + nb * 4096 + r * 64 + c8 * 8);
    }
    const int T = isS ? STT : PT;
    if (t0 + Lc == T && tid < 192) {
      const int k = tid >> 6;
      const float v = LX[(size_t)(row0 + Lc - 3 + k) * 512 + ch];
      if (isS) p.out[LC_S + (((size_t)l * SBT + b) * 3 + k) * 512 + ch] = v;
      else p.out[LC_P + (((size_t)l * PB + b) * 3 + k) * 512 + ch] = v;
    }
  }
  __syncthreads();
  {
    const float* ba = p.in[18] + (size_t)l * 512 + nb * 64;
    const float* bx = p.in[20] + (size_t)l * 512 + nb * 64;
    const float* lm = p.in[21] + (size_t)l * 512 + nb * 64;
#pragma unroll
    for (int n = 0; n < 4; ++n) {
      f32x4 r = lds_mm<2>(xcs, LP, wid * 16, was, LP, n * 16, f32x4{0.f, 0.f, 0.f, 0.f});
      f32x4 g = lds_mm<2>(xcs, LP, wid * 16, wxs, LP, n * 16, f32x4{0.f, 0.f, 0.f, 0.f});
      const int j = n * 16 + fr;
      const float sp = softplusf_(-lm[j]), bav = ba[j], bxv = bx[j];
#pragma unroll
      for (int q = 0; q < 4; ++q) {
        const int t = wid * 16 + fq * 4 + q;
        const float rr = sigmoidf_(r[q] + bav), ii = sigmoidf_(g[q] + bxv);
        const float la = -8.f * rr * sp;
        const float a = __expf(la);
        const float x2 = 2.f * la;
        const float om = (x2 > -0.01f) ? -x2 * (1.f + x2 * (0.5f + x2 * (1.f / 6.f))) : 1.f - __expf(x2);
        const float u = sqrtf(om) * ii * bf2f(xcs[t * LP + j]);
        as_[t * 64 + j] = a;
        us_[t * 64 + j] = u;
      }
    }
  }
  __syncthreads();
  {
    float av[16], uv[16];
#pragma unroll
    for (int k = 0; k < 16; ++k) { av[k] = as_[(tq * 16 + k) * 64 + i]; uv[k] = us_[(tq * 16 + k) * 64 + i]; }
    float P = 1.f, hh = 0.f;
#pragma unroll
    for (int k = 0; k < 16; ++k) { P *= av[k]; hh = av[k] * hh + uv[k]; }
    segP[tq * 64 + i] = P; segH[tq * 64 + i] = hh;
    __syncthreads();
    float Pin = 1.f, hin = 0.f;
    for (int g = 0; g < tq; ++g) { const float pg = segP[g * 64 + i], hg = segH[g * 64 + i]; hin = pg * hin + hg; Pin *= pg; }
    u16* HL = (u16*)(p.ws + O_HL);
    u16* PPp = (u16*)(p.ws + O_PP);
    P = Pin; hh = hin;
#pragma unroll
    for (int k = 0; k < 16; ++k) {
      const int t = tq * 16 + k;
      P *= av[k]; hh = av[k] * hh + uv[k];
      if (t < Lc) {
        HL[(size_t)(row0 + t) * 512 + ch] = f2bf(hh);
        PPp[(size_t)(row0 + t) * 512 + ch] = f2bf(P);
      }
    }
    if (tq * 16 + 16 == Lc) {
      ((float*)(p.ws + O_CA))[(size_t)ci * 512 + ch] = P;
      ((float*)(p.ws + O_CH))[(size_t)ci * 512 + ch] = hh;
    }
  }
}
constexpr int L2_ITEMS = 8 + 32;
DI void lru2_item(const Params& p, int l, int it) {
  const float* CA = (const float*)(p.ws + O_CA);
  const float* CH = (const float*)(p.ws + O_CH);
  float* HS = (float*)(p.ws + O_HS);
  if (it < 8) {
    const int e = it * 256 + TID(), b = e >> 9, ch = e & 511;
    float hh = 0.f;
    for (int c0 = 0; c0 < 128; c0 += 16) {
      float ca[16], chv[16];
#pragma unroll
      for (int c = 0; c < 16; ++c) { const size_t o = (size_t)(b * 128 + c0 + c) * 512 + ch; ca[c] = CA[o]; chv[c] = CH[o]; }
#pragma unroll
      for (int c = 0; c < 16; ++c) { const size_t o = (size_t)(b * 128 + c0 + c) * 512 + ch; HS[o] = hh; hh = ca[c] * hh + chv[c]; }
    }
    p.out[LH_P + ((size_t)l * PB + b) * 512 + ch] = hh;
  } else {
    const int e = (it - 8) * 256 + TID(), b = e >> 9, ch = e & 511;
    const float h0 = p.in[6][((size_t)l * SBT + b) * 512 + ch];
    const size_t o = (size_t)(MP / 64 + b) * 512 + ch;
    HS[o] = h0;
    p.out[LH_S + ((size_t)l * SBT + b) * 512 + ch] = CA[o] * h0 + CH[o];
  }
}
constexpr int L3_ITEMS = MT / 8;
DI void lru3_item(const Params& p, int it) {
  const u16* HL = (const u16*)(p.ws + O_HL);
  const u16* PPp = (const u16*)(p.ws + O_PP);
  const u16* LG = (const u16*)(p.ws + O_LG);
  const float* HS = (const float*)(p.ws + O_HS);
  u16* OL = (u16*)(p.ws + O_OL);
#pragma unroll
  for (int i = 0; i < 4; ++i) {
    const int id = TID() + i * 256;
    const int row = it * 8 + (id >> 7), c4 = (id & 127) * 4;
    const int ci = row < MP ? (row >> 6) : MP / 64 + ((row - MP) >> 5);
    const size_t o = (size_t)row * 512 + c4;
    const uint2 hl = *(const uint2*)(HL + o), pp = *(const uint2*)(PPp + o), lg = *(const uint2*)(LG + o);
    const float4 hs = *(const float4*)(HS + (size_t)ci * 512 + c4);
    float y0 = (bf2f(hl.x & 0xffff) + bf2f(pp.x & 0xffff) * hs.x) * gelu_tanh(bf2f(lg.x & 0xffff));
    float y1 = (bf2f(hl.x >> 16) + bf2f(pp.x >> 16) * hs.y) * gelu_tanh(bf2f(lg.x >> 16));
    float y2 = (bf2f(hl.y & 0xffff) + bf2f(pp.y & 0xffff) * hs.z) * gelu_tanh(bf2f(lg.y & 0xffff));
    float y3 = (bf2f(hl.y >> 16) + bf2f(pp.y >> 16) * hs.w) * gelu_tanh(bf2f(lg.y >> 16));
    *(uint2*)(OL + o) = uint2{pack2(y0, y1), pack2(y2, y3)};
  }
}

DI void ybr_tile(const Params& p, int l, int mt, int nt, char* smem) {
  const int row0 = mt * 256, col0 = nt * 256, br = nt >> 2;
  const u16* W = (const u16*)(p.ws + O_WT) + (size_t)l * W_LAYER + W_BR + (size_t)br * 1024 * 512 + (size_t)((nt & 3) * 256) * 512;
  const u16* O = (const u16*)(p.ws + (br == 0 ? O_OA : (br == 1 ? O_OG : O_OL))) + (size_t)row0 * 512;
  f32x4 acc[8][4];
  zero_acc8(acc);
  gemm512(O, 512, W, 512, 512, acc, smem);
  tile_out_bf16<false>(acc, (u16*)(p.ws + O_YP) + (size_t)row0 * 3072 + col0, 3072, smem, 1.f, 0, nullptr);
}
DI void gate_tile(const Params& p, int l, int mt, int nt, char* smem) {
  const int row0 = mt * 256, col0 = nt * 256;
  const u16* W = (const u16*)(p.ws + O_WT) + (size_t)l * W_LAYER + W_MG + (size_t)col0 * LDK;
  f32x4 acc[8][4];
  zero_acc8(acc);
  gemm512((const u16*)(p.ws + O_XN) + (size_t)row0 * LDK, LDK, W, LDK, 1024, acc, smem);
  EPI_IDS;
  u16* Y = (u16*)(p.ws + O_YP) + (size_t)row0 * 3072 + col0;
  const float* bm = p.in[26] + (size_t)l * 3072 + col0 + wc * 64 + fr;
  img_load_bf16(Y, 3072, smem, 256, 0);
  img_barrier();
  u16* img = (u16*)smem + (wr * 128 + fq * 4) * IMG_LD + wc * 64 + fr;
#pragma unroll
  for (int n = 0; n < 4; ++n) {
    const float bv = bm[n * 16];
#pragma unroll
    for (int m = 0; m < 8; ++m)
#pragma unroll
      for (int j = 0; j < 4; ++j) {
        u16* q = img + (m * 16 + j) * IMG_LD + n * 16;
        *q = f2bf(sigmoidf_(acc[m][n][j] + bv) * bf2f(*q));
      }
  }
  img_barrier();
  img_store_bf16(Y, 3072, smem, 0);
}
DI void resid_tile(const Params& p, const u16* A, int ldk, const u16* W, int mt, int nt, int k0, int klen, bool atomic, const float* xsrc, char* smem) {
  const int row0 = mt * 256, col0 = nt * 256;
  f32x4 acc[8][4];
  zero_acc8(acc);
  gemm512(A + (size_t)row0 * ldk + k0, ldk, W + (size_t)col0 * ldk + k0, ldk, klen, acc, smem);
  if (!atomic) { tile_out_f32<true, false>(acc, p.out + (size_t)row0 * 1024 + col0, 1024, smem, 0, nullptr, xsrc + (size_t)row0 * 1024 + col0); return; }
  EPI_IDS;
#pragma unroll
  for (int m = 0; m < 8; ++m) {
    asm volatile("" ::: "memory");
#pragma unroll
    for (int n = 0; n < 4; ++n)
#pragma unroll
      for (int j = 0; j < 4; ++j) {
        const int row = row0 + wr * 128 + m * 16 + fq * 4 + j, col = col0 + wc * 64 + n * 16 + fr;
        float* q = p.out + (size_t)row * 1024 + col;
        if (atomic) unsafeAtomicAdd(q, acc[m][n][j]); else *q += acc[m][n][j];
      }
  }
}
DI void resid_phase(const Params& p, const u16* A, int ldk, const u16* W, int B, int G, const float* xsrc, char* smem) {
  const int ns = ldk / 256;
  int k = 0, u = B;
  while (true) {
    int mt, nt, k0 = 0, kl = ldk;
    bool at = false;
    if (xcd_tile(B, G, k, 128, 4, mt, nt)) { ++k; }
    else if (u < 8 * ns) { const int t = u / ns, sl = u - t * ns; mt = 128 + (t >> 2); nt = t & 3; k0 = sl * 256; kl = 256; at = true; u += G; }
    else break;
    asm volatile("" : "+s"(kl));
    resid_tile(p, A, ldk, W, mt, nt, k0, kl, at, xsrc, smem);
  }
}

DI void ffgate_tile(const Params& p, int l, int mt, int nt, char* smem) {
  const int row0 = mt * 256, col0 = nt * 256;
  const u16* W = (const u16*)(p.ws + O_WT) + (size_t)l * W_LAYER + W_FG;
  f32x4 acc[8][4];
  zero_acc8(acc);
  gemm512((const u16*)(p.ws + O_XN) + (size_t)row0 * LDK, LDK, W + (size_t)col0 * LDK, LDK, 1024, acc, smem);
  if (mt < 128) {
    EPI_IDS;
    tile_out_bf16<false>(acc, (u16*)(p.ws + O_GU) + (size_t)row0 * DFF + col0, DFF, smem, 1.f, 0, nullptr);
    if (((row0 + 256) & 8191) == 0 && wr == 1 && fq == 3) {
      const int b = row0 >> 13;
#pragma unroll
      for (int n = 0; n < 4; ++n) {
        const int col = col0 + wc * 64 + n * 16 + fr;
        p.out[FC_P + (((size_t)l * PB + b) * 2 + 0) * DFF + col] = acc[7][n][2];
        p.out[FC_P + (((size_t)l * PB + b) * 2 + 1) * DFF + col] = acc[7][n][3];
      }
    }
    return;
  }
  EPI_IDS;
  u16* GU = (u16*)(p.ws + O_GU);
  const bool isS = row0 >= MP;
#pragma unroll
  for (int m = 0; m < 8; ++m) {
    asm volatile("" ::: "memory");
#pragma unroll
    for (int n = 0; n < 4; ++n)
#pragma unroll
      for (int j = 0; j < 4; ++j) {
        const int row = row0 + wr * 128 + m * 16 + fq * 4 + j, col = col0 + wc * 64 + n * 16 + fr;
        const float v = acc[m][n][j];
        GU[(size_t)row * DFF + col] = f2bf(v);
        if (isS) {
          const int rs = row - MP, b = rs >> 5, t = rs & 31;
          if (t >= STT - 2) p.out[FC_S + (((size_t)l * SBT + b) * 2 + (t - (STT - 2))) * DFF + col] = v;
        } else {
          const int b = row >> 13, t = row & 8191;
          if (t >= PT - 2) p.out[FC_P + (((size_t)l * PB + b) * 2 + (t - (PT - 2))) * DFF + col] = v;
        }
      }
  }
}
DI void ffup_tile(const Params& p, int l, int mt, int nt, char* smem) {
  const int row0 = mt * 256, col0 = nt * 256;
  const u16* W = (const u16*)(p.ws + O_WT) + (size_t)l * W_LAYER + W_FU;
  f32x4 acc[8][4];
  zero_acc8(acc);
  gemm512((const u16*)(p.ws + O_XN) + (size_t)row0 * LDK, LDK, W + (size_t)col0 * LDK, LDK, 1024, acc, smem);
  if (mt < 128) {
    EPI_IDS;
    const u16* GUt = (const u16*)(p.ws + O_GU) + (size_t)row0 * DFF + col0;
    if (row0 >= 2) img_load_bf16(GUt - 2 * DFF, DFF, smem, 258, 0); else img_load_bf16(GUt, DFF, smem, 256, 2);
    img_barrier();
    const u16* img = (const u16*)smem + (wr * 128 + fq * 4) * IMG_LD + wc * 64 + fr;
#pragma unroll
    for (int n = 0; n < 4; ++n) {
      const int col = col0 + wc * 64 + n * 16 + fr;
      const float* cw = p.in[30] + (size_t)l * 3 * DFF + col;
      const float w0 = cw[0], w1 = cw[DFF], w2 = cw[2 * DFF], cb = p.in[31][(size_t)l * DFF + col];
#pragma unroll
      for (int m = 0; m < 8; ++m) {
        if ((m & 1) == 0) asm volatile("" ::: "memory");
        const int t = (row0 + wr * 128 + m * 16 + fq * 4) & 8191;
        float g[6];
#pragma unroll
        for (int d = 0; d < 6; ++d) { const float gv = bf2f(img[(m * 16 + d) * IMG_LD + n * 16]); g[d] = (d >= 2 || t - 2 + d >= 0) ? gv : 0.f; }
#pragma unroll
        for (int j = 0; j < 4; ++j) acc[m][n][j] *= gelu_tanh(cb + w0 * g[j] + w1 * g[j + 1] + w2 * g[j + 2]);
      }
    }
    img_barrier();
    img_put_bf16<false>(acc, smem, 2, 1.f, 0, nullptr);
    img_barrier();
    img_store_bf16((u16*)(p.ws + O_FF) + (size_t)row0 * DFF + col0, DFF, smem, 2);
    return;
  }
  EPI_IDS;
  const u16* GU = (const u16*)(p.ws + O_GU);
  u16* FF = (u16*)(p.ws + O_FF);
  const bool isS = row0 >= MP;
  const int rowq = row0 + wr * 128 + fq * 4;
  const unsigned gbase = (unsigned)rowq * (unsigned)DFF + (unsigned)(col0 + wc * 64 + fr);
#pragma unroll
  for (int n = 0; n < 4; ++n) {
    const int col = col0 + wc * 64 + n * 16 + fr;
    const float* cw = p.in[30] + (size_t)l * 3 * DFF + col;
    const float w0 = cw[0], w1 = cw[DFF], w2 = cw[2 * DFF], cb = p.in[31][(size_t)l * DFF + col];
#pragma unroll
    for (int mh = 0; mh < 2; ++mh) {
      asm volatile("" ::: "memory");
      float g[4][6];
#pragma unroll
      for (int m = 0; m < 4; ++m) {
        const int rowb = rowq + (mh * 4 + m) * 16;
        int b, t;
        if (isS) { int rs = rowb - MP; b = rs >> 5; t = rs & 31; } else { b = rowb >> 13; t = rowb & 8191; }
#pragma unroll
        for (int d = 0; d < 6; ++d) {
          const int tt = t - 2 + d;
          if (tt >= 0) g[m][d] = bf2f(GU[gbase + (unsigned)((((mh * 4 + m) * 16 + d) * DFF) + n * 16) - 2u * (unsigned)DFF]);
          else g[m][d] = isS ? p.in[7][(((size_t)l * SBT + b) * 2 + (2 + tt)) * DFF + col] : 0.f;
        }
      }
#pragma unroll
      for (int m = 0; m < 4; ++m)
#pragma unroll
        for (int j = 0; j < 4; ++j) {
          const float gc = cb + w0 * g[m][j] + w1 * g[m][j + 1] + w2 * g[m][j + 2];
          FF[gbase + (unsigned)((((mh * 4 + m) * 16 + j) * DFF) + n * 16)] = f2bf(gelu_tanh(gc) * acc[mh * 4 + m][n][j]);
        }
    }
  }
}

DI void norm_phase(const Params& p, int l, int mode, int B, int G, char* smem) {
  const int tid = TID512(), lane = tid & 63, wid = tid >> 6;
  const float* gamma = mode == 0 ? p.in[8] + (size_t)l * 1024 : (mode == 1 ? p.in[28] + (size_t)l * 1024 : p.in[34]);
  float* wga = (float*)smem;
  if (mode == 0) {
    __syncthreads();
    const float* src = p.in[9] + (size_t)l * 1024 * PW + 3072;
#pragma unroll
    for (int i = 0; i < 8; ++i) {
      const int id = tid + i * 512, k = id >> 2, part = id & 3;
      ((float4*)wga)[(((k >> 8) * 4 + (k & 3)) * 4 + part) * 64 + ((k >> 2) & 63)] = *(const float4*)(src + (size_t)k * PW + part * 4);
    }
    __syncthreads();
  }
  float4 g[4];
#pragma unroll
  for (int i = 0; i < 4; ++i) g[i] = *(const float4*)(gamma + i * 256 + lane * 4);
  for (int row = B * 8 + wid; row < MT; row += G * 8) {
    float* X = p.out + (size_t)row * 1024;
    const float* Xr = (mode == 0 && l == 0 && row < MP) ? p.in[0] + (size_t)row * 1024 : X;
    float4 v[4];
    float ss = 0.f;
#pragma unroll
    for (int i = 0; i < 4; ++i) { { const f32x4 t4 = __builtin_nontemporal_load((const f32x4*)(Xr + i * 256 + lane * 4)); v[i] = float4{t4[0], t4[1], t4[2], t4[3]}; } ss += v[i].x * v[i].x + v[i].y * v[i].y + v[i].z * v[i].z + v[i].w * v[i].w; }
    ss = wave_sum(ss);
    const float rs = rsqrtf(ss * (1.f / 1024.f) + EPS);
    u16* XN = (u16*)(p.ws + O_XN) + (size_t)row * LDK;
#pragma unroll
    for (int i = 0; i < 4; ++i) {
      v[i] = float4{v[i].x * rs * g[i].x, v[i].y * rs * g[i].y, v[i].z * rs * g[i].z, v[i].w * rs * g[i].w};
      if (mode == 2) *(float4*)(X + i * 256 + lane * 4) = v[i];
      else *(uint2*)(XN + i * 256 + lane * 4) = uint2{pack2(v[i].x, v[i].y), pack2(v[i].z, v[i].w)};
    }
    if (mode == 0) {
      float ga[16];
#pragma unroll
      for (int r = 0; r < 16; ++r) ga[r] = 0.f;
#pragma unroll
      for (int i = 0; i < 4; ++i) {
        const float xv[4] = {v[i].x, v[i].y, v[i].z, v[i].w};
#pragma unroll
        for (int e = 0; e < 4; ++e) {
          asm volatile("" ::: "memory");
#pragma unroll
          for (int q = 0; q < 4; ++q) {
            const float4 w = ((const float4*)wga)[((i * 4 + e) * 4 + q) * 64 + lane];
            ga[q * 4 + 0] += xv[e] * w.x; ga[q * 4 + 1] += xv[e] * w.y; ga[q * 4 + 2] += xv[e] * w.z; ga[q * 4 + 3] += xv[e] * w.w;
          }
        }
      }
      float mine = 0.f;
#pragma unroll
      for (int r = 0; r < 16; ++r) { const float s = wave_sum(ga[r]); if (lane == r) mine = s; }
      if (lane < 16) ((float*)(p.ws + O_GA))[(size_t)row * 16 + lane] = mine;
    }
  }
}

#define XB_TMO      128
#define XB_XCNT(j)  (256  + 64 * (j))
#define XB_XSUB(j)  (1280 + 64 * (j))
#define XB_XGEN(j)  (2304 + 64 * (j))
#define XB_TOP      3328
#define XB_TOPGEN   3392
#define XCD_BAR_WORDS 3456
#define XB_SPIN_CAP (1u << 18)
#define LAS __attribute__((address_space(3)))

__device__ __forceinline__ unsigned xb_ld(unsigned* p)              { return __hip_atomic_load(p, __ATOMIC_RELAXED, __HIP_MEMORY_SCOPE_AGENT); }
__device__ __forceinline__ unsigned xb_add(unsigned* p, unsigned v) { return __hip_atomic_fetch_add(p, v, __ATOMIC_RELAXED, __HIP_MEMORY_SCOPE_AGENT); }
__device__ __forceinline__ unsigned xb_xcc_id() { return (unsigned)__builtin_amdgcn_s_getreg((3 << 11) | 20) & 0xFu; }
#define XB_SPIN(cond, bar) do { unsigned _sp = 0; while (cond) { __builtin_amdgcn_s_sleep(1); \
    if ((++_sp & 255u) == 0u) { if (xb_ld(&(bar)[XB_TMO])) break; if (_sp > XB_SPIN_CAP) { atomicAdd(&(bar)[XB_TMO], 1u); break; } } } } while (0)

struct XcdBarrier {
    unsigned* bar; unsigned x;
    volatile LAS unsigned* st;
};

__device__ __forceinline__ XcdBarrier xcd_barrier_post(unsigned* bar, volatile LAS unsigned* st) {
    XcdBarrier b; b.bar = bar; b.x = xb_xcc_id(); b.st = st;
    if (threadIdx.x == 0) (void)xb_add(&bar[XB_XCNT(b.x)], 1u);
    return b;
}
__device__ __forceinline__ void xcd_barrier_complete(unsigned* bar, unsigned x, unsigned& nloc, unsigned& nx) {
    const unsigned G = gridDim.x * gridDim.y * gridDim.z;
    unsigned sum, cnt, mine, sp = 0u;
    for (;;) {
        sum = 0u; cnt = 0u; mine = 0u;
#pragma unroll
        for (unsigned j = 0; j < 16; ++j) { const unsigned c = xb_ld(&bar[XB_XCNT(j)]); sum += c; cnt += (c > 0u) ? 1u : 0u; mine = (j == x) ? c : mine; }
        if (sum == G) break;
        __builtin_amdgcn_s_sleep(1);
        if ((++sp & 255u) == 0u) { if (xb_ld(&bar[XB_TMO])) break; if (sp > XB_SPIN_CAP) { atomicAdd(&bar[XB_TMO], 1u); break; } }
    }
    nloc = mine > 0u ? mine : 1u; nx = cnt > 0u ? cnt : 1u;
}

__device__ __forceinline__ void xcd_barrier(const XcdBarrier& b) {
    asm volatile("s_waitcnt vmcnt(0)" ::: "memory");
    __syncthreads();
    if (threadIdx.x == 0) {
        unsigned* bar = b.bar;
        __builtin_amdgcn_s_waitcnt(0);
        unsigned nloc = b.st[0], nx = b.st[1];
        if (nloc == 0u) { xcd_barrier_complete(bar, b.x, nloc, nx); b.st[0] = nloc; b.st[1] = nx; }
        const unsigned old = xb_add(&bar[XB_XSUB(b.x)], 1u);
        const unsigned gen = old / nloc;
        if (old + 1u == (gen + 1u) * nloc) {
            __builtin_amdgcn_fence(__ATOMIC_RELEASE, "agent");
            asm volatile("s_waitcnt vmcnt(0)" ::: "memory");
            const unsigned og = xb_add(&bar[XB_TOP], 1u);
            const unsigned tg = og / nx;
            if (og + 1u == (tg + 1u) * nx) xb_add(&bar[XB_TOPGEN], 1u);
            else XB_SPIN(xb_ld(&bar[XB_TOPGEN]) == tg, bar);
            __builtin_amdgcn_fence(__ATOMIC_ACQUIRE, "agent");
            xb_add(&bar[XB_XGEN(b.x)], 1u);
            asm volatile("s_waitcnt vmcnt(0)" ::: "memory");
        } else {
            XB_SPIN(xb_ld(&bar[XB_XGEN(b.x)]) == gen, bar);
            __builtin_amdgcn_fence(__ATOMIC_ACQUIRE, "agent");
            asm volatile("s_waitcnt vmcnt(0)" ::: "memory");
        }
    }
    __syncthreads();
}


#ifndef ONLY
#define ONLY -1
#endif
constexpr int HALF_LDS = 73728;
constexpr int SMEM_BYTES = 2 * HALF_LDS;
#define VB() (2 * B + (TID512() >> 8))
#define HS() (smem + (TID512() >> 8) * HALF_LDS)
__global__ void __launch_bounds__(512, 2) mega(Params p) {
  cg::grid_group grid = cg::this_grid();
  extern __shared__ __attribute__((aligned(16))) char smem[];
  const int G = gridDim.x, B = blockIdx.x;
  __shared__ __attribute__((aligned(16))) unsigned xb_words[4];
  if (threadIdx.x < 4) xb_words[threadIdx.x] = 0u;
  __syncthreads();
  const XcdBarrier xb = xcd_barrier_post((unsigned*)(p.ws + O_BAR), (volatile LAS unsigned*)xb_words);
  const int vG = 2 * G;
  if (ONLY < 0 || ONLY == 0) for (int it = VB(); it < PREP_ITEMS; it += vG) prep_item(p, it, HS());
  grid.sync();
  for (int l = 0; l < NL; ++l) {
    const u16* W = (const u16*)(p.ws + O_WT) + (size_t)l * W_LAYER;
    if (ONLY < 0 || ONLY == 1) norm_phase(p, l, 0, B, G, smem);
    xcd_barrier(xb);
    if (ONLY < 0 || ONLY == 2) { int mt, nt; for (int k = 0; xcd_tile(B, G, k, 130, 16, mt, nt); ++k) projin_tile(p, l, mt, nt, smem); for (int it = VB(); it < PB_KC + PB_VC; it += vG) cache_conv_item(p, l, it, HS()); }
    xcd_barrier(xb);
    if (ONLY < 0 || ONLY == 3) {
      for (int k = 0; k < (G == 256 ? 5 : (1088 + G - 1) / G); ++k) {
        bool isS = false; int bh = 0, cp = 0; bool have = true;
        if (G == 256) {
          const int q = B >> 4; bh = B & 15;
          if (k == 0) cp = 63 - q; else if (k == 1) cp = 32 + q; else if (k == 2) cp = 31 - q;
          else if (k == 3) { if (q <= 11) cp = q + 4; else { isS = true; bh = (q - 12) * 16 + (B & 15); } }
          else { if (q >= 12) cp = q - 12; else have = false; }
        } else {
          const int it = B + k * G;
          if (it >= 1088) have = false; else if (it < 1024) { cp = it >> 4; bh = it & 15; } else { isS = true; bh = it - 1024; }
        }
        if (have) attn_item(p, l, isS, isS ? (bh >> 2) : (bh >> 2), bh & 3, cp, smem);
      }
    }
    if (ONLY < 0 || ONLY == 13) for (int it = VB(); it < NGI; it += vG) gla1_item(p, l, it, HS());
    if (ONLY < 0 || ONLY == 14) for (int it = VB(); it < L1_ITEMS; it += vG) lru1_item(p, l, it, HS());
    xcd_barrier(xb);
    if (ONLY < 0 || ONLY == 4) for (int it = VB(); it < G2_ITEMS + L2_ITEMS; it += vG) { if (it < G2_ITEMS) gla2_item(p, l, it); else lru2_item(p, l, it - G2_ITEMS); }
    xcd_barrier(xb);
    if (ONLY < 0 || ONLY == 5) { for (int it = VB(); it < NGI; it += vG) gla3_item(p, l, it, HS()); for (int it = VB(); it < L3_ITEMS; it += vG) lru3_item(p, it); }
    xcd_barrier(xb);
    if (ONLY < 0 || ONLY == 6) { int mt, nt; for (int k = 0; xcd_tile(B, G, k, 130, 12, mt, nt); ++k) ybr_tile(p, l, mt, nt, smem); }
    xcd_barrier(xb);
    if (ONLY < 0 || ONLY == 7) { int mt, nt; for (int k = 0; xcd_tile(B, G, k, 130, 12, mt, nt); ++k) gate_tile(p, l, mt, nt, smem); }
    xcd_barrier(xb);
    if (ONLY < 0 || ONLY == 8) resid_phase(p, (const u16*)(p.ws + O_YP), 3072, W + W_OUT, B, G, l == 0 ? p.in[0] : p.out, smem);
    xcd_barrier(xb);
    if (ONLY < 0 || ONLY == 9) norm_phase(p, l, 1, B, G, smem);
    xcd_barrier(xb);
    if (ONLY < 0 || ONLY == 10) { int mt, nt; for (int k = 0; xcd_tile(B, G, k, 130, 11, mt, nt); ++k) ffgate_tile(p, l, mt, nt, smem); }
    xcd_barrier(xb);
    if (ONLY < 0 || ONLY == 11) { int mt, nt; for (int k = 0; xcd_tile(B, G, k, 130, 11, mt, nt); ++k) ffup_tile(p, l, mt, nt, smem); }
    xcd_barrier(xb);
    if (ONLY < 0 || ONLY == 12) resid_phase(p, (const u16*)(p.ws + O_FF), DFF, W + W_FD, B, G, p.out, smem);
    xcd_barrier(xb);
  }
  if (ONLY < 0 || ONLY == 15) norm_phase(p, 0, 2, B, G, smem);
}

extern "C" void kernel_launch(void* const* d_in, const int* in_sizes, int n_in, void* d_out, int out_size, void* d_ws, size_t ws_size,
                              hipStream_t stream) {
  static int grid_blocks = 0;
  if (!grid_blocks) {
    int dev = 0, cus = 0, per = 0;
    (void)hipGetDevice(&dev);
    (void)hipDeviceGetAttribute(&cus, hipDeviceAttributeMultiprocessorCount, dev);
    (void)hipFuncSetAttribute((const void*)mega, hipFuncAttributeMaxDynamicSharedMemorySize, SMEM_BYTES);
    (void)hipOccupancyMaxActiveBlocksPerMultiprocessor(&per, mega, 512, SMEM_BYTES);
    if (per < 1) per = 1;
    grid_blocks = cus;
  }
  if (ws_size < WS_NEED) fprintf(stderr, "workspace too small: %zu < %zu\n", ws_size, (size_t)WS_NEED);
  Params p{};
  for (int i = 0; i < 35; ++i) p.in[i] = (const float*)d_in[i];
  p.out = (float*)d_out;
  p.ws = (char*)d_ws;
  (void)hipMemsetAsync((char*)d_ws + O_BAR, 0, XCD_BAR_WORDS * sizeof(unsigned), stream);
  void* args[] = {&p};
  hipError_t e = hipLaunchCooperativeKernel((void*)mega, dim3(grid_blocks), dim3(512), args, SMEM_BYTES, stream);
  if (e != hipSuccess) fprintf(stderr, "cooperative launch failed: %s (grid %d)\n", hipGetErrorString(e), grid_blocks);
}
```
